# Optimizing an MI355X kernel written in HIP

```python
import math
import jax, jax.numpy as jnp
from jax import lax
import numpy as np

D_MODEL = 1024
BATCH = 4
SEQ = 8192
DEPTH = 4
DEC_BATCH = 32
DEC_SEQ = 2048
PAST_LEN = 128

GRID_W = 64
HEAD_DIM = 64
N_Q_HEADS = 8
N_KV_HEADS = 2
Q_PER_KV = N_Q_HEADS // N_KV_HEADS
Q_WIDTH = N_Q_HEADS * HEAD_DIM
KV_WIDTH = N_KV_HEADS * HEAD_DIM
SG_GROUPS = 8
SG_GROUP_DIM = 64
SG_WIDTH = SG_GROUPS * SG_GROUP_DIM
CHUNK = 128
Q_BLOCK = 128
D_FF = 2048
CONV_W = 3
ROPE_THETA = 10000.0
EPS = 1e-6
IN_WIDTH = Q_WIDTH + 2 * KV_WIDTH + 2 * SG_WIDTH + 2 * D_MODEL

kernel_name = "hybrid_gqa_gmlp_convffn_encoder"


def rmsnorm(x, g):
    xf = x.astype(jnp.float32)
    y = xf * lax.rsqrt(jnp.mean(xf * xf, axis=-1, keepdims=True) + EPS)
    return (y * g.astype(jnp.float32)).astype(x.dtype)


def axial_rope_tables(seq_len, dtype):
    t = jnp.arange(seq_len)
    row = (t // GRID_W).astype(jnp.float32)
    col = (t % GRID_W).astype(jnp.float32)
    half = HEAD_DIM // 2
    freq = ROPE_THETA ** (-jnp.arange(0, half, 2, dtype=jnp.float32) / half)
    ang_r = row[:, None] * freq[None, :]
    ang_c = col[:, None] * freq[None, :]
    return (jnp.cos(ang_r).astype(dtype), jnp.sin(ang_r).astype(dtype),
            jnp.cos(ang_c).astype(dtype), jnp.sin(ang_c).astype(dtype))


def _rot_half(x, cos, sin):
    x1, x2 = jnp.split(x, 2, axis=-1)
    c = cos[:, None, :]
    s = sin[:, None, :]
    return jnp.concatenate([x1 * c - x2 * s, x1 * s + x2 * c], axis=-1)


def apply_axial_rope(x, tabs):
    cr, sr, cc, sc = tabs
    xr, xc = jnp.split(x, 2, axis=-1)
    return jnp.concatenate([_rot_half(xr, cr, sr), _rot_half(xc, cc, sc)], axis=-1)


def gqa_attention(q, k, v):
    b, s, _, d = q.shape
    nb = s // Q_BLOCK
    scale = 1.0 / math.sqrt(HEAD_DIM)
    qb = q.reshape(b, nb, Q_BLOCK, N_KV_HEADS, Q_PER_KV, d).transpose(1, 0, 2, 3, 4, 5)

    def block(qblk):
        sc = jnp.einsum('bqgrd,bkgd->bgrqk', qblk, k).astype(jnp.float32) * scale
        p = jax.nn.softmax(sc, axis=-1).astype(v.dtype)
        return jnp.einsum('bgrqk,bkgd->bqgrd', p, v)

    o = lax.map(block, qb)
    return o.transpose(1, 0, 2, 3, 4, 5).reshape(b, s, Q_WIDTH)


def spatial_gating(u, vs, sg_norm_g, sg_w, sg_b):
    b, s, _ = u.shape
    n = s // CHUNK
    vs = rmsnorm(vs, sg_norm_g).reshape(b, n, CHUNK, SG_GROUPS, SG_GROUP_DIM)
    sp = jnp.einsum('gpq,bnqgc->bnpgc', sg_w, vs) + jnp.swapaxes(sg_b, 0, 1)[:, :, None]
    return (u.reshape(b, n, CHUNK, SG_GROUPS, SG_GROUP_DIM) * sp).reshape(b, s, SG_WIDTH)


def token_mixer(h, tabs, w_in, q_norm_g, k_norm_g, sg_norm_g, sg_w, sg_b,
                w_branch_a, w_branch_b, w_mix_out):
    b, s, _ = h.shape
    z = h @ w_in
    q, k, v, u, vs, ga, gb = jnp.split(z, np.cumsum(
        [Q_WIDTH, KV_WIDTH, KV_WIDTH, SG_WIDTH, SG_WIDTH, D_MODEL]).tolist(), axis=-1)
    q = rmsnorm(q.reshape(b, s, N_Q_HEADS, HEAD_DIM), q_norm_g)
    k = rmsnorm(k.reshape(b, s, N_KV_HEADS, HEAD_DIM), k_norm_g)
    v = v.reshape(b, s, N_KV_HEADS, HEAD_DIM)
    q = apply_axial_rope(q, tabs)
    k = apply_axial_rope(k, tabs)
    ya = gqa_attention(q, k, v) @ w_branch_a
    yb = spatial_gating(jax.nn.gelu(u), jax.nn.gelu(vs), sg_norm_g, sg_w, sg_b) @ w_branch_b
    m = jax.nn.sigmoid(ga) * ya + jax.nn.sigmoid(gb) * yb
    return m @ w_mix_out


def conv_ffn(h, w_up, conv_w, conv_b, w_down):
    a = h @ w_up
    s = a.shape[1]
    ap = jnp.pad(a, ((0, 0), (CONV_W // 2, CONV_W // 2), (0, 0)))
    c = ap[:, 0:s] * conv_w[0] + ap[:, 1:s + 1] * conv_w[1] + ap[:, 2:s + 2] * conv_w[2] + conv_b
    g, val = jnp.split(c, 2, axis=-1)
    return (jax.nn.gelu(g) * val) @ w_down


def trunk(x, attn_norm_g, w_in, q_norm_g, k_norm_g, sg_norm_g, sg_w, sg_b,
          w_branch_a, w_branch_b, w_mix_out, ffn_norm_g, w_up, conv_w, conv_b,
          w_down, final_norm_g):
    tabs = axial_rope_tables(x.shape[1], x.dtype)
    for l in range(DEPTH):
        x = x + token_mixer(rmsnorm(x, attn_norm_g[l]), tabs, w_in[l], q_norm_g[l],
                            k_norm_g[l], sg_norm_g[l], sg_w[l], sg_b[l],
                            w_branch_a[l], w_branch_b[l], w_mix_out[l])
        x = x + conv_ffn(rmsnorm(x, ffn_norm_g[l]), w_up[l], conv_w[l], conv_b[l], w_down[l])
    return rmsnorm(x, final_norm_g)


def setup_inputs(seed: int = 0) -> dict:
    key = jax.random.key(seed)
    ks = jax.random.split(key, 20)
    f32 = jnp.float32

    def nrm(k, shape, fan_in):
        return jax.random.normal(k, shape, f32) * (fan_in ** -0.5)

    def gain(k, shape):
        return 1.0 + 0.02 * jax.random.normal(k, shape, f32)

    return {
        "x_prompt": jax.random.normal(ks[0], (BATCH, SEQ, D_MODEL), f32),
        "x_sample": jax.random.normal(ks[1], (DEC_BATCH, DEC_SEQ, D_MODEL), f32),
        "attn_norm_g": gain(ks[2], (DEPTH, D_MODEL)),
        "w_in": nrm(ks[3], (DEPTH, D_MODEL, IN_WIDTH), D_MODEL),
        "q_norm_g": gain(ks[4], (DEPTH, HEAD_DIM)),
        "k_norm_g": gain(ks[5], (DEPTH, HEAD_DIM)),
        "sg_norm_g": gain(ks[6], (DEPTH, SG_WIDTH)),
        "sg_w": nrm(ks[7], (DEPTH, SG_GROUPS, CHUNK, CHUNK), CHUNK),
        "sg_b": gain(ks[8], (DEPTH, SG_GROUPS, CHUNK)),
        "w_branch_a": nrm(ks[9], (DEPTH, Q_WIDTH, D_MODEL), Q_WIDTH),
        "w_branch_b": nrm(ks[10], (DEPTH, SG_WIDTH, D_MODEL), SG_WIDTH),
        "w_mix_out": nrm(ks[11], (DEPTH, D_MODEL, D_MODEL), D_MODEL),
        "ffn_norm_g": gain(ks[12], (DEPTH, D_MODEL)),
        "w_up": nrm(ks[13], (DEPTH, D_MODEL, 2 * D_FF), D_MODEL),
        "conv_w": nrm(ks[14], (DEPTH, CONV_W, 2 * D_FF), CONV_W),
        "conv_b": 0.02 * jax.random.normal(ks[15], (DEPTH, 2 * D_FF), f32),
        "w_down": nrm(ks[16], (DEPTH, D_FF, D_MODEL), D_FF),
        "final_norm_g": gain(ks[17], (D_MODEL,)),
    }


def reference(x_prompt, x_sample, attn_norm_g, w_in, q_norm_g, k_norm_g, sg_norm_g,
              sg_w, sg_b, w_branch_a, w_branch_b, w_mix_out, ffn_norm_g, w_up, conv_w,
              conv_b, w_down, final_norm_g):
    y_prompt = trunk(x_prompt, attn_norm_g, w_in, q_norm_g, k_norm_g, sg_norm_g, sg_w, sg_b,
                     w_branch_a, w_branch_b, w_mix_out, ffn_norm_g, w_up, conv_w, conv_b,
                     w_down, final_norm_g)
    y_sample = trunk(x_sample, attn_norm_g, w_in, q_norm_g, k_norm_g, sg_norm_g, sg_w, sg_b,
                     w_branch_a, w_branch_b, w_mix_out, ffn_norm_g, w_up, conv_w, conv_b,
                     w_down, final_norm_g)
    return (y_prompt, y_sample)
```

```cpp
#include <hip/hip_runtime.h>
#include <hip/hip_cooperative_groups.h>
#include <hip/hip_bf16.h>
#include <cstdio>
#include <cstdint>
#include <cmath>
namespace cg = cooperative_groups;

constexpr int M_TOK = 98304, NPROMPT = 32768, SEQ_P = 8192, SEQ_S = 2048;
constexpr int DMOD = 1024, INW = 3840, DFF = 2048, NLAYER = 4;
constexpr float EPS = 1e-6f;
constexpr float C2 = 0.125f * 1.4426950408889634f;

#define LAS __attribute__((address_space(3)))
typedef unsigned short bf16_t;
typedef short bf16x8 __attribute__((ext_vector_type(8)));
typedef float f32x4 __attribute__((ext_vector_type(4)));
typedef float f32x2 __attribute__((ext_vector_type(2)));
typedef unsigned u32x4 __attribute__((ext_vector_type(4)));
typedef unsigned u32x2 __attribute__((ext_vector_type(2)));

typedef __bf16 bf16x2_t_ __attribute__((ext_vector_type(2)));
__device__ __forceinline__ unsigned cvt_pk_bf16(float lo, float hi) { f32x2 v = {lo, hi}; bf16x2_t_ b = __builtin_convertvector(v, bf16x2_t_); return __builtin_bit_cast(unsigned, b); }
__device__ __forceinline__ float bf_lo(unsigned w) { return __uint_as_float(w << 16); }
__device__ __forceinline__ float bf_hi(unsigned w) { return __uint_as_float(w & 0xffff0000u); }
__device__ __forceinline__ float gelu_t(float x) {
    const float u = x * (0.7978845608f + 0.0356774081f * x * x);
    const float e = __builtin_amdgcn_exp2f(u * -2.8853900818f);
    return x * __builtin_amdgcn_rcpf(1.0f + e);
}
__device__ __forceinline__ float sigmoid_f(float x) { return __builtin_amdgcn_rcpf(1.0f + __builtin_amdgcn_exp2f(x * -1.4426950409f)); }
__device__ __forceinline__ float dpp_shr1(float v) { return __int_as_float(__builtin_amdgcn_update_dpp(0, __float_as_int(v), 0x111, 0xF, 0xF, true)); }
__device__ __forceinline__ float dpp_shl1(float v) { return __int_as_float(__builtin_amdgcn_update_dpp(0, __float_as_int(v), 0x101, 0xF, 0xF, true)); }

namespace pg8 {
constexpr int BM = 256, BK = 64, HALF = 128, HTB = HALF * BK * 2, STAGE_BYTES = 8 * HTB, NXCD = 8, WGM = 8;
__host__ __device__ __forceinline__ int lds_byte(int r, int c) { const int st = (r >> 4) * 2 + (c >> 5), rr = r & 15, cc = c & 31, ob = rr * 64 + cc * 2; return st * 1024 + (ob ^ (((ob >> 9) & 1) << 5)); }
__host__ __device__ __forceinline__ void stage_rc(int b, int& R, int& C) { const int st = b / 1024, sb = b % 1024, swz = sb ^ (((sb >> 9) & 1) << 5); R = (st >> 1) * 16 + swz / 64; C = (st & 1) * 32 + (swz % 64) / 2; }

struct Unit { int pm, pn, part; };
struct Gemm { const bf16_t* A; const bf16_t* Bt; int lda, ldb, K; long partA, partB; int tstride, wstride, shift; };

struct StaticOrder {
    int nM, nN, nwg, G, c, parts, pn_lo, pn_split, pn_hi;
    __device__ void init(int nM_, int nN_, int parts_, int G_, int c_, int pn_lo_ = 0, int pn_split_ = 1 << 20, int pn_hi_ = 0) { nM = nM_; nN = nN_; nwg = nM * nN; G = G_; c = c_; parts = parts_; pn_lo = pn_lo_; pn_split = pn_split_; pn_hi = pn_hi_; }
    __device__ bool next(int i, Unit& u) const {
        const int it = (parts == 2) ? (i >> 1) : i; u.part = (parts == 2) ? (i & 1) : 0;
        const long L = (long)it * G + c; if (L >= nwg) return false;
        int wgid = (int)L; { const int q = nwg / NXCD, r = nwg % NXCD, xcd = wgid % NXCD, off = wgid / NXCD; wgid = (xcd < r ? xcd * (q + 1) : r * (q + 1) + (xcd - r) * q) + off; }
        const int nig = WGM * nN, gid = wgid / nig, fm = gid * WGM, gsz = (nM - fm) < WGM ? (nM - fm) : WGM;
        u.pm = fm + ((wgid % nig) % gsz); { const int ix = (wgid % nig) / gsz; u.pn = ix < pn_split ? pn_lo + ix : pn_hi + (ix - pn_split); } return true;
    }
};

template <class Epi, int PARTS>
__device__ __forceinline__ void gemm_phase(LAS unsigned char* lds, const Gemm g, const StaticOrder& S, const Epi& E) {
    int tid_ = threadIdx.x; asm volatile("" : "+v"(tid_));
    const int tid = tid_, wid = __builtin_amdgcn_readfirstlane(tid >> 6), lane = tid & 63, wr = wid >> 2, wc = wid & 3, fr = lane & 15, fq = lane >> 4;
    const int K = g.K, nt = K / BK;
    unsigned voffA[2], voffB[2];
#pragma unroll
    for (int i = 0; i < 2; ++i) { int R, C; stage_rc(tid * 16 + i * 8192, R, C);
        const int TR = g.wstride ? g.wstride * (R >> 6) + 8 * (R & 15) + ((R >> 4) & 3) : R;
        voffA[i] = (unsigned)(TR * g.lda + C) * 2u; voffB[i] = (unsigned)(R * g.ldb + C) * 2u; }
    const size_t kstep = (size_t)(BK * 2);
    const size_t hstepA = (size_t)(g.wstride ? 4 : HALF) * g.lda * 2, hstepB = (size_t)HALF * g.ldb * 2;
    const unsigned ldsw = (unsigned)wid * 1024u;
    const int aoff = lds_byte(wr * 64 + fr, fq * 8), boff = lds_byte(wc * 32 + fr, fq * 8);
#define PG8_SA(b, h) (((b) * 2 + (h)) * HTB)
#define PG8_SB(b, h) ((4 + (b) * 2 + (h)) * HTB)
#define PG8_STAGE(bufoff, gbase, voff) do { _Pragma("unroll") for (int _i = 0; _i < 2; ++_i) \
        __builtin_amdgcn_global_load_lds((const unsigned*)((const char*)(gbase) + (voff)[_i]), (LAS unsigned*)(lds + (bufoff) + ldsw + _i * 8192), 16, 0, 0); } while (0)
#define PG8_STAGEA(bufoff, gbase, voff) do { _Pragma("unroll") for (int _i = 0; _i < 2; ++_i) \
        __builtin_amdgcn_global_load_lds((const unsigned*)((const char*)(gbase) + (voff)[_i]), (LAS unsigned*)(lds + (bufoff) + ldsw + _i * 8192), 16, 0, 0); } while (0)
#define PG8_LDA(dst, b, h) do { _Pragma("unroll") for (int m = 0; m < 4; ++m) _Pragma("unroll") for (int k = 0; k < 2; ++k) dst[m][k] = *(const LAS bf16x8*)(lds + PG8_SA(b, h) + aoff + m * 2048 + k * 1024); } while (0)
#define PG8_LDB(dst, b, h) do { _Pragma("unroll") for (int n = 0; n < 2; ++n) _Pragma("unroll") for (int k = 0; k < 2; ++k) dst[n][k] = *(const LAS bf16x8*)(lds + PG8_SB(b, h) + boff + n * 2048 + k * 1024); } while (0)
#define PG8_MMA(ai, bj, At, Bt) do { __builtin_amdgcn_s_setprio(1); _Pragma("unroll") for (int m = 0; m < 4; ++m) _Pragma("unroll") for (int n = 0; n < 2; ++n) _Pragma("unroll") for (int k = 0; k < 2; ++k) \
        acc[ai][bj][m][n] = __builtin_amdgcn_mfma_f32_16x16x32_bf16(Bt[n][k], At[m][k], acc[ai][bj][m][n], 0, 0, 0); __builtin_amdgcn_s_setprio(0); } while (0)
#define PG8_WAIT_V(n) asm volatile("s_waitcnt vmcnt(" #n ")" ::: "memory")
#define PG8_WAIT_L(n) asm volatile("s_waitcnt lgkmcnt(" #n ")" ::: "memory")
#define PG8_BAR __builtin_amdgcn_s_barrier()
#define PG8_SCHED __builtin_amdgcn_sched_barrier(0)
#define PG8_UA(u) ((const char*)g.A + (size_t)(u).part * g.partA + ((long)(u).pm * g.tstride + g.shift) * (long)g.lda * 2)
#define PG8_UB(u) ((const char*)g.Bt + (size_t)(u).part * g.partB + (size_t)(u).pn * 256 * g.ldb * 2)
    Unit cur, nxt; int ui = 0;
    if (!S.next(0, cur)) return;
    f32x4 acc[2][2][4][2];
#pragma unroll
    for (int a = 0; a < 2; ++a)
#pragma unroll
        for (int b = 0; b < 2; ++b)
#pragma unroll
            for (int m = 0; m < 4; ++m)
#pragma unroll
                for (int n = 0; n < 2; ++n) acc[a][b][m][n] = (f32x4){0.f, 0.f, 0.f, 0.f};
    bf16x8 At[4][2], B0[2][2], B1[2][2];
    const char* cA = PG8_UA(cur); const char* cB = PG8_UB(cur);
    PG8_STAGE(PG8_SB(0, 0), cB, voffB); PG8_STAGE(PG8_SB(0, 1), cB + hstepB, voffB); PG8_STAGEA(PG8_SA(0, 0), cA, voffA); PG8_STAGEA(PG8_SA(0, 1), cA + hstepA, voffA);
    if (wr == 1) PG8_BAR;
    PG8_WAIT_V(2); PG8_BAR;
    PG8_STAGE(PG8_SB(1, 0), cB + kstep, voffB); PG8_STAGEA(PG8_SA(1, 0), cA + kstep, voffA); PG8_STAGE(PG8_SB(1, 1), cB + hstepB + kstep, voffB);
    PG8_WAIT_V(6); PG8_BAR;
    for (;;) {
        const bool has_next = S.next(ui + 1, nxt);
        const char* nA = has_next ? PG8_UA(nxt) : cA; const char* nB = has_next ? PG8_UB(nxt) : cB;
        for (int t = 0; t < nt; t += 2) {
            const bool last = (t == nt - 2);
            const char* a1 = cA + (size_t)(t + 1) * kstep;
            const char* a2 = last ? nA : cA + (size_t)(t + 2) * kstep; const char* b2 = last ? nB : cB + (size_t)(t + 2) * kstep;
            const char* a3 = a2 + kstep; const char* b3 = b2 + kstep;
            PG8_LDB(B0, 0, 0); PG8_LDB(B1, 0, 1); PG8_SCHED; PG8_LDA(At, 0, 0); PG8_STAGEA(PG8_SA(1, 1), a1 + hstepA, voffA);
            PG8_WAIT_V(8); PG8_WAIT_L(0); PG8_BAR; PG8_MMA(0, 0, At, B0); PG8_MMA(0, 1, At, B1); PG8_BAR; PG8_SCHED;
            PG8_LDA(At, 0, 1); PG8_STAGE(PG8_SB(0, 0), b2, voffB); PG8_STAGE(PG8_SB(0, 1), b2 + hstepB, voffB); PG8_STAGEA(PG8_SA(0, 0), a2, voffA);
            PG8_WAIT_V(8); PG8_WAIT_L(0); PG8_BAR; PG8_MMA(1, 0, At, B0); PG8_MMA(1, 1, At, B1); PG8_BAR; PG8_SCHED;
            PG8_LDB(B0, 1, 0); PG8_LDB(B1, 1, 1); PG8_SCHED; PG8_LDA(At, 1, 0); PG8_STAGEA(PG8_SA(0, 1), a2 + hstepA, voffA);
            PG8_WAIT_V(8); PG8_WAIT_L(0); PG8_BAR; PG8_MMA(0, 0, At, B0); PG8_MMA(0, 1, At, B1); PG8_BAR; PG8_SCHED;
            PG8_LDA(At, 1, 1); PG8_STAGE(PG8_SB(1, 0), b3, voffB); PG8_STAGE(PG8_SB(1, 1), b3 + hstepB, voffB); PG8_STAGEA(PG8_SA(1, 0), a3, voffA);
            PG8_WAIT_V(8); PG8_WAIT_L(0); PG8_BAR; PG8_MMA(1, 0, At, B0); PG8_MMA(1, 1, At, B1); PG8_BAR; PG8_SCHED;
        }
        if (wr == 0) PG8_BAR;
        E(acc, cur, wr, wc, fr, fq);
        if (!has_next) break;
        if (PARTS == 1 || nxt.part == 0) {
#pragma unroll
        for (int a = 0; a < 2; ++a)
#pragma unroll
            for (int b = 0; b < 2; ++b)
#pragma unroll
                for (int m = 0; m < 4; ++m)
#pragma unroll
                    for (int n = 0; n < 2; ++n) acc[a][b][m][n] = (f32x4){0.f, 0.f, 0.f, 0.f};
        }
        cur = nxt; cA = nA; cB = nB; ++ui;
        if (wr == 1) PG8_BAR;
    }
    PG8_WAIT_V(0);
    PG8_BAR;
#undef PG8_SA
#undef PG8_SB
#undef PG8_STAGE
#undef PG8_STAGEA
#undef PG8_LDA
#undef PG8_LDB
#undef PG8_MMA
#undef PG8_WAIT_V
#undef PG8_WAIT_L
#undef PG8_BAR
#undef PG8_SCHED
#undef PG8_UA
#undef PG8_UB
}

__device__ __forceinline__ void load_rs8(const float* ss, int t0, int fq, float (&rs)[8], int tmax) {
#pragma unroll
    for (int j = 0; j < 8; ++j) { int t = t0 + j; t = t < 0 ? 0 : (t > tmax ? tmax : t);
        const f32x4 p = *(const f32x4*)(ss + (size_t)t * 16 + 4 * fq); float s = (p.x + p.y) + (p.z + p.w);
        s += __shfl_xor(s, 16); s += __shfl_xor(s, 32); rs[j] = __builtin_amdgcn_rsqf(s * (1.0f / DMOD) + EPS); }
}

__device__ __forceinline__ void load_rs8n(const float* ss, int t0, int fq, float (&rs)[8]) {
#pragma unroll
    for (int j = 0; j < 8; ++j) { const int t = t0 + 128 * (j >> 2) + 16 * (j & 3);
        const f32x4 p = *(const f32x4*)(ss + (size_t)t * 16 + 4 * fq); float s = (p.x + p.y) + (p.z + p.w);
        s += __shfl_xor(s, 16); s += __shfl_xor(s, 32); rs[j] = __builtin_amdgcn_rsqf(s * (1.0f / DMOD) + EPS); }
}

struct EpiQKV {
    const float* ss; const float* qg; const float* kg; const float* rope;
    bf16_t* QU; bf16_t* Kb; bf16_t* Vb;
    __device__ __forceinline__ void operator()(f32x4 (&acc)[2][2][4][2], const Unit& u, int wr, int wc, int fr, int fq) const {
        const int t0 = u.pm * 256 + wr * 128 + fr * 8;
        { float rs[8]; load_rs8(ss, t0, fq, rs, M_TOK - 1);
#pragma unroll
          for (int ai = 0; ai < 2; ++ai)
#pragma unroll
            for (int m = 0; m < 4; ++m)
#pragma unroll
                for (int bj = 0; bj < 2; ++bj)
#pragma unroll
                    for (int n = 0; n < 2; ++n) acc[ai][bj][m][n] = acc[ai][bj][m][n] * rs[4 * ai + m]; }
        const int pn = u.pn;
        {
            const bool isq = pn < 2;
            if (isq || wc < 2) {
                const float* gp = isq ? qg : kg; const float osc = isq ? C2 : 1.0f;
                f32x4 gv[2][2];
#pragma unroll
                for (int bj = 0; bj < 2; ++bj)
#pragma unroll
                    for (int n = 0; n < 2; ++n) gv[bj][n] = *(const f32x4*)(gp + 32 * bj + 16 * n + 4 * fq);
                const int smask = (t0 < NPROMPT) ? (SEQ_P - 1) : (SEQ_S - 1);
                const int prow = (t0 & smask) >> 6;
                const f32x4 rr0 = *(const f32x4*)(rope + (prow * 16 + 4 * fq) * 2), rr1 = *(const f32x4*)(rope + (prow * 16 + 4 * fq) * 2 + 4);
                bf16_t* dst = isq ? (QU + (size_t)t0 * 1024 + (4 * pn + wc) * 64) : (Kb + (size_t)t0 * 128 + wc * 64);
                const int pitch = isq ? 1024 : 128;
#pragma unroll
                for (int ai = 0; ai < 2; ++ai)
#pragma unroll
                    for (int m = 0; m < 4; ++m) {
                        const int j = 4 * ai + m;
                        float sq = 0.f;
#pragma unroll
                        for (int bj = 0; bj < 2; ++bj)
#pragma unroll
                            for (int n = 0; n < 2; ++n) { const f32x4 v = acc[ai][bj][m][n]; sq += (v.x * v.x + v.y * v.y) + (v.z * v.z + v.w * v.w); }
                        sq += __shfl_xor(sq, 16); sq += __shfl_xor(sq, 32);
                        const float rn = __builtin_amdgcn_rsqf(sq * (1.0f / 64.0f) + EPS) * osc;
                        const int pcol = (t0 + j) & 63;
                        const f32x4 cc0 = *(const f32x4*)(rope + (pcol * 16 + 4 * fq) * 2), cc1 = *(const f32x4*)(rope + (pcol * 16 + 4 * fq) * 2 + 4);
#pragma unroll
                        for (int bj = 0; bj < 2; ++bj) {
                            const f32x4 t0v = bj == 0 ? rr0 : cc0, t1v = bj == 0 ? rr1 : cc1;
                            const f32x4 x1 = acc[ai][bj][m][0] * gv[bj][0] * rn, x2 = acc[ai][bj][m][1] * gv[bj][1] * rn;
                            const f32x4 cs = (f32x4){t0v.x, t0v.z, t1v.x, t1v.z}, sn = (f32x4){t0v.y, t0v.w, t1v.y, t1v.w};
                            const f32x4 o1 = x1 * cs - x2 * sn, o2 = x1 * sn + x2 * cs;
                            u32x2 w1, w2; w1.x = cvt_pk_bf16(o1.x, o1.y); w1.y = cvt_pk_bf16(o1.z, o1.w); w2.x = cvt_pk_bf16(o2.x, o2.y); w2.y = cvt_pk_bf16(o2.z, o2.w);
                            bf16_t* p = dst + (size_t)j * pitch + 32 * bj + 4 * fq;
                            *(u32x2*)p = w1; *(u32x2*)(p + 16) = w2;
                        }
                    }
            } else {
                bf16_t* dst = Vb + (size_t)t0 * 128 + (wc - 2) * 64;
#pragma unroll
                for (int ai = 0; ai < 2; ++ai)
#pragma unroll
                    for (int m = 0; m < 4; ++m)
#pragma unroll
                        for (int bj = 0; bj < 2; ++bj)
#pragma unroll
                            for (int n = 0; n < 2; ++n) { const f32x4 v = acc[ai][bj][m][n]; u32x2 w; w.x = cvt_pk_bf16(v.x, v.y); w.y = cvt_pk_bf16(v.z, v.w);
                                *(u32x2*)(dst + (size_t)(4 * ai + m) * 128 + 32 * bj + 16 * n + 4 * fq) = w; }
            }
        }
    }
};
struct EpiVS {
    const float* ss; bf16_t* VST; float* ssg;
    __device__ __forceinline__ void operator()(f32x4 (&acc)[2][2][4][2], const Unit& u, int wr, int wc, int fr, int fq) const {
        const int t0 = u.pm * 256 + wr * 128 + fr * 8;
        { float rs[8]; load_rs8(ss, t0, fq, rs, M_TOK - 1);
#pragma unroll
          for (int ai = 0; ai < 2; ++ai)
#pragma unroll
            for (int m = 0; m < 4; ++m)
#pragma unroll
                for (int bj = 0; bj < 2; ++bj)
#pragma unroll
                    for (int n = 0; n < 2; ++n) acc[ai][bj][m][n] = acc[ai][bj][m][n] * rs[4 * ai + m]; }
        const int pn = u.pn;
        {
            const int chunk = 2 * u.pm + wr;
            bf16_t* dst = VST + ((size_t)chunk * 512 + 256 * (pn - 5) + 32 * wc + 8 * fq) * 128 + 8 * fr;
#pragma unroll
            for (int ai = 0; ai < 2; ++ai)
#pragma unroll
                for (int m = 0; m < 4; ++m) {
                    float sq = 0.f;
#pragma unroll
                    for (int bj = 0; bj < 2; ++bj)
#pragma unroll
                        for (int n = 0; n < 2; ++n) { f32x4 v = acc[ai][bj][m][n]; v = (f32x4){gelu_t(v.x), gelu_t(v.y), gelu_t(v.z), gelu_t(v.w)}; acc[ai][bj][m][n] = v;
                            sq += (v.x * v.x + v.y * v.y) + (v.z * v.z + v.w * v.w); }
                    sq += __shfl_xor(sq, 16); sq += __shfl_xor(sq, 32);
                    if (fq == 0) ssg[(size_t)(t0 + 4 * ai + m) * 8 + 4 * (pn - 5) + wc] = sq;
                    asm volatile("" : "+v"(acc[ai][0][m][0]), "+v"(acc[ai][0][m][1]), "+v"(acc[ai][1][m][0]), "+v"(acc[ai][1][m][1]));
                }
#pragma unroll
            for (int bj = 0; bj < 2; ++bj)
#pragma unroll
                for (int n = 0; n < 2; ++n)
#pragma unroll
                    for (int i = 0; i < 4; ++i) {
                        u32x4 w; w.x = cvt_pk_bf16(acc[0][bj][0][n][i], acc[0][bj][1][n][i]); w.y = cvt_pk_bf16(acc[0][bj][2][n][i], acc[0][bj][3][n][i]);
                        w.z = cvt_pk_bf16(acc[1][bj][0][n][i], acc[1][bj][1][n][i]); w.w = cvt_pk_bf16(acc[1][bj][2][n][i], acc[1][bj][3][n][i]);
                        *(u32x4*)(dst + (size_t)(128 * bj + 4 * n + i) * 128) = w;
                    }
        }
    }
};
struct EpiEW {
    const float* ss; bf16_t* QU; bf16_t* GA; bf16_t* GB;
    __device__ __forceinline__ void operator()(f32x4 (&acc)[2][2][4][2], const Unit& u, int wr, int wc, int fr, int fq) const {
        const int t0 = u.pm * 256 + wr * 64 + fr;
        float rs[8]; load_rs8n(ss, t0, fq, rs);
        const int pn = u.pn;
        const bool isu = pn < 5;
        bf16_t* dst = (isu ? QU + 512 + 256 * (pn - 3) : ((pn < 11) ? GA : GB) + 256 * ((pn - 7) & 3)) + (size_t)t0 * 1024 + 32 * wc + 8 * fq;
        if (isu) {
#pragma unroll
            for (int ai = 0; ai < 2; ++ai)
#pragma unroll
                for (int m = 0; m < 4; ++m)
#pragma unroll
                    for (int bj = 0; bj < 2; ++bj) { const f32x4 a = acc[ai][bj][m][0] * rs[4 * ai + m], b = acc[ai][bj][m][1] * rs[4 * ai + m]; u32x4 w;
                        w.x = cvt_pk_bf16(gelu_t(a.x), gelu_t(a.y)); w.y = cvt_pk_bf16(gelu_t(a.z), gelu_t(a.w)); w.z = cvt_pk_bf16(gelu_t(b.x), gelu_t(b.y)); w.w = cvt_pk_bf16(gelu_t(b.z), gelu_t(b.w));
                        *(u32x4*)(dst + (size_t)(128 * ai + 16 * m) * 1024 + 128 * bj) = w; }
        } else {
#pragma unroll
            for (int ai = 0; ai < 2; ++ai)
#pragma unroll
                for (int m = 0; m < 4; ++m) { const float k2 = rs[4 * ai + m] * -1.4426950409f;
#pragma unroll
                    for (int bj = 0; bj < 2; ++bj) { const f32x4 a = acc[ai][bj][m][0], b = acc[ai][bj][m][1]; u32x4 w;
#define SG_(x) __builtin_amdgcn_rcpf(1.0f + __builtin_amdgcn_exp2f((x) * k2))
                        w.x = cvt_pk_bf16(SG_(a.x), SG_(a.y)); w.y = cvt_pk_bf16(SG_(a.z), SG_(a.w)); w.z = cvt_pk_bf16(SG_(b.x), SG_(b.y)); w.w = cvt_pk_bf16(SG_(b.z), SG_(b.w));
#undef SG_
                        *(u32x4*)(dst + (size_t)(128 * ai + 16 * m) * 1024 + 128 * bj) = w; } }
        }
    }
};

struct EpiMerge {
    bf16_t* GA; const bf16_t* GB;
    __device__ __forceinline__ void operator()(f32x4 (&acc)[2][2][4][2], const Unit& u, int wr, int wc, int fr, int fq) const {
        const int t0 = u.pm * 256 + wr * 64 + fr;
        const size_t off0 = (size_t)t0 * 1024 + 256 * u.pn + 32 * wc + 8 * fq;
#pragma unroll
        for (int ai = 0; ai < 2; ++ai)
#pragma unroll
            for (int m = 0; m < 4; ++m)
#pragma unroll
                for (int bj = 0; bj < 2; ++bj) {
                    const size_t off = off0 + (size_t)(128 * ai + 16 * m) * 1024 + 128 * bj;
                    const u32x4 gb = *(const u32x4*)(GB + off);
                    f32x4 s0 = (f32x4){bf_lo(gb.x), bf_hi(gb.x), bf_lo(gb.y), bf_hi(gb.y)}, s1 = (f32x4){bf_lo(gb.z), bf_hi(gb.z), bf_lo(gb.w), bf_hi(gb.w)};
                    if (u.part == 0) {
                        const u32x4 ga = *(const u32x4*)(GA + off);
                        const f32x4 a0 = (f32x4){bf_lo(ga.x), bf_hi(ga.x), bf_lo(ga.y), bf_hi(ga.y)}, a1 = (f32x4){bf_lo(ga.z), bf_hi(ga.z), bf_lo(ga.w), bf_hi(ga.w)};
                        s0 = (f32x4){__builtin_amdgcn_rcpf(s0.x), __builtin_amdgcn_rcpf(s0.y), __builtin_amdgcn_rcpf(s0.z), __builtin_amdgcn_rcpf(s0.w)};
                        s1 = (f32x4){__builtin_amdgcn_rcpf(s1.x), __builtin_amdgcn_rcpf(s1.y), __builtin_amdgcn_rcpf(s1.z), __builtin_amdgcn_rcpf(s1.w)};
                        acc[ai][bj][m][0] = acc[ai][bj][m][0] * (a0 * s0); acc[ai][bj][m][1] = acc[ai][bj][m][1] * (a1 * s1);
                    } else {
                        const f32x4 v0 = acc[ai][bj][m][0] * s0, v1 = acc[ai][bj][m][1] * s1; u32x4 w;
                        w.x = cvt_pk_bf16(v0.x, v0.y); w.y = cvt_pk_bf16(v0.z, v0.w); w.z = cvt_pk_bf16(v1.x, v1.y); w.w = cvt_pk_bf16(v1.z, v1.w);
                        *(u32x4*)(GA + off) = w;
                    }
                }
    }
};

struct EpiRes {
    const float* xp; const float* xs; int first; float* out; bf16_t* xb; float* ss;
    __device__ __forceinline__ void operator()(f32x4 (&acc)[2][2][4][2], const Unit& u, int wr, int wc, int fr, int fq) const {
        const int t0 = u.pm * 256 + wr * 64 + fr;
        const int col0 = 256 * u.pn + 32 * wc + 8 * fq;
        const float* bp0 = first ? ((t0 < NPROMPT) ? xp + (size_t)t0 * 1024 : xs + (size_t)(t0 - NPROMPT) * 1024) : out + (size_t)t0 * 1024;
#pragma unroll
        for (int ai = 0; ai < 2; ++ai)
#pragma unroll
            for (int m = 0; m < 4; ++m) {
                const int j = 128 * ai + 16 * m; float sq = 0.f;
#pragma unroll
                for (int bj = 0; bj < 2; ++bj) {
                    const size_t o = (size_t)j * 1024 + col0 + 128 * bj;
                    f32x4 a = *(const f32x4*)(bp0 + o), b = *(const f32x4*)(bp0 + o + 4);
                    a = a + acc[ai][bj][m][0]; b = b + acc[ai][bj][m][1];
                    float* op = out + (size_t)t0 * 1024 + o; *(f32x4*)op = a; *(f32x4*)(op + 4) = b;
                    u32x4 w; w.x = cvt_pk_bf16(a.x, a.y); w.y = cvt_pk_bf16(a.z, a.w); w.z = cvt_pk_bf16(b.x, b.y); w.w = cvt_pk_bf16(b.z, b.w);
                    *(u32x4*)(xb + (size_t)t0 * 1024 + o) = w;
                    sq += (a.x * a.x + a.y * a.y) + (a.z * a.z + a.w * a.w) + (b.x * b.x + b.y * b.y) + (b.z * b.z + b.w * b.w);
                }
                sq += __shfl_xor(sq, 16); sq += __shfl_xor(sq, 32);
                if (fq == 0) ss[(size_t)(t0 + j) * 16 + 4 * u.pn + wc] = sq;
            }
    }
};

struct EpiUp {
    const float* ss; const float* cw; const float* cb; bf16_t* H2;
    __device__ __forceinline__ void operator()(f32x4 (&acc)[2][2][4][2], const Unit& u, int wr, int wc, int fr, int fq) const {
        const int t0 = u.pm * 252 - 1 + wr * 126 + fr * 8;
        { float rs[8]; load_rs8(ss, t0, fq, rs, M_TOK - 1);
#pragma unroll
          for (int ai = 0; ai < 2; ++ai)
#pragma unroll
            for (int m = 0; m < 4; ++m)
#pragma unroll
                for (int bj = 0; bj < 2; ++bj)
#pragma unroll
                    for (int n = 0; n < 2; ++n) acc[ai][bj][m][n] = acc[ai][bj][m][n] * rs[4 * ai + m]; }
        unsigned vmask = 0, smask = 0, emask = 0;
#pragma unroll
        for (int j = 0; j < 8; ++j) { const int t = t0 + j, loc = fr * 8 + j;
            if (loc >= 1 && loc <= 126 && t < M_TOK) vmask |= 1u << j;
            const int sm = (t < NPROMPT) ? (SEQ_P - 1) : (SEQ_S - 1);
            if ((t & sm) == 0) smask |= 1u << j;
            if ((t & sm) == sm) emask |= 1u << j; }
#pragma unroll
        for (int n = 0; n < 2; ++n) {
            const int cg_ = 128 * u.pn + 32 * wc + 8 * fq + 4 * n;
            const f32x4 w0g = *(const f32x4*)(cw + cg_), w1g = *(const f32x4*)(cw + 4096 + cg_), w2g = *(const f32x4*)(cw + 8192 + cg_), bg = *(const f32x4*)(cb + cg_);
            const f32x4 w0v = *(const f32x4*)(cw + 2048 + cg_), w1v = *(const f32x4*)(cw + 4096 + 2048 + cg_), w2v = *(const f32x4*)(cw + 8192 + 2048 + cg_), bv = *(const f32x4*)(cb + 2048 + cg_);
            float h[8][4];
#pragma unroll
            for (int i = 0; i < 4; ++i) {
                float ag[8], av[8];
#pragma unroll
                for (int j = 0; j < 8; ++j) { ag[j] = acc[j >> 2][0][j & 3][n][i]; av[j] = acc[j >> 2][1][j & 3][n][i]; }
                const float lg = dpp_shr1(ag[7]), rg = dpp_shl1(ag[0]), lv = dpp_shr1(av[7]), rv = dpp_shl1(av[0]);
#pragma unroll
                for (int j = 0; j < 8; ++j) {
                    float Lg = j == 0 ? lg : ag[j == 0 ? 0 : j - 1], Rg = j == 7 ? rg : ag[j == 7 ? 7 : j + 1];
                    float Lv = j == 0 ? lv : av[j == 0 ? 0 : j - 1], Rv = j == 7 ? rv : av[j == 7 ? 7 : j + 1];
                    if ((smask >> j) & 1u) { Lg = 0.f; Lv = 0.f; }
                    if ((emask >> j) & 1u) { Rg = 0.f; Rv = 0.f; }
                    const float cgv = w0g[i] * Lg + w1g[i] * ag[j] + w2g[i] * Rg + bg[i];
                    const float cvv = w0v[i] * Lv + w1v[i] * av[j] + w2v[i] * Rv + bv[i];
                    h[j][i] = gelu_t(cgv) * cvv;
                }
            }
#pragma unroll
            for (int j = 0; j < 8; ++j) if ((vmask >> j) & 1u) { u32x2 w; w.x = cvt_pk_bf16(h[j][0], h[j][1]); w.y = cvt_pk_bf16(h[j][2], h[j][3]);
                *(u32x2*)(H2 + (size_t)(t0 + j) * 2048 + cg_) = w; }
        }
    }
};
}

namespace attn_body {
using bf16=__hip_bfloat16;
using bf16x8=__attribute__((ext_vector_type(8)))short;
using s16x4=__attribute__((ext_vector_type(4)))short;
using f32x16=__attribute__((ext_vector_type(16)))float;
using u32x4=__attribute__((ext_vector_type(4)))unsigned;
constexpr int D=64,QP=1024,KP=128;
constexpr int NW=8,QBLK=32,QB=QBLK*NW,KVBLK=64;
__device__ __forceinline__ int crow(int r,int hi){return (r&3)+8*(r>>2)+4*hi;}
#define SBAR() __builtin_amdgcn_sched_barrier(0)
constexpr int NSLOT=3, SLOTB=8192;
constexpr int LDS_K=0, LDS_V=NSLOT*SLOTB, LDS_WS=2*NSLOT*SLOTB, LDS_OST=LDS_WS+NW*64*4, LDS_BYTES=LDS_OST+NW*4096;
__device__ __forceinline__ void glds16(const void*gsrc,unsigned lds_dst){unsigned keep;
  asm volatile("s_mov_b32 %0, m0\n\ts_mov_b32 m0, %2\n\ts_nop 0\n\tglobal_load_lds_dwordx4 %1, off\n\ts_mov_b32 m0, %0":"=&s"(keep):"v"(gsrc),"s"(lds_dst):"memory");}
__device__ __forceinline__ float max3f(float a,float b,float c){float r;asm("v_max3_f32 %0, %1, %2, %3":"=v"(r):"v"(a),"v"(b),"v"(c));return r;}
__device__ __forceinline__ float max2f(float a,float b){float r;asm("v_max_f32_e32 %0, %1, %2":"=v"(r):"v"(a),"v"(b));return r;}
__device__ __forceinline__ float fadd_s(float a,float b){float r;asm("v_add_f32_e32 %0, %1, %2":"=v"(r):"v"(a),"v"(b));return r;}
__device__ __forceinline__ float fsub_s(float a,float b){float r;asm("v_sub_f32_e32 %0, %1, %2":"=v"(r):"v"(a),"v"(b));return r;}
typedef float f32x2_t __attribute__((ext_vector_type(2))); typedef __bf16 bf16x2_t __attribute__((ext_vector_type(2)));
__device__ __forceinline__ unsigned cvtpk_s(float lo,float hi){f32x2_t v={lo,hi};bf16x2_t b=__builtin_convertvector(v,bf16x2_t);return __builtin_bit_cast(unsigned,b);}
#define WAIT_BAR(N) asm volatile("s_waitcnt vmcnt(" #N ") lgkmcnt(0)\n\ts_barrier":::"memory")
__device__ __forceinline__ void qkt(f32x16&p0,f32x16&p1,const char*Kslot,const bf16x8*qr,const f32x16&negm,int r32,int hi){
  const char*kb=Kslot+hi*1024+r32*16;
  #pragma unroll
  for(int d0=0;d0<4;++d0){
    const bf16x8 b0=*reinterpret_cast<const bf16x8*>(kb+d0*2048);
    const bf16x8 b1=*reinterpret_cast<const bf16x8*>(kb+d0*2048+512);
    if(d0==0){p0=__builtin_amdgcn_mfma_f32_32x32x16_bf16(b0,qr[0],negm,0,0,0);p1=__builtin_amdgcn_mfma_f32_32x32x16_bf16(b1,qr[0],negm,0,0,0);}
    else{p0=__builtin_amdgcn_mfma_f32_32x32x16_bf16(b0,qr[d0],p0,0,0,0);p1=__builtin_amdgcn_mfma_f32_32x32x16_bf16(b1,qr[d0],p1,0,0,0);}}
}
typedef __attribute__((address_space(3))) const char* lds_cptr;
typedef short v4i16_t __attribute__((ext_vector_type(4)));
__device__ __forceinline__ void kload8(bf16x8*kf,lds_cptr kp){
  kf[0]=*(const __attribute__((address_space(3))) bf16x8*)(kp);      kf[1]=*(const __attribute__((address_space(3))) bf16x8*)(kp+512);
  kf[2]=*(const __attribute__((address_space(3))) bf16x8*)(kp+2048); kf[3]=*(const __attribute__((address_space(3))) bf16x8*)(kp+2560);
  kf[4]=*(const __attribute__((address_space(3))) bf16x8*)(kp+4096); kf[5]=*(const __attribute__((address_space(3))) bf16x8*)(kp+4608);
  kf[6]=*(const __attribute__((address_space(3))) bf16x8*)(kp+6144); kf[7]=*(const __attribute__((address_space(3))) bf16x8*)(kp+6656);
}
__device__ __forceinline__ void kload2(bf16x8*kf,lds_cptr kp,int j){ kf[2*j]=*(const __attribute__((address_space(3))) bf16x8*)(kp+j*2048); kf[2*j+1]=*(const __attribute__((address_space(3))) bf16x8*)(kp+j*2048+512); }
__device__ __forceinline__ s16x4 vtr(lds_cptr p){ return __builtin_bit_cast(s16x4,__builtin_amdgcn_ds_read_tr16_b64_v4i16((__attribute__((address_space(3))) v4i16_t*)p)); }
__device__ __forceinline__ float rowmax(const f32x16&p0,const f32x16&p1){
  float a=max3f(p0[0],p0[1],p1[0]),b=max3f(p0[2],p0[3],p1[1]);a=max3f(a,p1[2],p1[3]);
  #pragma unroll
  for(int r=4;r<16;r+=4){a=max3f(a,p0[r],p0[r+1]);b=max3f(b,p0[r+2],p0[r+3]);a=max3f(a,p1[r],p1[r+1]);b=max3f(b,p1[r+2],p1[r+3]);}
  const float m=max2f(a,b);
  auto rr=__builtin_amdgcn_permlane32_swap(__float_as_uint(m),__float_as_uint(m),false,false);
  return max2f(__uint_as_float(rr[0]),__uint_as_float(rr[1]));
}
__device__ __forceinline__ void pv(f32x16*o,int vb,bf16x8 pa0,bf16x8 pa1,bf16x8 pa2,bf16x8 pa3){
  #pragma unroll
  for(int d0=0;d0<2;++d0){s16x4 lo[4],hi[4];
    #pragma unroll
    for(int ks=0;ks<4;++ks){
      asm volatile("ds_read_b64_tr_b16 %0,%1 offset:%c2":"=&v"(lo[ks]):"v"(vb),"i"(d0*4096+ks*1024):"memory");
      asm volatile("ds_read_b64_tr_b16 %0,%1 offset:%c2":"=&v"(hi[ks]):"v"(vb),"i"(d0*4096+ks*1024+512):"memory");}
    asm volatile("s_waitcnt lgkmcnt(0)":::"memory");SBAR();
    #define PK(k) (bf16x8){lo[k][0],lo[k][1],lo[k][2],lo[k][3],hi[k][0],hi[k][1],hi[k][2],hi[k][3]}
    o[d0]=__builtin_amdgcn_mfma_f32_32x32x16_bf16(pa0,PK(0),o[d0],0,0,0);
    o[d0]=__builtin_amdgcn_mfma_f32_32x32x16_bf16(pa1,PK(1),o[d0],0,0,0);
    o[d0]=__builtin_amdgcn_mfma_f32_32x32x16_bf16(pa2,PK(2),o[d0],0,0,0);
    o[d0]=__builtin_amdgcn_mfma_f32_32x32x16_bf16(pa3,PK(3),o[d0],0,0,0);
    #undef PK
  }
}
template<int THRL> __device__ __forceinline__ void attn_unit(long rowbase,int seq,int h,int q0,const bf16*Q,const bf16*__restrict__ K,const bf16*__restrict__ V,bf16*O,char*shm){
  int tid_=threadIdx.x; asm volatile("":"+v"(tid_));
  const int tid=tid_,lane=tid&63,r32=lane&31,hi=lane>>5; const int wid=__builtin_amdgcn_readfirstlane(tid>>6);
  const bf16*Qw=Q+(rowbase+q0+wid*QBLK)*QP+h*D;
  const bf16*Kh=K+rowbase*KP+(h>>2)*D,*Vh=V+rowbase*KP+(h>>2)*D;
  const unsigned lds0=(unsigned)(uintptr_t)shm;
  float*wsf=(float*)(shm+LDS_WS)+wid*64;
  const bf16*ksrc=Kh+(long)lane*KP+wid*8;
  const bf16*vsrc=Vh+(long)(16*(wid&3)+(lane>>2))*KP+(wid>>2)*32+(lane&3)*8;
  const unsigned kdst=lds0+LDS_K+wid*1024, vdst=lds0+LDS_V+wid*1024;
  #define DMA_K(t,slot) glds16(ksrc+(long)(t)*KVBLK*KP,(unsigned)__builtin_amdgcn_readfirstlane(kdst+(slot)))
  #define DMA_V(t,slot) glds16(vsrc+(long)(t)*KVBLK*KP,(unsigned)__builtin_amdgcn_readfirstlane(vdst+(slot)))
  const int vb0=(int)(lds0+LDS_V)+((lane>>4)&1)*32+(lane&3)*8+(4*hi+((lane&15)>>2))*64;
  const char*Kbase=shm+LDS_K; bf16x8 kf[8];
  const lds_cptr shm3=(lds_cptr)shm; const lds_cptr kp0=shm3+LDS_K+hi*1024+r32*16; const lds_cptr vp0=shm3+LDS_V+((lane>>4)&1)*32+(lane&3)*8+(4*hi+((lane&15)>>2))*64;
  const int NT=seq/KVBLK;
  DMA_K(0,0);DMA_V(0,0);DMA_K(1,SLOTB);
  bf16x8 qr[4];
  #pragma unroll
  for(int d0=0;d0<4;++d0)qr[d0]=*reinterpret_cast<const bf16x8*>(&Qw[(long)r32*QP+d0*16+hi*8]);
  float mhat=0.f,l_reg=0.f;f32x16 o[2];o[0]=f32x16{};o[1]=f32x16{};f32x16 negm=f32x16{};asm volatile("":"+v"(negm));
  bool resc=false;
  #define START(P0,P1) do{ const float rm=rowmax(P0,P1); resc=false; \
    { const float dl=rm; mhat=fadd_s(mhat,dl); \
      _Pragma("unroll") for(int r=0;r<16;++r){P0[r]=fsub_s(P0[r],dl);P1[r]=fsub_s(P1[r],dl);} \
      _Pragma("unroll") for(int r=0;r<16;++r)negm[r]=-mhat; asm volatile("":"+v"(negm)); } \
    _Pragma("unroll") for(int r=0;r<16;++r)P0[r]=__builtin_amdgcn_exp2f(P0[r]); }while(0)
  #define RESC() do{ if(resc){ asm volatile("s_waitcnt lgkmcnt(0)":::"memory"); \
      _Pragma("unroll") for(int d_=0;d_<2;++d_) _Pragma("unroll") for(int r=0;r<16;++r)o[d_][r]*=wsf[crow(r,hi)]; } }while(0)
  f32x16 pA0,pA1,pB0,pB1;
  int sl_prev=0,sl_cur=0,sl_next=SLOTB;
  #define ROT() do{sl_prev=sl_cur;sl_cur=sl_next;sl_next=(sl_next==(NSLOT-1)*SLOTB)?0:sl_next+SLOTB;}while(0)
  DMA_K(2,2*SLOTB);
  WAIT_BAR(3);
  qkt(pA0,pA1,Kbase,qr,negm,r32,hi);asm volatile("s_nop 15\n\ts_nop 7":"+v"(pA0),"+v"(pA1));
  START(pA0,pA1);
  _Pragma("unroll") for(int r=0;r<16;++r)pA1[r]=__builtin_amdgcn_exp2f(pA1[r]);
  WAIT_BAR(0);
  DMA_K(3,0);DMA_V(1,SLOTB);
  ROT();
  kload8(kf,kp0+sl_cur);
  WAIT_BAR(2);
  s16x4 vlo[8],vhi[8]; u32x4 pw0,pw1,pw2,pw3;
  #define PKW(P,B) cvtpk_s(P[B],P[B+1])
  #define PAF(k) __builtin_bit_cast(bf16x8,pw##k)
  #define VFR(i) (bf16x8){vlo[i][0],vlo[i][1],vlo[i][2],vlo[i][3],vhi[i][0],vhi[i][1],vhi[i][2],vhi[i][3]}
  #define PIN(x) asm volatile("":"+v"(x))
  #define MX3(a,b,c) __builtin_fmaxf(__builtin_fmaxf((a),(b)),(c))
  #define GAPA(MF,A0,A1,A2,A3,W0,W1,PW) do{ MF; sacc+=A0; sacc+=A1; sacc+=A2; sacc+=A3; PIN(sacc); W0; W1; PIN(PW); SBAR(); }while(0)
  #define EX(v) __builtin_amdgcn_exp2f(v)
  #define GAPB(MF,X,B) do{ MF; X[B]=EX(X[B]); X[B+1]=EX(X[B+1]); X[B+2]=EX(X[B+2]); X[B+3]=EX(X[B+3]); PIN(X); SBAR(); }while(0)
  #define VRD(i) do{ vlo[i]=vtr(vp_+(((i)>>2)*4096+((i)&3)*1024)); vhi[i]=vtr(vp_+(((i)>>2)*4096+((i)&3)*1024+512)); }while(0)
  #define KRD(G,j) do{ if(G){ kload2(kf,kp0+sl_next,j); SBAR(); } }while(0)
  #define STEP(C0,C1,P0,P1,t,GK,GV,GL) do{ SBAR(); \
    const lds_cptr vp_=vp0+sl_prev; \
    VRD(0); SBAR(); float sacc=(P0[0]+P0[1]); \
    GAPA(C0=__builtin_amdgcn_mfma_f32_32x32x16_bf16(kf[0],qr[0],negm,0,0,0), P0[2],P0[3],P0[4],P0[5],     pw0[0]=PKW(P0,0), pw0[1]=PKW(P0,2), pw0); \
    VRD(4); SBAR(); GAPA(C1=__builtin_amdgcn_mfma_f32_32x32x16_bf16(kf[1],qr[0],negm,0,0,0), P0[6],P0[7],P0[8],P0[9],     pw0[2]=PKW(P0,4), pw0[3]=PKW(P0,6), pw0); \
    VRD(1); SBAR(); GAPA(C0=__builtin_amdgcn_mfma_f32_32x32x16_bf16(kf[2],qr[1],C0,0,0,0),   P0[10],P0[11],P0[12],P0[13], pw1[0]=PKW(P0,8), pw1[1]=PKW(P0,10), pw1); \
    VRD(5); SBAR(); GAPA(C1=__builtin_amdgcn_mfma_f32_32x32x16_bf16(kf[3],qr[1],C1,0,0,0),   P0[14],P0[15],P1[0],P1[1],   pw1[2]=PKW(P0,12),pw1[3]=PKW(P0,14), pw1); \
    VRD(2); SBAR(); GAPA(C0=__builtin_amdgcn_mfma_f32_32x32x16_bf16(kf[4],qr[2],C0,0,0,0),   P1[2],P1[3],P1[4],P1[5],     pw2[0]=PKW(P1,0), pw2[1]=PKW(P1,2), pw2); \
    VRD(6); SBAR(); GAPA(C1=__builtin_amdgcn_mfma_f32_32x32x16_bf16(kf[5],qr[2],C1,0,0,0),   P1[6],P1[7],P1[8],P1[9],     pw2[2]=PKW(P1,4), pw2[3]=PKW(P1,6), pw2); \
    VRD(3); SBAR(); GAPA(C0=__builtin_amdgcn_mfma_f32_32x32x16_bf16(kf[6],qr[3],C0,0,0,0),   P1[10],P1[11],P1[12],P1[13], pw3[0]=PKW(P1,8), pw3[1]=PKW(P1,10), pw3); \
    VRD(7); SBAR(); GAPA(C1=__builtin_amdgcn_mfma_f32_32x32x16_bf16(kf[7],qr[3],C1,0,0,0),   P1[14],P1[15],0.f,0.f,       pw3[2]=PKW(P1,12),pw3[3]=PKW(P1,14), pw3); \
    l_reg+=sacc; \
    if(GK){DMA_K((t)+3,sl_cur);} if(GV){DMA_V((t)+1,sl_next);} \
    { float a=MX3(C0[0],C0[1],C1[0]),b=MX3(C0[2],C0[3],C1[1]); a=MX3(a,C1[2],C1[3]); \
      _Pragma("unroll") for(int r=4;r<16;r+=4){a=MX3(a,C0[r],C0[r+1]);b=MX3(b,C0[r+2],C0[r+3]);a=MX3(a,C1[r],C1[r+1]);b=MX3(b,C1[r+2],C1[r+3]);} \
      float rm=__builtin_fmaxf(a,b); { auto rr=__builtin_amdgcn_permlane32_swap(__float_as_uint(rm),__float_as_uint(rm),false,false); rm=__builtin_fmaxf(__uint_as_float(rr[0]),__uint_as_float(rr[1])); } \
      resc=false; \
      if(__builtin_expect(__any(rm>(float)THRL),0)){ const float dl=__builtin_fmaxf(rm,0.f); mhat+=dl; \
        _Pragma("unroll") for(int r=0;r<16;++r){C0[r]-=dl;C1[r]-=dl;} \
        _Pragma("unroll") for(int r=0;r<16;++r)negm[r]=-mhat; asm volatile("":"+v"(negm)); \
        const float f=__builtin_amdgcn_exp2f(-dl); l_reg*=f; if(hi==0)wsf[r32]=f; resc=true; } } \
    SBAR(); \
    GAPB(o[0]=__builtin_amdgcn_mfma_f32_32x32x16_bf16(PAF(0),VFR(0),o[0],0,0,0), C0,0); \
    GAPB(o[1]=__builtin_amdgcn_mfma_f32_32x32x16_bf16(PAF(0),VFR(4),o[1],0,0,0), C0,4); \
    KRD(GL,0); GAPB(o[0]=__builtin_amdgcn_mfma_f32_32x32x16_bf16(PAF(1),VFR(1),o[0],0,0,0), C0,8); \
    KRD(GL,1); GAPB(o[1]=__builtin_amdgcn_mfma_f32_32x32x16_bf16(PAF(1),VFR(5),o[1],0,0,0), C0,12); \
    KRD(GL,2); GAPB(o[0]=__builtin_amdgcn_mfma_f32_32x32x16_bf16(PAF(2),VFR(2),o[0],0,0,0), C1,0); \
    KRD(GL,3); GAPB(o[1]=__builtin_amdgcn_mfma_f32_32x32x16_bf16(PAF(2),VFR(6),o[1],0,0,0), C1,4); \
    GAPB(o[0]=__builtin_amdgcn_mfma_f32_32x32x16_bf16(PAF(3),VFR(3),o[0],0,0,0), C1,8); \
    GAPB(o[1]=__builtin_amdgcn_mfma_f32_32x32x16_bf16(PAF(3),VFR(7),o[1],0,0,0), C1,12); \
    }while(0)
  int t=1;
  for(;t+5<NT;t+=2){
    STEP(pB0,pB1,pA0,pA1,t,true,true,true);     WAIT_BAR(2); RESC(); ROT();
    STEP(pA0,pA1,pB0,pB1,t+1,true,true,true);   WAIT_BAR(2); RESC(); ROT();
  }
  #define ENDW(tt) do{ if((tt)+3<NT){WAIT_BAR(2);} else if((tt)+2<NT){WAIT_BAR(1);} else {WAIT_BAR(0);} }while(0)
  for(;t+1<NT;t+=2){
    STEP(pB0,pB1,pA0,pA1,t,(t+3<NT),(t+1<NT),(t+1<NT));       ENDW(t);   RESC(); ROT();
    STEP(pA0,pA1,pB0,pB1,t+1,(t+4<NT),(t+2<NT),(t+2<NT));     ENDW(t+1); RESC(); ROT();
  }
  STEP(pB0,pB1,pA0,pA1,NT-1,false,false,false); RESC();
  { float sacc=pB0[0]+pB0[1]; _Pragma("unroll") for(int r=2;r<16;++r)sacc+=pB0[r]; _Pragma("unroll") for(int r=0;r<16;++r)sacc+=pB1[r]; l_reg+=sacc;
    pw0=(u32x4){PKW(pB0,0),PKW(pB0,2),PKW(pB0,4),PKW(pB0,6)};pw1=(u32x4){PKW(pB0,8),PKW(pB0,10),PKW(pB0,12),PKW(pB0,14)};pw2=(u32x4){PKW(pB1,0),PKW(pB1,2),PKW(pB1,4),PKW(pB1,6)};pw3=(u32x4){PKW(pB1,8),PKW(pB1,10),PKW(pB1,12),PKW(pB1,14)};
    SBAR(); pv(o,vb0+sl_cur,PAF(0),PAF(1),PAF(2),PAF(3)); }
  #undef PKW
  #undef PAF
  #undef VFR
  #undef PIN
  #undef MX3
  #undef GAPA
  #undef GAPB
  #undef EX
  #undef VRD
  #undef KRD
  #undef STEP
  #undef ENDW
  {auto rr=__builtin_amdgcn_permlane32_swap(__float_as_uint(l_reg),__float_as_uint(l_reg),false,false);l_reg=__uint_as_float(rr[0])+__uint_as_float(rr[1]);}
  if(hi==0)wsf[32+r32]=l_reg;asm volatile("s_waitcnt lgkmcnt(0)":::"memory");
  float rli[16];
  #pragma unroll
  for(int r=0;r<16;++r)rli[r]=__builtin_amdgcn_rcpf(wsf[32+crow(r,hi)]);
  bf16*Ow=O+(rowbase+q0+wid*QBLK)*QP+h*D;
  { bf16*stg=(bf16*)(shm+LDS_OST)+wid*2048;
    #pragma unroll
    for(int r=0;r<16;++r){const int orow=crow(r,hi);
      #pragma unroll
      for(int d0=0;d0<2;++d0)stg[orow*64+d0*32+r32]=__float2bfloat16(o[d0][r]*rli[r]);}
    asm volatile("s_waitcnt lgkmcnt(0)":::"memory");
    #pragma unroll
    for(int i=0;i<4;++i){const int row=i*8+(lane>>3),ch=lane&7; const u32x4 v=*(const u32x4*)(stg+row*64+ch*8); *(u32x4*)(Ow+(long)row*QP+ch*8)=v;} }
  asm volatile("s_waitcnt lgkmcnt(0)\n\ts_barrier":::"memory");
  #undef DMA_K
  #undef DMA_V
  #undef START
  #undef RESC
  #undef ROT
}
constexpr int ATTN_LDS_BYTES=LDS_BYTES;
#undef SBAR
#undef WAIT_BAR
}

#define GRID_SYNC() do { asm volatile("s_waitcnt vmcnt(0) lgkmcnt(0)" ::: "memory"); grid.sync(); __builtin_amdgcn_fence(__ATOMIC_ACQUIRE, "agent"); asm volatile("s_waitcnt vmcnt(0)" ::: "memory"); } while (0)
#ifndef N_LAUNCH_MODE
#define N_LAUNCH_MODE 0
#endif
constexpr int N_PHASES = 2 + 6 * NLAYER;
constexpr int NWAVES = 8;
constexpr size_t MiB = 1u << 20;
constexpr size_t WL_IN = 0, WL_A = WL_IN + (size_t)INW * 1024, WL_B = WL_A + 1024 * 512, WL_MIX = WL_B + 1024 * 512, WL_UP = WL_MIX + 1024 * 1024,
                 WL_DOWN = WL_UP + 4096 * 1024, WL_SG = WL_DOWN + 1024 * 2048, WL_SIZE = WL_SG + 8 * 128 * 128;
static_assert(WL_SIZE * 2 * NLAYER <= 95 * MiB, "weights region");
constexpr size_t WS_ROPE = 0, WS_W = 1 * MiB, WS_XB = 96 * MiB + 4096, WS_QU = 289 * MiB, WS_K = 481 * MiB, WS_V = 505 * MiB, WS_VST = 529 * MiB,
                 WS_GA = 625 * MiB, WS_GB = 817 * MiB, WS_H2 = 625 * MiB, WS_SS = 1009 * MiB, WS_SSG = 1015 * MiB, WS_END = 1018 * MiB;
constexpr int LDS_BYTES = 147456, SG_SCR_OFF = 135168, BARST_OFF = 140288;
constexpr size_t WS_BAR = 65536, BAR_BYTES = 16384;


#define XB_TMO      128
#define XB_XCNT(j)  (256  + 64 * (j))
#define XB_XSUB(j)  (1280 + 64 * (j))
#define XB_XGEN(j)  (2304 + 64 * (j))
#define XB_TOP      3328
#define XB_TOPGEN   3392
#define XCD_BAR_WORDS 3456
#define XB_SPIN_CAP (1u << 22)
__device__ __forceinline__ unsigned xb_ld(unsigned* p)              { return __hip_atomic_load(p, __ATOMIC_RELAXED, __HIP_MEMORY_SCOPE_AGENT); }
__device__ __forceinline__ unsigned xb_add(unsigned* p, unsigned v) { return __hip_atomic_fetch_add(p, v, __ATOMIC_RELAXED, __HIP_MEMORY_SCOPE_AGENT); }
__device__ __forceinline__ unsigned xb_xcc_id() { return (unsigned)__builtin_amdgcn_s_getreg((3 << 11) | 20) & 0xFu; }
#define XB_SPIN(cond, bar) do { unsigned _sp = 0; while (cond) { __builtin_amdgcn_s_sleep(1); \
    if ((++_sp & 255u) == 0u) { if (xb_ld(&(bar)[XB_TMO])) break; if (_sp > XB_SPIN_CAP) { atomicAdd(&(bar)[XB_TMO], 1u); break; } } } } while (0)
struct XcdBarrier { unsigned* bar; unsigned x; volatile LAS unsigned* st; };
__device__ __forceinline__ XcdBarrier xcd_barrier_post(unsigned* bar, volatile LAS unsigned* st) {
    XcdBarrier b; b.bar = bar; b.x = xb_xcc_id(); b.st = st;
    if (threadIdx.x == 0) (void)xb_add(&bar[XB_XCNT(b.x)], 1u);
    return b;
}
__device__ __forceinline__ void xcd_barrier_complete(unsigned* bar, unsigned x, unsigned& nloc, unsigned& nx) {
    const unsigned G = gridDim.x * gridDim.y * gridDim.z;
    unsigned sum, cnt, mine, sp = 0u;
    for (;;) {
        sum = 0u; cnt = 0u; mine = 0u;
#pragma unroll
        for (unsigned j = 0; j < 16; ++j) { const unsigned c = xb_ld(&bar[XB_XCNT(j)]); sum += c; cnt += (c > 0u) ? 1u : 0u; mine = (j == x) ? c : mine; }
        if (sum == G) break;
        __builtin_amdgcn_s_sleep(1);
        if ((++sp & 255u) == 0u) { if (xb_ld(&bar[XB_TMO])) break; if (sp > XB_SPIN_CAP) { atomicAdd(&bar[XB_TMO], 1u); break; } }
    }
    nloc = mine > 0u ? mine : 1u; nx = cnt > 0u ? cnt : 1u;
}
__device__ __forceinline__ void xcd_barrier(const XcdBarrier& b) {
    asm volatile("s_waitcnt vmcnt(0)" ::: "memory");
    __syncthreads();
    if (threadIdx.x == 0) {
        unsigned* bar = b.bar;
        __builtin_amdgcn_s_waitcnt(0);
        unsigned nloc = b.st[0], nx = b.st[1];
        if (nloc == 0u) { xcd_barrier_complete(bar, b.x, nloc, nx); b.st[0] = nloc; b.st[1] = nx; }
        const unsigned old = xb_add(&bar[XB_XSUB(b.x)], 1u);
        const unsigned gen = old / nloc;
        if (old + 1u == (gen + 1u) * nloc) {
            __builtin_amdgcn_fence(__ATOMIC_RELEASE, "agent");
            asm volatile("s_waitcnt vmcnt(0)" ::: "memory");
            const unsigned og = xb_add(&bar[XB_TOP], 1u);
            const unsigned tg = og / nx;
            if (og + 1u == (tg + 1u) * nx) xb_add(&bar[XB_TOPGEN], 1u);
            else XB_SPIN(xb_ld(&bar[XB_TOPGEN]) == tg, bar);
            __builtin_amdgcn_fence(__ATOMIC_ACQUIRE, "agent");
            xb_add(&bar[XB_XGEN(b.x)], 1u);
            asm volatile("s_waitcnt vmcnt(0)" ::: "memory");
        } else {
            XB_SPIN(xb_ld(&bar[XB_XGEN(b.x)]) == gen, bar);
            __builtin_amdgcn_fence(__ATOMIC_ACQUIRE, "agent");
            asm volatile("s_waitcnt vmcnt(0)" ::: "memory");
        }
    }
    __syncthreads();
}

struct Args { const float* in[18]; float* out; unsigned char* ws; int ph_lo, ph_hi; };

__device__ __forceinline__ float wave_sum(float v) {
#pragma unroll
    for (int o = 1; o < 64; o <<= 1) v += __shfl_xor(v, o);
    return v;
}
__device__ __forceinline__ int invperm32(int cc) { return 16 * ((cc >> 2) & 1) + 4 * (cc >> 3) + (cc & 3); }
__device__ __forceinline__ int map_plain(int n) { return (n & ~31) + invperm32(n & 31); }
__device__ __forceinline__ int map_in(int n) {
    if (n < 512) { const int pn = n >> 8, hh = (n >> 6) & 3, d = n & 63; return 256 * pn + 128 * (d >> 5) + 32 * hh + (d & 31); }
    if (n < 768) { const int c = n - 512, isv = c >> 7, head = (c >> 6) & 1, d = c & 63, wc = 2 * isv + head; return 512 + 128 * (d >> 5) + 32 * wc + (d & 31); }
    return map_plain(n);
}
__device__ __forceinline__ int map_up(int n) { const int bj = n >> 11, c = n & 2047, pn = c >> 7, r = c & 127; return 256 * pn + 128 * bj + (r & ~31) + invperm32(r & 31); }

template <int MAP>
__device__ __forceinline__ void transpose_item(const float* W, const float* g, int K, int N, bf16_t* WT, LAS float* scr, int item, int lane) {
    const int nblk = N / 32, kb = item / nblk, nb = item % nblk, k0 = 64 * kb, n0 = 32 * nb;
#pragma unroll 8
    for (int i = 0; i < 32; ++i) { const int kk = 2 * i + (lane >> 5); float v = W[(size_t)(k0 + kk) * N + n0 + (lane & 31)]; if (g) v *= g[k0 + kk]; scr[kk * 33 + (lane & 31)] = v; }
    asm volatile("s_waitcnt lgkmcnt(0)" ::: "memory");
    const int c = lane & 7;
#pragma unroll
    for (int j = 0; j < 4; ++j) { const int n = (lane >> 3) + 8 * j; const LAS float* s = scr + (8 * c) * 33 + n;
        u32x4 o; o.x = cvt_pk_bf16(s[0 * 33], s[1 * 33]); o.y = cvt_pk_bf16(s[2 * 33], s[3 * 33]); o.z = cvt_pk_bf16(s[4 * 33], s[5 * 33]); o.w = cvt_pk_bf16(s[6 * 33], s[7 * 33]);
        const int nn = n0 + n; const int row = MAP == 0 ? map_plain(nn) : (MAP == 1 ? map_in(nn) : map_up(nn));
        *(u32x4*)(WT + (size_t)row * K + k0 + 8 * c) = o; }
    asm volatile("s_waitcnt lgkmcnt(0)" ::: "memory");
}

__device__ __forceinline__ void sincos_tab(float x, float& c, float& s) {
    const float n = rintf(x * 0.63661977236758134308f);
    float r = fmaf(-n, 1.5703125f, x); r = fmaf(-n, 4.83751296997070312500e-4f, r); r = fmaf(-n, 7.5497899548918821e-8f, r);
    const float r2 = r * r;
    const float sp = r + r * r2 * (-1.0f / 6 + r2 * (1.0f / 120 + r2 * (-1.0f / 5040 + r2 * (1.0f / 362880))));
    const float cp = 1.0f + r2 * (-0.5f + r2 * (1.0f / 24 + r2 * (-1.0f / 720 + r2 * (1.0f / 40320 + r2 * (-1.0f / 3628800)))));
    const int q = ((int)n) & 3;
    s = (q == 0) ? sp : (q == 1) ? cp : (q == 2) ? -sp : -cp;
    c = (q == 0) ? cp : (q == 1) ? -sp : (q == 2) ? -cp : sp;
}

__device__ __forceinline__ void sg_unit(int ch, int g, const bf16_t* VST, const float* ssg, const bf16_t* Wg, const float* sgb, const float* gsg, bf16_t* QU, LAS float* scr, int lane) {
    asm volatile("" : "+v"(lane));
    const int fr = lane & 15, fq = lane >> 4;
#pragma unroll
    for (int hh = 0; hh < 2; ++hh) { const int p = lane + 64 * hh; const float* sp = ssg + (size_t)(ch * 128 + p) * 8; const f32x4 a = *(const f32x4*)sp, b = *(const f32x4*)(sp + 4);
        const float s = ((a.x + a.y) + (a.z + a.w)) + ((b.x + b.y) + (b.z + b.w)); scr[p] = __builtin_amdgcn_rsqf(s * (1.0f / 512.0f) + EPS); }
    asm volatile("s_waitcnt lgkmcnt(0)" ::: "memory");
    f32x4 acc[8][4];
#pragma unroll
    for (int pt = 0; pt < 8; ++pt)
#pragma unroll
        for (int ct = 0; ct < 4; ++ct) acc[pt][ct] = (f32x4){0.f, 0.f, 0.f, 0.f};
    const bf16_t* vbase = VST + ((size_t)ch * 512 + g * 64) * 128;
    const bf16_t* wbase = Wg + (size_t)g * 128 * 128;
#pragma unroll 1
    for (int kk = 0; kk < 4; ++kk) {
        const int k0 = kk * 32 + 8 * fq;
        bf16x8 af[4];
#pragma unroll
        for (int ct = 0; ct < 4; ++ct) af[ct] = *(const bf16x8*)(vbase + (size_t)(ct * 16 + fr) * 128 + k0);
        float r[8];
#pragma unroll
        for (int e = 0; e < 8; ++e) r[e] = scr[k0 + e];
#pragma unroll
        for (int pt = 0; pt < 8; ++pt) {
            const u32x4 w = *(const u32x4*)(wbase + (size_t)(pt * 16 + fr) * 128 + k0);
            u32x4 ws; ws.x = cvt_pk_bf16(bf_lo(w.x) * r[0], bf_hi(w.x) * r[1]); ws.y = cvt_pk_bf16(bf_lo(w.y) * r[2], bf_hi(w.y) * r[3]);
            ws.z = cvt_pk_bf16(bf_lo(w.z) * r[4], bf_hi(w.z) * r[5]); ws.w = cvt_pk_bf16(bf_lo(w.w) * r[6], bf_hi(w.w) * r[7]);
            const bf16x8 bfz = __builtin_bit_cast(bf16x8, ws);
#pragma unroll
            for (int ct = 0; ct < 4; ++ct) acc[pt][ct] = __builtin_amdgcn_mfma_f32_16x16x32_bf16(af[ct], bfz, acc[pt][ct], 0, 0, 0);
        }
    }
    f32x4 gs[4];
#pragma unroll
    for (int ct = 0; ct < 4; ++ct) gs[ct] = *(const f32x4*)(gsg + g * 64 + ct * 16 + 4 * fq);
#pragma unroll
    for (int pt = 0; pt < 8; ++pt) {
        const int p = pt * 16 + fr; const float b = sgb[g * 128 + p];
        bf16_t* up = QU + (size_t)(ch * 128 + p) * 1024 + 512 + g * 64 + 4 * fq;
#pragma unroll
        for (int ct = 0; ct < 4; ++ct) {
            const u32x2 uu = *(const u32x2*)(up + ct * 16);
            const f32x4 sp = acc[pt][ct] * gs[ct] + b;
            u32x2 w; w.x = cvt_pk_bf16(bf_lo(uu.x) * sp.x, bf_hi(uu.x) * sp.y); w.y = cvt_pk_bf16(bf_lo(uu.y) * sp.z, bf_hi(uu.y) * sp.w);
            *(u32x2*)(up + ct * 16) = w;
        }
    }
    asm volatile("s_waitcnt lgkmcnt(0)" ::: "memory");
}

__global__ void __launch_bounds__(NWAVES * 64, 2) fwd_megakernel(Args args) {
    extern __shared__ __attribute__((aligned(16))) unsigned char lds[];
    cg::grid_group grid = cg::this_grid();
    LAS unsigned char* L = (LAS unsigned char*)lds;
    volatile LAS unsigned* barst = (volatile LAS unsigned*)(L + BARST_OFF);
    if (threadIdx.x < 2) barst[threadIdx.x] = 0u;
    __syncthreads();
    const XcdBarrier xbar = xcd_barrier_post((unsigned*)(args.ws + WS_BAR), barst);
    const int G = gridDim.x, bx = blockIdx.x;
    const int vcu = (G % 8 == 0) ? (bx % 8) * (G / 8) + bx / 8 : bx;
    const int NGW = G * NWAVES;
    unsigned char* ws = args.ws;
    const float* x_prompt = args.in[0]; const float* x_sample = args.in[1];
    const float* attn_norm_g = args.in[2]; const float* w_in = args.in[3]; const float* q_norm_g = args.in[4]; const float* k_norm_g = args.in[5];
    const float* sg_norm_g = args.in[6]; const float* sg_w = args.in[7]; const float* sg_b = args.in[8]; const float* w_branch_a = args.in[9];
    const float* w_branch_b = args.in[10]; const float* w_mix_out = args.in[11]; const float* ffn_norm_g = args.in[12]; const float* w_up = args.in[13];
    const float* conv_w = args.in[14]; const float* conv_b = args.in[15]; const float* w_down = args.in[16]; const float* final_norm_g = args.in[17];
    float* out = args.out;
    float* rope = (float*)(ws + WS_ROPE);
    bf16_t* Wall = (bf16_t*)(ws + WS_W);
    bf16_t* XB = (bf16_t*)(ws + WS_XB); bf16_t* QU = (bf16_t*)(ws + WS_QU); bf16_t* KB = (bf16_t*)(ws + WS_K); bf16_t* VB = (bf16_t*)(ws + WS_V);
    bf16_t* VST = (bf16_t*)(ws + WS_VST); bf16_t* GA = (bf16_t*)(ws + WS_GA); bf16_t* GB = (bf16_t*)(ws + WS_GB); bf16_t* H2 = (bf16_t*)(ws + WS_H2);
    float* SSQ = (float*)(ws + WS_SS); float* SSG = (float*)(ws + WS_SSG);

    for (int p = args.ph_lo; p < args.ph_hi; ++p) {
    if (p > args.ph_lo) { if (p == 1) GRID_SYNC(); else xcd_barrier(xbar); }
    int tid_ = threadIdx.x; asm volatile("" : "+v"(tid_));
    const int tid = tid_, lane = tid & 63, wave = __builtin_amdgcn_readfirstlane(tid >> 6);
    const int gw = vcu * NWAVES + wave;
    if (p == 0) {
        LAS float* scr = (LAS float*)(L + wave * 16384);
        constexpr int I_IN = 16 * (INW / 32), I_A = 8 * 32, I_MIX = 16 * 32, I_UP = 16 * 128, I_DOWN = 32 * 32, I_L = I_IN + 2 * I_A + I_MIX + I_UP + I_DOWN;
        for (int it = gw; it < I_L * NLAYER; it += NGW) {
            const int l = it / I_L; int r = it % I_L; bf16_t* wl = Wall + (size_t)l * WL_SIZE;
            if (r < I_IN) { transpose_item<1>(w_in + (size_t)l * 1024 * INW, attn_norm_g + l * 1024, 1024, INW, wl + WL_IN, scr, r, lane); continue; } r -= I_IN;
            if (r < I_A) { transpose_item<0>(w_branch_a + (size_t)l * 512 * 1024, nullptr, 512, 1024, wl + WL_A, scr, r, lane); continue; } r -= I_A;
            if (r < I_A) { transpose_item<0>(w_branch_b + (size_t)l * 512 * 1024, nullptr, 512, 1024, wl + WL_B, scr, r, lane); continue; } r -= I_A;
            if (r < I_MIX) { transpose_item<0>(w_mix_out + (size_t)l * 1024 * 1024, nullptr, 1024, 1024, wl + WL_MIX, scr, r, lane); continue; } r -= I_MIX;
            if (r < I_UP) { transpose_item<2>(w_up + (size_t)l * 1024 * 4096, ffn_norm_g + l * 1024, 1024, 4096, wl + WL_UP, scr, r, lane); continue; } r -= I_UP;
            transpose_item<0>(w_down + (size_t)l * 2048 * 1024, nullptr, 2048, 1024, wl + WL_DOWN, scr, r, lane);
        }
        for (int i = gw * 64 + lane; i < NLAYER * 8 * 128 * 128 / 4; i += NGW * 64) {
            const int l = i / (8 * 128 * 128 / 4), r = i % (8 * 128 * 128 / 4);
            const f32x4 v = *(const f32x4*)(sg_w + (size_t)l * 131072 + (size_t)r * 4);
            u32x2 w; w.x = cvt_pk_bf16(v.x, v.y); w.y = cvt_pk_bf16(v.z, v.w);
            *(u32x2*)(Wall + (size_t)l * WL_SIZE + WL_SG + (size_t)r * 4) = w;
        }
        for (int i = gw * 64 + lane; i < 128 * 16; i += NGW * 64) {
            const int pos = i >> 4, f = i & 15; float fr_ = 1.0f; for (int k = 0; k < f; ++k) fr_ *= 0.56234132519034907f;
            float c, s; sincos_tab((float)pos * fr_, c, s); rope[2 * i] = c; rope[2 * i + 1] = s;
        }
        for (int i = gw * 64 + lane; i < 257 * 128; i += NGW * 64) {
            const int r = i / 128, c = i % 128; const long row = (r == 0) ? -1 : (long)M_TOK + r - 1;
            *(u32x4*)(XB + row * 1024 + c * 8) = (u32x4){0u, 0u, 0u, 0u};
        }
        for (int m0 = gw; m0 < M_TOK; m0 += 2 * NGW) {
            const int nr = (m0 + NGW < M_TOK) ? 2 : 1;
            f32x4 v[2][4]; float sq[2];
#pragma unroll
            for (int r = 0; r < 2; ++r) { const int m = (r < nr) ? m0 + r * NGW : m0;
                const float* xr = (m < NPROMPT) ? x_prompt + (size_t)m * 1024 : x_sample + (size_t)(m - NPROMPT) * 1024; float s = 0.f;
#pragma unroll
                for (int j = 0; j < 4; ++j) { v[r][j] = *(const f32x4*)(xr + 4 * lane + 256 * j); s += (v[r][j].x * v[r][j].x + v[r][j].y * v[r][j].y) + (v[r][j].z * v[r][j].z + v[r][j].w * v[r][j].w); }
                sq[r] = s; }
#pragma unroll
            for (int r = 0; r < 2; ++r) if (r < nr) { const int m = m0 + r * NGW; const float s = wave_sum(sq[r]);
#pragma unroll
                for (int j = 0; j < 4; ++j) { u32x2 w; w.x = cvt_pk_bf16(v[r][j].x, v[r][j].y); w.y = cvt_pk_bf16(v[r][j].z, v[r][j].w); *(u32x2*)(XB + (size_t)m * 1024 + 4 * lane + 256 * j) = w; }
                if (lane < 16) SSQ[(size_t)m * 16 + lane] = (lane == 0) ? s : 0.f; }
        }
    }
    else if (p < N_PHASES - 1) {
        const int l = (p - 1) / 6, k = (p - 1) % 6;
        const bf16_t* wl = Wall + (size_t)l * WL_SIZE;
        if (k == 0) {
            pg8::Gemm g{XB, wl + WL_IN, 1024, 1024, 1024, 0, 0, 256, 128, 0};
            { pg8::StaticOrder S; S.init(M_TOK / 256, 3, 1, G, bx, 0);
              pg8::EpiQKV E{SSQ, q_norm_g + l * 64, k_norm_g + l * 64, rope, QU, KB, VB};
              pg8::gemm_phase<pg8::EpiQKV, 1>(L, g, S, E); }
            { pg8::StaticOrder S; S.init(M_TOK / 256, 2, 1, G, bx, 5);
              pg8::EpiVS E{SSQ, VST, SSG};
              pg8::gemm_phase<pg8::EpiVS, 1>(L, g, S, E); }
            { pg8::StaticOrder S; S.init(M_TOK / 256, 10, 1, G, bx, 3, 2, 7);
              pg8::EpiEW E{SSQ, QU, GA, GB};
              pg8::Gemm gn = g; gn.wstride = 0;
              pg8::gemm_phase<pg8::EpiEW, 1>(L, gn, S, E); }
        }
        else if (k == 1) {
            LAS float* scr = (LAS float*)(L + SG_SCR_OFF) + wave * 128;
            for (int u = gw; u < 768 * 8; u += NGW)
                sg_unit(u >> 3, u & 7, VST, SSG, wl + WL_SG, sg_b + l * 1024, sg_norm_g + l * 512, QU, scr, lane);
            for (int u = bx; u < 3072; u += G) {
                const int i = u >> 8, c = u & 255, x = c & 7, w = c >> 3;
                long rowbase; int seq, h, q0;
                if (i < 4) { const int idx = w * 4 + i; rowbase = (long)(x >> 1) * SEQ_P; seq = SEQ_P; h = (x & 1) * 4 + (idx >> 5); q0 = (idx & 31) * 256; }
                else { const int pair = 8 * x + (i - 4); rowbase = (long)NPROMPT + (long)(pair >> 1) * SEQ_S; seq = SEQ_S; h = (pair & 1) * 4 + (w >> 3); q0 = (w & 7) * 256; }
                attn_body::attn_unit<8>(rowbase, seq, h, q0, (const attn_body::bf16*)QU, (const attn_body::bf16*)KB, (const attn_body::bf16*)VB, (attn_body::bf16*)QU, (char*)lds);
            }
        }
        else if (k == 2) {
            pg8::Gemm g{QU, wl + WL_A, 1024, 512, 512, 512 * 2, (long)(WL_B - WL_A) * 2, 256, 0, 0};
            pg8::StaticOrder S; S.init(M_TOK / 256, 4, 2, G, bx);
            pg8::EpiMerge E{GA, GB};
            pg8::gemm_phase<pg8::EpiMerge, 2>(L, g, S, E);
        }
        else if (k == 3) {
            pg8::Gemm g{GA, wl + WL_MIX, 1024, 1024, 1024, 0, 0, 256, 0, 0};
            pg8::StaticOrder S; S.init(M_TOK / 256, 4, 1, G, bx);
            pg8::EpiRes E{x_prompt, x_sample, l == 0 ? 1 : 0, out, XB, SSQ};
            pg8::gemm_phase<pg8::EpiRes, 1>(L, g, S, E);
        }
        else if (k == 4) {
            pg8::Gemm g{XB, wl + WL_UP, 1024, 1024, 1024, 0, 0, 252, 126, -1};
            pg8::StaticOrder S; S.init((M_TOK + 251) / 252, 16, 1, G, bx);
            pg8::EpiUp E{SSQ, conv_w + (size_t)l * 3 * 4096, conv_b + (size_t)l * 4096, H2};
            pg8::gemm_phase<pg8::EpiUp, 1>(L, g, S, E);
        }
        else {
            pg8::Gemm g{H2, wl + WL_DOWN, 2048, 2048, 2048, 0, 0, 256, 0, 0};
            pg8::StaticOrder S; S.init(M_TOK / 256, 4, 1, G, bx);
            pg8::EpiRes E{x_prompt, x_sample, 0, out, XB, SSQ};
            pg8::gemm_phase<pg8::EpiRes, 1>(L, g, S, E);
        }
    } else
    {
        f32x4 gv[4];
#pragma unroll
        for (int j = 0; j < 4; ++j) gv[j] = *(const f32x4*)(final_norm_g + 4 * lane + 256 * j);
        for (int m = gw; m < M_TOK; m += 2 * NGW) {
            const int m2 = (m + NGW < M_TOK) ? m + NGW : m;
            float* xr = out + (size_t)m * 1024; float* xr2 = out + (size_t)m2 * 1024;
            const float sp = (lane < 16) ? SSQ[(size_t)m * 16 + lane] : 0.f, sp2 = (lane < 16) ? SSQ[(size_t)m2 * 16 + lane] : 0.f;
            f32x4 v[4], w[4];
#pragma unroll
            for (int j = 0; j < 4; ++j) { v[j] = *(const f32x4*)(xr + 4 * lane + 256 * j); w[j] = *(const f32x4*)(xr2 + 4 * lane + 256 * j); }
            const float rs = __builtin_amdgcn_rsqf(wave_sum(sp) * (1.0f / DMOD) + EPS), rs2 = __builtin_amdgcn_rsqf(wave_sum(sp2) * (1.0f / DMOD) + EPS);
#pragma unroll
            for (int j = 0; j < 4; ++j) { *(f32x4*)(xr + 4 * lane + 256 * j) = v[j] * gv[j] * rs; if (m2 != m) *(f32x4*)(xr2 + 4 * lane + 256 * j) = w[j] * gv[j] * rs2; }
        }
    }
    }
}

extern "C" void kernel_launch(void* const* d_in, const int* in_sizes, int n_in, void* d_out, int out_size, void* d_ws, size_t ws_size, hipStream_t stream) {
    static int grid = 0;
    if (grid == 0) {
        if (n_in != 18 || out_size != M_TOK * DMOD || ws_size < WS_END) { fprintf(stderr, "kernel_launch: unexpected shapes (n_in %d out %d ws %zu)\n", n_in, out_size, ws_size); grid = -1; return; }
        int dev = 0, cus = 0, per_cu = 0;
        (void)hipGetDevice(&dev); (void)hipDeviceGetAttribute(&cus, hipDeviceAttributeMultiprocessorCount, dev);
        (void)hipFuncSetAttribute((const void*)fwd_megakernel, hipFuncAttributeMaxDynamicSharedMemorySize, LDS_BYTES);
        (void)hipOccupancyMaxActiveBlocksPerMultiprocessor(&per_cu, (const void*)fwd_megakernel, NWAVES * 64, LDS_BYTES);
        if (per_cu < 1) { fprintf(stderr, "kernel_launch: occupancy query says %d blocks/CU\n", per_cu); per_cu = 1; }
        (void)hipGetLastError();
        grid = cus * 1;
    }
    if (grid < 0) return;
    (void)hipMemsetAsync((char*)d_ws + WS_BAR, 0, BAR_BYTES, stream);
    Args a{};
    for (int i = 0; i < 18; ++i) a.in[i] = (const float*)d_in[i];
    a.out = (float*)d_out; a.ws = (unsigned char*)d_ws;
    if (N_LAUNCH_MODE == 0) {
        a.ph_lo = 0; a.ph_hi = N_PHASES;
        void* params[] = {&a};
        hipError_t e = hipLaunchCooperativeKernel((const void*)fwd_megakernel, dim3(grid), dim3(NWAVES * 64), params, LDS_BYTES, stream);
        if (e != hipSuccess) fprintf(stderr, "cooperative launch failed: %s (grid %d)\n", hipGetErrorString(e), grid);
    } else {
        for (int p = 0; p < N_PHASES; ++p) { a.ph_lo = p; a.ph_hi = p + 1;
            hipLaunchKernelGGL(fwd_megakernel, dim3(grid), dim3(NWAVES * 64), LDS_BYTES, stream, a); }
    }
}
```

```cpp
#include <hip/hip_runtime.h>
#include <hip/hip_cooperative_groups.h>
#include <hip/hip_bf16.h>
#include <cstdio>
#include <cstdint>
#include <cmath>
namespace cg = cooperative_groups;

constexpr int M_TOK = 98304, NPROMPT = 32768, SEQ_P = 8192, SEQ_S = 2048;
constexpr int DMOD = 1024, INW = 3840, DFF = 2048, NLAYER = 4;
constexpr float EPS = 1e-6f;
constexpr float C2 = 0.125f * 1.4426950408889634f;

#define LAS __attribute__((address_space(3)))
typedef unsigned short bf16_t;
typedef short bf16x8 __attribute__((ext_vector_type(8)));
typedef float f32x4 __attribute__((ext_vector_type(4)));
typedef float f32x2 __attribute__((ext_vector_type(2)));
typedef unsigned u32x4 __attribute__((ext_vector_type(4)));
typedef unsigned u32x2 __attribute__((ext_vector_type(2)));

typedef __bf16 bf16x2_t_ __attribute__((ext_vector_type(2)));
__device__ __forceinline__ unsigned cvt_pk_bf16(float lo, float hi) { f32x2 v = {lo, hi}; bf16x2_t_ b = __builtin_convertvector(v, bf16x2_t_); return __builtin_bit_cast(unsigned, b); }
__device__ __forceinline__ float bf_lo(unsigned w) { return __uint_as_float(w << 16); }
__device__ __forceinline__ float bf_hi(unsigned w) { return __uint_as_float(w & 0xffff0000u); }
__device__ __forceinline__ float gelu_t(float x) {
    const float u = x * (0.7978845608f + 0.0356774081f * x * x);
    const float e = __builtin_amdgcn_exp2f(u * -2.8853900818f);
    return x * __builtin_amdgcn_rcpf(1.0f + e);
}
__device__ __forceinline__ float sigmoid_f(float x) { return __builtin_amdgcn_rcpf(1.0f + __builtin_amdgcn_exp2f(x * -1.4426950409f)); }
__device__ __forceinline__ float dpp_shr1(float v) { return __int_as_float(__builtin_amdgcn_update_dpp(0, __float_as_int(v), 0x111, 0xF, 0xF, true)); }
__device__ __forceinline__ float dpp_shl1(float v) { return __int_as_float(__builtin_amdgcn_update_dpp(0, __float_as_int(v), 0x101, 0xF, 0xF, true)); }

namespace pg8 {
constexpr int BM = 256, BK = 64, HALF = 128, HTB = HALF * BK * 2, STAGE_BYTES = 8 * HTB, NXCD = 8, WGM = 8;
__host__ __device__ __forceinline__ int lds_byte(int r, int c) { const int st = (r >> 4) * 2 + (c >> 5), rr = r & 15, cc = c & 31, ob = rr * 64 + cc * 2; return st * 1024 + (ob ^ (((ob >> 9) & 1) << 5)); }
__host__ __device__ __forceinline__ void stage_rc(int b, int& R, int& C) { const int st = b / 1024, sb = b % 1024, swz = sb ^ (((sb >> 9) & 1) << 5); R = (st >> 1) * 16 + swz / 64; C = (st & 1) * 32 + (swz % 64) / 2; }

struct Unit { int pm, pn, part; };
struct Gemm { const bf16_t* A; const bf16_t* Bt; int lda, ldb, K; long partA, partB; int tstride, wstride, shift; };

struct StaticOrder {
    int nM, nN, nwg, G, c, parts, pn_lo, pn_split, pn_hi;
    __device__ void init(int nM_, int nN_, int parts_, int G_, int c_, int pn_lo_ = 0, int pn_split_ = 1 << 20, int pn_hi_ = 0) { nM = nM_; nN = nN_; nwg = nM * nN; G = G_; c = c_; parts = parts_; pn_lo = pn_lo_; pn_split = pn_split_; pn_hi = pn_hi_; }
    __device__ bool next(int i, Unit& u) const {
        const int it = (parts == 2) ? (i >> 1) : i; u.part = (parts == 2) ? (i & 1) : 0;
        const long L = (long)it * G + c; if (L >= nwg) return false;
        int wgid = (int)L; { const int q = nwg / NXCD, r = nwg % NXCD, xcd = wgid % NXCD, off = wgid / NXCD; wgid = (xcd < r ? xcd * (q + 1) : r * (q + 1) + (xcd - r) * q) + off; }
        const int nig = WGM * nN, gid = wgid / nig, fm = gid * WGM, gsz = (nM - fm) < WGM ? (nM - fm) : WGM;
        u.pm = fm + ((wgid % nig) % gsz); { const int ix = (wgid % nig) / gsz; u.pn = ix < pn_split ? pn_lo + ix : pn_hi + (ix - pn_split); } return true;
    }
};

template <class Epi, int PARTS>
__device__ __forceinline__ void gemm_phase(LAS unsigned char* lds, const Gemm g, const StaticOrder& S, const Epi& E) {
    int tid_ = threadIdx.x; asm volatile("" : "+v"(tid_));
    const int tid = tid_, wid = __builtin_amdgcn_readfirstlane(tid >> 6), lane = tid & 63, wr = wid >> 2, wc = wid & 3, fr = lane & 15, fq = lane >> 4;
    const int K = g.K, nt = K / BK;
    unsigned voffA[2], voffB[2];
#pragma unroll
    for (int i = 0; i < 2; ++i) { int R, C; stage_rc(tid * 16 + i * 8192, R, C);
        const int TR = g.wstride ? g.wstride * (R >> 6) + 8 * (R & 15) + ((R >> 4) & 3) : R;
        voffA[i] = (unsigned)(TR * g.lda + C) * 2u; voffB[i] = (unsigned)(R * g.ldb + C) * 2u; }
    const size_t kstep = (size_t)(BK * 2);
    const size_t hstepA = (size_t)(g.wstride ? 4 : HALF) * g.lda * 2, hstepB = (size_t)HALF * g.ldb * 2;
    const unsigned ldsw = (unsigned)wid * 1024u;
    const int aoff = lds_byte(wr * 64 + fr, fq * 8), boff = lds_byte(wc * 32 + fr, fq * 8);
#define PG8_SA(b, h) (((b) * 2 + (h)) * HTB)
#define PG8_SB(b, h) ((4 + (b) * 2 + (h)) * HTB)
#define PG8_STAGE(bufoff, gbase, voff) do { _Pragma("unroll") for (int _i = 0; _i < 2; ++_i) \
        __builtin_amdgcn_global_load_lds((const unsigned*)((const char*)(gbase) + (voff)[_i]), (LAS unsigned*)(lds + (bufoff) + ldsw + _i * 8192), 16, 0, 0); } while (0)
#define PG8_STAGEA(bufoff, gbase, voff) do { _Pragma("unroll") for (int _i = 0; _i < 2; ++_i) \
        __builtin_amdgcn_global_load_lds((const unsigned*)((const char*)(gbase) + (voff)[_i]), (LAS unsigned*)(lds + (bufoff) + ldsw + _i * 8192), 16, 0, 0); } while (0)
#define PG8_LDA(dst, b, h) do { _Pragma("unroll") for (int m = 0; m < 4; ++m) _Pragma("unroll") for (int k = 0; k < 2; ++k) dst[m][k] = *(const LAS bf16x8*)(lds + PG8_SA(b, h) + aoff + m * 2048 + k * 1024); } while (0)
#define PG8_LDB(dst, b, h) do { _Pragma("unroll") for (int n = 0; n < 2; ++n) _Pragma("unroll") for (int k = 0; k < 2; ++k) dst[n][k] = *(const LAS bf16x8*)(lds + PG8_SB(b, h) + boff + n * 2048 + k * 1024); } while (0)
#define PG8_MMA(ai, bj, At, Bt) do { __builtin_amdgcn_s_setprio(1); _Pragma("unroll") for (int m = 0; m < 4; ++m) _Pragma("unroll") for (int n = 0; n < 2; ++n) _Pragma("unroll") for (int k = 0; k < 2; ++k) \
        acc[ai][bj][m][n] = __builtin_amdgcn_mfma_f32_16x16x32_bf16(Bt[n][k], At[m][k], acc[ai][bj][m][n], 0, 0, 0); __builtin_amdgcn_s_setprio(0); } while (0)
#define PG8_WAIT_V(n) asm volatile("s_waitcnt vmcnt(" #n ")" ::: "memory")
#define PG8_WAIT_L(n) asm volatile("s_waitcnt lgkmcnt(" #n ")" ::: "memory")
#define PG8_BAR __builtin_amdgcn_s_barrier()
#define PG8_SCHED __builtin_amdgcn_sched_barrier(0)
#define PG8_UA(u) ((const char*)g.A + (size_t)(u).part * g.partA + ((long)(u).pm * g.tstride + g.shift) * (long)g.lda * 2)
#define PG8_UB(u) ((const char*)g.Bt + (size_t)(u).part * g.partB + (size_t)(u).pn * 256 * g.ldb * 2)
    Unit cur, nxt; int ui = 0;
    if (!S.next(0, cur)) return;
    f32x4 acc[2][2][4][2];
#pragma unroll
    for (int a = 0; a < 2; ++a)
#pragma unroll
        for (int b = 0; b < 2; ++b)
#pragma unroll
            for (int m = 0; m < 4; ++m)
#pragma unroll
                for (int n = 0; n < 2; ++n) acc[a][b][m][n] = (f32x4){0.f, 0.f, 0.f, 0.f};
    bf16x8 At[4][2], B0[2][2], B1[2][2];
    const char* cA = PG8_UA(cur); const char* cB = PG8_UB(cur);
    PG8_STAGE(PG8_SB(0, 0), cB, voffB); PG8_STAGE(PG8_SB(0, 1), cB + hstepB, voffB); PG8_STAGEA(PG8_SA(0, 0), cA, voffA); PG8_STAGEA(PG8_SA(0, 1), cA + hstepA, voffA);
    if (wr == 1) PG8_BAR;
    PG8_WAIT_V(2); PG8_BAR;
    PG8_STAGE(PG8_SB(1, 0), cB + kstep, voffB); PG8_STAGEA(PG8_SA(1, 0), cA + kstep, voffA); PG8_STAGE(PG8_SB(1, 1), cB + hstepB + kstep, voffB);
    PG8_WAIT_V(6); PG8_BAR;
    for (;;) {
        const bool has_next = S.next(ui + 1, nxt);
        const char* nA = has_next ? PG8_UA(nxt) : cA; const char* nB = has_next ? PG8_UB(nxt) : cB;
        for (int t = 0; t < nt; t += 2) {
            const bool last = (t == nt - 2);
            const char* a1 = cA + (size_t)(t + 1) * kstep;
            const char* a2 = last ? nA : cA + (size_t)(t + 2) * kstep; const char* b2 = last ? nB : cB + (size_t)(t + 2) * kstep;
            const char* a3 = a2 + kstep; const char* b3 = b2 + kstep;
            PG8_LDB(B0, 0, 0); PG8_LDB(B1, 0, 1); PG8_SCHED; PG8_LDA(At, 0, 0); PG8_STAGEA(PG8_SA(1, 1), a1 + hstepA, voffA);
            PG8_WAIT_V(8); PG8_WAIT_L(0); PG8_BAR; PG8_MMA(0, 0, At, B0); PG8_MMA(0, 1, At, B1); PG8_BAR; PG8_SCHED;
            PG8_LDA(At, 0, 1); PG8_STAGE(PG8_SB(0, 0), b2, voffB); PG8_STAGE(PG8_SB(0, 1), b2 + hstepB, voffB); PG8_STAGEA(PG8_SA(0, 0), a2, voffA);
            PG8_WAIT_V(8); PG8_WAIT_L(0); PG8_BAR; PG8_MMA(1, 0, At, B0); PG8_MMA(1, 1, At, B1); PG8_BAR; PG8_SCHED;
            PG8_LDB(B0, 1, 0); PG8_LDB(B1, 1, 1); PG8_SCHED; PG8_LDA(At, 1, 0); PG8_STAGEA(PG8_SA(0, 1), a2 + hstepA, voffA);
            PG8_WAIT_V(8); PG8_WAIT_L(0); PG8_BAR; PG8_MMA(0, 0, At, B0); PG8_MMA(0, 1, At, B1); PG8_BAR; PG8_SCHED;
            PG8_LDA(At, 1, 1); PG8_STAGE(PG8_SB(1, 0), b3, voffB); PG8_STAGE(PG8_SB(1, 1), b3 + hstepB, voffB); PG8_STAGEA(PG8_SA(1, 0), a3, voffA);
            PG8_WAIT_V(8); PG8_WAIT_L(0); PG8_BAR; PG8_MMA(1, 0, At, B0); PG8_MMA(1, 1, At, B1); PG8_BAR; PG8_SCHED;
        }
        if (wr == 0) PG8_BAR;
        E(acc, cur, wr, wc, fr, fq);
        if (!has_next) break;
        if (PARTS == 1 || nxt.part == 0) {
#pragma unroll
        for (int a = 0; a < 2; ++a)
#pragma unroll
            for (int b = 0; b < 2; ++b)
#pragma unroll
                for (int m = 0; m < 4; ++m)
#pragma unroll
                    for (int n = 0; n < 2; ++n) acc[a][b][m][n] = (f32x4){0.f, 0.f, 0.f, 0.f};
        }
        cur = nxt; cA = nA; cB = nB; ++ui;
        if (wr == 1) PG8_BAR;
    }
    PG8_WAIT_V(0);
    PG8_BAR;
#undef PG8_SA
#undef PG8_SB
#undef PG8_STAGE
#undef PG8_STAGEA
#undef PG8_LDA
#undef PG8_LDB
#undef PG8_MMA
#undef PG8_WAIT_V
#undef PG8_WAIT_L
#undef PG8_BAR
#undef PG8_SCHED
#undef PG8_UA
#undef PG8_UB
}

__device__ __forceinline__ void load_rs8(const float* ss, int t0, int fq, float (&rs)[8], int tmax) {
#pragma unroll
    for (int j = 0; j < 8; ++j) { int t = t0 + j; t = t < 0 ? 0 : (t > tmax ? tmax : t);
        const f32x4 p = *(const f32x4*)(ss + (size_t)t * 16 + 4 * fq); float s = (p.x + p.y) + (p.z + p.w);
        s += __shfl_xor(s, 16); s += __shfl_xor(s, 32); rs[j] = __builtin_amdgcn_rsqf(s * (1.0f / DMOD) + EPS); }
}

struct EpiQKV {
    const float* ss; const float* qg; const float* kg; const float* rope;
    bf16_t* QU; bf16_t* Kb; bf16_t* Vb;
    __device__ __forceinline__ void operator()(f32x4 (&acc)[2][2][4][2], const Unit& u, int wr, int wc, int fr, int fq) const {
        const int t0 = u.pm * 256 + wr * 128 + fr * 8;
        { float rs[8]; load_rs8(ss, t0, fq, rs, M_TOK - 1);
#pragma unroll
          for (int ai = 0; ai < 2; ++ai)
#pragma unroll
            for (int m = 0; m < 4; ++m)
#pragma unroll
                for (int bj = 0; bj < 2; ++bj)
#pragma unroll
                    for (int n = 0; n < 2; ++n) acc[ai][bj][m][n] = acc[ai][bj][m][n] * rs[4 * ai + m]; }
        const int pn = u.pn;
        {
            const bool isq = pn < 2;
            if (isq || wc < 2) {
                const float* gp = isq ? qg : kg; const float osc = isq ? C2 : 1.0f;
                f32x4 gv[2][2];
#pragma unroll
                for (int bj = 0; bj < 2; ++bj)
#pragma unroll
                    for (int n = 0; n < 2; ++n) gv[bj][n] = *(const f32x4*)(gp + 32 * bj + 16 * n + 4 * fq);
                const int smask = (t0 < NPROMPT) ? (SEQ_P - 1) : (SEQ_S - 1);
                const int prow = (t0 & smask) >> 6;
                const f32x4 rr0 = *(const f32x4*)(rope + (prow * 16 + 4 * fq) * 2), rr1 = *(const f32x4*)(rope + (prow * 16 + 4 * fq) * 2 + 4);
                bf16_t* dst = isq ? (QU + (size_t)t0 * 1024 + (4 * pn + wc) * 64) : (Kb + (size_t)t0 * 128 + wc * 64);
                const int pitch = isq ? 1024 : 128;
#pragma unroll
                for (int ai = 0; ai < 2; ++ai)
#pragma unroll
                    for (int m = 0; m < 4; ++m) {
                        const int j = 4 * ai + m;
                        float sq = 0.f;
#pragma unroll
                        for (int bj = 0; bj < 2; ++bj)
#pragma unroll
                            for (int n = 0; n < 2; ++n) { const f32x4 v = acc[ai][bj][m][n]; sq += (v.x * v.x + v.y * v.y) + (v.z * v.z + v.w * v.w); }
                        sq += __shfl_xor(sq, 16); sq += __shfl_xor(sq, 32);
                        const float rn = __builtin_amdgcn_rsqf(sq * (1.0f / 64.0f) + EPS) * osc;
                        const int pcol = (t0 + j) & 63;
                        const f32x4 cc0 = *(const f32x4*)(rope + (pcol * 16 + 4 * fq) * 2), cc1 = *(const f32x4*)(rope + (pcol * 16 + 4 * fq) * 2 + 4);
#pragma unroll
                        for (int bj = 0; bj < 2; ++bj) {
                            const f32x4 t0v = bj == 0 ? rr0 : cc0, t1v = bj == 0 ? rr1 : cc1;
                            const f32x4 x1 = acc[ai][bj][m][0] * gv[bj][0] * rn, x2 = acc[ai][bj][m][1] * gv[bj][1] * rn;
                            const f32x4 cs = (f32x4){t0v.x, t0v.z, t1v.x, t1v.z}, sn = (f32x4){t0v.y, t0v.w, t1v.y, t1v.w};
                            const f32x4 o1 = x1 * cs - x2 * sn, o2 = x1 * sn + x2 * cs;
                            u32x2 w1, w2; w1.x = cvt_pk_bf16(o1.x, o1.y); w1.y = cvt_pk_bf16(o1.z, o1.w); w2.x = cvt_pk_bf16(o2.x, o2.y); w2.y = cvt_pk_bf16(o2.z, o2.w);
                            bf16_t* p = dst + (size_t)j * pitch + 32 * bj + 4 * fq;
                            *(u32x2*)p = w1; *(u32x2*)(p + 16) = w2;
                        }
                    }
            } else {
                bf16_t* dst = Vb + (size_t)t0 * 128 + (wc - 2) * 64;
#pragma unroll
                for (int ai = 0; ai < 2; ++ai)
#pragma unroll
                    for (int m = 0; m < 4; ++m)
#pragma unroll
                        for (int bj = 0; bj < 2; ++bj)
#pragma unroll
                            for (int n = 0; n < 2; ++n) { const f32x4 v = acc[ai][bj][m][n]; u32x2 w; w.x = cvt_pk_bf16(v.x, v.y); w.y = cvt_pk_bf16(v.z, v.w);
                                *(u32x2*)(dst + (size_t)(4 * ai + m) * 128 + 32 * bj + 16 * n + 4 * fq) = w; }
            }
        }
    }
};
struct EpiVS {
    const float* ss; bf16_t* VST; float* ssg;
    __device__ __forceinline__ void operator()(f32x4 (&acc)[2][2][4][2], const Unit& u, int wr, int wc, int fr, int fq) const {
        const int t0 = u.pm * 256 + wr * 128 + fr * 8;
        { float rs[8]; load_rs8(ss, t0, fq, rs, M_TOK - 1);
#pragma unroll
          for (int ai = 0; ai < 2; ++ai)
#pragma unroll
            for (int m = 0; m < 4; ++m)
#pragma unroll
                for (int bj = 0; bj < 2; ++bj)
#pragma unroll
                    for (int n = 0; n < 2; ++n) acc[ai][bj][m][n] = acc[ai][bj][m][n] * rs[4 * ai + m]; }
        const int pn = u.pn;
        {
            const int chunk = 2 * u.pm + wr;
            bf16_t* dst = VST + ((size_t)chunk * 512 + 256 * (pn - 5) + 32 * wc + 8 * fq) * 128 + 8 * fr;
#pragma unroll
            for (int ai = 0; ai < 2; ++ai)
#pragma unroll
                for (int m = 0; m < 4; ++m) {
                    float sq = 0.f;
#pragma unroll
                    for (int bj = 0; bj < 2; ++bj)
#pragma unroll
                        for (int n = 0; n < 2; ++n) { f32x4 v = acc[ai][bj][m][n]; v = (f32x4){gelu_t(v.x), gelu_t(v.y), gelu_t(v.z), gelu_t(v.w)}; acc[ai][bj][m][n] = v;
                            sq += (v.x * v.x + v.y * v.y) + (v.z * v.z + v.w * v.w); }
                    sq += __shfl_xor(sq, 16); sq += __shfl_xor(sq, 32);
                    if (fq == 0) ssg[(size_t)(t0 + 4 * ai + m) * 8 + 4 * (pn - 5) + wc] = sq;
                    asm volatile("" : "+v"(acc[ai][0][m][0]), "+v"(acc[ai][0][m][1]), "+v"(acc[ai][1][m][0]), "+v"(acc[ai][1][m][1]));
                }
#pragma unroll
            for (int bj = 0; bj < 2; ++bj)
#pragma unroll
                for (int n = 0; n < 2; ++n)
#pragma unroll
                    for (int i = 0; i < 4; ++i) {
                        u32x4 w; w.x = cvt_pk_bf16(acc[0][bj][0][n][i], acc[0][bj][1][n][i]); w.y = cvt_pk_bf16(acc[0][bj][2][n][i], acc[0][bj][3][n][i]);
                        w.z = cvt_pk_bf16(acc[1][bj][0][n][i], acc[1][bj][1][n][i]); w.w = cvt_pk_bf16(acc[1][bj][2][n][i], acc[1][bj][3][n][i]);
                        *(u32x4*)(dst + (size_t)(128 * bj + 4 * n + i) * 128) = w;
                    }
        }
    }
};
struct EpiEW {
    const float* ss; bf16_t* QU; bf16_t* GA; bf16_t* GB;
    __device__ __forceinline__ void operator()(f32x4 (&acc)[2][2][4][2], const Unit& u, int wr, int wc, int fr, int fq) const {
        const int t0 = u.pm * 256 + wr * 128 + fr * 8;
        float rs[8]; load_rs8(ss, t0, fq, rs, M_TOK - 1);
        const int pn = u.pn;
        const bool isu = pn < 5;
        bf16_t* dst = (isu ? QU + 512 + 256 * (pn - 3) : ((pn < 11) ? GA : GB) + 256 * ((pn - 7) & 3)) + (size_t)t0 * 1024 + 32 * wc + 8 * fq;
        if (isu) {
#pragma unroll
            for (int ai = 0; ai < 2; ++ai)
#pragma unroll
                for (int m = 0; m < 4; ++m)
#pragma unroll
                    for (int bj = 0; bj < 2; ++bj) { const f32x4 a = acc[ai][bj][m][0] * rs[4 * ai + m], b = acc[ai][bj][m][1] * rs[4 * ai + m]; u32x4 w;
                        w.x = cvt_pk_bf16(gelu_t(a.x), gelu_t(a.y)); w.y = cvt_pk_bf16(gelu_t(a.z), gelu_t(a.w)); w.z = cvt_pk_bf16(gelu_t(b.x), gelu_t(b.y)); w.w = cvt_pk_bf16(gelu_t(b.z), gelu_t(b.w));
                        *(u32x4*)(dst + (size_t)(4 * ai + m) * 1024 + 128 * bj) = w; }
        } else {
#pragma unroll
            for (int ai = 0; ai < 2; ++ai)
#pragma unroll
                for (int m = 0; m < 4; ++m) { const float k2 = rs[4 * ai + m] * -1.4426950409f;
#pragma unroll
                    for (int bj = 0; bj < 2; ++bj) { const f32x4 a = acc[ai][bj][m][0], b = acc[ai][bj][m][1]; u32x4 w;
#define SG_(x) __builtin_amdgcn_rcpf(1.0f + __builtin_amdgcn_exp2f((x) * k2))
                        w.x = cvt_pk_bf16(SG_(a.x), SG_(a.y)); w.y = cvt_pk_bf16(SG_(a.z), SG_(a.w)); w.z = cvt_pk_bf16(SG_(b.x), SG_(b.y)); w.w = cvt_pk_bf16(SG_(b.z), SG_(b.w));
#undef SG_
                        *(u32x4*)(dst + (size_t)(4 * ai + m) * 1024 + 128 * bj) = w; } }
        }
    }
};

struct EpiMerge {
    bf16_t* GA; const bf16_t* GB;
    __device__ __forceinline__ void operator()(f32x4 (&acc)[2][2][4][2], const Unit& u, int wr, int wc, int fr, int fq) const {
        const int t0 = u.pm * 256 + wr * 64 + fr;
        const size_t off0 = (size_t)t0 * 1024 + 256 * u.pn + 32 * wc + 8 * fq;
#pragma unroll
        for (int ai = 0; ai < 2; ++ai)
#pragma unroll
            for (int m = 0; m < 4; ++m)
#pragma unroll
                for (int bj = 0; bj < 2; ++bj) {
                    const size_t off = off0 + (size_t)(128 * ai + 16 * m) * 1024 + 128 * bj;
                    const u32x4 gb = *(const u32x4*)(GB + off);
                    f32x4 s0 = (f32x4){bf_lo(gb.x), bf_hi(gb.x), bf_lo(gb.y), bf_hi(gb.y)}, s1 = (f32x4){bf_lo(gb.z), bf_hi(gb.z), bf_lo(gb.w), bf_hi(gb.w)};
                    if (u.part == 0) {
                        const u32x4 ga = *(const u32x4*)(GA + off);
                        const f32x4 a0 = (f32x4){bf_lo(ga.x), bf_hi(ga.x), bf_lo(ga.y), bf_hi(ga.y)}, a1 = (f32x4){bf_lo(ga.z), bf_hi(ga.z), bf_lo(ga.w), bf_hi(ga.w)};
                        s0 = (f32x4){__builtin_amdgcn_rcpf(s0.x), __builtin_amdgcn_rcpf(s0.y), __builtin_amdgcn_rcpf(s0.z), __builtin_amdgcn_rcpf(s0.w)};
                        s1 = (f32x4){__builtin_amdgcn_rcpf(s1.x), __builtin_amdgcn_rcpf(s1.y), __builtin_amdgcn_rcpf(s1.z), __builtin_amdgcn_rcpf(s1.w)};
                        acc[ai][bj][m][0] = acc[ai][bj][m][0] * (a0 * s0); acc[ai][bj][m][1] = acc[ai][bj][m][1] * (a1 * s1);
                    } else {
                        const f32x4 v0 = acc[ai][bj][m][0] * s0, v1 = acc[ai][bj][m][1] * s1; u32x4 w;
                        w.x = cvt_pk_bf16(v0.x, v0.y); w.y = cvt_pk_bf16(v0.z, v0.w); w.z = cvt_pk_bf16(v1.x, v1.y); w.w = cvt_pk_bf16(v1.z, v1.w);
                        *(u32x4*)(GA + off) = w;
                    }
                }
    }
};

struct EpiRes {
    const float* xp; const float* xs; int first; float* out; bf16_t* xb; float* ss; int bb; int wout;
    __device__ __forceinline__ void operator()(f32x4 (&acc)[2][2][4][2], const Unit& u, int wr, int wc, int fr, int fq) const {
        const int t0 = u.pm * 256 + wr * 64 + fr;
        const int col0 = 256 * u.pn + 32 * wc + 8 * fq;
        const float* bp0 = first ? ((t0 < NPROMPT) ? xp + (size_t)t0 * 1024 : xs + (size_t)(t0 - NPROMPT) * 1024) : out + (size_t)t0 * 1024;
#pragma unroll
        for (int ai = 0; ai < 2; ++ai)
#pragma unroll
            for (int m = 0; m < 4; ++m) {
                const int j = 128 * ai + 16 * m; float sq = 0.f;
#pragma unroll
                for (int bj = 0; bj < 2; ++bj) {
                    const size_t o = (size_t)j * 1024 + col0 + 128 * bj;
                    f32x4 a, b;
                    if (bb) { const u32x4 w = *(const u32x4*)(xb + (size_t)t0 * 1024 + o);
                        a = (f32x4){bf_lo(w.x), bf_hi(w.x), bf_lo(w.y), bf_hi(w.y)}; b = (f32x4){bf_lo(w.z), bf_hi(w.z), bf_lo(w.w), bf_hi(w.w)}; }
                    else { a = *(const f32x4*)(bp0 + o); b = *(const f32x4*)(bp0 + o + 4); }
                    a = a + acc[ai][bj][m][0]; b = b + acc[ai][bj][m][1];
                    if (wout) { float* op = out + (size_t)t0 * 1024 + o; *(f32x4*)op = a; *(f32x4*)(op + 4) = b; }
                    u32x4 w; w.x = cvt_pk_bf16(a.x, a.y); w.y = cvt_pk_bf16(a.z, a.w); w.z = cvt_pk_bf16(b.x, b.y); w.w = cvt_pk_bf16(b.z, b.w);
                    *(u32x4*)(xb + (size_t)t0 * 1024 + o) = w;
                    sq += (a.x * a.x + a.y * a.y) + (a.z * a.z + a.w * a.w) + (b.x * b.x + b.y * b.y) + (b.z * b.z + b.w * b.w);
                }
                sq += __shfl_xor(sq, 16); sq += __shfl_xor(sq, 32);
                if (fq == 0) ss[(size_t)(t0 + j) * 16 + 4 * u.pn + wc] = sq;
            }
    }
};

struct EpiUp {
    const float* ss; const float* cw; const float* cb; bf16_t* H2;
    __device__ __forceinline__ void operator()(f32x4 (&acc)[2][2][4][2], const Unit& u, int wr, int wc, int fr, int fq) const {
        const int t0 = u.pm * 252 - 1 + wr * 126 + fr * 8;
        { float rs[8]; load_rs8(ss, t0, fq, rs, M_TOK - 1);
#pragma unroll
          for (int ai = 0; ai < 2; ++ai)
#pragma unroll
            for (int m = 0; m < 4; ++m)
#pragma unroll
                for (int bj = 0; bj < 2; ++bj)
#pragma unroll
                    for (int n = 0; n < 2; ++n) acc[ai][bj][m][n] = acc[ai][bj][m][n] * rs[4 * ai + m]; }
        unsigned vmask = 0, smask = 0, emask = 0;
#pragma unroll
        for (int j = 0; j < 8; ++j) { const int t = t0 + j, loc = fr * 8 + j;
            if (loc >= 1 && loc <= 126 && t < M_TOK) vmask |= 1u << j;
            const int sm = (t < NPROMPT) ? (SEQ_P - 1) : (SEQ_S - 1);
            if ((t & sm) == 0) smask |= 1u << j;
            if ((t & sm) == sm) emask |= 1u << j; }
#pragma unroll
        for (int n = 0; n < 2; ++n) {
            const int cg_ = 128 * u.pn + 32 * wc + 8 * fq + 4 * n;
            const f32x4 w0g = *(const f32x4*)(cw + cg_), w1g = *(const f32x4*)(cw + 4096 + cg_), w2g = *(const f32x4*)(cw + 8192 + cg_), bg = *(const f32x4*)(cb + cg_);
            const f32x4 w0v = *(const f32x4*)(cw + 2048 + cg_), w1v = *(const f32x4*)(cw + 4096 + 2048 + cg_), w2v = *(const f32x4*)(cw + 8192 + 2048 + cg_), bv = *(const f32x4*)(cb + 2048 + cg_);
            float h[8][4];
#pragma unroll
            for (int i = 0; i < 4; ++i) {
                float ag[8], av[8];
#pragma unroll
                for (int j = 0; j < 8; ++j) { ag[j] = acc[j >> 2][0][j & 3][n][i]; av[j] = acc[j >> 2][1][j & 3][n][i]; }
                const float lg = dpp_shr1(ag[7]), rg = dpp_shl1(ag[0]), lv = dpp_shr1(av[7]), rv = dpp_shl1(av[0]);
#pragma unroll
                for (int j = 0; j < 8; ++j) {
                    float Lg = j == 0 ? lg : ag[j == 0 ? 0 : j - 1], Rg = j == 7 ? rg : ag[j == 7 ? 7 : j + 1];
                    float Lv = j == 0 ? lv : av[j == 0 ? 0 : j - 1], Rv = j == 7 ? rv : av[j == 7 ? 7 : j + 1];
                    if ((smask >> j) & 1u) { Lg = 0.f; Lv = 0.f; }
                    if ((emask >> j) & 1u) { Rg = 0.f; Rv = 0.f; }
                    const float cgv = w0g[i] * Lg + w1g[i] * ag[j] + w2g[i] * Rg + bg[i];
                    const float cvv = w0v[i] * Lv + w1v[i] * av[j] + w2v[i] * Rv + bv[i];
                    h[j][i] = gelu_t(cgv) * cvv;
                }
            }
#pragma unroll
            for (int j = 0; j < 8; ++j) if ((vmask >> j) & 1u) { u32x2 w; w.x = cvt_pk_bf16(h[j][0], h[j][1]); w.y = cvt_pk_bf16(h[j][2], h[j][3]);
                *(u32x2*)(H2 + (size_t)(t0 + j) * 2048 + cg_) = w; }
        }
    }
};
}

namespace attn_body {
using bf16=__hip_bfloat16;
using bf16x8=__attribute__((ext_vector_type(8)))short;
using s16x4=__attribute__((ext_vector_type(4)))short;
using f32x16=__attribute__((ext_vector_type(16)))float;
using u32x4=__attribute__((ext_vector_type(4)))unsigned;
constexpr int D=64,QP=1024,KP=128;
constexpr int NW=8,QBLK=32,QB=QBLK*NW,KVBLK=64;
__device__ __forceinline__ int crow(int r,int hi){return (r&3)+8*(r>>2)+4*hi;}
#define SBAR() __builtin_amdgcn_sched_barrier(0)
constexpr int NSLOT=3, SLOTB=8192;
constexpr int LDS_K=0, LDS_V=NSLOT*SLOTB, LDS_WS=2*NSLOT*SLOTB, LDS_OST=LDS_WS+NW*64*4, LDS_BYTES=LDS_OST+NW*4096;
__device__ __forceinline__ void glds16(const void*gsrc,unsigned lds_dst){unsigned keep;
  asm volatile("s_mov_b32 %0, m0\n\ts_mov_b32 m0, %2\n\ts_nop 0\n\tglobal_load_lds_dwordx4 %1, off\n\ts_mov_b32 m0, %0":"=&s"(keep):"v"(gsrc),"s"(lds_dst):"memory");}
__device__ __forceinline__ float max3f(float a,float b,float c){float r;asm("v_max3_f32 %0, %1, %2, %3":"=v"(r):"v"(a),"v"(b),"v"(c));return r;}
__device__ __forceinline__ float max2f(float a,float b){float r;asm("v_max_f32_e32 %0, %1, %2":"=v"(r):"v"(a),"v"(b));return r;}
__device__ __forceinline__ float fadd_s(float a,float b){float r;asm("v_add_f32_e32 %0, %1, %2":"=v"(r):"v"(a),"v"(b));return r;}
__device__ __forceinline__ float fsub_s(float a,float b){float r;asm("v_sub_f32_e32 %0, %1, %2":"=v"(r):"v"(a),"v"(b));return r;}
typedef float f32x2_t __attribute__((ext_vector_type(2))); typedef __bf16 bf16x2_t __attribute__((ext_vector_type(2)));
__device__ __forceinline__ unsigned cvtpk_s(float lo,float hi){f32x2_t v={lo,hi};bf16x2_t b=__builtin_convertvector(v,bf16x2_t);return __builtin_bit_cast(unsigned,b);}
#define WAIT_BAR(N) asm volatile("s_waitcnt vmcnt(" #N ") lgkmcnt(0)\n\ts_barrier":::"memory")
__device__ __forceinline__ void qkt(f32x16&p0,f32x16&p1,const char*Kslot,const bf16x8*qr,const f32x16&negm,int r32,int hi){
  const char*kb=Kslot+hi*1024+r32*16;
  #pragma unroll
  for(int d0=0;d0<4;++d0){
    const bf16x8 b0=*reinterpret_cast<const bf16x8*>(kb+d0*2048);
    const bf16x8 b1=*reinterpret_cast<const bf16x8*>(kb+d0*2048+512);
    if(d0==0){p0=__builtin_amdgcn_mfma_f32_32x32x16_bf16(b0,qr[0],negm,0,0,0);p1=__builtin_amdgcn_mfma_f32_32x32x16_bf16(b1,qr[0],negm,0,0,0);}
    else{p0=__builtin_amdgcn_mfma_f32_32x32x16_bf16(b0,qr[d0],p0,0,0,0);p1=__builtin_amdgcn_mfma_f32_32x32x16_bf16(b1,qr[d0],p1,0,0,0);}}
}
typedef __attribute__((address_space(3))) const char* lds_cptr;
typedef short v4i16_t __attribute__((ext_vector_type(4)));
__device__ __forceinline__ void kload8(bf16x8*kf,lds_cptr kp){
  kf[0]=*(const __attribute__((address_space(3))) bf16x8*)(kp);      kf[1]=*(const __attribute__((address_space(3))) bf16x8*)(kp+512);
  kf[2]=*(const __attribute__((address_space(3))) bf16x8*)(kp+2048); kf[3]=*(const __attribute__((address_space(3))) bf16x8*)(kp+2560);
  kf[4]=*(const __attribute__((address_space(3))) bf16x8*)(kp+4096); kf[5]=*(const __attribute__((address_space(3))) bf16x8*)(kp+4608);
  kf[6]=*(const __attribute__((address_space(3))) bf16x8*)(kp+6144); kf[7]=*(const __attribute__((address_space(3))) bf16x8*)(kp+6656);
}
__device__ __forceinline__ void kload2(bf16x8*kf,lds_cptr kp,int j){ kf[2*j]=*(const __attribute__((address_space(3))) bf16x8*)(kp+j*2048); kf[2*j+1]=*(const __attribute__((address_space(3))) bf16x8*)(kp+j*2048+512); }
__device__ __forceinline__ s16x4 vtr(lds_cptr p){ return __builtin_bit_cast(s16x4,__builtin_amdgcn_ds_read_tr16_b64_v4i16((__attribute__((address_space(3))) v4i16_t*)p)); }
__device__ __forceinline__ float rowmax(const f32x16&p0,const f32x16&p1){
  float a=max3f(p0[0],p0[1],p1[0]),b=max3f(p0[2],p0[3],p1[1]);a=max3f(a,p1[2],p1[3]);
  #pragma unroll
  for(int r=4;r<16;r+=4){a=max3f(a,p0[r],p0[r+1]);b=max3f(b,p0[r+2],p0[r+3]);a=max3f(a,p1[r],p1[r+1]);b=max3f(b,p1[r+2],p1[r+3]);}
  const float m=max2f(a,b);
  auto rr=__builtin_amdgcn_permlane32_swap(__float_as_uint(m),__float_as_uint(m),false,false);
  return max2f(__uint_as_float(rr[0]),__uint_as_float(rr[1]));
}
__device__ __forceinline__ void pv(f32x16*o,int vb,bf16x8 pa0,bf16x8 pa1,bf16x8 pa2,bf16x8 pa3){
  #pragma unroll
  for(int d0=0;d0<2;++d0){s16x4 lo[4],hi[4];
    #pragma unroll
    for(int ks=0;ks<4;++ks){
      asm volatile("ds_read_b64_tr_b16 %0,%1 offset:%c2":"=&v"(lo[ks]):"v"(vb),"i"(d0*4096+ks*1024):"memory");
      asm volatile("ds_read_b64_tr_b16 %0,%1 offset:%c2":"=&v"(hi[ks]):"v"(vb),"i"(d0*4096+ks*1024+512):"memory");}
    asm volatile("s_waitcnt lgkmcnt(0)":::"memory");SBAR();
    #define PK(k) (bf16x8){lo[k][0],lo[k][1],lo[k][2],lo[k][3],hi[k][0],hi[k][1],hi[k][2],hi[k][3]}
    o[d0]=__builtin_amdgcn_mfma_f32_32x32x16_bf16(pa0,PK(0),o[d0],0,0,0);
    o[d0]=__builtin_amdgcn_mfma_f32_32x32x16_bf16(pa1,PK(1),o[d0],0,0,0);
    o[d0]=__builtin_amdgcn_mfma_f32_32x32x16_bf16(pa2,PK(2),o[d0],0,0,0);
    o[d0]=__builtin_amdgcn_mfma_f32_32x32x16_bf16(pa3,PK(3),o[d0],0,0,0);
    #undef PK
  }
}
template<int THRL> __device__ __forceinline__ void attn_unit(long rowbase,int seq,int h,int q0,const bf16*Q,const bf16*__restrict__ K,const bf16*__restrict__ V,bf16*O,char*shm){
  int tid_=threadIdx.x; asm volatile("":"+v"(tid_));
  const int tid=tid_,lane=tid&63,r32=lane&31,hi=lane>>5; const int wid=__builtin_amdgcn_readfirstlane(tid>>6);
  const bf16*Qw=Q+(rowbase+q0+wid*QBLK)*QP+h*D;
  const bf16*Kh=K+rowbase*KP+(h>>2)*D,*Vh=V+rowbase*KP+(h>>2)*D;
  const unsigned lds0=(unsigned)(uintptr_t)shm;
  float*wsf=(float*)(shm+LDS_WS)+wid*64;
  const bf16*ksrc=Kh+(long)lane*KP+wid*8;
  const bf16*vsrc=Vh+(long)(16*(wid&3)+(lane>>2))*KP+(wid>>2)*32+(lane&3)*8;
  const unsigned kdst=lds0+LDS_K+wid*1024, vdst=lds0+LDS_V+wid*1024;
  #define DMA_K(t,slot) glds16(ksrc+(long)(t)*KVBLK*KP,(unsigned)__builtin_amdgcn_readfirstlane(kdst+(slot)))
  #define DMA_V(t,slot) glds16(vsrc+(long)(t)*KVBLK*KP,(unsigned)__builtin_amdgcn_readfirstlane(vdst+(slot)))
  const int vb0=(int)(lds0+LDS_V)+((lane>>4)&1)*32+(lane&3)*8+(4*hi+((lane&15)>>2))*64;
  const char*Kbase=shm+LDS_K; bf16x8 kf[8];
  const lds_cptr shm3=(lds_cptr)shm; const lds_cptr kp0=shm3+LDS_K+hi*1024+r32*16; const lds_cptr vp0=shm3+LDS_V+((lane>>4)&1)*32+(lane&3)*8+(4*hi+((lane&15)>>2))*64;
  const int NT=seq/KVBLK;
  DMA_K(0,0);DMA_V(0,0);DMA_K(1,SLOTB);
  bf16x8 qr[4];
  #pragma unroll
  for(int d0=0;d0<4;++d0)qr[d0]=*reinterpret_cast<const bf16x8*>(&Qw[(long)r32*QP+d0*16+hi*8]);
  float mhat=0.f,l_reg=0.f;f32x16 o[2];o[0]=f32x16{};o[1]=f32x16{};f32x16 negm=f32x16{};asm volatile("":"+v"(negm));
  bool resc=false;
  #define START(P0,P1) do{ const float rm=rowmax(P0,P1); resc=false; \
    { const float dl=rm; mhat=fadd_s(mhat,dl); \
      _Pragma("unroll") for(int r=0;r<16;++r){P0[r]=fsub_s(P0[r],dl);P1[r]=fsub_s(P1[r],dl);} \
      _Pragma("unroll") for(int r=0;r<16;++r)negm[r]=-mhat; asm volatile("":"+v"(negm)); } \
    _Pragma("unroll") for(int r=0;r<16;++r)P0[r]=__builtin_amdgcn_exp2f(P0[r]); }while(0)
  #define RESC() do{ if(resc){ asm volatile("s_waitcnt lgkmcnt(0)":::"memory"); \
      _Pragma("unroll") for(int d_=0;d_<2;++d_) _Pragma("unroll") for(int r=0;r<16;++r)o[d_][r]*=wsf[crow(r,hi)]; } }while(0)
  f32x16 pA0,pA1,pB0,pB1;
  int sl_prev=0,sl_cur=0,sl_next=SLOTB;
  #define ROT() do{sl_prev=sl_cur;sl_cur=sl_next;sl_next=(sl_next==(NSLOT-1)*SLOTB)?0:sl_next+SLOTB;}while(0)
  DMA_K(2,2*SLOTB);
  WAIT_BAR(3);
  qkt(pA0,pA1,Kbase,qr,negm,r32,hi);asm volatile("s_nop 15\n\ts_nop 7":"+v"(pA0),"+v"(pA1));
  START(pA0,pA1);
  _Pragma("unroll") for(int r=0;r<16;++r)pA1[r]=__builtin_amdgcn_exp2f(pA1[r]);
  WAIT_BAR(0);
  DMA_K(3,0);DMA_V(1,SLOTB);
  ROT();
  kload8(kf,kp0+sl_cur);
  WAIT_BAR(2);
  s16x4 vlo[8],vhi[8]; u32x4 pw0,pw1,pw2,pw3;
  #define PKW(P,B) cvtpk_s(P[B],P[B+1])
  #define PAF(k) __builtin_bit_cast(bf16x8,pw##k)
  #define VFR(i) (bf16x8){vlo[i][0],vlo[i][1],vlo[i][2],vlo[i][3],vhi[i][0],vhi[i][1],vhi[i][2],vhi[i][3]}
  #define PIN(x) asm volatile("":"+v"(x))
  #define MX3(a,b,c) __builtin_fmaxf(__builtin_fmaxf((a),(b)),(c))
  #define GAPA(MF,A0,A1,A2,A3,W0,W1,PW) do{ MF; sacc+=A0; sacc+=A1; sacc+=A2; sacc+=A3; PIN(sacc); W0; W1; PIN(PW); SBAR(); }while(0)
  #define EX(v) __builtin_amdgcn_exp2f(v)
  #define GAPB(MF,X,B) do{ MF; X[B]=EX(X[B]); X[B+1]=EX(X[B+1]); X[B+2]=EX(X[B+2]); X[B+3]=EX(X[B+3]); PIN(X); SBAR(); }while(0)
  #define VRD(i) do{ vlo[i]=vtr(vp_+(((i)>>2)*4096+((i)&3)*1024)); vhi[i]=vtr(vp_+(((i)>>2)*4096+((i)&3)*1024+512)); }while(0)
  #define KRD(G,j) do{ if(G){ kload2(kf,kp0+sl_next,j); SBAR(); } }while(0)
  #define STEP(C0,C1,P0,P1,t,GK,GV,GL) do{ SBAR(); \
    const lds_cptr vp_=vp0+sl_prev; \
    VRD(0); SBAR(); float sacc=(P0[0]+P0[1]); \
    GAPA(C0=__builtin_amdgcn_mfma_f32_32x32x16_bf16(kf[0],qr[0],negm,0,0,0), P0[2],P0[3],P0[4],P0[5],     pw0[0]=PKW(P0,0), pw0[1]=PKW(P0,2), pw0); \
    VRD(4); SBAR(); GAPA(C1=__builtin_amdgcn_mfma_f32_32x32x16_bf16(kf[1],qr[0],negm,0,0,0), P0[6],P0[7],P0[8],P0[9],     pw0[2]=PKW(P0,4), pw0[3]=PKW(P0,6), pw0); \
    VRD(1); SBAR(); GAPA(C0=__builtin_amdgcn_mfma_f32_32x32x16_bf16(kf[2],qr[1],C0,0,0,0),   P0[10],P0[11],P0[12],P0[13], pw1[0]=PKW(P0,8), pw1[1]=PKW(P0,10), pw1); \
    VRD(5); SBAR(); GAPA(C1=__builtin_amdgcn_mfma_f32_32x32x16_bf16(kf[3],qr[1],C1,0,0,0),   P0[14],P0[15],P1[0],P1[1],   pw1[2]=PKW(P0,12),pw1[3]=PKW(P0,14), pw1); \
    VRD(2); SBAR(); GAPA(C0=__builtin_amdgcn_mfma_f32_32x32x16_bf16(kf[4],qr[2],C0,0,0,0),   P1[2],P1[3],P1[4],P1[5],     pw2[0]=PKW(P1,0), pw2[1]=PKW(P1,2), pw2); \
    VRD(6); SBAR(); GAPA(C1=__builtin_amdgcn_mfma_f32_32x32x16_bf16(kf[5],qr[2],C1,0,0,0),   P1[6],P1[7],P1[8],P1[9],     pw2[2]=PKW(P1,4), pw2[3]=PKW(P1,6), pw2); \
    VRD(3); SBAR(); GAPA(C0=__builtin_amdgcn_mfma_f32_32x32x16_bf16(kf[6],qr[3],C0,0,0,0),   P1[10],P1[11],P1[12],P1[13], pw3[0]=PKW(P1,8), pw3[1]=PKW(P1,10), pw3); \
    VRD(7); SBAR(); GAPA(C1=__builtin_amdgcn_mfma_f32_32x32x16_bf16(kf[7],qr[3],C1,0,0,0),   P1[14],P1[15],0.f,0.f,       pw3[2]=PKW(P1,12),pw3[3]=PKW(P1,14), pw3); \
    l_reg+=sacc; \
    if(GK){DMA_K((t)+3,sl_cur);} if(GV){DMA_V((t)+1,sl_next);} \
    { float a=MX3(C0[0],C0[1],C1[0]),b=MX3(C0[2],C0[3],C1[1]); a=MX3(a,C1[2],C1[3]); \
      _Pragma("unroll") for(int r=4;r<16;r+=4){a=MX3(a,C0[r],C0[r+1]);b=MX3(b,C0[r+2],C0[r+3]);a=MX3(a,C1[r],C1[r+1]);b=MX3(b,C1[r+2],C1[r+3]);} \
      float rm=__builtin_fmaxf(a,b); { auto rr=__builtin_amdgcn_permlane32_swap(__float_as_uint(rm),__float_as_uint(rm),false,false); rm=__builtin_fmaxf(__uint_as_float(rr[0]),__uint_as_float(rr[1])); } \
      resc=false; \
      if(__builtin_expect(__any(rm>(float)THRL),0)){ const float dl=__builtin_fmaxf(rm,0.f); mhat+=dl; \
        _Pragma("unroll") for(int r=0;r<16;++r){C0[r]-=dl;C1[r]-=dl;} \
        _Pragma("unroll") for(int r=0;r<16;++r)negm[r]=-mhat; asm volatile("":"+v"(negm)); \
        const float f=__builtin_amdgcn_exp2f(-dl); l_reg*=f; if(hi==0)wsf[r32]=f; resc=true; } } \
    SBAR(); \
    GAPB(o[0]=__builtin_amdgcn_mfma_f32_32x32x16_bf16(PAF(0),VFR(0),o[0],0,0,0), C0,0); \
    GAPB(o[1]=__builtin_amdgcn_mfma_f32_32x32x16_bf16(PAF(0),VFR(4),o[1],0,0,0), C0,4); \
    KRD(GL,0); GAPB(o[0]=__builtin_amdgcn_mfma_f32_32x32x16_bf16(PAF(1),VFR(1),o[0],0,0,0), C0,8); \
    KRD(GL,1); GAPB(o[1]=__builtin_amdgcn_mfma_f32_32x32x16_bf16(PAF(1),VFR(5),o[1],0,0,0), C0,12); \
    KRD(GL,2); GAPB(o[0]=__builtin_amdgcn_mfma_f32_32x32x16_bf16(PAF(2),VFR(2),o[0],0,0,0), C1,0); \
    KRD(GL,3); GAPB(o[1]=__builtin_amdgcn_mfma_f32_32x32x16_bf16(PAF(2),VFR(6),o[1],0,0,0), C1,4); \
    GAPB(o[0]=__builtin_amdgcn_mfma_f32_32x32x16_bf16(PAF(3),VFR(3),o[0],0,0,0), C1,8); \
    GAPB(o[1]=__builtin_amdgcn_mfma_f32_32x32x16_bf16(PAF(3),VFR(7),o[1],0,0,0), C1,12); \
    }while(0)
  int t=1;
  for(;t+5<NT;t+=2){
    STEP(pB0,pB1,pA0,pA1,t,true,true,true);     WAIT_BAR(2); RESC(); ROT();
    STEP(pA0,pA1,pB0,pB1,t+1,true,true,true);   WAIT_BAR(2); RESC(); ROT();
  }
  #define ENDW(tt) do{ if((tt)+3<NT){WAIT_BAR(2);} else if((tt)+2<NT){WAIT_BAR(1);} else {WAIT_BAR(0);} }while(0)
  for(;t+1<NT;t+=2){
    STEP(pB0,pB1,pA0,pA1,t,(t+3<NT),(t+1<NT),(t+1<NT));       ENDW(t);   RESC(); ROT();
    STEP(pA0,pA1,pB0,pB1,t+1,(t+4<NT),(t+2<NT),(t+2<NT));     ENDW(t+1); RESC(); ROT();
  }
  STEP(pB0,pB1,pA0,pA1,NT-1,false,false,false); RESC();
  { float sacc=pB0[0]+pB0[1]; _Pragma("unroll") for(int r=2;r<16;++r)sacc+=pB0[r]; _Pragma("unroll") for(int r=0;r<16;++r)sacc+=pB1[r]; l_reg+=sacc;
    pw0=(u32x4){PKW(pB0,0),PKW(pB0,2),PKW(pB0,4),PKW(pB0,6)};pw1=(u32x4){PKW(pB0,8),PKW(pB0,10),PKW(pB0,12),PKW(pB0,14)};pw2=(u32x4){PKW(pB1,0),PKW(pB1,2),PKW(pB1,4),PKW(pB1,6)};pw3=(u32x4){PKW(pB1,8),PKW(pB1,10),PKW(pB1,12),PKW(pB1,14)};
    SBAR(); pv(o,vb0+sl_cur,PAF(0),PAF(1),PAF(2),PAF(3)); }
  #undef PKW
  #undef PAF
  #undef VFR
  #undef PIN
  #undef MX3
  #undef GAPA
  #undef GAPB
  #undef EX
  #undef VRD
  #undef KRD
  #undef STEP
  #undef ENDW
  {auto rr=__builtin_amdgcn_permlane32_swap(__float_as_uint(l_reg),__float_as_uint(l_reg),false,false);l_reg=__uint_as_float(rr[0])+__uint_as_float(rr[1]);}
  if(hi==0)wsf[32+r32]=l_reg;asm volatile("s_waitcnt lgkmcnt(0)":::"memory");
  float rli[16];
  #pragma unroll
  for(int r=0;r<16;++r)rli[r]=__builtin_amdgcn_rcpf(wsf[32+crow(r,hi)]);
  bf16*Ow=O+(rowbase+q0+wid*QBLK)*QP+h*D;
  { bf16*stg=(bf16*)(shm+LDS_OST)+wid*2048;
    #pragma unroll
    for(int r=0;r<16;++r){const int orow=crow(r,hi);
      #pragma unroll
      for(int d0=0;d0<2;++d0)stg[orow*64+d0*32+r32]=__float2bfloat16(o[d0][r]*rli[r]);}
    asm volatile("s_waitcnt lgkmcnt(0)":::"memory");
    #pragma unroll
    for(int i=0;i<4;++i){const int row=i*8+(lane>>3),ch=lane&7; const u32x4 v=*(const u32x4*)(stg+row*64+ch*8); *(u32x4*)(Ow+(long)row*QP+ch*8)=v;} }
  asm volatile("s_waitcnt lgkmcnt(0)\n\ts_barrier":::"memory");
  #undef DMA_K
  #undef DMA_V
  #undef START
  #undef RESC
  #undef ROT
}
constexpr int ATTN_LDS_BYTES=LDS_BYTES;
#undef SBAR
#undef WAIT_BAR
}

#define GRID_SYNC() do { asm volatile("s_waitcnt vmcnt(0) lgkmcnt(0)" ::: "memory"); grid.sync(); __builtin_amdgcn_fence(__ATOMIC_ACQUIRE, "agent"); asm volatile("s_waitcnt vmcnt(0)" ::: "memory"); } while (0)
#ifndef N_LAUNCH_MODE
#define N_LAUNCH_MODE 0
#endif
constexpr int N_PHASES = 2 + 6 * NLAYER;
constexpr int NWAVES = 8;
constexpr size_t MiB = 1u << 20;
constexpr size_t WL_IN = 0, WL_A = WL_IN + (size_t)INW * 1024, WL_B = WL_A + 1024 * 512, WL_MIX = WL_B + 1024 * 512, WL_UP = WL_MIX + 1024 * 1024,
                 WL_DOWN = WL_UP + 4096 * 1024, WL_SG = WL_DOWN + 1024 * 2048, WL_SIZE = WL_SG + 8 * 128 * 128;
static_assert(WL_SIZE * 2 * NLAYER <= 95 * MiB, "weights region");
constexpr size_t WS_ROPE = 0, WS_W = 1 * MiB, WS_XB = 96 * MiB + 4096, WS_QU = 289 * MiB, WS_K = 481 * MiB, WS_V = 505 * MiB, WS_VST = 529 * MiB,
                 WS_GA = 625 * MiB, WS_GB = 817 * MiB, WS_H2 = 625 * MiB, WS_SS = 1009 * MiB, WS_SSG = 1015 * MiB, WS_END = 1018 * MiB;
constexpr int LDS_BYTES = 147456, SG_SCR_OFF = 135168, BARST_OFF = 140288;
constexpr size_t WS_BAR = 65536, BAR_BYTES = 16384;


#define XB_TMO      128
#define XB_XCNT(j)  (256  + 64 * (j))
#define XB_XSUB(j)  (1280 + 64 * (j))
#define XB_XGEN(j)  (2304 + 64 * (j))
#define XB_TOP      3328
#define XB_TOPGEN   3392
#define XCD_BAR_WORDS 3456
#define XB_SPIN_CAP (1u << 22)
__device__ __forceinline__ unsigned xb_ld(unsigned* p)              { return __hip_atomic_load(p, __ATOMIC_RELAXED, __HIP_MEMORY_SCOPE_AGENT); }
__device__ __forceinline__ unsigned xb_add(unsigned* p, unsigned v) { return __hip_atomic_fetch_add(p, v, __ATOMIC_RELAXED, __HIP_MEMORY_SCOPE_AGENT); }
__device__ __forceinline__ unsigned xb_xcc_id() { return (unsigned)__builtin_amdgcn_s_getreg((3 << 11) | 20) & 0xFu; }
#define XB_SPIN(cond, bar) do { unsigned _sp = 0; while (cond) { __builtin_amdgcn_s_sleep(1); \
    if ((++_sp & 255u) == 0u) { if (xb_ld(&(bar)[XB_TMO])) break; if (_sp > XB_SPIN_CAP) { atomicAdd(&(bar)[XB_TMO], 1u); break; } } } } while (0)
struct XcdBarrier { unsigned* bar; unsigned x; volatile LAS unsigned* st; };
__device__ __forceinline__ XcdBarrier xcd_barrier_post(unsigned* bar, volatile LAS unsigned* st) {
    XcdBarrier b; b.bar = bar; b.x = xb_xcc_id(); b.st = st;
    if (threadIdx.x == 0) (void)xb_add(&bar[XB_XCNT(b.x)], 1u);
    return b;
}
__device__ __forceinline__ void xcd_barrier_complete(unsigned* bar, unsigned x, unsigned& nloc, unsigned& nx) {
    const unsigned G = gridDim.x * gridDim.y * gridDim.z;
    unsigned sum, cnt, mine, sp = 0u;
    for (;;) {
        sum = 0u; cnt = 0u; mine = 0u;
#pragma unroll
        for (unsigned j = 0; j < 16; ++j) { const unsigned c = xb_ld(&bar[XB_XCNT(j)]); sum += c; cnt += (c > 0u) ? 1u : 0u; mine = (j == x) ? c : mine; }
        if (sum == G) break;
        __builtin_amdgcn_s_sleep(1);
        if ((++sp & 255u) == 0u) { if (xb_ld(&bar[XB_TMO])) break; if (sp > XB_SPIN_CAP) { atomicAdd(&bar[XB_TMO], 1u); break; } }
    }
    nloc = mine > 0u ? mine : 1u; nx = cnt > 0u ? cnt : 1u;
}
__device__ __forceinline__ void xcd_barrier(const XcdBarrier& b) {
    asm volatile("s_waitcnt vmcnt(0)" ::: "memory");
    __syncthreads();
    if (threadIdx.x == 0) {
        unsigned* bar = b.bar;
        __builtin_amdgcn_s_waitcnt(0);
        unsigned nloc = b.st[0], nx = b.st[1];
        if (nloc == 0u) { xcd_barrier_complete(bar, b.x, nloc, nx); b.st[0] = nloc; b.st[1] = nx; }
        const unsigned old = xb_add(&bar[XB_XSUB(b.x)], 1u);
        const unsigned gen = old / nloc;
        if (old + 1u == (gen + 1u) * nloc) {
            __builtin_amdgcn_fence(__ATOMIC_RELEASE, "agent");
            asm volatile("s_waitcnt vmcnt(0)" ::: "memory");
            const unsigned og = xb_add(&bar[XB_TOP], 1u);
            const unsigned tg = og / nx;
            if (og + 1u == (tg + 1u) * nx) xb_add(&bar[XB_TOPGEN], 1u);
            else XB_SPIN(xb_ld(&bar[XB_TOPGEN]) == tg, bar);
            __builtin_amdgcn_fence(__ATOMIC_ACQUIRE, "agent");
            xb_add(&bar[XB_XGEN(b.x)], 1u);
            asm volatile("s_waitcnt vmcnt(0)" ::: "memory");
        } else {
            XB_SPIN(xb_ld(&bar[XB_XGEN(b.x)]) == gen, bar);
            __builtin_amdgcn_fence(__ATOMIC_ACQUIRE, "agent");
            asm volatile("s_waitcnt vmcnt(0)" ::: "memory");
        }
    }
    __syncthreads();
}

struct Args { const float* in[18]; float* out; unsigned char* ws; int ph_lo, ph_hi; };

__device__ __forceinline__ float wave_sum(float v) {
#pragma unroll
    for (int o = 1; o < 64; o <<= 1) v += __shfl_xor(v, o);
    return v;
}
__device__ __forceinline__ int invperm32(int cc) { return 16 * ((cc >> 2) & 1) + 4 * (cc >> 3) + (cc & 3); }
__device__ __forceinline__ int map_plain(int n) { return (n & ~31) + invperm32(n & 31); }
__device__ __forceinline__ int map_in(int n) {
    if (n < 512) { const int pn = n >> 8, hh = (n >> 6) & 3, d = n & 63; return 256 * pn + 128 * (d >> 5) + 32 * hh + (d & 31); }
    if (n < 768) { const int c = n - 512, isv = c >> 7, head = (c >> 6) & 1, d = c & 63, wc = 2 * isv + head; return 512 + 128 * (d >> 5) + 32 * wc + (d & 31); }
    return map_plain(n);
}
__device__ __forceinline__ int map_up(int n) { const int bj = n >> 11, c = n & 2047, pn = c >> 7, r = c & 127; return 256 * pn + 128 * bj + (r & ~31) + invperm32(r & 31); }

template <int MAP>
__device__ __forceinline__ void transpose_item(const float* W, const float* g, int K, int N, bf16_t* WT, LAS float* scr, int item, int lane) {
    const int nblk = N / 32, kb = item / nblk, nb = item % nblk, k0 = 64 * kb, n0 = 32 * nb;
#pragma unroll 8
    for (int i = 0; i < 32; ++i) { const int kk = 2 * i + (lane >> 5); float v = W[(size_t)(k0 + kk) * N + n0 + (lane & 31)]; if (g) v *= g[k0 + kk]; scr[kk * 33 + (lane & 31)] = v; }
    asm volatile("s_waitcnt lgkmcnt(0)" ::: "memory");
    const int c = lane & 7;
#pragma unroll
    for (int j = 0; j < 4; ++j) { const int n = (lane >> 3) + 8 * j; const LAS float* s = scr + (8 * c) * 33 + n;
        u32x4 o; o.x = cvt_pk_bf16(s[0 * 33], s[1 * 33]); o.y = cvt_pk_bf16(s[2 * 33], s[3 * 33]); o.z = cvt_pk_bf16(s[4 * 33], s[5 * 33]); o.w = cvt_pk_bf16(s[6 * 33], s[7 * 33]);
        const int nn = n0 + n; const int row = MAP == 0 ? map_plain(nn) : (MAP == 1 ? map_in(nn) : map_up(nn));
        *(u32x4*)(WT + (size_t)row * K + k0 + 8 * c) = o; }
    asm volatile("s_waitcnt lgkmcnt(0)" ::: "memory");
}

__device__ __forceinline__ void sincos_tab(float x, float& c, float& s) {
    const float n = rintf(x * 0.63661977236758134308f);
    float r = fmaf(-n, 1.5703125f, x); r = fmaf(-n, 4.83751296997070312500e-4f, r); r = fmaf(-n, 7.5497899548918821e-8f, r);
    const float r2 = r * r;
    const float sp = r + r * r2 * (-1.0f / 6 + r2 * (1.0f / 120 + r2 * (-1.0f / 5040 + r2 * (1.0f / 362880))));
    const float cp = 1.0f + r2 * (-0.5f + r2 * (1.0f / 24 + r2 * (-1.0f / 720 + r2 * (1.0f / 40320 + r2 * (-1.0f / 3628800)))));
    const int q = ((int)n) & 3;
    s = (q == 0) ? sp : (q == 1) ? cp : (q == 2) ? -sp : -cp;
    c = (q == 0) ? cp : (q == 1) ? -sp : (q == 2) ? -cp : sp;
}

__device__ __forceinline__ void sg_unit(int ch, int g, const bf16_t* VST, const float* ssg, const bf16_t* Wg, const float* sgb, const float* gsg, bf16_t* QU, LAS float* scr, int lane) {
    asm volatile("" : "+v"(lane));
    const int fr = lane & 15, fq = lane >> 4;
#pragma unroll
    for (int hh = 0; hh < 2; ++hh) { const int p = lane + 64 * hh; const float* sp = ssg + (size_t)(ch * 128 + p) * 8; const f32x4 a = *(const f32x4*)sp, b = *(const f32x4*)(sp + 4);
        const float s = ((a.x + a.y) + (a.z + a.w)) + ((b.x + b.y) + (b.z + b.w)); scr[p] = __builtin_amdgcn_rsqf(s * (1.0f / 512.0f) + EPS); }
    asm volatile("s_waitcnt lgkmcnt(0)" ::: "memory");
    f32x4 acc[8][4];
#pragma unroll
    for (int pt = 0; pt < 8; ++pt)
#pragma unroll
        for (int ct = 0; ct < 4; ++ct) acc[pt][ct] = (f32x4){0.f, 0.f, 0.f, 0.f};
    const bf16_t* vbase = VST + ((size_t)ch * 512 + g * 64) * 128;
    const bf16_t* wbase = Wg + (size_t)g * 128 * 128;
#pragma unroll 1
    for (int kk = 0; kk < 4; ++kk) {
        const int k0 = kk * 32 + 8 * fq;
        bf16x8 af[4];
#pragma unroll
        for (int ct = 0; ct < 4; ++ct) af[ct] = *(const bf16x8*)(vbase + (size_t)(ct * 16 + fr) * 128 + k0);
        float r[8];
#pragma unroll
        for (int e = 0; e < 8; ++e) r[e] = scr[k0 + e];
#pragma unroll
        for (int pt = 0; pt < 8; ++pt) {
            const u32x4 w = *(const u32x4*)(wbase + (size_t)(pt * 16 + fr) * 128 + k0);
            u32x4 ws; ws.x = cvt_pk_bf16(bf_lo(w.x) * r[0], bf_hi(w.x) * r[1]); ws.y = cvt_pk_bf16(bf_lo(w.y) * r[2], bf_hi(w.y) * r[3]);
            ws.z = cvt_pk_bf16(bf_lo(w.z) * r[4], bf_hi(w.z) * r[5]); ws.w = cvt_pk_bf16(bf_lo(w.w) * r[6], bf_hi(w.w) * r[7]);
            const bf16x8 bfz = __builtin_bit_cast(bf16x8, ws);
#pragma unroll
            for (int ct = 0; ct < 4; ++ct) acc[pt][ct] = __builtin_amdgcn_mfma_f32_16x16x32_bf16(af[ct], bfz, acc[pt][ct], 0, 0, 0);
        }
    }
    f32x4 gs[4];
#pragma unroll
    for (int ct = 0; ct < 4; ++ct) gs[ct] = *(const f32x4*)(gsg + g * 64 + ct * 16 + 4 * fq);
#pragma unroll
    for (int pt = 0; pt < 8; ++pt) {
        const int p = pt * 16 + fr; const float b = sgb[g * 128 + p];
        bf16_t* up = QU + (size_t)(ch * 128 + p) * 1024 + 512 + g * 64 + 4 * fq;
#pragma unroll
        for (int ct = 0; ct < 4; ++ct) {
            const u32x2 uu = *(const u32x2*)(up + ct * 16);
            const f32x4 sp = acc[pt][ct] * gs[ct] + b;
            u32x2 w; w.x = cvt_pk_bf16(bf_lo(uu.x) * sp.x, bf_hi(uu.x) * sp.y); w.y = cvt_pk_bf16(bf_lo(uu.y) * sp.z, bf_hi(uu.y) * sp.w);
            *(u32x2*)(up + ct * 16) = w;
        }
    }
    asm volatile("s_waitcnt lgkmcnt(0)" ::: "memory");
}

__global__ void __launch_bounds__(NWAVES * 64, 2) fwd_megakernel(Args args) {
    extern __shared__ __attribute__((aligned(16))) unsigned char lds[];
    cg::grid_group grid = cg::this_grid();
    LAS unsigned char* L = (LAS unsigned char*)lds;
    volatile LAS unsigned* barst = (volatile LAS unsigned*)(L + BARST_OFF);
    if (threadIdx.x < 2) barst[threadIdx.x] = 0u;
    __syncthreads();
    const XcdBarrier xbar = xcd_barrier_post((unsigned*)(args.ws + WS_BAR), barst);
    const int G = gridDim.x, bx = blockIdx.x;
    const int vcu = (G % 8 == 0) ? (bx % 8) * (G / 8) + bx / 8 : bx;
    const int NGW = G * NWAVES;
    unsigned char* ws = args.ws;
    const float* x_prompt = args.in[0]; const float* x_sample = args.in[1];
    const float* attn_norm_g = args.in[2]; const float* w_in = args.in[3]; const float* q_norm_g = args.in[4]; const float* k_norm_g = args.in[5];
    const float* sg_norm_g = args.in[6]; const float* sg_w = args.in[7]; const float* sg_b = args.in[8]; const float* w_branch_a = args.in[9];
    const float* w_branch_b = args.in[10]; const float* w_mix_out = args.in[11]; const float* ffn_norm_g = args.in[12]; const float* w_up = args.in[13];
    const float* conv_w = args.in[14]; const float* conv_b = args.in[15]; const float* w_down = args.in[16]; const float* final_norm_g = args.in[17];
    float* out = args.out;
    float* rope = (float*)(ws + WS_ROPE);
    bf16_t* Wall = (bf16_t*)(ws + WS_W);
    bf16_t* XB = (bf16_t*)(ws + WS_XB); bf16_t* QU = (bf16_t*)(ws + WS_QU); bf16_t* KB = (bf16_t*)(ws + WS_K); bf16_t* VB = (bf16_t*)(ws + WS_V);
    bf16_t* VST = (bf16_t*)(ws + WS_VST); bf16_t* GA = (bf16_t*)(ws + WS_GA); bf16_t* GB = (bf16_t*)(ws + WS_GB); bf16_t* H2 = (bf16_t*)(ws + WS_H2);
    float* SSQ = (float*)(ws + WS_SS); float* SSG = (float*)(ws + WS_SSG);

    for (int p = args.ph_lo; p < args.ph_hi; ++p) {
    if (p > args.ph_lo) { if (p == 1) GRID_SYNC(); else xcd_barrier(xbar); }
    int tid_ = threadIdx.x; asm volatile("" : "+v"(tid_));
    const int tid = tid_, lane = tid & 63, wave = __builtin_amdgcn_readfirstlane(tid >> 6);
    const int gw = vcu * NWAVES + wave;
    if (p == 0) {
        LAS float* scr = (LAS float*)(L + wave * 16384);
        constexpr int I_IN = 16 * (INW / 32), I_A = 8 * 32, I_MIX = 16 * 32, I_UP = 16 * 128, I_DOWN = 32 * 32, I_L = I_IN + 2 * I_A + I_MIX + I_UP + I_DOWN;
        for (int it = gw; it < I_L * NLAYER; it += NGW) {
            const int l = it / I_L; int r = it % I_L; bf16_t* wl = Wall + (size_t)l * WL_SIZE;
            if (r < I_IN) { transpose_item<1>(w_in + (size_t)l * 1024 * INW, attn_norm_g + l * 1024, 1024, INW, wl + WL_IN, scr, r, lane); continue; } r -= I_IN;
            if (r < I_A) { transpose_item<0>(w_branch_a + (size_t)l * 512 * 1024, nullptr, 512, 1024, wl + WL_A, scr, r, lane); continue; } r -= I_A;
            if (r < I_A) { transpose_item<0>(w_branch_b + (size_t)l * 512 * 1024, nullptr, 512, 1024, wl + WL_B, scr, r, lane); continue; } r -= I_A;
            if (r < I_MIX) { transpose_item<0>(w_mix_out + (size_t)l * 1024 * 1024, nullptr, 1024, 1024, wl + WL_MIX, scr, r, lane); continue; } r -= I_MIX;
            if (r < I_UP) { transpose_item<2>(w_up + (size_t)l * 1024 * 4096, ffn_norm_g + l * 1024, 1024, 4096, wl + WL_UP, scr, r, lane); continue; } r -= I_UP;
            transpose_item<0>(w_down + (size_t)l * 2048 * 1024, nullptr, 2048, 1024, wl + WL_DOWN, scr, r, lane);
        }
        for (int i = gw * 64 + lane; i < NLAYER * 8 * 128 * 128 / 4; i += NGW * 64) {
            const int l = i / (8 * 128 * 128 / 4), r = i % (8 * 128 * 128 / 4);
            const f32x4 v = *(const f32x4*)(sg_w + (size_t)l * 131072 + (size_t)r * 4);
            u32x2 w; w.x = cvt_pk_bf16(v.x, v.y); w.y = cvt_pk_bf16(v.z, v.w);
            *(u32x2*)(Wall + (size_t)l * WL_SIZE + WL_SG + (size_t)r * 4) = w;
        }
        for (int i = gw * 64 + lane; i < 128 * 16; i += NGW * 64) {
            const int pos = i >> 4, f = i & 15; float fr_ = 1.0f; for (int k = 0; k < f; ++k) fr_ *= 0.56234132519034907f;
            float c, s; sincos_tab((float)pos * fr_, c, s); rope[2 * i] = c; rope[2 * i + 1] = s;
        }
        for (int i = gw * 64 + lane; i < 257 * 128; i += NGW * 64) {
            const int r = i / 128, c = i % 128; const long row = (r == 0) ? -1 : (long)M_TOK + r - 1;
            *(u32x4*)(XB + row * 1024 + c * 8) = (u32x4){0u, 0u, 0u, 0u};
        }
        for (int m0 = gw; m0 < M_TOK; m0 += 2 * NGW) {
            const int nr = (m0 + NGW < M_TOK) ? 2 : 1;
            f32x4 v[2][4]; float sq[2];
#pragma unroll
            for (int r = 0; r < 2; ++r) { const int m = (r < nr) ? m0 + r * NGW : m0;
                const float* xr = (m < NPROMPT) ? x_prompt + (size_t)m * 1024 : x_sample + (size_t)(m - NPROMPT) * 1024; float s = 0.f;
#pragma unroll
                for (int j = 0; j < 4; ++j) { v[r][j] = *(const f32x4*)(xr + 4 * lane + 256 * j); s += (v[r][j].x * v[r][j].x + v[r][j].y * v[r][j].y) + (v[r][j].z * v[r][j].z + v[r][j].w * v[r][j].w); }
                sq[r] = s; }
#pragma unroll
            for (int r = 0; r < 2; ++r) if (r < nr) { const int m = m0 + r * NGW; const float s = wave_sum(sq[r]);
#pragma unroll
                for (int j = 0; j < 4; ++j) { u32x2 w; w.x = cvt_pk_bf16(v[r][j].x, v[r][j].y); w.y = cvt_pk_bf16(v[r][j].z, v[r][j].w); *(u32x2*)(XB + (size_t)m * 1024 + 4 * lane + 256 * j) = w; }
                if (lane < 16) SSQ[(size_t)m * 16 + lane] = (lane == 0) ? s : 0.f; }
        }
    }
    else if (p < N_PHASES - 1) {
        const int l = (p - 1) / 6, k = (p - 1) % 6;
        const bf16_t* wl = Wall + (size_t)l * WL_SIZE;
        if (k == 0) {
            pg8::Gemm g{XB, wl + WL_IN, 1024, 1024, 1024, 0, 0, 256, 128, 0};
            { pg8::StaticOrder S; S.init(M_TOK / 256, 3, 1, G, bx, 0);
              pg8::EpiQKV E{SSQ, q_norm_g + l * 64, k_norm_g + l * 64, rope, QU, KB, VB};
              pg8::gemm_phase<pg8::EpiQKV, 1>(L, g, S, E); }
            { pg8::StaticOrder S; S.init(M_TOK / 256, 2, 1, G, bx, 5);
              pg8::EpiVS E{SSQ, VST, SSG};
              pg8::gemm_phase<pg8::EpiVS, 1>(L, g, S, E); }
            { pg8::StaticOrder S; S.init(M_TOK / 256, 10, 1, G, bx, 3, 2, 7);
              pg8::EpiEW E{SSQ, QU, GA, GB};
              pg8::gemm_phase<pg8::EpiEW, 1>(L, g, S, E); }
        }
        else if (k == 1) {
            LAS float* scr = (LAS float*)(L + SG_SCR_OFF) + wave * 128;
            for (int u = gw; u < 768 * 8; u += NGW)
                sg_unit(u >> 3, u & 7, VST, SSG, wl + WL_SG, sg_b + l * 1024, sg_norm_g + l * 512, QU, scr, lane);
            for (int u = bx; u < 3072; u += G) {
                const int i = u >> 8, c = u & 255, x = c & 7, w = c >> 3;
                long rowbase; int seq, h, q0;
                if (i < 4) { const int idx = w * 4 + i; rowbase = (long)(x >> 1) * SEQ_P; seq = SEQ_P; h = (x & 1) * 4 + (idx >> 5); q0 = (idx & 31) * 256; }
                else { const int pair = 8 * x + (i - 4); rowbase = (long)NPROMPT + (long)(pair >> 1) * SEQ_S; seq = SEQ_S; h = (pair & 1) * 4 + (w >> 3); q0 = (w & 7) * 256; }
                attn_body::attn_unit<8>(rowbase, seq, h, q0, (const attn_body::bf16*)QU, (const attn_body::bf16*)KB, (const attn_body::bf16*)VB, (attn_body::bf16*)QU, (char*)lds);
            }
        }
        else if (k == 2) {
            pg8::Gemm g{QU, wl + WL_A, 1024, 512, 512, 512 * 2, (long)(WL_B - WL_A) * 2, 256, 0, 0};
            pg8::StaticOrder S; S.init(M_TOK / 256, 4, 2, G, bx);
            pg8::EpiMerge E{GA, GB};
            pg8::gemm_phase<pg8::EpiMerge, 2>(L, g, S, E);
        }
        else if (k == 3) {
            pg8::Gemm g{GA, wl + WL_MIX, 1024, 1024, 1024, 0, 0, 256, 0, 0};
            pg8::StaticOrder S; S.init(M_TOK / 256, 4, 1, G, bx);
            pg8::EpiRes E{x_prompt, x_sample, l == 0 ? 1 : 0, out, XB, SSQ, 0, 0};
            pg8::gemm_phase<pg8::EpiRes, 1>(L, g, S, E);
        }
        else if (k == 4) {
            pg8::Gemm g{XB, wl + WL_UP, 1024, 1024, 1024, 0, 0, 252, 126, -1};
            pg8::StaticOrder S; S.init((M_TOK + 251) / 252, 16, 1, G, bx);
            pg8::EpiUp E{SSQ, conv_w + (size_t)l * 3 * 4096, conv_b + (size_t)l * 4096, H2};
            pg8::gemm_phase<pg8::EpiUp, 1>(L, g, S, E);
        }
        else {
            pg8::Gemm g{H2, wl + WL_DOWN, 2048, 2048, 2048, 0, 0, 256, 0, 0};
            pg8::StaticOrder S; S.init(M_TOK / 256, 4, 1, G, bx);
            pg8::EpiRes E{x_prompt, x_sample, 0, out, XB, SSQ, 1, 1};
            pg8::gemm_phase<pg8::EpiRes, 1>(L, g, S, E);
        }
    } else
    {
        f32x4 gv[4];
#pragma unroll
        for (int j = 0; j < 4; ++j) gv[j] = *(const f32x4*)(final_norm_g + 4 * lane + 256 * j);
        for (int m = gw; m < M_TOK; m += 2 * NGW) {
            const int m2 = (m + NGW < M_TOK) ? m + NGW : m;
            float* xr = out + (size_t)m * 1024; float* xr2 = out + (size_t)m2 * 1024;
            const float sp = (lane < 16) ? SSQ[(size_t)m * 16 + lane] : 0.f, sp2 = (lane < 16) ? SSQ[(size_t)m2 * 16 + lane] : 0.f;
            f32x4 v[4], w[4];
#pragma unroll
            for (int j = 0; j < 4; ++j) { v[j] = *(const f32x4*)(xr + 4 * lane + 256 * j); w[j] = *(const f32x4*)(xr2 + 4 * lane + 256 * j); }
            const float rs = __builtin_amdgcn_rsqf(wave_sum(sp) * (1.0f / DMOD) + EPS), rs2 = __builtin_amdgcn_rsqf(wave_sum(sp2) * (1.0f / DMOD) + EPS);
#pragma unroll
            for (int j = 0; j < 4; ++j) { *(f32x4*)(xr + 4 * lane + 256 * j) = v[j] * gv[j] * rs; if (m2 != m) *(f32x4*)(xr2 + 4 * lane + 256 * j) = w[j] * gv[j] * rs2; }
        }
    }
    }
}

extern "C" void kernel_launch(void* const* d_in, const int* in_sizes, int n_in, void* d_out, int out_size, void* d_ws, size_t ws_size, hipStream_t stream) {
    static int grid = 0;
    if (grid == 0) {
        if (n_in != 18 || out_size != M_TOK * DMOD || ws_size < WS_END) { fprintf(stderr, "kernel_launch: unexpected shapes (n_in %d out %d ws %zu)\n", n_in, out_size, ws_size); grid = -1; return; }
        int dev = 0, cus = 0, per_cu = 0;
        (void)hipGetDevice(&dev); (void)hipDeviceGetAttribute(&cus, hipDeviceAttributeMultiprocessorCount, dev);
        (void)hipFuncSetAttribute((const void*)fwd_megakernel, hipFuncAttributeMaxDynamicSharedMemorySize, LDS_BYTES);
        (void)hipOccupancyMaxActiveBlocksPerMultiprocessor(&per_cu, (const void*)fwd_megakernel, NWAVES * 64, LDS_BYTES);
        if (per_cu < 1) { fprintf(stderr, "kernel_launch: occupancy query says %d blocks/CU\n", per_cu); per_cu = 1; }
        (void)hipGetLastError();
        grid = cus * 1;
    }
    if (grid < 0) return;
    (void)hipMemsetAsync((char*)d_ws + WS_BAR, 0, BAR_BYTES, stream);
    Args a{};
    for (int i = 0; i < 18; ++i) a.in[i] = (const float*)d_in[i];
    a.out = (float*)d_out; a.ws = (unsigned char*)d_ws;
    if (N_LAUNCH_MODE == 0) {
        a.ph_lo = 0; a.ph_hi = N_PHASES;
        void* params[] = {&a};
        hipError_t e = hipLaunchCooperativeKernel((const void*)fwd_megakernel, dim3(grid), dim3(NWAVES * 64), params, LDS_BYTES, stream);
        if (e != hipSuccess) fprintf(stderr, "cooperative launch failed: %s (grid %d)\n", hipGetErrorString(e), grid);
    } else {
        for (int p = 0; p < N_PHASES; ++p) { a.ph_lo = p; a.ph_hi = p + 1;
            hipLaunchKernelGGL(fwd_megakernel, dim3(grid), dim3(NWAVES * 64), LDS_BYTES, stream, a); }
    }
}
```

```cpp
#include <hip/hip_runtime.h>
#include <hip/hip_cooperative_groups.h>
#include <hip/hip_bf16.h>
#include <cstdio>
#include <cstdint>
#include <cmath>
namespace cg = cooperative_groups;

constexpr int M_TOK = 98304, NPROMPT = 32768, SEQ_P = 8192, SEQ_S = 2048;
constexpr int DMOD = 1024, INW = 3840, DFF = 2048, NLAYER = 4;
constexpr float EPS = 1e-6f;
constexpr float C2 = 0.125f * 1.4426950408889634f;

#define LAS __attribute__((address_space(3)))
typedef unsigned short bf16_t;
typedef short bf16x8 __attribute__((ext_vector_type(8)));
typedef float f32x4 __attribute__((ext_vector_type(4)));
typedef float f32x2 __attribute__((ext_vector_type(2)));
typedef unsigned u32x4 __attribute__((ext_vector_type(4)));
typedef unsigned u32x2 __attribute__((ext_vector_type(2)));

typedef __bf16 bf16x2_t_ __attribute__((ext_vector_type(2)));
__device__ __forceinline__ unsigned cvt_pk_bf16(float lo, float hi) { f32x2 v = {lo, hi}; bf16x2_t_ b = __builtin_convertvector(v, bf16x2_t_); return __builtin_bit_cast(unsigned, b); }
__device__ __forceinline__ float bf_lo(unsigned w) { return __uint_as_float(w << 16); }
__device__ __forceinline__ float bf_hi(unsigned w) { return __uint_as_float(w & 0xffff0000u); }
__device__ __forceinline__ float gelu_t(float x) {
    const float u = x * (0.7978845608f + 0.0356774081f * x * x);
    const float e = __builtin_amdgcn_exp2f(u * -2.8853900818f);
    return x * __builtin_amdgcn_rcpf(1.0f + e);
}
__device__ __forceinline__ float sigmoid_f(float x) { return __builtin_amdgcn_rcpf(1.0f + __builtin_amdgcn_exp2f(x * -1.4426950409f)); }
__device__ __forceinline__ float dpp_shr1(float v) { return __int_as_float(__builtin_amdgcn_update_dpp(0, __float_as_int(v), 0x111, 0xF, 0xF, true)); }
__device__ __forceinline__ float dpp_shl1(float v) { return __int_as_float(__builtin_amdgcn_update_dpp(0, __float_as_int(v), 0x101, 0xF, 0xF, true)); }

namespace pg8 {
constexpr int BM = 256, BK = 64, HALF = 128, HTB = HALF * BK * 2, STAGE_BYTES = 8 * HTB, NXCD = 8, WGM = 8;
__host__ __device__ __forceinline__ int lds_byte(int r, int c) { const int st = (r >> 4) * 2 + (c >> 5), rr = r & 15, cc = c & 31, ob = rr * 64 + cc * 2; return st * 1024 + (ob ^ (((ob >> 9) & 1) << 5)); }
__host__ __device__ __forceinline__ void stage_rc(int b, int& R, int& C) { const int st = b / 1024, sb = b % 1024, swz = sb ^ (((sb >> 9) & 1) << 5); R = (st >> 1) * 16 + swz / 64; C = (st & 1) * 32 + (swz % 64) / 2; }

struct Unit { int pm, pn, part; };
struct Gemm { const bf16_t* A; const bf16_t* Bt; int lda, ldb, K; long partA, partB; int tstride, wstride, shift; };

struct StaticOrder {
    int nM, nN, nwg, G, c, parts, pn_lo, pn_split, pn_hi;
    __device__ void init(int nM_, int nN_, int parts_, int G_, int c_, int pn_lo_ = 0, int pn_split_ = 1 << 20, int pn_hi_ = 0) { nM = nM_; nN = nN_; nwg = nM * nN; G = G_; c = c_; parts = parts_; pn_lo = pn_lo_; pn_split = pn_split_; pn_hi = pn_hi_; }
    __device__ bool next(int i, Unit& u) const {
        const int it = (parts == 2) ? (i >> 1) : i; u.part = (parts == 2) ? (i & 1) : 0;
        const long L = (long)it * G + c; if (L >= nwg) return false;
        int wgid = (int)L; { const int q = nwg / NXCD, r = nwg % NXCD, xcd = wgid % NXCD, off = wgid / NXCD; wgid = (xcd < r ? xcd * (q + 1) : r * (q + 1) + (xcd - r) * q) + off; }
        const int nig = WGM * nN, gid = wgid / nig, fm = gid * WGM, gsz = (nM - fm) < WGM ? (nM - fm) : WGM;
        u.pm = fm + ((wgid % nig) % gsz); { const int ix = (wgid % nig) / gsz; u.pn = ix < pn_split ? pn_lo + ix : pn_hi + (ix - pn_split); } return true;
    }
};

template <class Epi, int PARTS>
__device__ __forceinline__ void gemm_phase(LAS unsigned char* lds, const Gemm g, const StaticOrder& S, const Epi& E) {
    int tid_ = threadIdx.x; asm volatile("" : "+v"(tid_));
    const int tid = tid_, wid = __builtin_amdgcn_readfirstlane(tid >> 6), lane = tid & 63, wr = wid >> 2, wc = wid & 3, fr = lane & 15, fq = lane >> 4;
    const int K = g.K, nt = K / BK;
    unsigned voffA[2], voffB[2];
#pragma unroll
    for (int i = 0; i < 2; ++i) { int R, C; stage_rc(tid * 16 + i * 8192, R, C);
        const int TR = g.wstride ? g.wstride * (R >> 6) + 8 * (R & 15) + ((R >> 4) & 3) : R;
        voffA[i] = (unsigned)(TR * g.lda + C) * 2u; voffB[i] = (unsigned)(R * g.ldb + C) * 2u; }
    const size_t kstep = (size_t)(BK * 2);
    const size_t hstepA = (size_t)(g.wstride ? 4 : HALF) * g.lda * 2, hstepB = (size_t)HALF * g.ldb * 2;
    const unsigned ldsw = (unsigned)wid * 1024u;
    const int aoff = lds_byte(wr * 64 + fr, fq * 8), boff = lds_byte(wc * 32 + fr, fq * 8);
#define PG8_SA(b, h) (((b) * 2 + (h)) * HTB)
#define PG8_SB(b, h) ((4 + (b) * 2 + (h)) * HTB)
#define PG8_STAGE(bufoff, gbase, voff) do { _Pragma("unroll") for (int _i = 0; _i < 2; ++_i) \
        __builtin_amdgcn_global_load_lds((const unsigned*)((const char*)(gbase) + (voff)[_i]), (LAS unsigned*)(lds + (bufoff) + ldsw + _i * 8192), 16, 0, 0); } while (0)
#define PG8_STAGEA(bufoff, gbase, voff) do { _Pragma("unroll") for (int _i = 0; _i < 2; ++_i) \
        __builtin_amdgcn_global_load_lds((const unsigned*)((const char*)(gbase) + (voff)[_i]), (LAS unsigned*)(lds + (bufoff) + ldsw + _i * 8192), 16, 0, 0); } while (0)
#define PG8_LDA(dst, b, h) do { _Pragma("unroll") for (int m = 0; m < 4; ++m) _Pragma("unroll") for (int k = 0; k < 2; ++k) dst[m][k] = *(const LAS bf16x8*)(lds + PG8_SA(b, h) + aoff + m * 2048 + k * 1024); } while (0)
#define PG8_LDB(dst, b, h) do { _Pragma("unroll") for (int n = 0; n < 2; ++n) _Pragma("unroll") for (int k = 0; k < 2; ++k) dst[n][k] = *(const LAS bf16x8*)(lds + PG8_SB(b, h) + boff + n * 2048 + k * 1024); } while (0)
#define PG8_MMA(ai, bj, At, Bt) do { __builtin_amdgcn_s_setprio(1); _Pragma("unroll") for (int m = 0; m < 4; ++m) _Pragma("unroll") for (int n = 0; n < 2; ++n) _Pragma("unroll") for (int k = 0; k < 2; ++k) \
        acc[ai][bj][m][n] = __builtin_amdgcn_mfma_f32_16x16x32_bf16(Bt[n][k], At[m][k], acc[ai][bj][m][n], 0, 0, 0); __builtin_amdgcn_s_setprio(0); } while (0)
#define PG8_WAIT_V(n) asm volatile("s_waitcnt vmcnt(" #n ")" ::: "memory")
#define PG8_WAIT_L(n) asm volatile("s_waitcnt lgkmcnt(" #n ")" ::: "memory")
#define PG8_BAR __builtin_amdgcn_s_barrier()
#define PG8_SCHED __builtin_amdgcn_sched_barrier(0)
#define PG8_UA(u) ((const char*)g.A + (size_t)(u).part * g.partA + ((long)(u).pm * g.tstride + g.shift) * (long)g.lda * 2)
#define PG8_UB(u) ((const char*)g.Bt + (size_t)(u).part * g.partB + (size_t)(u).pn * 256 * g.ldb * 2)
    Unit cur, nxt; int ui = 0;
    if (!S.next(0, cur)) return;
    f32x4 acc[2][2][4][2];
#pragma unroll
    for (int a = 0; a < 2; ++a)
#pragma unroll
        for (int b = 0; b < 2; ++b)
#pragma unroll
            for (int m = 0; m < 4; ++m)
#pragma unroll
                for (int n = 0; n < 2; ++n) acc[a][b][m][n] = (f32x4){0.f, 0.f, 0.f, 0.f};
    bf16x8 At[4][2], B0[2][2], B1[2][2];
    const char* cA = PG8_UA(cur); const char* cB = PG8_UB(cur);
    PG8_STAGE(PG8_SB(0, 0), cB, voffB); PG8_STAGE(PG8_SB(0, 1), cB + hstepB, voffB); PG8_STAGEA(PG8_SA(0, 0), cA, voffA); PG8_STAGEA(PG8_SA(0, 1), cA + hstepA, voffA);
    if (wr == 1) PG8_BAR;
    PG8_WAIT_V(2); PG8_BAR;
    PG8_STAGE(PG8_SB(1, 0), cB + kstep, voffB); PG8_STAGEA(PG8_SA(1, 0), cA + kstep, voffA); PG8_STAGE(PG8_SB(1, 1), cB + hstepB + kstep, voffB);
    PG8_WAIT_V(6); PG8_BAR;
    for (;;) {
        const bool has_next = S.next(ui + 1, nxt);
        const char* nA = has_next ? PG8_UA(nxt) : cA; const char* nB = has_next ? PG8_UB(nxt) : cB;
        for (int t = 0; t < nt; t += 2) {
            const bool last = (t == nt - 2);
            const char* a1 = cA + (size_t)(t + 1) * kstep;
            const char* a2 = last ? nA : cA + (size_t)(t + 2) * kstep; const char* b2 = last ? nB : cB + (size_t)(t + 2) * kstep;
            const char* a3 = a2 + kstep; const char* b3 = b2 + kstep;
            PG8_LDB(B0, 0, 0); PG8_LDB(B1, 0, 1); PG8_SCHED; PG8_LDA(At, 0, 0); PG8_STAGEA(PG8_SA(1, 1), a1 + hstepA, voffA);
            PG8_WAIT_V(8); PG8_WAIT_L(0); PG8_BAR; PG8_MMA(0, 0, At, B0); PG8_MMA(0, 1, At, B1); PG8_BAR; PG8_SCHED;
            PG8_LDA(At, 0, 1); PG8_STAGE(PG8_SB(0, 0), b2, voffB); PG8_STAGE(PG8_SB(0, 1), b2 + hstepB, voffB); PG8_STAGEA(PG8_SA(0, 0), a2, voffA);
            PG8_WAIT_V(8); PG8_WAIT_L(0); PG8_BAR; PG8_MMA(1, 0, At, B0); PG8_MMA(1, 1, At, B1); PG8_BAR; PG8_SCHED;
            PG8_LDB(B0, 1, 0); PG8_LDB(B1, 1, 1); PG8_SCHED; PG8_LDA(At, 1, 0); PG8_STAGEA(PG8_SA(0, 1), a2 + hstepA, voffA);
            PG8_WAIT_V(8); PG8_WAIT_L(0); PG8_BAR; PG8_MMA(0, 0, At, B0); PG8_MMA(0, 1, At, B1); PG8_BAR; PG8_SCHED;
            PG8_LDA(At, 1, 1); PG8_STAGE(PG8_SB(1, 0), b3, voffB); PG8_STAGE(PG8_SB(1, 1), b3 + hstepB, voffB); PG8_STAGEA(PG8_SA(1, 0), a3, voffA);
            PG8_WAIT_V(8); PG8_WAIT_L(0); PG8_BAR; PG8_MMA(1, 0, At, B0); PG8_MMA(1, 1, At, B1); PG8_BAR; PG8_SCHED;
        }
        if (wr == 0) PG8_BAR;
        E(acc, cur, wr, wc, fr, fq);
        if (!has_next) break;
        if (PARTS == 1 || nxt.part == 0) {
#pragma unroll
        for (int a = 0; a < 2; ++a)
#pragma unroll
            for (int b = 0; b < 2; ++b)
#pragma unroll
                for (int m = 0; m < 4; ++m)
#pragma unroll
                    for (int n = 0; n < 2; ++n) acc[a][b][m][n] = (f32x4){0.f, 0.f, 0.f, 0.f};
        }
        cur = nxt; cA = nA; cB = nB; ++ui;
        if (wr == 1) PG8_BAR;
    }
    PG8_WAIT_V(0);
    PG8_BAR;
#undef PG8_SA
#undef PG8_SB
#undef PG8_STAGE
#undef PG8_STAGEA
#undef PG8_LDA
#undef PG8_LDB
#undef PG8_MMA
#undef PG8_WAIT_V
#undef PG8_WAIT_L
#undef PG8_BAR
#undef PG8_SCHED
#undef PG8_UA
#undef PG8_UB
}

__device__ __forceinline__ void load_rs8(const float* ss, int t0, int fq, float (&rs)[8], int tmax) {
#pragma unroll
    for (int j = 0; j < 8; ++j) { int t = t0 + j; t = t < 0 ? 0 : (t > tmax ? tmax : t);
        const f32x4 p = *(const f32x4*)(ss + (size_t)t * 16 + 4 * fq); float s = (p.x + p.y) + (p.z + p.w);
        s += __shfl_xor(s, 16); s += __shfl_xor(s, 32); rs[j] = __builtin_amdgcn_rsqf(s * (1.0f / DMOD) + EPS); }
}

struct EpiQKV {
    const float* ss; const float* qg; const float* kg; const float* rope;
    bf16_t* QU; bf16_t* Kb; bf16_t* Vb;
    __device__ __forceinline__ void operator()(f32x4 (&acc)[2][2][4][2], const Unit& u, int wr, int wc, int fr, int fq) const {
        const int t0 = u.pm * 256 + wr * 128 + fr * 8;
        { float rs[8]; load_rs8(ss, t0, fq, rs, M_TOK - 1);
#pragma unroll
          for (int ai = 0; ai < 2; ++ai)
#pragma unroll
            for (int m = 0; m < 4; ++m)
#pragma unroll
                for (int bj = 0; bj < 2; ++bj)
#pragma unroll
                    for (int n = 0; n < 2; ++n) acc[ai][bj][m][n] = acc[ai][bj][m][n] * rs[4 * ai + m]; }
        const int pn = u.pn;
        {
            const bool isq = pn < 2;
            if (isq || wc < 2) {
                const float* gp = isq ? qg : kg; const float osc = isq ? C2 : 1.0f;
                f32x4 gv[2][2];
#pragma unroll
                for (int bj = 0; bj < 2; ++bj)
#pragma unroll
                    for (int n = 0; n < 2; ++n) gv[bj][n] = *(const f32x4*)(gp + 32 * bj + 16 * n + 4 * fq);
                const int smask = (t0 < NPROMPT) ? (SEQ_P - 1) : (SEQ_S - 1);
                const int prow = (t0 & smask) >> 6;
                const f32x4 rr0 = *(const f32x4*)(rope + (prow * 16 + 4 * fq) * 2), rr1 = *(const f32x4*)(rope + (prow * 16 + 4 * fq) * 2 + 4);
                bf16_t* dst = isq ? (QU + (size_t)t0 * 1024 + (4 * pn + wc) * 64) : (Kb + (size_t)t0 * 128 + wc * 64);
                const int pitch = isq ? 1024 : 128;
#pragma unroll
                for (int ai = 0; ai < 2; ++ai)
#pragma unroll
                    for (int m = 0; m < 4; ++m) {
                        const int j = 4 * ai + m;
                        float sq = 0.f;
#pragma unroll
                        for (int bj = 0; bj < 2; ++bj)
#pragma unroll
                            for (int n = 0; n < 2; ++n) { const f32x4 v = acc[ai][bj][m][n]; sq += (v.x * v.x + v.y * v.y) + (v.z * v.z + v.w * v.w); }
                        sq += __shfl_xor(sq, 16); sq += __shfl_xor(sq, 32);
                        const float rn = __builtin_amdgcn_rsqf(sq * (1.0f / 64.0f) + EPS) * osc;
                        const int pcol = (t0 + j) & 63;
                        const f32x4 cc0 = *(const f32x4*)(rope + (pcol * 16 + 4 * fq) * 2), cc1 = *(const f32x4*)(rope + (pcol * 16 + 4 * fq) * 2 + 4);
#pragma unroll
                        for (int bj = 0; bj < 2; ++bj) {
                            const f32x4 t0v = bj == 0 ? rr0 : cc0, t1v = bj == 0 ? rr1 : cc1;
                            const f32x4 x1 = acc[ai][bj][m][0] * gv[bj][0] * rn, x2 = acc[ai][bj][m][1] * gv[bj][1] * rn;
                            const f32x4 cs = (f32x4){t0v.x, t0v.z, t1v.x, t1v.z}, sn = (f32x4){t0v.y, t0v.w, t1v.y, t1v.w};
                            const f32x4 o1 = x1 * cs - x2 * sn, o2 = x1 * sn + x2 * cs;
                            u32x2 w1, w2; w1.x = cvt_pk_bf16(o1.x, o1.y); w1.y = cvt_pk_bf16(o1.z, o1.w); w2.x = cvt_pk_bf16(o2.x, o2.y); w2.y = cvt_pk_bf16(o2.z, o2.w);
                            bf16_t* p = dst + (size_t)j * pitch + 32 * bj + 4 * fq;
                            *(u32x2*)p = w1; *(u32x2*)(p + 16) = w2;
                        }
                    }
            } else {
                bf16_t* dst = Vb + (size_t)t0 * 128 + (wc - 2) * 64;
#pragma unroll
                for (int ai = 0; ai < 2; ++ai)
#pragma unroll
                    for (int m = 0; m < 4; ++m)
#pragma unroll
                        for (int bj = 0; bj < 2; ++bj)
#pragma unroll
                            for (int n = 0; n < 2; ++n) { const f32x4 v = acc[ai][bj][m][n]; u32x2 w; w.x = cvt_pk_bf16(v.x, v.y); w.y = cvt_pk_bf16(v.z, v.w);
                                *(u32x2*)(dst + (size_t)(4 * ai + m) * 128 + 32 * bj + 16 * n + 4 * fq) = w; }
            }
        }
    }
};
struct EpiVS {
    const float* ss; bf16_t* VST; float* ssg;
    __device__ __forceinline__ void operator()(f32x4 (&acc)[2][2][4][2], const Unit& u, int wr, int wc, int fr, int fq) const {
        const int t0 = u.pm * 256 + wr * 128 + fr * 8;
        { float rs[8]; load_rs8(ss, t0, fq, rs, M_TOK - 1);
#pragma unroll
          for (int ai = 0; ai < 2; ++ai)
#pragma unroll
            for (int m = 0; m < 4; ++m)
#pragma unroll
                for (int bj = 0; bj < 2; ++bj)
#pragma unroll
                    for (int n = 0; n < 2; ++n) acc[ai][bj][m][n] = acc[ai][bj][m][n] * rs[4 * ai + m]; }
        const int pn = u.pn;
        {
            const int chunk = 2 * u.pm + wr;
            bf16_t* dst = VST + ((size_t)chunk * 512 + 256 * (pn - 5) + 32 * wc + 8 * fq) * 128 + 8 * fr;
#pragma unroll
            for (int ai = 0; ai < 2; ++ai)
#pragma unroll
                for (int m = 0; m < 4; ++m) {
                    float sq = 0.f;
#pragma unroll
                    for (int bj = 0; bj < 2; ++bj)
#pragma unroll
                        for (int n = 0; n < 2; ++n) { f32x4 v = acc[ai][bj][m][n]; v = (f32x4){gelu_t(v.x), gelu_t(v.y), gelu_t(v.z), gelu_t(v.w)}; acc[ai][bj][m][n] = v;
                            sq += (v.x * v.x + v.y * v.y) + (v.z * v.z + v.w * v.w); }
                    sq += __shfl_xor(sq, 16); sq += __shfl_xor(sq, 32);
                    if (fq == 0) ssg[(size_t)(t0 + 4 * ai + m) * 8 + 4 * (pn - 5) + wc] = sq;
                    asm volatile("" : "+v"(acc[ai][0][m][0]), "+v"(acc[ai][0][m][1]), "+v"(acc[ai][1][m][0]), "+v"(acc[ai][1][m][1]));
                }
#pragma unroll
            for (int bj = 0; bj < 2; ++bj)
#pragma unroll
                for (int n = 0; n < 2; ++n)
#pragma unroll
                    for (int i = 0; i < 4; ++i) {
                        u32x4 w; w.x = cvt_pk_bf16(acc[0][bj][0][n][i], acc[0][bj][1][n][i]); w.y = cvt_pk_bf16(acc[0][bj][2][n][i], acc[0][bj][3][n][i]);
                        w.z = cvt_pk_bf16(acc[1][bj][0][n][i], acc[1][bj][1][n][i]); w.w = cvt_pk_bf16(acc[1][bj][2][n][i], acc[1][bj][3][n][i]);
                        *(u32x4*)(dst + (size_t)(128 * bj + 4 * n + i) * 128) = w;
                    }
        }
    }
};
struct EpiEW {
    const float* ss; bf16_t* QU; bf16_t* GA; bf16_t* GB;
    __device__ __forceinline__ void operator()(f32x4 (&acc)[2][2][4][2], const Unit& u, int wr, int wc, int fr, int fq) const {
        const int t0 = u.pm * 256 + wr * 128 + fr * 8;
        float rs[8]; load_rs8(ss, t0, fq, rs, M_TOK - 1);
        const int pn = u.pn;
        const bool isu = pn < 5;
        bf16_t* dst = (isu ? QU + 512 + 256 * (pn - 3) : ((pn < 11) ? GA : GB) + 256 * ((pn - 7) & 3)) + (size_t)t0 * 1024 + 32 * wc + 8 * fq;
        if (isu) {
#pragma unroll
            for (int ai = 0; ai < 2; ++ai)
#pragma unroll
                for (int m = 0; m < 4; ++m)
#pragma unroll
                    for (int bj = 0; bj < 2; ++bj) { const f32x4 a = acc[ai][bj][m][0] * rs[4 * ai + m], b = acc[ai][bj][m][1] * rs[4 * ai + m]; u32x4 w;
                        w.x = cvt_pk_bf16(gelu_t(a.x), gelu_t(a.y)); w.y = cvt_pk_bf16(gelu_t(a.z), gelu_t(a.w)); w.z = cvt_pk_bf16(gelu_t(b.x), gelu_t(b.y)); w.w = cvt_pk_bf16(gelu_t(b.z), gelu_t(b.w));
                        *(u32x4*)(dst + (size_t)(4 * ai + m) * 1024 + 128 * bj) = w; }
        } else {
#pragma unroll
            for (int ai = 0; ai < 2; ++ai)
#pragma unroll
                for (int m = 0; m < 4; ++m) { const float k2 = rs[4 * ai + m] * -1.4426950409f;
#pragma unroll
                    for (int bj = 0; bj < 2; ++bj) { const f32x4 a = acc[ai][bj][m][0], b = acc[ai][bj][m][1]; u32x4 w;
#define SG_(x) __builtin_amdgcn_rcpf(1.0f + __builtin_amdgcn_exp2f((x) * k2))
                        w.x = cvt_pk_bf16(SG_(a.x), SG_(a.y)); w.y = cvt_pk_bf16(SG_(a.z), SG_(a.w)); w.z = cvt_pk_bf16(SG_(b.x), SG_(b.y)); w.w = cvt_pk_bf16(SG_(b.z), SG_(b.w));
#undef SG_
                        *(u32x4*)(dst + (size_t)(4 * ai + m) * 1024 + 128 * bj) = w; } }
        }
    }
};

struct EpiMerge {
    bf16_t* GA; const bf16_t* GB;
    __device__ __forceinline__ void operator()(f32x4 (&acc)[2][2][4][2], const Unit& u, int wr, int wc, int fr, int fq) const {
        const int t0 = u.pm * 256 + wr * 64 + fr;
        const size_t off0 = (size_t)t0 * 1024 + 256 * u.pn + 32 * wc + 8 * fq;
#pragma unroll
        for (int ai = 0; ai < 2; ++ai)
#pragma unroll
            for (int m = 0; m < 4; ++m)
#pragma unroll
                for (int bj = 0; bj < 2; ++bj) {
                    const size_t off = off0 + (size_t)(128 * ai + 16 * m) * 1024 + 128 * bj;
                    const u32x4 gb = *(const u32x4*)(GB + off);
                    f32x4 s0 = (f32x4){bf_lo(gb.x), bf_hi(gb.x), bf_lo(gb.y), bf_hi(gb.y)}, s1 = (f32x4){bf_lo(gb.z), bf_hi(gb.z), bf_lo(gb.w), bf_hi(gb.w)};
                    if (u.part == 0) {
                        const u32x4 ga = *(const u32x4*)(GA + off);
                        const f32x4 a0 = (f32x4){bf_lo(ga.x), bf_hi(ga.x), bf_lo(ga.y), bf_hi(ga.y)}, a1 = (f32x4){bf_lo(ga.z), bf_hi(ga.z), bf_lo(ga.w), bf_hi(ga.w)};
                        s0 = (f32x4){__builtin_amdgcn_rcpf(s0.x), __builtin_amdgcn_rcpf(s0.y), __builtin_amdgcn_rcpf(s0.z), __builtin_amdgcn_rcpf(s0.w)};
                        s1 = (f32x4){__builtin_amdgcn_rcpf(s1.x), __builtin_amdgcn_rcpf(s1.y), __builtin_amdgcn_rcpf(s1.z), __builtin_amdgcn_rcpf(s1.w)};
                        acc[ai][bj][m][0] = acc[ai][bj][m][0] * (a0 * s0); acc[ai][bj][m][1] = acc[ai][bj][m][1] * (a1 * s1);
                    } else {
                        const f32x4 v0 = acc[ai][bj][m][0] * s0, v1 = acc[ai][bj][m][1] * s1; u32x4 w;
                        w.x = cvt_pk_bf16(v0.x, v0.y); w.y = cvt_pk_bf16(v0.z, v0.w); w.z = cvt_pk_bf16(v1.x, v1.y); w.w = cvt_pk_bf16(v1.z, v1.w);
                        *(u32x4*)(GA + off) = w;
                    }
                }
    }
};

struct EpiRes {
    const float* xp; const float* xs; int first; float* out; bf16_t* xb; float* ss; int bb; int wout;
    __device__ __forceinline__ void operator()(f32x4 (&acc)[2][2][4][2], const Unit& u, int wr, int wc, int fr, int fq) const {
        const int t0 = u.pm * 256 + wr * 64 + fr;
        const int col0 = 256 * u.pn + 32 * wc + 8 * fq;
        const float* bp0 = first ? ((t0 < NPROMPT) ? xp + (size_t)t0 * 1024 : xs + (size_t)(t0 - NPROMPT) * 1024) : out + (size_t)t0 * 1024;
#pragma unroll
        for (int ai = 0; ai < 2; ++ai)
#pragma unroll
            for (int m = 0; m < 4; ++m) {
                const int j = 128 * ai + 16 * m; float sq = 0.f;
#pragma unroll
                for (int bj = 0; bj < 2; ++bj) {
                    const size_t o = (size_t)j * 1024 + col0 + 128 * bj;
                    f32x4 a, b;
                    if (bb) { const u32x4 w = *(const u32x4*)(xb + (size_t)t0 * 1024 + o);
                        a = (f32x4){bf_lo(w.x), bf_hi(w.x), bf_lo(w.y), bf_hi(w.y)}; b = (f32x4){bf_lo(w.z), bf_hi(w.z), bf_lo(w.w), bf_hi(w.w)}; }
                    else { a = *(const f32x4*)(bp0 + o); b = *(const f32x4*)(bp0 + o + 4); }
                    a = a + acc[ai][bj][m][0]; b = b + acc[ai][bj][m][1];
                    if (wout) { float* op = out + (size_t)t0 * 1024 + o; *(f32x4*)op = a; *(f32x4*)(op + 4) = b; }
                    u32x4 w; w.x = cvt_pk_bf16(a.x, a.y); w.y = cvt_pk_bf16(a.z, a.w); w.z = cvt_pk_bf16(b.x, b.y); w.w = cvt_pk_bf16(b.z, b.w);
                    *(u32x4*)(xb + (size_t)t0 * 1024 + o) = w;
                    sq += (a.x * a.x + a.y * a.y) + (a.z * a.z + a.w * a.w) + (b.x * b.x + b.y * b.y) + (b.z * b.z + b.w * b.w);
                }
                sq += __shfl_xor(sq, 16); sq += __shfl_xor(sq, 32);
                if (fq == 0) ss[(size_t)(t0 + j) * 16 + 4 * u.pn + wc] = sq;
            }
    }
};

struct EpiUp {
    const float* ss; const float* cw; const float* cb; bf16_t* H2;
    __device__ __forceinline__ void operator()(f32x4 (&acc)[2][2][4][2], const Unit& u, int wr, int wc, int fr, int fq) const {
        const int t0 = u.pm * 252 - 1 + wr * 126 + fr * 8;
        { float rs[8]; load_rs8(ss, t0, fq, rs, M_TOK - 1);
#pragma unroll
          for (int ai = 0; ai < 2; ++ai)
#pragma unroll
            for (int m = 0; m < 4; ++m)
#pragma unroll
                for (int bj = 0; bj < 2; ++bj)
#pragma unroll
                    for (int n = 0; n < 2; ++n) acc[ai][bj][m][n] = acc[ai][bj][m][n] * rs[4 * ai + m]; }
        unsigned vmask = 0, smask = 0, emask = 0;
#pragma unroll
        for (int j = 0; j < 8; ++j) { const int t = t0 + j, loc = fr * 8 + j;
            if (loc >= 1 && loc <= 126 && t < M_TOK) vmask |= 1u << j;
            const int sm = (t < NPROMPT) ? (SEQ_P - 1) : (SEQ_S - 1);
            if ((t & sm) == 0) smask |= 1u << j;
            if ((t & sm) == sm) emask |= 1u << j; }
#pragma unroll
        for (int n = 0; n < 2; ++n) {
            const int cg_ = 128 * u.pn + 32 * wc + 8 * fq + 4 * n;
            const f32x4 w0g = *(const f32x4*)(cw + cg_), w1g = *(const f32x4*)(cw + 4096 + cg_), w2g = *(const f32x4*)(cw + 8192 + cg_), bg = *(const f32x4*)(cb + cg_);
            const f32x4 w0v = *(const f32x4*)(cw + 2048 + cg_), w1v = *(const f32x4*)(cw + 4096 + 2048 + cg_), w2v = *(const f32x4*)(cw + 8192 + 2048 + cg_), bv = *(const f32x4*)(cb + 2048 + cg_);
            float h[8][4];
#pragma unroll
            for (int i = 0; i < 4; ++i) {
                float ag[8], av[8];
#pragma unroll
                for (int j = 0; j < 8; ++j) { ag[j] = acc[j >> 2][0][j & 3][n][i]; av[j] = acc[j >> 2][1][j & 3][n][i]; }
                const float lg = dpp_shr1(ag[7]), rg = dpp_shl1(ag[0]), lv = dpp_shr1(av[7]), rv = dpp_shl1(av[0]);
#pragma unroll
                for (int j = 0; j < 8; ++j) {
                    float Lg = j == 0 ? lg : ag[j == 0 ? 0 : j - 1], Rg = j == 7 ? rg : ag[j == 7 ? 7 : j + 1];
                    float Lv = j == 0 ? lv : av[j == 0 ? 0 : j - 1], Rv = j == 7 ? rv : av[j == 7 ? 7 : j + 1];
                    if ((smask >> j) & 1u) { Lg = 0.f; Lv = 0.f; }
                    if ((emask >> j) & 1u) { Rg = 0.f; Rv = 0.f; }
                    const float cgv = w0g[i] * Lg + w1g[i] * ag[j] + w2g[i] * Rg + bg[i];
                    const float cvv = w0v[i] * Lv + w1v[i] * av[j] + w2v[i] * Rv + bv[i];
                    h[j][i] = gelu_t(cgv) * cvv;
                }
            }
#pragma unroll
            for (int j = 0; j < 8; ++j) if ((vmask >> j) & 1u) { u32x2 w; w.x = cvt_pk_bf16(h[j][0], h[j][1]); w.y = cvt_pk_bf16(h[j][2], h[j][3]);
                *(u32x2*)(H2 + (size_t)(t0 + j) * 2048 + cg_) = w; }
        }
    }
};
}

namespace attn_body {
using bf16=__hip_bfloat16;
using bf16x8=__attribute__((ext_vector_type(8)))short;
using s16x4=__attribute__((ext_vector_type(4)))short;
using f32x16=__attribute__((ext_vector_type(16)))float;
using u32x4=__attribute__((ext_vector_type(4)))unsigned;
constexpr int D=64,QP=1024,KP=128;
constexpr int NW=8,QBLK=32,QB=QBLK*NW,KVBLK=64;
__device__ __forceinline__ int crow(int r,int hi){return (r&3)+8*(r>>2)+4*hi;}
#define SBAR() __builtin_amdgcn_sched_barrier(0)
constexpr int NSLOT=3, SLOTB=8192;
constexpr int LDS_K=0, LDS_V=NSLOT*SLOTB, LDS_WS=2*NSLOT*SLOTB, LDS_OST=LDS_WS+NW*64*4, LDS_BYTES=LDS_OST+NW*4096;
__device__ __forceinline__ void glds16(const void*gsrc,unsigned lds_dst){unsigned keep;
  asm volatile("s_mov_b32 %0, m0\n\ts_mov_b32 m0, %2\n\ts_nop 0\n\tglobal_load_lds_dwordx4 %1, off\n\ts_mov_b32 m0, %0":"=&s"(keep):"v"(gsrc),"s"(lds_dst):"memory");}
__device__ __forceinline__ float max3f(float a,float b,float c){float r;asm("v_max3_f32 %0, %1, %2, %3":"=v"(r):"v"(a),"v"(b),"v"(c));return r;}
__device__ __forceinline__ float max2f(float a,float b){float r;asm("v_max_f32_e32 %0, %1, %2":"=v"(r):"v"(a),"v"(b));return r;}
__device__ __forceinline__ float fadd_s(float a,float b){float r;asm("v_add_f32_e32 %0, %1, %2":"=v"(r):"v"(a),"v"(b));return r;}
__device__ __forceinline__ float fsub_s(float a,float b){float r;asm("v_sub_f32_e32 %0, %1, %2":"=v"(r):"v"(a),"v"(b));return r;}
typedef float f32x2_t __attribute__((ext_vector_type(2))); typedef __bf16 bf16x2_t __attribute__((ext_vector_type(2)));
__device__ __forceinline__ unsigned cvtpk_s(float lo,float hi){f32x2_t v={lo,hi};bf16x2_t b=__builtin_convertvector(v,bf16x2_t);return __builtin_bit_cast(unsigned,b);}
#define WAIT_BAR(N) asm volatile("s_waitcnt vmcnt(" #N ") lgkmcnt(0)\n\ts_barrier":::"memory")
__device__ __forceinline__ void qkt(f32x16&p0,f32x16&p1,const char*Kslot,const bf16x8*qr,const f32x16&negm,int r32,int hi){
  const char*kb=Kslot+hi*1024+r32*16;
  #pragma unroll
  for(int d0=0;d0<4;++d0){
    const bf16x8 b0=*reinterpret_cast<const bf16x8*>(kb+d0*2048);
    const bf16x8 b1=*reinterpret_cast<const bf16x8*>(kb+d0*2048+512);
    if(d0==0){p0=__builtin_amdgcn_mfma_f32_32x32x16_bf16(b0,qr[0],negm,0,0,0);p1=__builtin_amdgcn_mfma_f32_32x32x16_bf16(b1,qr[0],negm,0,0,0);}
    else{p0=__builtin_amdgcn_mfma_f32_32x32x16_bf16(b0,qr[d0],p0,0,0,0);p1=__builtin_amdgcn_mfma_f32_32x32x16_bf16(b1,qr[d0],p1,0,0,0);}}
}
typedef __attribute__((address_space(3))) const char* lds_cptr;
typedef short v4i16_t __attribute__((ext_vector_type(4)));
__device__ __forceinline__ void kload8(bf16x8*kf,lds_cptr kp){
  kf[0]=*(const __attribute__((address_space(3))) bf16x8*)(kp);      kf[1]=*(const __attribute__((address_space(3))) bf16x8*)(kp+512);
  kf[2]=*(const __attribute__((address_space(3))) bf16x8*)(kp+2048); kf[3]=*(const __attribute__((address_space(3))) bf16x8*)(kp+2560);
  kf[4]=*(const __attribute__((address_space(3))) bf16x8*)(kp+4096); kf[5]=*(const __attribute__((address_space(3))) bf16x8*)(kp+4608);
  kf[6]=*(const __attribute__((address_space(3))) bf16x8*)(kp+6144); kf[7]=*(const __attribute__((address_space(3))) bf16x8*)(kp+6656);
}
__device__ __forceinline__ void kload2(bf16x8*kf,lds_cptr kp,int j){ kf[2*j]=*(const __attribute__((address_space(3))) bf16x8*)(kp+j*2048); kf[2*j+1]=*(const __attribute__((address_space(3))) bf16x8*)(kp+j*2048+512); }
__device__ __forceinline__ s16x4 vtr(lds_cptr p){ return __builtin_bit_cast(s16x4,__builtin_amdgcn_ds_read_tr16_b64_v4i16((__attribute__((address_space(3))) v4i16_t*)p)); }
__device__ __forceinline__ float rowmax(const f32x16&p0,const f32x16&p1){
  float a=max3f(p0[0],p0[1],p1[0]),b=max3f(p0[2],p0[3],p1[1]);a=max3f(a,p1[2],p1[3]);
  #pragma unroll
  for(int r=4;r<16;r+=4){a=max3f(a,p0[r],p0[r+1]);b=max3f(b,p0[r+2],p0[r+3]);a=max3f(a,p1[r],p1[r+1]);b=max3f(b,p1[r+2],p1[r+3]);}
  const float m=max2f(a,b);
  auto rr=__builtin_amdgcn_permlane32_swap(__float_as_uint(m),__float_as_uint(m),false,false);
  return max2f(__uint_as_float(rr[0]),__uint_as_float(rr[1]));
}
__device__ __forceinline__ void pv(f32x16*o,int vb,bf16x8 pa0,bf16x8 pa1,bf16x8 pa2,bf16x8 pa3){
  #pragma unroll
  for(int d0=0;d0<2;++d0){s16x4 lo[4],hi[4];
    #pragma unroll
    for(int ks=0;ks<4;++ks){
      asm volatile("ds_read_b64_tr_b16 %0,%1 offset:%c2":"=&v"(lo[ks]):"v"(vb),"i"(d0*4096+ks*1024):"memory");
      asm volatile("ds_read_b64_tr_b16 %0,%1 offset:%c2":"=&v"(hi[ks]):"v"(vb),"i"(d0*4096+ks*1024+512):"memory");}
    asm volatile("s_waitcnt lgkmcnt(0)":::"memory");SBAR();
    #define PK(k) (bf16x8){lo[k][0],lo[k][1],lo[k][2],lo[k][3],hi[k][0],hi[k][1],hi[k][2],hi[k][3]}
    o[d0]=__builtin_amdgcn_mfma_f32_32x32x16_bf16(pa0,PK(0),o[d0],0,0,0);
    o[d0]=__builtin_amdgcn_mfma_f32_32x32x16_bf16(pa1,PK(1),o[d0],0,0,0);
    o[d0]=__builtin_amdgcn_mfma_f32_32x32x16_bf16(pa2,PK(2),o[d0],0,0,0);
    o[d0]=__builtin_amdgcn_mfma_f32_32x32x16_bf16(pa3,PK(3),o[d0],0,0,0);
    #undef PK
  }
}
template<int THRL> __device__ __forceinline__ void attn_unit(long rowbase,int seq,int h,int q0,const bf16*Q,const bf16*__restrict__ K,const bf16*__restrict__ V,bf16*O,char*shm){
  int tid_=threadIdx.x; asm volatile("":"+v"(tid_));
  const int tid=tid_,lane=tid&63,r32=lane&31,hi=lane>>5; const int wid=__builtin_amdgcn_readfirstlane(tid>>6);
  const bf16*Qw=Q+(rowbase+q0+wid*QBLK)*QP+h*D;
  const bf16*Kh=K+rowbase*KP+(h>>2)*D,*Vh=V+rowbase*KP+(h>>2)*D;
  const unsigned lds0=(unsigned)(uintptr_t)shm;
  float*wsf=(float*)(shm+LDS_WS)+wid*64;
  const bf16*ksrc=Kh+(long)lane*KP+wid*8;
  const bf16*vsrc=Vh+(long)(16*(wid&3)+(lane>>2))*KP+(wid>>2)*32+(lane&3)*8;
  const unsigned kdst=lds0+LDS_K+wid*1024, vdst=lds0+LDS_V+wid*1024;
  #define DMA_K(t,slot) glds16(ksrc+(long)(t)*KVBLK*KP,(unsigned)__builtin_amdgcn_readfirstlane(kdst+(slot)))
  #define DMA_V(t,slot) glds16(vsrc+(long)(t)*KVBLK*KP,(unsigned)__builtin_amdgcn_readfirstlane(vdst+(slot)))
  const int vb0=(int)(lds0+LDS_V)+((lane>>4)&1)*32+(lane&3)*8+(4*hi+((lane&15)>>2))*64;
  const char*Kbase=shm+LDS_K; bf16x8 kf[8];
  const lds_cptr shm3=(lds_cptr)shm; const lds_cptr kp0=shm3+LDS_K+hi*1024+r32*16; const lds_cptr vp0=shm3+LDS_V+((lane>>4)&1)*32+(lane&3)*8+(4*hi+((lane&15)>>2))*64;
  const int NT=seq/KVBLK;
  DMA_K(0,0);DMA_V(0,0);DMA_K(1,SLOTB);
  bf16x8 qr[4];
  #pragma unroll
  for(int d0=0;d0<4;++d0)qr[d0]=*reinterpret_cast<const bf16x8*>(&Qw[(long)r32*QP+d0*16+hi*8]);
  float mhat=0.f,l_reg=0.f;f32x16 o[2];o[0]=f32x16{};o[1]=f32x16{};f32x16 negm=f32x16{};asm volatile("":"+v"(negm));
  bool resc=false;
  #define START(P0,P1) do{ const float rm=rowmax(P0,P1); resc=false; \
    { const float dl=rm; mhat=fadd_s(mhat,dl); \
      _Pragma("unroll") for(int r=0;r<16;++r){P0[r]=fsub_s(P0[r],dl);P1[r]=fsub_s(P1[r],dl);} \
      _Pragma("unroll") for(int r=0;r<16;++r)negm[r]=-mhat; asm volatile("":"+v"(negm)); } \
    _Pragma("unroll") for(int r=0;r<16;++r)P0[r]=__builtin_amdgcn_exp2f(P0[r]); }while(0)
  #define RESC() do{ if(resc){ asm volatile("s_waitcnt lgkmcnt(0)":::"memory"); \
      _Pragma("unroll") for(int d_=0;d_<2;++d_) _Pragma("unroll") for(int r=0;r<16;++r)o[d_][r]*=wsf[crow(r,hi)]; } }while(0)
  f32x16 pA0,pA1,pB0,pB1;
  int sl_prev=0,sl_cur=0,sl_next=SLOTB;
  #define ROT() do{sl_prev=sl_cur;sl_cur=sl_next;sl_next=(sl_next==(NSLOT-1)*SLOTB)?0:sl_next+SLOTB;}while(0)
  DMA_K(2,2*SLOTB);
  WAIT_BAR(3);
  qkt(pA0,pA1,Kbase,qr,negm,r32,hi);asm volatile("s_nop 15\n\ts_nop 7":"+v"(pA0),"+v"(pA1));
  START(pA0,pA1);
  _Pragma("unroll") for(int r=0;r<16;++r)pA1[r]=__builtin_amdgcn_exp2f(pA1[r]);
  WAIT_BAR(0);
  DMA_K(3,0);DMA_V(1,SLOTB);
  ROT();
  kload8(kf,kp0+sl_cur);
  WAIT_BAR(2);
  s16x4 vlo[8],vhi[8]; u32x4 pw0,pw1,pw2,pw3;
  #define PKW(P,B) cvtpk_s(P[B],P[B+1])
  #define PAF(k) __builtin_bit_cast(bf16x8,pw##k)
  #define VFR(i) (bf16x8){vlo[i][0],vlo[i][1],vlo[i][2],vlo[i][3],vhi[i][0],vhi[i][1],vhi[i][2],vhi[i][3]}
  #define PIN(x) asm volatile("":"+v"(x))
  #define MX3(a,b,c) __builtin_fmaxf(__builtin_fmaxf((a),(b)),(c))
  #define GAPA(MF,A0,A1,A2,A3,W0,W1,PW) do{ MF; sacc+=A0; sacc+=A1; sacc+=A2; sacc+=A3; PIN(sacc); W0; W1; PIN(PW); SBAR(); }while(0)
  #define EX(v) __builtin_amdgcn_exp2f(v)
  #define GAPB(MF,X,B) do{ MF; X[B]=EX(X[B]); X[B+1]=EX(X[B+1]); X[B+2]=EX(X[B+2]); X[B+3]=EX(X[B+3]); PIN(X); SBAR(); }while(0)
  #define VRD(i) do{ vlo[i]=vtr(vp_+(((i)>>2)*4096+((i)&3)*1024)); vhi[i]=vtr(vp_+(((i)>>2)*4096+((i)&3)*1024+512)); }while(0)
  #define KRD(G,j) do{ if(G){ kload2(kf,kp0+sl_next,j); SBAR(); } }while(0)
  #define STEP(C0,C1,P0,P1,t,GK,GV,GL) do{ SBAR(); \
    const lds_cptr vp_=vp0+sl_prev; \
    VRD(0); SBAR(); float sacc=(P0[0]+P0[1]); \
    GAPA(C0=__builtin_amdgcn_mfma_f32_32x32x16_bf16(kf[0],qr[0],negm,0,0,0), P0[2],P0[3],P0[4],P0[5],     pw0[0]=PKW(P0,0), pw0[1]=PKW(P0,2), pw0); \
    VRD(4); SBAR(); GAPA(C1=__builtin_amdgcn_mfma_f32_32x32x16_bf16(kf[1],qr[0],negm,0,0,0), P0[6],P0[7],P0[8],P0[9],     pw0[2]=PKW(P0,4), pw0[3]=PKW(P0,6), pw0); \
    VRD(1); SBAR(); GAPA(C0=__builtin_amdgcn_mfma_f32_32x32x16_bf16(kf[2],qr[1],C0,0,0,0),   P0[10],P0[11],P0[12],P0[13], pw1[0]=PKW(P0,8), pw1[1]=PKW(P0,10), pw1); \
    VRD(5); SBAR(); GAPA(C1=__builtin_amdgcn_mfma_f32_32x32x16_bf16(kf[3],qr[1],C1,0,0,0),   P0[14],P0[15],P1[0],P1[1],   pw1[2]=PKW(P0,12),pw1[3]=PKW(P0,14), pw1); \
    VRD(2); SBAR(); GAPA(C0=__builtin_amdgcn_mfma_f32_32x32x16_bf16(kf[4],qr[2],C0,0,0,0),   P1[2],P1[3],P1[4],P1[5],     pw2[0]=PKW(P1,0), pw2[1]=PKW(P1,2), pw2); \
    VRD(6); SBAR(); GAPA(C1=__builtin_amdgcn_mfma_f32_32x32x16_bf16(kf[5],qr[2],C1,0,0,0),   P1[6],P1[7],P1[8],P1[9],     pw2[2]=PKW(P1,4), pw2[3]=PKW(P1,6), pw2); \
    VRD(3); SBAR(); GAPA(C0=__builtin_amdgcn_mfma_f32_32x32x16_bf16(kf[6],qr[3],C0,0,0,0),   P1[10],P1[11],P1[12],P1[13], pw3[0]=PKW(P1,8), pw3[1]=PKW(P1,10), pw3); \
    VRD(7); SBAR(); GAPA(C1=__builtin_amdgcn_mfma_f32_32x32x16_bf16(kf[7],qr[3],C1,0,0,0),   P1[14],P1[15],0.f,0.f,       pw3[2]=PKW(P1,12),pw3[3]=PKW(P1,14), pw3); \
    l_reg+=sacc; \
    if(GK){DMA_K((t)+3,sl_cur);} if(GV){DMA_V((t)+1,sl_next);} \
    { float a=MX3(C0[0],C0[1],C1[0]),b=MX3(C0[2],C0[3],C1[1]); a=MX3(a,C1[2],C1[3]); \
      _Pragma("unroll") for(int r=4;r<16;r+=4){a=MX3(a,C0[r],C0[r+1]);b=MX3(b,C0[r+2],C0[r+3]);a=MX3(a,C1[r],C1[r+1]);b=MX3(b,C1[r+2],C1[r+3]);} \
      float rm=__builtin_fmaxf(a,b); { auto rr=__builtin_amdgcn_permlane32_swap(__float_as_uint(rm),__float_as_uint(rm),false,false); rm=__builtin_fmaxf(__uint_as_float(rr[0]),__uint_as_float(rr[1])); } \
      resc=false; \
      if(__builtin_expect(__any(rm>(float)THRL),0)){ const float dl=__builtin_fmaxf(rm,0.f); mhat+=dl; \
        _Pragma("unroll") for(int r=0;r<16;++r){C0[r]-=dl;C1[r]-=dl;} \
        _Pragma("unroll") for(int r=0;r<16;++r)negm[r]=-mhat; asm volatile("":"+v"(negm)); \
        const float f=__builtin_amdgcn_exp2f(-dl); l_reg*=f; if(hi==0)wsf[r32]=f; resc=true; } } \
    SBAR(); \
    GAPB(o[0]=__builtin_amdgcn_mfma_f32_32x32x16_bf16(PAF(0),VFR(0),o[0],0,0,0), C0,0); \
    GAPB(o[1]=__builtin_amdgcn_mfma_f32_32x32x16_bf16(PAF(0),VFR(4),o[1],0,0,0), C0,4); \
    KRD(GL,0); GAPB(o[0]=__builtin_amdgcn_mfma_f32_32x32x16_bf16(PAF(1),VFR(1),o[0],0,0,0), C0,8); \
    KRD(GL,1); GAPB(o[1]=__builtin_amdgcn_mfma_f32_32x32x16_bf16(PAF(1),VFR(5),o[1],0,0,0), C0,12); \
    KRD(GL,2); GAPB(o[0]=__builtin_amdgcn_mfma_f32_32x32x16_bf16(PAF(2),VFR(2),o[0],0,0,0), C1,0); \
    KRD(GL,3); GAPB(o[1]=__builtin_amdgcn_mfma_f32_32x32x16_bf16(PAF(2),VFR(6),o[1],0,0,0), C1,4); \
    GAPB(o[0]=__builtin_amdgcn_mfma_f32_32x32x16_bf16(PAF(3),VFR(3),o[0],0,0,0), C1,8); \
    GAPB(o[1]=__builtin_amdgcn_mfma_f32_32x32x16_bf16(PAF(3),VFR(7),o[1],0,0,0), C1,12); \
    }while(0)
  int t=1;
  for(;t+5<NT;t+=2){
    STEP(pB0,pB1,pA0,pA1,t,true,true,true);     WAIT_BAR(2); RESC(); ROT();
    STEP(pA0,pA1,pB0,pB1,t+1,true,true,true);   WAIT_BAR(2); RESC(); ROT();
  }
  #define ENDW(tt) do{ if((tt)+3<NT){WAIT_BAR(2);} else if((tt)+2<NT){WAIT_BAR(1);} else {WAIT_BAR(0);} }while(0)
  for(;t+1<NT;t+=2){
    STEP(pB0,pB1,pA0,pA1,t,(t+3<NT),(t+1<NT),(t+1<NT));       ENDW(t);   RESC(); ROT();
    STEP(pA0,pA1,pB0,pB1,t+1,(t+4<NT),(t+2<NT),(t+2<NT));     ENDW(t+1); RESC(); ROT();
  }
  STEP(pB0,pB1,pA0,pA1,NT-1,false,false,false); RESC();
  { float sacc=pB0[0]+pB0[1]; _Pragma("unroll") for(int r=2;r<16;++r)sacc+=pB0[r]; _Pragma("unroll") for(int r=0;r<16;++r)sacc+=pB1[r]; l_reg+=sacc;
    pw0=(u32x4){PKW(pB0,0),PKW(pB0,2),PKW(pB0,4),PKW(pB0,6)};pw1=(u32x4){PKW(pB0,8),PKW(pB0,10),PKW(pB0,12),PKW(pB0,14)};pw2=(u32x4){PKW(pB1,0),PKW(pB1,2),PKW(pB1,4),PKW(pB1,6)};pw3=(u32x4){PKW(pB1,8),PKW(pB1,10),PKW(pB1,12),PKW(pB1,14)};
    SBAR(); pv(o,vb0+sl_cur,PAF(0),PAF(1),PAF(2),PAF(3)); }
  #undef PKW
  #undef PAF
  #undef VFR
  #undef PIN
  #undef MX3
  #undef GAPA
  #undef GAPB
  #undef EX
  #undef VRD
  #undef KRD
  #undef STEP
  #undef ENDW
  {auto rr=__builtin_amdgcn_permlane32_swap(__float_as_uint(l_reg),__float_as_uint(l_reg),false,false);l_reg=__uint_as_float(rr[0])+__uint_as_float(rr[1]);}
  if(hi==0)wsf[32+r32]=l_reg;asm volatile("s_waitcnt lgkmcnt(0)":::"memory");
  float rli[16];
  #pragma unroll
  for(int r=0;r<16;++r)rli[r]=__builtin_amdgcn_rcpf(wsf[32+crow(r,hi)]);
  bf16*Ow=O+(rowbase+q0+wid*QBLK)*QP+h*D;
  { bf16*stg=(bf16*)(shm+LDS_OST)+wid*2048;
    #pragma unroll
    for(int r=0;r<16;++r){const int orow=crow(r,hi);
      #pragma unroll
      for(int d0=0;d0<2;++d0)stg[orow*64+d0*32+r32]=__float2bfloat16(o[d0][r]*rli[r]);}
    asm volatile("s_waitcnt lgkmcnt(0)":::"memory");
    #pragma unroll
    for(int i=0;i<4;++i){const int row=i*8+(lane>>3),ch=lane&7; const u32x4 v=*(const u32x4*)(stg+row*64+ch*8); *(u32x4*)(Ow+(long)row*QP+ch*8)=v;} }
  asm volatile("s_waitcnt lgkmcnt(0)\n\ts_barrier":::"memory");
  #undef DMA_K
  #undef DMA_V
  #undef START
  #undef RESC
  #undef ROT
}
constexpr int ATTN_LDS_BYTES=LDS_BYTES;
#undef SBAR
#undef WAIT_BAR
}

#define GRID_SYNC() do { asm volatile("s_waitcnt vmcnt(0) lgkmcnt(0)" ::: "memory"); grid.sync(); __builtin_amdgcn_fence(__ATOMIC_ACQUIRE, "agent"); asm volatile("s_waitcnt vmcnt(0)" ::: "memory"); } while (0)
#ifndef N_LAUNCH_MODE
#define N_LAUNCH_MODE 0
#endif
constexpr int N_PHASES = 2 + 6 * NLAYER;
constexpr int NWAVES = 8;
constexpr size_t MiB = 1u << 20;
constexpr size_t WL_IN = 0, WL_A = WL_IN + (size_t)INW * 1024, WL_B = WL_A + 1024 * 512, WL_MIX = WL_B + 1024 * 512, WL_UP = WL_MIX + 1024 * 1024,
                 WL_DOWN = WL_UP + 4096 * 1024, WL_SG = WL_DOWN + 1024 * 2048, WL_SIZE = WL_SG + 8 * 128 * 128;
static_assert(WL_SIZE * 2 * NLAYER <= 95 * MiB, "weights region");
constexpr size_t WS_ROPE = 0, WS_W = 1 * MiB, WS_XB = 96 * MiB + 4096, WS_QU = 289 * MiB, WS_K = 481 * MiB, WS_V = 505 * MiB, WS_VST = 529 * MiB,
                 WS_GA = 625 * MiB, WS_GB = 817 * MiB, WS_H2 = 625 * MiB, WS_SS = 1009 * MiB, WS_SSG = 1015 * MiB, WS_END = 1018 * MiB;
constexpr int LDS_BYTES = 147456, SG_SCR_OFF = 135168, BARST_OFF = 140288;
constexpr size_t WS_BAR = 65536, BAR_BYTES = 16384;


#define XB_TMO      128
#define XB_XCNT(j)  (256  + 64 * (j))
#define XB_XSUB(j)  (1280 + 64 * (j))
#define XB_XGEN(j)  (2304 + 64 * (j))
#define XB_TOP      3328
#define XB_TOPGEN   3392
#define XCD_BAR_WORDS 3456
#define XB_SPIN_CAP (1u << 22)
__device__ __forceinline__ unsigned xb_ld(unsigned* p)              { return __hip_atomic_load(p, __ATOMIC_RELAXED, __HIP_MEMORY_SCOPE_AGENT); }
__device__ __forceinline__ unsigned xb_add(unsigned* p, unsigned v) { return __hip_atomic_fetch_add(p, v, __ATOMIC_RELAXED, __HIP_MEMORY_SCOPE_AGENT); }
__device__ __forceinline__ unsigned xb_xcc_id() { return (unsigned)__builtin_amdgcn_s_getreg((3 << 11) | 20) & 0xFu; }
#define XB_SPIN(cond, bar) do { unsigned _sp = 0; while (cond) { __builtin_amdgcn_s_sleep(1); \
    if ((++_sp & 255u) == 0u) { if (xb_ld(&(bar)[XB_TMO])) break; if (_sp > XB_SPIN_CAP) { atomicAdd(&(bar)[XB_TMO], 1u); break; } } } } while (0)
struct XcdBarrier { unsigned* bar; unsigned x; volatile LAS unsigned* st; };
__device__ __forceinline__ XcdBarrier xcd_barrier_post(unsigned* bar, volatile LAS unsigned* st) {
    XcdBarrier b; b.bar = bar; b.x = xb_xcc_id(); b.st = st;
    if (threadIdx.x == 0) (void)xb_add(&bar[XB_XCNT(b.x)], 1u);
    return b;
}
__device__ __forceinline__ void xcd_barrier_complete(unsigned* bar, unsigned x, unsigned& nloc, unsigned& nx) {
    const unsigned G = gridDim.x * gridDim.y * gridDim.z;
    unsigned sum, cnt, mine, sp = 0u;
    for (;;) {
        sum = 0u; cnt = 0u; mine = 0u;
#pragma unroll
        for (unsigned j = 0; j < 16; ++j) { const unsigned c = xb_ld(&bar[XB_XCNT(j)]); sum += c; cnt += (c > 0u) ? 1u : 0u; mine = (j == x) ? c : mine; }
        if (sum == G) break;
        __builtin_amdgcn_s_sleep(1);
        if ((++sp & 255u) == 0u) { if (xb_ld(&bar[XB_TMO])) break; if (sp > XB_SPIN_CAP) { atomicAdd(&bar[XB_TMO], 1u); break; } }
    }
    nloc = mine > 0u ? mine : 1u; nx = cnt > 0u ? cnt : 1u;
}
__device__ __forceinline__ void xcd_barrier(const XcdBarrier& b) {
    asm volatile("s_waitcnt vmcnt(0)" ::: "memory");
    __syncthreads();
    if (threadIdx.x == 0) {
        unsigned* bar = b.bar;
        __builtin_amdgcn_s_waitcnt(0);
        unsigned nloc = b.st[0], nx = b.st[1];
        if (nloc == 0u) { xcd_barrier_complete(bar, b.x, nloc, nx); b.st[0] = nloc; b.st[1] = nx; }
        const unsigned old = xb_add(&bar[XB_XSUB(b.x)], 1u);
        const unsigned gen = old / nloc;
        if (old + 1u == (gen + 1u) * nloc) {
            __builtin_amdgcn_fence(__ATOMIC_RELEASE, "agent");
            asm volatile("s_waitcnt vmcnt(0)" ::: "memory");
            const unsigned og = xb_add(&bar[XB_TOP], 1u);
            const unsigned tg = og / nx;
            if (og + 1u == (tg + 1u) * nx) xb_add(&bar[XB_TOPGEN], 1u);
            else XB_SPIN(xb_ld(&bar[XB_TOPGEN]) == tg, bar);
            __builtin_amdgcn_fence(__ATOMIC_ACQUIRE, "agent");
            xb_add(&bar[XB_XGEN(b.x)], 1u);
            asm volatile("s_waitcnt vmcnt(0)" ::: "memory");
        } else {
            XB_SPIN(xb_ld(&bar[XB_XGEN(b.x)]) == gen, bar);
            __builtin_amdgcn_fence(__ATOMIC_ACQUIRE, "agent");
            asm volatile("s_waitcnt vmcnt(0)" ::: "memory");
        }
    }
    __syncthreads();
}

struct Args { const float* in[18]; float* out; unsigned char* ws; int ph_lo, ph_hi; };

__device__ __forceinline__ float wave_sum(float v) {
#pragma unroll
    for (int o = 1; o < 64; o <<= 1) v += __shfl_xor(v, o);
    return v;
}
__device__ __forceinline__ int invperm32(int cc) { return 16 * ((cc >> 2) & 1) + 4 * (cc >> 3) + (cc & 3); }
__device__ __forceinline__ int map_plain(int n) { return (n & ~31) + invperm32(n & 31); }
__device__ __forceinline__ int map_in(int n) {
    if (n < 512) { const int pn = n >> 8, hh = (n >> 6) & 3, d = n & 63; return 256 * pn + 128 * (d >> 5) + 32 * hh + (d & 31); }
    if (n < 768) { const int c = n - 512, isv = c >> 7, head = (c >> 6) & 1, d = c & 63, wc = 2 * isv + head; return 512 + 128 * (d >> 5) + 32 * wc + (d & 31); }
    return map_plain(n);
}
__device__ __forceinline__ int map_up(int n) { const int bj = n >> 11, c = n & 2047, pn = c >> 7, r = c & 127; return 256 * pn + 128 * bj + (r & ~31) + invperm32(r & 31); }

template <int MAP>
__device__ __forceinline__ void transpose_item(const float* W, const float* g, int K, int N, bf16_t* WT, LAS float* scr, int item, int lane) {
    const int nblk = N / 32, kb = item / nblk, nb = item % nblk, k0 = 64 * kb, n0 = 32 * nb;
#pragma unroll 8
    for (int i = 0; i < 32; ++i) { const int kk = 2 * i + (lane >> 5); float v = W[(size_t)(k0 + kk) * N + n0 + (lane & 31)]; if (g) v *= g[k0 + kk]; scr[kk * 33 + (lane & 31)] = v; }
    asm volatile("s_waitcnt lgkmcnt(0)" ::: "memory");
    const int c = lane & 7;
#pragma unroll
    for (int j = 0; j < 4; ++j) { const int n = (lane >> 3) + 8 * j; const LAS float* s = scr + (8 * c) * 33 + n;
        u32x4 o; o.x = cvt_pk_bf16(s[0 * 33], s[1 * 33]); o.y = cvt_pk_bf16(s[2 * 33], s[3 * 33]); o.z = cvt_pk_bf16(s[4 * 33], s[5 * 33]); o.w = cvt_pk_bf16(s[6 * 33], s[7 * 33]);
        const int nn = n0 + n; const int row = MAP == 0 ? map_plain(nn) : (MAP == 1 ? map_in(nn) : map_up(nn));
        *(u32x4*)(WT + (size_t)row * K + k0 + 8 * c) = o; }
    asm volatile("s_waitcnt lgkmcnt(0)" ::: "memory");
}

__device__ __forceinline__ void sincos_tab(float x, float& c, float& s) {
    const float n = rintf(x * 0.63661977236758134308f);
    float r = fmaf(-n, 1.5703125f, x); r = fmaf(-n, 4.83751296997070312500e-4f, r); r = fmaf(-n, 7.5497899548918821e-8f, r);
    const float r2 = r * r;
    const float sp = r + r * r2 * (-1.0f / 6 + r2 * (1.0f / 120 + r2 * (-1.0f / 5040 + r2 * (1.0f / 362880))));
    const float cp = 1.0f + r2 * (-0.5f + r2 * (1.0f / 24 + r2 * (-1.0f / 720 + r2 * (1.0f / 40320 + r2 * (-1.0f / 3628800)))));
    const int q = ((int)n) & 3;
    s = (q == 0) ? sp : (q == 1) ? cp : (q == 2) ? -sp : -cp;
    c = (q == 0) ? cp : (q == 1) ? -sp : (q == 2) ? -cp : sp;
}

__device__ __forceinline__ void sg_unit(int ch, int g, const bf16_t* VST, const float* ssg, const bf16_t* Wg, const float* sgb, const float* gsg, bf16_t* QU, LAS float* scr, int lane) {
    asm volatile("" : "+v"(lane));
    const int fr = lane & 15, fq = lane >> 4;
#pragma unroll
    for (int hh = 0; hh < 2; ++hh) { const int p = lane + 64 * hh; const float* sp = ssg + (size_t)(ch * 128 + p) * 8; const f32x4 a = *(const f32x4*)sp, b = *(const f32x4*)(sp + 4);
        const float s = ((a.x + a.y) + (a.z + a.w)) + ((b.x + b.y) + (b.z + b.w)); scr[p] = __builtin_amdgcn_rsqf(s * (1.0f / 512.0f) + EPS); }
    asm volatile("s_waitcnt lgkmcnt(0)" ::: "memory");
    f32x4 acc[8][4];
#pragma unroll
    for (int pt = 0; pt < 8; ++pt)
#pragma unroll
        for (int ct = 0; ct < 4; ++ct) acc[pt][ct] = (f32x4){0.f, 0.f, 0.f, 0.f};
    const bf16_t* vbase = VST + ((size_t)ch * 512 + g * 64) * 128;
    const bf16_t* wbase = Wg + (size_t)g * 128 * 128;
#pragma unroll 1
    for (int kk = 0; kk < 4; ++kk) {
        const int k0 = kk * 32 + 8 * fq;
        bf16x8 af[4];
#pragma unroll
        for (int ct = 0; ct < 4; ++ct) af[ct] = *(const bf16x8*)(vbase + (size_t)(ct * 16 + fr) * 128 + k0);
        float r[8];
#pragma unroll
        for (int e = 0; e < 8; ++e) r[e] = scr[k0 + e];
#pragma unroll
        for (int pt = 0; pt < 8; ++pt) {
            const u32x4 w = *(const u32x4*)(wbase + (size_t)(pt * 16 + fr) * 128 + k0);
            u32x4 ws; ws.x = cvt_pk_bf16(bf_lo(w.x) * r[0], bf_hi(w.x) * r[1]); ws.y = cvt_pk_bf16(bf_lo(w.y) * r[2], bf_hi(w.y) * r[3]);
            ws.z = cvt_pk_bf16(bf_lo(w.z) * r[4], bf_hi(w.z) * r[5]); ws.w = cvt_pk_bf16(bf_lo(w.w) * r[6], bf_hi(w.w) * r[7]);
            const bf16x8 bfz = __builtin_bit_cast(bf16x8, ws);
#pragma unroll
            for (int ct = 0; ct < 4; ++ct) acc[pt][ct] = __builtin_amdgcn_mfma_f32_16x16x32_bf16(af[ct], bfz, acc[pt][ct], 0, 0, 0);
        }
    }
    f32x4 gs[4];
#pragma unroll
    for (int ct = 0; ct < 4; ++ct) gs[ct] = *(const f32x4*)(gsg + g * 64 + ct * 16 + 4 * fq);
#pragma unroll
    for (int pt = 0; pt < 8; ++pt) {
        const int p = pt * 16 + fr; const float b = sgb[g * 128 + p];
        bf16_t* up = QU + (size_t)(ch * 128 + p) * 1024 + 512 + g * 64 + 4 * fq;
#pragma unroll
        for (int ct = 0; ct < 4; ++ct) {
            const u32x2 uu = *(const u32x2*)(up + ct * 16);
            const f32x4 sp = acc[pt][ct] * gs[ct] + b;
            u32x2 w; w.x = cvt_pk_bf16(bf_lo(uu.x) * sp.x, bf_hi(uu.x) * sp.y); w.y = cvt_pk_bf16(bf_lo(uu.y) * sp.z, bf_hi(uu.y) * sp.w);
            *(u32x2*)(up + ct * 16) = w;
        }
    }
    asm volatile("s_waitcnt lgkmcnt(0)" ::: "memory");
}

__global__ void __launch_bounds__(NWAVES * 64, 2) fwd_megakernel(Args args) {
    extern __shared__ __attribute__((aligned(16))) unsigned char lds[];
    cg::grid_group grid = cg::this_grid();
    LAS unsigned char* L = (LAS unsigned char*)lds;
    volatile LAS unsigned* barst = (volatile LAS unsigned*)(L + BARST_OFF);
    if (threadIdx.x < 2) barst[threadIdx.x] = 0u;
    __syncthreads();
    const XcdBarrier xbar = xcd_barrier_post((unsigned*)(args.ws + WS_BAR), barst);
    const int G = gridDim.x, bx = blockIdx.x;
    const int vcu = (G % 8 == 0) ? (bx % 8) * (G / 8) + bx / 8 : bx;
    const int NGW = G * NWAVES;
    unsigned char* ws = args.ws;
    const float* x_prompt = args.in[0]; const float* x_sample = args.in[1];
    const float* attn_norm_g = args.in[2]; const float* w_in = args.in[3]; const float* q_norm_g = args.in[4]; const float* k_norm_g = args.in[5];
    const float* sg_norm_g = args.in[6]; const float* sg_w = args.in[7]; const float* sg_b = args.in[8]; const float* w_branch_a = args.in[9];
    const float* w_branch_b = args.in[10]; const float* w_mix_out = args.in[11]; const float* ffn_norm_g = args.in[12]; const float* w_up = args.in[13];
    const float* conv_w = args.in[14]; const float* conv_b = args.in[15]; const float* w_down = args.in[16]; const float* final_norm_g = args.in[17];
    float* out = args.out;
    float* rope = (float*)(ws + WS_ROPE);
    bf16_t* Wall = (bf16_t*)(ws + WS_W);
    bf16_t* XB = (bf16_t*)(ws + WS_XB); bf16_t* QU = (bf16_t*)(ws + WS_QU); bf16_t* KB = (bf16_t*)(ws + WS_K); bf16_t* VB = (bf16_t*)(ws + WS_V);
    bf16_t* VST = (bf16_t*)(ws + WS_VST); bf16_t* GA = (bf16_t*)(ws + WS_GA); bf16_t* GB = (bf16_t*)(ws + WS_GB); bf16_t* H2 = (bf16_t*)(ws + WS_H2);
    float* SSQ = (float*)(ws + WS_SS); float* SSG = (float*)(ws + WS_SSG);

    for (int p = args.ph_lo; p < args.ph_hi; ++p) {
    if (p > args.ph_lo) { if (p == 1) GRID_SYNC(); else xcd_barrier(xbar); }
    int tid_ = threadIdx.x; asm volatile("" : "+v"(tid_));
    const int tid = tid_, lane = tid & 63, wave = __builtin_amdgcn_readfirstlane(tid >> 6);
    const int gw = vcu * NWAVES + wave;
    if (p == 0) {
        LAS float* scr = (LAS float*)(L + wave * 16384);
        constexpr int I_IN = 16 * (INW / 32), I_A = 8 * 32, I_MIX = 16 * 32, I_UP = 16 * 128, I_DOWN = 32 * 32, I_L = I_IN + 2 * I_A + I_MIX + I_UP + I_DOWN;
        for (int it = gw; it < I_L * NLAYER; it += NGW) {
            const int l = it / I_L; int r = it % I_L; bf16_t* wl = Wall + (size_t)l * WL_SIZE;
            if (r < I_IN) { transpose_item<1>(w_in + (size_t)l * 1024 * INW, attn_norm_g + l * 1024, 1024, INW, wl + WL_IN, scr, r, lane); continue; } r -= I_IN;
            if (r < I_A) { transpose_item<0>(w_branch_a + (size_t)l * 512 * 1024, nullptr, 512, 1024, wl + WL_A, scr, r, lane); continue; } r -= I_A;
            if (r < I_A) { transpose_item<0>(w_branch_b + (size_t)l * 512 * 1024, nullptr, 512, 1024, wl + WL_B, scr, r, lane); continue; } r -= I_A;
            if (r < I_MIX) { transpose_item<0>(w_mix_out + (size_t)l * 1024 * 1024, nullptr, 1024, 1024, wl + WL_MIX, scr, r, lane); continue; } r -= I_MIX;
            if (r < I_UP) { transpose_item<2>(w_up + (size_t)l * 1024 * 4096, ffn_norm_g + l * 1024, 1024, 4096, wl + WL_UP, scr, r, lane); continue; } r -= I_UP;
            transpose_item<0>(w_down + (size_t)l * 2048 * 1024, nullptr, 2048, 1024, wl + WL_DOWN, scr, r, lane);
        }
        for (int i = gw * 64 + lane; i < NLAYER * 8 * 128 * 128 / 4; i += NGW * 64) {
            const int l = i / (8 * 128 * 128 / 4), r = i % (8 * 128 * 128 / 4);
            const f32x4 v = *(const f32x4*)(sg_w + (size_t)l * 131072 + (size_t)r * 4);
            u32x2 w; w.x = cvt_pk_bf16(v.x, v.y); w.y = cvt_pk_bf16(v.z, v.w);
            *(u32x2*)(Wall + (size_t)l * WL_SIZE + WL_SG + (size_t)r * 4) = w;
        }
        for (int i = gw * 64 + lane; i < 128 * 16; i += NGW * 64) {
            const int pos = i >> 4, f = i & 15; float fr_ = 1.0f; for (int k = 0; k < f; ++k) fr_ *= 0.56234132519034907f;
            float c, s; sincos_tab((float)pos * fr_, c, s); rope[2 * i] = c; rope[2 * i + 1] = s;
        }
        for (int i = gw * 64 + lane; i < 257 * 128; i += NGW * 64) {
            const int r = i / 128, c = i % 128; const long row = (r == 0) ? -1 : (long)M_TOK + r - 1;
            *(u32x4*)(XB + row * 1024 + c * 8) = (u32x4){0u, 0u, 0u, 0u};
        }
        for (int m0 = gw; m0 < M_TOK; m0 += 2 * NGW) {
            const int nr = (m0 + NGW < M_TOK) ? 2 : 1;
            f32x4 v[2][4]; float sq[2];
#pragma unroll
            for (int r = 0; r < 2; ++r) { const int m = (r < nr) ? m0 + r * NGW : m0;
                const float* xr = (m < NPROMPT) ? x_prompt + (size_t)m * 1024 : x_sample + (size_t)(m - NPROMPT) * 1024; float s = 0.f;
#pragma unroll
                for (int j = 0; j < 4; ++j) { v[r][j] = *(const f32x4*)(xr + 4 * lane + 256 * j); s += (v[r][j].x * v[r][j].x + v[r][j].y * v[r][j].y) + (v[r][j].z * v[r][j].z + v[r][j].w * v[r][j].w); }
                sq[r] = s; }
#pragma unroll
            for (int r = 0; r < 2; ++r) if (r < nr) { const int m = m0 + r * NGW; const float s = wave_sum(sq[r]);
#pragma unroll
                for (int j = 0; j < 4; ++j) { u32x2 w; w.x = cvt_pk_bf16(v[r][j].x, v[r][j].y); w.y = cvt_pk_bf16(v[r][j].z, v[r][j].w); *(u32x2*)(XB + (size_t)m * 1024 + 4 * lane + 256 * j) = w; }
                if (lane < 16) SSQ[(size_t)m * 16 + lane] = (lane == 0) ? s : 0.f; }
        }
    }
    else if (p < N_PHASES - 1) {
        const int l = (p - 1) / 6, k = (p - 1) % 6;
        const bf16_t* wl = Wall + (size_t)l * WL_SIZE;
        if (k == 0) {
            pg8::Gemm g{XB, wl + WL_IN, 1024, 1024, 1024, 0, 0, 256, 128, 0};
            { pg8::StaticOrder S; S.init(M_TOK / 256, 3, 1, G, bx, 0);
              pg8::EpiQKV E{SSQ, q_norm_g + l * 64, k_norm_g + l * 64, rope, QU, KB, VB};
              pg8::gemm_phase<pg8::EpiQKV, 1>(L, g, S, E); }
            { pg8::StaticOrder S; S.init(M_TOK / 256, 2, 1, G, bx, 5);
              pg8::EpiVS E{SSQ, VST, SSG};
              pg8::gemm_phase<pg8::EpiVS, 1>(L, g, S, E); }
            { pg8::StaticOrder S; S.init(M_TOK / 256, 10, 1, G, bx, 3, 2, 7);
              pg8::EpiEW E{SSQ, QU, GA, GB};
              pg8::gemm_phase<pg8::EpiEW, 1>(L, g, S, E); }
        }
        else if (k == 1) {
            LAS float* scr = (LAS float*)(L + SG_SCR_OFF) + wave * 128;
            for (int u = gw; u < 768 * 8; u += NGW)
                sg_unit(u >> 3, u & 7, VST, SSG, wl + WL_SG, sg_b + l * 1024, sg_norm_g + l * 512, QU, scr, lane);
            for (int u = bx; u < 3072; u += G) {
                const int i = u >> 8, c = u & 255, x = c & 7, w = c >> 3;
                long rowbase; int seq, h, q0;
                if (i < 4) { const int idx = w * 4 + i; rowbase = (long)(x >> 1) * SEQ_P; seq = SEQ_P; h = (x & 1) * 4 + (idx >> 5); q0 = (idx & 31) * 256; }
                else { const int pair = 8 * x + (i - 4); rowbase = (long)NPROMPT + (long)(pair >> 1) * SEQ_S; seq = SEQ_S; h = (pair & 1) * 4 + (w >> 3); q0 = (w & 7) * 256; }
                attn_body::attn_unit<8>(rowbase, seq, h, q0, (const attn_body::bf16*)QU, (const attn_body::bf16*)KB, (const attn_body::bf16*)VB, (attn_body::bf16*)QU, (char*)lds);
            }
        }
        else if (k == 2) {
            pg8::Gemm g{QU, wl + WL_A, 1024, 512, 512, 512 * 2, (long)(WL_B - WL_A) * 2, 256, 0, 0};
            pg8::StaticOrder S; S.init(M_TOK / 256, 4, 2, G, bx);
            pg8::EpiMerge E{GA, GB};
            pg8::gemm_phase<pg8::EpiMerge, 2>(L, g, S, E);
        }
        else if (k == 3) {
            pg8::Gemm g{GA, wl + WL_MIX, 1024, 1024, 1024, 0, 0, 256, 0, 0};
            pg8::StaticOrder S; S.init(M_TOK / 256, 4, 1, G, bx);
            pg8::EpiRes E{x_prompt, x_sample, l == 0 ? 1 : 0, out, XB, SSQ, l == 0 ? 0 : 1, 0};
            pg8::gemm_phase<pg8::EpiRes, 1>(L, g, S, E);
        }
        else if (k == 4) {
            pg8::Gemm g{XB, wl + WL_UP, 1024, 1024, 1024, 0, 0, 252, 126, -1};
            pg8::StaticOrder S; S.init((M_TOK + 251) / 252, 16, 1, G, bx);
            pg8::EpiUp E{SSQ, conv_w + (size_t)l * 3 * 4096, conv_b + (size_t)l * 4096, H2};
            pg8::gemm_phase<pg8::EpiUp, 1>(L, g, S, E);
        }
        else {
            pg8::Gemm g{H2, wl + WL_DOWN, 2048, 2048, 2048, 0, 0, 256, 0, 0};
            pg8::StaticOrder S; S.init(M_TOK / 256, 4, 1, G, bx);
            pg8::EpiRes E{x_prompt, x_sample, 0, out, XB, SSQ, 1, l == NLAYER - 1 ? 1 : 0};
            pg8::gemm_phase<pg8::EpiRes, 1>(L, g, S, E);
        }
    } else
    {
        f32x4 gv[4];
#pragma unroll
        for (int j = 0; j < 4; ++j) gv[j] = *(const f32x4*)(final_norm_g + 4 * lane + 256 * j);
        for (int m = gw; m < M_TOK; m += 2 * NGW) {
            const int m2 = (m + NGW < M_TOK) ? m + NGW : m;
            float* xr = out + (size_t)m * 1024; float* xr2 = out + (size_t)m2 * 1024;
            const float sp = (lane < 16) ? SSQ[(size_t)m * 16 + lane] : 0.f, sp2 = (lane < 16) ? SSQ[(size_t)m2 * 16 + lane] : 0.f;
            f32x4 v[4], w[4];
#pragma unroll
            for (int j = 0; j < 4; ++j) { v[j] = *(const f32x4*)(xr + 4 * lane + 256 * j); w[j] = *(const f32x4*)(xr2 + 4 * lane + 256 * j); }
            const float rs = __builtin_amdgcn_rsqf(wave_sum(sp) * (1.0f / DMOD) + EPS), rs2 = __builtin_amdgcn_rsqf(wave_sum(sp2) * (1.0f / DMOD) + EPS);
#pragma unroll
            for (int j = 0; j < 4; ++j) { *(f32x4*)(xr + 4 * lane + 256 * j) = v[j] * gv[j] * rs; if (m2 != m) *(f32x4*)(xr2 + 4 * lane + 256 * j) = w[j] * gv[j] * rs2; }
        }
    }
    }
}

extern "C" void kernel_launch(void* const* d_in, const int* in_sizes, int n_in, void* d_out, int out_size, void* d_ws, size_t ws_size, hipStream_t stream) {
    static int grid = 0;
    if (grid == 0) {
        if (n_in != 18 || out_size != M_TOK * DMOD || ws_size < WS_END) { fprintf(stderr, "kernel_launch: unexpected shapes (n_in %d out %d ws %zu)\n", n_in, out_size, ws_size); grid = -1; return; }
        int dev = 0, cus = 0, per_cu = 0;
        (void)hipGetDevice(&dev); (void)hipDeviceGetAttribute(&cus, hipDeviceAttributeMultiprocessorCount, dev);
        (void)hipFuncSetAttribute((const void*)fwd_megakernel, hipFuncAttributeMaxDynamicSharedMemorySize, LDS_BYTES);
        (void)hipOccupancyMaxActiveBlocksPerMultiprocessor(&per_cu, (const void*)fwd_megakernel, NWAVES * 64, LDS_BYTES);
        if (per_cu < 1) { fprintf(stderr, "kernel_launch: occupancy query says %d blocks/CU\n", per_cu); per_cu = 1; }
        (void)hipGetLastError();
        grid = cus * 1;
    }
    if (grid < 0) return;
    (void)hipMemsetAsync((char*)d_ws + WS_BAR, 0, BAR_BYTES, stream);
    Args a{};
    for (int i = 0; i < 18; ++i) a.in[i] = (const float*)d_in[i];
    a.out = (float*)d_out; a.ws = (unsigned char*)d_ws;
    if (N_LAUNCH_MODE == 0) {
        a.ph_lo = 0; a.ph_hi = N_PHASES;
        void* params[] = {&a};
        hipError_t e = hipLaunchCooperativeKernel((const void*)fwd_megakernel, dim3(grid), dim3(NWAVES * 64), params, LDS_BYTES, stream);
        if (e != hipSuccess) fprintf(stderr, "cooperative launch failed: %s (grid %d)\n", hipGetErrorString(e), grid);
    } else {
        for (int p = 0; p < N_PHASES; ++p) { a.ph_lo = p; a.ph_hi = p + 1;
            hipLaunchKernelGGL(fwd_megakernel, dim3(grid), dim3(NWAVES * 64), LDS_BYTES, stream, a); }
    }
}
```

```cpp
#include <hip/hip_runtime.h>
#include <hip/hip_cooperative_groups.h>
#include <hip/hip_bf16.h>
#include <cstdio>
#include <cstdint>
#include <cmath>
namespace cg = cooperative_groups;

constexpr int M_TOK = 98304, NPROMPT = 32768, SEQ_P = 8192, SEQ_S = 2048;
constexpr int DMOD = 1024, INW = 3840, DFF = 2048, NLAYER = 4;
constexpr float EPS = 1e-6f;
constexpr float C2 = 0.125f * 1.4426950408889634f;

#define LAS __attribute__((address_space(3)))
typedef unsigned short bf16_t;
typedef short bf16x8 __attribute__((ext_vector_type(8)));
typedef float f32x4 __attribute__((ext_vector_type(4)));
typedef float f32x2 __attribute__((ext_vector_type(2)));
typedef unsigned u32x4 __attribute__((ext_vector_type(4)));
typedef unsigned u32x2 __attribute__((ext_vector_type(2)));

typedef __bf16 bf16x2_t_ __attribute__((ext_vector_type(2)));
__device__ __forceinline__ unsigned cvt_pk_bf16(float lo, float hi) { f32x2 v = {lo, hi}; bf16x2_t_ b = __builtin_convertvector(v, bf16x2_t_); return __builtin_bit_cast(unsigned, b); }
__device__ __forceinline__ float bf_lo(unsigned w) { return __uint_as_float(w << 16); }
__device__ __forceinline__ float bf_hi(unsigned w) { return __uint_as_float(w & 0xffff0000u); }
__device__ __forceinline__ float gelu_t(float x) {
    const float u = x * (0.7978845608f + 0.0356774081f * x * x);
    const float e = __builtin_amdgcn_exp2f(u * -2.8853900818f);
    return x * __builtin_amdgcn_rcpf(1.0f + e);
}
__device__ __forceinline__ float sigmoid_f(float x) { return __builtin_amdgcn_rcpf(1.0f + __builtin_amdgcn_exp2f(x * -1.4426950409f)); }
__device__ __forceinline__ float dpp_shr1(float v) { return __int_as_float(__builtin_amdgcn_update_dpp(0, __float_as_int(v), 0x111, 0xF, 0xF, true)); }
__device__ __forceinline__ float dpp_shl1(float v) { return __int_as_float(__builtin_amdgcn_update_dpp(0, __float_as_int(v), 0x101, 0xF, 0xF, true)); }

namespace pg8 {
constexpr int BM = 256, BK = 64, HALF = 128, HTB = HALF * BK * 2, STAGE_BYTES = 8 * HTB, NXCD = 8, WGM = 8;
__host__ __device__ __forceinline__ int lds_byte(int r, int c) { const int st = (r >> 4) * 2 + (c >> 5), rr = r & 15, cc = c & 31, ob = rr * 64 + cc * 2; return st * 1024 + (ob ^ (((ob >> 9) & 1) << 5)); }
__host__ __device__ __forceinline__ void stage_rc(int b, int& R, int& C) { const int st = b / 1024, sb = b % 1024, swz = sb ^ (((sb >> 9) & 1) << 5); R = (st >> 1) * 16 + swz / 64; C = (st & 1) * 32 + (swz % 64) / 2; }

struct Unit { int pm, pn, part; };
struct Gemm { const bf16_t* A; const bf16_t* Bt; int lda, ldb, K; long partA, partB; int tstride, wstride, shift; };

struct StaticOrder {
    int nM, nN, nwg, G, c, parts, pn_lo, pn_split, pn_hi, rev;
    __device__ void init(int nM_, int nN_, int parts_, int G_, int c_, int pn_lo_ = 0, int pn_split_ = 1 << 20, int pn_hi_ = 0) { nM = nM_; nN = nN_; nwg = nM * nN; G = G_; c = c_; parts = parts_; pn_lo = pn_lo_; pn_split = pn_split_; pn_hi = pn_hi_; rev = 0; }
    __device__ bool next(int i, Unit& u) const {
        const int it = (parts == 2) ? (i >> 1) : i; u.part = (parts == 2) ? (i & 1) : 0;
        const long L = (long)it * G + c; if (L >= nwg) return false;
        int wgid = (int)L; { const int q = nwg / NXCD, r = nwg % NXCD, xcd = wgid % NXCD, off = wgid / NXCD; wgid = (xcd < r ? xcd * (q + 1) : r * (q + 1) + (xcd - r) * q) + off; }
        const int nig = WGM * nN, gid = wgid / nig, fm = gid * WGM, gsz = (nM - fm) < WGM ? (nM - fm) : WGM;
        u.pm = fm + ((wgid % nig) % gsz); if (rev) u.pm = nM - 1 - u.pm; { const int ix = (wgid % nig) / gsz; u.pn = ix < pn_split ? pn_lo + ix : pn_hi + (ix - pn_split); } return true;
    }
};

template <class Epi, int PARTS>
__device__ __forceinline__ void gemm_phase(LAS unsigned char* lds, const Gemm g, const StaticOrder& S, const Epi& E) {
    int tid_ = threadIdx.x; asm volatile("" : "+v"(tid_));
    const int tid = tid_, wid = __builtin_amdgcn_readfirstlane(tid >> 6), lane = tid & 63, wr = wid >> 2, wc = wid & 3, fr = lane & 15, fq = lane >> 4;
    const int K = g.K, nt = K / BK;
    unsigned voffA[2], voffB[2];
#pragma unroll
    for (int i = 0; i < 2; ++i) { int R, C; stage_rc(tid * 16 + i * 8192, R, C);
        const int TR = g.wstride ? g.wstride * (R >> 6) + 8 * (R & 15) + ((R >> 4) & 3) : R;
        voffA[i] = (unsigned)(TR * g.lda + C) * 2u; voffB[i] = (unsigned)(R * g.ldb + C) * 2u; }
    const size_t kstep = (size_t)(BK * 2);
    const size_t hstepA = (size_t)(g.wstride ? 4 : HALF) * g.lda * 2, hstepB = (size_t)HALF * g.ldb * 2;
    const unsigned ldsw = (unsigned)wid * 1024u;
    const int aoff = lds_byte(wr * 64 + fr, fq * 8), boff = lds_byte(wc * 32 + fr, fq * 8);
#define PG8_SA(b, h) (((b) * 2 + (h)) * HTB)
#define PG8_SB(b, h) ((4 + (b) * 2 + (h)) * HTB)
#define PG8_STAGE(bufoff, gbase, voff) do { _Pragma("unroll") for (int _i = 0; _i < 2; ++_i) \
        __builtin_amdgcn_global_load_lds((const unsigned*)((const char*)(gbase) + (voff)[_i]), (LAS unsigned*)(lds + (bufoff) + ldsw + _i * 8192), 16, 0, 0); } while (0)
#define PG8_STAGEA(bufoff, gbase, voff) do { _Pragma("unroll") for (int _i = 0; _i < 2; ++_i) \
        __builtin_amdgcn_global_load_lds((const unsigned*)((const char*)(gbase) + (voff)[_i]), (LAS unsigned*)(lds + (bufoff) + ldsw + _i * 8192), 16, 0, 0); } while (0)
#define PG8_LDA(dst, b, h) do { _Pragma("unroll") for (int m = 0; m < 4; ++m) _Pragma("unroll") for (int k = 0; k < 2; ++k) dst[m][k] = *(const LAS bf16x8*)(lds + PG8_SA(b, h) + aoff + m * 2048 + k * 1024); } while (0)
#define PG8_LDB(dst, b, h) do { _Pragma("unroll") for (int n = 0; n < 2; ++n) _Pragma("unroll") for (int k = 0; k < 2; ++k) dst[n][k] = *(const LAS bf16x8*)(lds + PG8_SB(b, h) + boff + n * 2048 + k * 1024); } while (0)
#define PG8_MMA(ai, bj, At, Bt) do { __builtin_amdgcn_s_setprio(1); _Pragma("unroll") for (int m = 0; m < 4; ++m) _Pragma("unroll") for (int n = 0; n < 2; ++n) _Pragma("unroll") for (int k = 0; k < 2; ++k) \
        acc[ai][bj][m][n] = __builtin_amdgcn_mfma_f32_16x16x32_bf16(Bt[n][k], At[m][k], acc[ai][bj][m][n], 0, 0, 0); __builtin_amdgcn_s_setprio(0); } while (0)
#define PG8_WAIT_V(n) asm volatile("s_waitcnt vmcnt(" #n ")" ::: "memory")
#define PG8_WAIT_L(n) asm volatile("s_waitcnt lgkmcnt(" #n ")" ::: "memory")
#define PG8_BAR __builtin_amdgcn_s_barrier()
#define PG8_SCHED __builtin_amdgcn_sched_barrier(0)
#define PG8_UA(u) ((const char*)g.A + (size_t)(u).part * g.partA + ((long)(u).pm * g.tstride + g.shift) * (long)g.lda * 2)
#define PG8_UB(u) ((const char*)g.Bt + (size_t)(u).part * g.partB + (size_t)(u).pn * 256 * g.ldb * 2)
    Unit cur, nxt; int ui = 0;
    if (!S.next(0, cur)) return;
    f32x4 acc[2][2][4][2];
#pragma unroll
    for (int a = 0; a < 2; ++a)
#pragma unroll
        for (int b = 0; b < 2; ++b)
#pragma unroll
            for (int m = 0; m < 4; ++m)
#pragma unroll
                for (int n = 0; n < 2; ++n) acc[a][b][m][n] = (f32x4){0.f, 0.f, 0.f, 0.f};
    bf16x8 At[4][2], B0[2][2], B1[2][2];
    const char* cA = PG8_UA(cur); const char* cB = PG8_UB(cur);
    PG8_STAGE(PG8_SB(0, 0), cB, voffB); PG8_STAGE(PG8_SB(0, 1), cB + hstepB, voffB); PG8_STAGEA(PG8_SA(0, 0), cA, voffA); PG8_STAGEA(PG8_SA(0, 1), cA + hstepA, voffA);
    if (wr == 1) PG8_BAR;
    PG8_WAIT_V(2); PG8_BAR;
    PG8_STAGE(PG8_SB(1, 0), cB + kstep, voffB); PG8_STAGEA(PG8_SA(1, 0), cA + kstep, voffA); PG8_STAGE(PG8_SB(1, 1), cB + hstepB + kstep, voffB);
    PG8_WAIT_V(6); PG8_BAR;
    for (;;) {
        const bool has_next = S.next(ui + 1, nxt);
        const char* nA = has_next ? PG8_UA(nxt) : cA; const char* nB = has_next ? PG8_UB(nxt) : cB;
        for (int t = 0; t < nt; t += 2) {
            const bool last = (t == nt - 2);
            const char* a1 = cA + (size_t)(t + 1) * kstep;
            const char* a2 = last ? nA : cA + (size_t)(t + 2) * kstep; const char* b2 = last ? nB : cB + (size_t)(t + 2) * kstep;
            const char* a3 = a2 + kstep; const char* b3 = b2 + kstep;
            PG8_LDB(B0, 0, 0); PG8_LDB(B1, 0, 1); PG8_SCHED; PG8_LDA(At, 0, 0); PG8_STAGEA(PG8_SA(1, 1), a1 + hstepA, voffA);
            PG8_WAIT_V(8); PG8_WAIT_L(0); PG8_BAR; PG8_MMA(0, 0, At, B0); PG8_MMA(0, 1, At, B1); PG8_BAR; PG8_SCHED;
            PG8_LDA(At, 0, 1); PG8_STAGE(PG8_SB(0, 0), b2, voffB); PG8_STAGE(PG8_SB(0, 1), b2 + hstepB, voffB); PG8_STAGEA(PG8_SA(0, 0), a2, voffA);
            PG8_WAIT_V(8); PG8_WAIT_L(0); PG8_BAR; PG8_MMA(1, 0, At, B0); PG8_MMA(1, 1, At, B1); PG8_BAR; PG8_SCHED;
            PG8_LDB(B0, 1, 0); PG8_LDB(B1, 1, 1); PG8_SCHED; PG8_LDA(At, 1, 0); PG8_STAGEA(PG8_SA(0, 1), a2 + hstepA, voffA);
            PG8_WAIT_V(8); PG8_WAIT_L(0); PG8_BAR; PG8_MMA(0, 0, At, B0); PG8_MMA(0, 1, At, B1); PG8_BAR; PG8_SCHED;
            PG8_LDA(At, 1, 1); PG8_STAGE(PG8_SB(1, 0), b3, voffB); PG8_STAGE(PG8_SB(1, 1), b3 + hstepB, voffB); PG8_STAGEA(PG8_SA(1, 0), a3, voffA);
            PG8_WAIT_V(8); PG8_WAIT_L(0); PG8_BAR; PG8_MMA(1, 0, At, B0); PG8_MMA(1, 1, At, B1); PG8_BAR; PG8_SCHED;
        }
        if (wr == 0) PG8_BAR;
        E(acc, cur, wr, wc, fr, fq);
        if (!has_next) break;
        if (PARTS == 1 || nxt.part == 0) {
#pragma unroll
        for (int a = 0; a < 2; ++a)
#pragma unroll
            for (int b = 0; b < 2; ++b)
#pragma unroll
                for (int m = 0; m < 4; ++m)
#pragma unroll
                    for (int n = 0; n < 2; ++n) acc[a][b][m][n] = (f32x4){0.f, 0.f, 0.f, 0.f};
        }
        cur = nxt; cA = nA; cB = nB; ++ui;
        if (wr == 1) PG8_BAR;
    }
    PG8_WAIT_V(0);
    PG8_BAR;
#undef PG8_SA
#undef PG8_SB
#undef PG8_STAGE
#undef PG8_STAGEA
#undef PG8_LDA
#undef PG8_LDB
#undef PG8_MMA
#undef PG8_WAIT_V
#undef PG8_WAIT_L
#undef PG8_BAR
#undef PG8_SCHED
#undef PG8_UA
#undef PG8_UB
}

__device__ __forceinline__ void load_rs8(const float* ss, int t0, int fq, float (&rs)[8], int tmax) {
#pragma unroll
    for (int j = 0; j < 8; ++j) { int t = t0 + j; t = t < 0 ? 0 : (t > tmax ? tmax : t);
        const f32x4 p = *(const f32x4*)(ss + (size_t)t * 16 + 4 * fq); float s = (p.x + p.y) + (p.z + p.w);
        s += __shfl_xor(s, 16); s += __shfl_xor(s, 32); rs[j] = __builtin_amdgcn_rsqf(s * (1.0f / DMOD) + EPS); }
}

struct EpiQKV {
    const float* ss; const float* qg; const float* kg; const float* rope;
    bf16_t* QU; bf16_t* Kb; bf16_t* Vb;
    __device__ __forceinline__ void operator()(f32x4 (&acc)[2][2][4][2], const Unit& u, int wr, int wc, int fr, int fq) const {
        const int t0 = u.pm * 256 + wr * 128 + fr * 8;
        { float rs[8]; load_rs8(ss, t0, fq, rs, M_TOK - 1);
#pragma unroll
          for (int ai = 0; ai < 2; ++ai)
#pragma unroll
            for (int m = 0; m < 4; ++m)
#pragma unroll
                for (int bj = 0; bj < 2; ++bj)
#pragma unroll
                    for (int n = 0; n < 2; ++n) acc[ai][bj][m][n] = acc[ai][bj][m][n] * rs[4 * ai + m]; }
        const int pn = u.pn;
        {
            const bool isq = pn < 2;
            if (isq || wc < 2) {
                const float* gp = isq ? qg : kg; const float osc = isq ? C2 : 1.0f;
                f32x4 gv[2][2];
#pragma unroll
                for (int bj = 0; bj < 2; ++bj)
#pragma unroll
                    for (int n = 0; n < 2; ++n) gv[bj][n] = *(const f32x4*)(gp + 32 * bj + 16 * n + 4 * fq);
                const int smask = (t0 < NPROMPT) ? (SEQ_P - 1) : (SEQ_S - 1);
                const int prow = (t0 & smask) >> 6;
                const f32x4 rr0 = *(const f32x4*)(rope + (prow * 16 + 4 * fq) * 2), rr1 = *(const f32x4*)(rope + (prow * 16 + 4 * fq) * 2 + 4);
                bf16_t* dst = isq ? (QU + (size_t)t0 * 1024 + (4 * pn + wc) * 64) : (Kb + (size_t)t0 * 128 + wc * 64);
                const int pitch = isq ? 1024 : 128;
#pragma unroll
                for (int ai = 0; ai < 2; ++ai)
#pragma unroll
                    for (int m = 0; m < 4; ++m) {
                        const int j = 4 * ai + m;
                        float sq = 0.f;
#pragma unroll
                        for (int bj = 0; bj < 2; ++bj)
#pragma unroll
                            for (int n = 0; n < 2; ++n) { const f32x4 v = acc[ai][bj][m][n]; sq += (v.x * v.x + v.y * v.y) + (v.z * v.z + v.w * v.w); }
                        sq += __shfl_xor(sq, 16); sq += __shfl_xor(sq, 32);
                        const float rn = __builtin_amdgcn_rsqf(sq * (1.0f / 64.0f) + EPS) * osc;
                        const int pcol = (t0 + j) & 63;
                        const f32x4 cc0 = *(const f32x4*)(rope + (pcol * 16 + 4 * fq) * 2), cc1 = *(const f32x4*)(rope + (pcol * 16 + 4 * fq) * 2 + 4);
#pragma unroll
                        for (int bj = 0; bj < 2; ++bj) {
                            const f32x4 t0v = bj == 0 ? rr0 : cc0, t1v = bj == 0 ? rr1 : cc1;
                            const f32x4 x1 = acc[ai][bj][m][0] * gv[bj][0] * rn, x2 = acc[ai][bj][m][1] * gv[bj][1] * rn;
                            const f32x4 cs = (f32x4){t0v.x, t0v.z, t1v.x, t1v.z}, sn = (f32x4){t0v.y, t0v.w, t1v.y, t1v.w};
                            const f32x4 o1 = x1 * cs - x2 * sn, o2 = x1 * sn + x2 * cs;
                            u32x2 w1, w2; w1.x = cvt_pk_bf16(o1.x, o1.y); w1.y = cvt_pk_bf16(o1.z, o1.w); w2.x = cvt_pk_bf16(o2.x, o2.y); w2.y = cvt_pk_bf16(o2.z, o2.w);
                            bf16_t* p = dst + (size_t)j * pitch + 32 * bj + 4 * fq;
                            *(u32x2*)p = w1; *(u32x2*)(p + 16) = w2;
                        }
                    }
            } else {
                bf16_t* dst = Vb + (size_t)t0 * 128 + (wc - 2) * 64;
#pragma unroll
                for (int ai = 0; ai < 2; ++ai)
#pragma unroll
                    for (int m = 0; m < 4; ++m)
#pragma unroll
                        for (int bj = 0; bj < 2; ++bj)
#pragma unroll
                            for (int n = 0; n < 2; ++n) { const f32x4 v = acc[ai][bj][m][n]; u32x2 w; w.x = cvt_pk_bf16(v.x, v.y); w.y = cvt_pk_bf16(v.z, v.w);
                                *(u32x2*)(dst + (size_t)(4 * ai + m) * 128 + 32 * bj + 16 * n + 4 * fq) = w; }
            }
        }
    }
};
struct EpiVS {
    const float* ss; bf16_t* VST; float* ssg;
    __device__ __forceinline__ void operator()(f32x4 (&acc)[2][2][4][2], const Unit& u, int wr, int wc, int fr, int fq) const {
        const int t0 = u.pm * 256 + wr * 128 + fr * 8;
        { float rs[8]; load_rs8(ss, t0, fq, rs, M_TOK - 1);
#pragma unroll
          for (int ai = 0; ai < 2; ++ai)
#pragma unroll
            for (int m = 0; m < 4; ++m)
#pragma unroll
                for (int bj = 0; bj < 2; ++bj)
#pragma unroll
                    for (int n = 0; n < 2; ++n) acc[ai][bj][m][n] = acc[ai][bj][m][n] * rs[4 * ai + m]; }
        const int pn = u.pn;
        {
            const int chunk = 2 * u.pm + wr;
            bf16_t* dst = VST + ((size_t)chunk * 512 + 256 * (pn - 5) + 32 * wc + 8 * fq) * 128 + 8 * fr;
#pragma unroll
            for (int ai = 0; ai < 2; ++ai)
#pragma unroll
                for (int m = 0; m < 4; ++m) {
                    float sq = 0.f;
#pragma unroll
                    for (int bj = 0; bj < 2; ++bj)
#pragma unroll
                        for (int n = 0; n < 2; ++n) { f32x4 v = acc[ai][bj][m][n]; v = (f32x4){gelu_t(v.x), gelu_t(v.y), gelu_t(v.z), gelu_t(v.w)}; acc[ai][bj][m][n] = v;
                            sq += (v.x * v.x + v.y * v.y) + (v.z * v.z + v.w * v.w); }
                    sq += __shfl_xor(sq, 16); sq += __shfl_xor(sq, 32);
                    if (fq == 0) ssg[(size_t)(t0 + 4 * ai + m) * 8 + 4 * (pn - 5) + wc] = sq;
                    asm volatile("" : "+v"(acc[ai][0][m][0]), "+v"(acc[ai][0][m][1]), "+v"(acc[ai][1][m][0]), "+v"(acc[ai][1][m][1]));
                }
#pragma unroll
            for (int bj = 0; bj < 2; ++bj)
#pragma unroll
                for (int n = 0; n < 2; ++n)
#pragma unroll
                    for (int i = 0; i < 4; ++i) {
                        u32x4 w; w.x = cvt_pk_bf16(acc[0][bj][0][n][i], acc[0][bj][1][n][i]); w.y = cvt_pk_bf16(acc[0][bj][2][n][i], acc[0][bj][3][n][i]);
                        w.z = cvt_pk_bf16(acc[1][bj][0][n][i], acc[1][bj][1][n][i]); w.w = cvt_pk_bf16(acc[1][bj][2][n][i], acc[1][bj][3][n][i]);
                        *(u32x4*)(dst + (size_t)(128 * bj + 4 * n + i) * 128) = w;
                    }
        }
    }
};
struct EpiEW {
    const float* ss; bf16_t* QU; bf16_t* GA; bf16_t* GB;
    __device__ __forceinline__ void operator()(f32x4 (&acc)[2][2][4][2], const Unit& u, int wr, int wc, int fr, int fq) const {
        const int t0 = u.pm * 256 + wr * 128 + fr * 8;
        float rs[8]; load_rs8(ss, t0, fq, rs, M_TOK - 1);
        const int pn = u.pn;
        const bool isu = pn < 5;
        bf16_t* dst = (isu ? QU + 512 + 256 * (pn - 3) : ((pn < 11) ? GA : GB) + 256 * ((pn - 7) & 3)) + (size_t)t0 * 1024 + 32 * wc + 8 * fq;
        if (isu) {
#pragma unroll
            for (int ai = 0; ai < 2; ++ai)
#pragma unroll
                for (int m = 0; m < 4; ++m)
#pragma unroll
                    for (int bj = 0; bj < 2; ++bj) { const f32x4 a = acc[ai][bj][m][0] * rs[4 * ai + m], b = acc[ai][bj][m][1] * rs[4 * ai + m]; u32x4 w;
                        w.x = cvt_pk_bf16(gelu_t(a.x), gelu_t(a.y)); w.y = cvt_pk_bf16(gelu_t(a.z), gelu_t(a.w)); w.z = cvt_pk_bf16(gelu_t(b.x), gelu_t(b.y)); w.w = cvt_pk_bf16(gelu_t(b.z), gelu_t(b.w));
                        *(u32x4*)(dst + (size_t)(4 * ai + m) * 1024 + 128 * bj) = w; }
        } else {
#pragma unroll
            for (int ai = 0; ai < 2; ++ai)
#pragma unroll
                for (int m = 0; m < 4; ++m) { const float k2 = rs[4 * ai + m] * -1.4426950409f;
#pragma unroll
                    for (int bj = 0; bj < 2; ++bj) { const f32x4 a = acc[ai][bj][m][0], b = acc[ai][bj][m][1]; u32x4 w;
#define SG_(x) __builtin_amdgcn_rcpf(1.0f + __builtin_amdgcn_exp2f((x) * k2))
                        w.x = cvt_pk_bf16(SG_(a.x), SG_(a.y)); w.y = cvt_pk_bf16(SG_(a.z), SG_(a.w)); w.z = cvt_pk_bf16(SG_(b.x), SG_(b.y)); w.w = cvt_pk_bf16(SG_(b.z), SG_(b.w));
#undef SG_
                        *(u32x4*)(dst + (size_t)(4 * ai + m) * 1024 + 128 * bj) = w; } }
        }
    }
};

struct EpiMerge {
    bf16_t* GA; const bf16_t* GB;
    __device__ __forceinline__ void operator()(f32x4 (&acc)[2][2][4][2], const Unit& u, int wr, int wc, int fr, int fq) const {
        const int t0 = u.pm * 256 + wr * 64 + fr;
        const size_t off0 = (size_t)t0 * 1024 + 256 * u.pn + 32 * wc + 8 * fq;
#pragma unroll
        for (int ai = 0; ai < 2; ++ai)
#pragma unroll
            for (int m = 0; m < 4; ++m)
#pragma unroll
                for (int bj = 0; bj < 2; ++bj) {
                    const size_t off = off0 + (size_t)(128 * ai + 16 * m) * 1024 + 128 * bj;
                    const u32x4 gb = *(const u32x4*)(GB + off);
                    f32x4 s0 = (f32x4){bf_lo(gb.x), bf_hi(gb.x), bf_lo(gb.y), bf_hi(gb.y)}, s1 = (f32x4){bf_lo(gb.z), bf_hi(gb.z), bf_lo(gb.w), bf_hi(gb.w)};
                    if (u.part == 0) {
                        const u32x4 ga = *(const u32x4*)(GA + off);
                        const f32x4 a0 = (f32x4){bf_lo(ga.x), bf_hi(ga.x), bf_lo(ga.y), bf_hi(ga.y)}, a1 = (f32x4){bf_lo(ga.z), bf_hi(ga.z), bf_lo(ga.w), bf_hi(ga.w)};
                        s0 = (f32x4){__builtin_amdgcn_rcpf(s0.x), __builtin_amdgcn_rcpf(s0.y), __builtin_amdgcn_rcpf(s0.z), __builtin_amdgcn_rcpf(s0.w)};
                        s1 = (f32x4){__builtin_amdgcn_rcpf(s1.x), __builtin_amdgcn_rcpf(s1.y), __builtin_amdgcn_rcpf(s1.z), __builtin_amdgcn_rcpf(s1.w)};
                        acc[ai][bj][m][0] = acc[ai][bj][m][0] * (a0 * s0); acc[ai][bj][m][1] = acc[ai][bj][m][1] * (a1 * s1);
                    } else {
                        const f32x4 v0 = acc[ai][bj][m][0] * s0, v1 = acc[ai][bj][m][1] * s1; u32x4 w;
                        w.x = cvt_pk_bf16(v0.x, v0.y); w.y = cvt_pk_bf16(v0.z, v0.w); w.z = cvt_pk_bf16(v1.x, v1.y); w.w = cvt_pk_bf16(v1.z, v1.w);
                        *(u32x4*)(GA + off) = w;
                    }
                }
    }
};

struct EpiRes {
    const float* xp; const float* xs; int first; float* out; bf16_t* xb; float* ss; int bb; int wout;
    __device__ __forceinline__ void operator()(f32x4 (&acc)[2][2][4][2], const Unit& u, int wr, int wc, int fr, int fq) const {
        const int t0 = u.pm * 256 + wr * 64 + fr;
        const int col0 = 256 * u.pn + 32 * wc + 8 * fq;
        const float* bp0 = first ? ((t0 < NPROMPT) ? xp + (size_t)t0 * 1024 : xs + (size_t)(t0 - NPROMPT) * 1024) : out + (size_t)t0 * 1024;
#pragma unroll
        for (int ai = 0; ai < 2; ++ai)
#pragma unroll
            for (int m = 0; m < 4; ++m) {
                const int j = 128 * ai + 16 * m; float sq = 0.f;
#pragma unroll
                for (int bj = 0; bj < 2; ++bj) {
                    const size_t o = (size_t)j * 1024 + col0 + 128 * bj;
                    f32x4 a, b;
                    if (bb) { const u32x4 w = *(const u32x4*)(xb + (size_t)t0 * 1024 + o);
                        a = (f32x4){bf_lo(w.x), bf_hi(w.x), bf_lo(w.y), bf_hi(w.y)}; b = (f32x4){bf_lo(w.z), bf_hi(w.z), bf_lo(w.w), bf_hi(w.w)}; }
                    else { a = *(const f32x4*)(bp0 + o); b = *(const f32x4*)(bp0 + o + 4); }
                    a = a + acc[ai][bj][m][0]; b = b + acc[ai][bj][m][1];
                    if (wout) { float* op = out + (size_t)t0 * 1024 + o; *(f32x4*)op = a; *(f32x4*)(op + 4) = b; }
                    u32x4 w; w.x = cvt_pk_bf16(a.x, a.y); w.y = cvt_pk_bf16(a.z, a.w); w.z = cvt_pk_bf16(b.x, b.y); w.w = cvt_pk_bf16(b.z, b.w);
                    *(u32x4*)(xb + (size_t)t0 * 1024 + o) = w;
                    sq += (a.x * a.x + a.y * a.y) + (a.z * a.z + a.w * a.w) + (b.x * b.x + b.y * b.y) + (b.z * b.z + b.w * b.w);
                }
                sq += __shfl_xor(sq, 16); sq += __shfl_xor(sq, 32);
                if (fq == 0) ss[(size_t)(t0 + j) * 16 + 4 * u.pn + wc] = sq;
            }
    }
};

struct EpiUp {
    const float* ss; const float* cw; const float* cb; bf16_t* H2;
    __device__ __forceinline__ void operator()(f32x4 (&acc)[2][2][4][2], const Unit& u, int wr, int wc, int fr, int fq) const {
        const int t0 = u.pm * 252 - 1 + wr * 126 + fr * 8;
        { float rs[8]; load_rs8(ss, t0, fq, rs, M_TOK - 1);
#pragma unroll
          for (int ai = 0; ai < 2; ++ai)
#pragma unroll
            for (int m = 0; m < 4; ++m)
#pragma unroll
                for (int bj = 0; bj < 2; ++bj)
#pragma unroll
                    for (int n = 0; n < 2; ++n) acc[ai][bj][m][n] = acc[ai][bj][m][n] * rs[4 * ai + m]; }
        unsigned vmask = 0, smask = 0, emask = 0;
#pragma unroll
        for (int j = 0; j < 8; ++j) { const int t = t0 + j, loc = fr * 8 + j;
            if (loc >= 1 && loc <= 126 && t < M_TOK) vmask |= 1u << j;
            const int sm = (t < NPROMPT) ? (SEQ_P - 1) : (SEQ_S - 1);
            if ((t & sm) == 0) smask |= 1u << j;
            if ((t & sm) == sm) emask |= 1u << j; }
#pragma unroll
        for (int n = 0; n < 2; ++n) {
            const int cg_ = 128 * u.pn + 32 * wc + 8 * fq + 4 * n;
            const f32x4 w0g = *(const f32x4*)(cw + cg_), w1g = *(const f32x4*)(cw + 4096 + cg_), w2g = *(const f32x4*)(cw + 8192 + cg_), bg = *(const f32x4*)(cb + cg_);
            const f32x4 w0v = *(const f32x4*)(cw + 2048 + cg_), w1v = *(const f32x4*)(cw + 4096 + 2048 + cg_), w2v = *(const f32x4*)(cw + 8192 + 2048 + cg_), bv = *(const f32x4*)(cb + 2048 + cg_);
            float h[8][4];
#pragma unroll
            for (int i = 0; i < 4; ++i) {
                float ag[8], av[8];
#pragma unroll
                for (int j = 0; j < 8; ++j) { ag[j] = acc[j >> 2][0][j & 3][n][i]; av[j] = acc[j >> 2][1][j & 3][n][i]; }
                const float lg = dpp_shr1(ag[7]), rg = dpp_shl1(ag[0]), lv = dpp_shr1(av[7]), rv = dpp_shl1(av[0]);
#pragma unroll
                for (int j = 0; j < 8; ++j) {
                    float Lg = j == 0 ? lg : ag[j == 0 ? 0 : j - 1], Rg = j == 7 ? rg : ag[j == 7 ? 7 : j + 1];
                    float Lv = j == 0 ? lv : av[j == 0 ? 0 : j - 1], Rv = j == 7 ? rv : av[j == 7 ? 7 : j + 1];
                    if ((smask >> j) & 1u) { Lg = 0.f; Lv = 0.f; }
                    if ((emask >> j) & 1u) { Rg = 0.f; Rv = 0.f; }
                    const float cgv = w0g[i] * Lg + w1g[i] * ag[j] + w2g[i] * Rg + bg[i];
                    const float cvv = w0v[i] * Lv + w1v[i] * av[j] + w2v[i] * Rv + bv[i];
                    h[j][i] = gelu_t(cgv) * cvv;
                }
            }
#pragma unroll
            for (int j = 0; j < 8; ++j) if ((vmask >> j) & 1u) { u32x2 w; w.x = cvt_pk_bf16(h[j][0], h[j][1]); w.y = cvt_pk_bf16(h[j][2], h[j][3]);
                *(u32x2*)(H2 + (size_t)(t0 + j) * 2048 + cg_) = w; }
        }
    }
};
}

namespace attn_body {
using bf16=__hip_bfloat16;
using bf16x8=__attribute__((ext_vector_type(8)))short;
using s16x4=__attribute__((ext_vector_type(4)))short;
using f32x16=__attribute__((ext_vector_type(16)))float;
using u32x4=__attribute__((ext_vector_type(4)))unsigned;
constexpr int D=64,QP=1024,KP=128;
constexpr int NW=8,QBLK=32,QB=QBLK*NW,KVBLK=64;
__device__ __forceinline__ int crow(int r,int hi){return (r&3)+8*(r>>2)+4*hi;}
#define SBAR() __builtin_amdgcn_sched_barrier(0)
constexpr int NSLOT=3, SLOTB=8192;
constexpr int LDS_K=0, LDS_V=NSLOT*SLOTB, LDS_WS=2*NSLOT*SLOTB, LDS_OST=LDS_WS+NW*64*4, LDS_BYTES=LDS_OST+NW*4096;
__device__ __forceinline__ void glds16(const void*gsrc,unsigned lds_dst){unsigned keep;
  asm volatile("s_mov_b32 %0, m0\n\ts_mov_b32 m0, %2\n\ts_nop 0\n\tglobal_load_lds_dwordx4 %1, off\n\ts_mov_b32 m0, %0":"=&s"(keep):"v"(gsrc),"s"(lds_dst):"memory");}
__device__ __forceinline__ float max3f(float a,float b,float c){float r;asm("v_max3_f32 %0, %1, %2, %3":"=v"(r):"v"(a),"v"(b),"v"(c));return r;}
__device__ __forceinline__ float max2f(float a,float b){float r;asm("v_max_f32_e32 %0, %1, %2":"=v"(r):"v"(a),"v"(b));return r;}
__device__ __forceinline__ float fadd_s(float a,float b){float r;asm("v_add_f32_e32 %0, %1, %2":"=v"(r):"v"(a),"v"(b));return r;}
__device__ __forceinline__ float fsub_s(float a,float b){float r;asm("v_sub_f32_e32 %0, %1, %2":"=v"(r):"v"(a),"v"(b));return r;}
typedef float f32x2_t __attribute__((ext_vector_type(2))); typedef __bf16 bf16x2_t __attribute__((ext_vector_type(2)));
__device__ __forceinline__ unsigned cvtpk_s(float lo,float hi){f32x2_t v={lo,hi};bf16x2_t b=__builtin_convertvector(v,bf16x2_t);return __builtin_bit_cast(unsigned,b);}
#define WAIT_BAR(N) asm volatile("s_waitcnt vmcnt(" #N ") lgkmcnt(0)\n\ts_barrier":::"memory")
__device__ __forceinline__ void qkt(f32x16&p0,f32x16&p1,const char*Kslot,const bf16x8*qr,const f32x16&negm,int r32,int hi){
  const char*kb=Kslot+hi*1024+r32*16;
  #pragma unroll
  for(int d0=0;d0<4;++d0){
    const bf16x8 b0=*reinterpret_cast<const bf16x8*>(kb+d0*2048);
    const bf16x8 b1=*reinterpret_cast<const bf16x8*>(kb+d0*2048+512);
    if(d0==0){p0=__builtin_amdgcn_mfma_f32_32x32x16_bf16(b0,qr[0],negm,0,0,0);p1=__builtin_amdgcn_mfma_f32_32x32x16_bf16(b1,qr[0],negm,0,0,0);}
    else{p0=__builtin_amdgcn_mfma_f32_32x32x16_bf16(b0,qr[d0],p0,0,0,0);p1=__builtin_amdgcn_mfma_f32_32x32x16_bf16(b1,qr[d0],p1,0,0,0);}}
}
typedef __attribute__((address_space(3))) const char* lds_cptr;
typedef short v4i16_t __attribute__((ext_vector_type(4)));
__device__ __forceinline__ void kload8(bf16x8*kf,lds_cptr kp){
  kf[0]=*(const __attribute__((address_space(3))) bf16x8*)(kp);      kf[1]=*(const __attribute__((address_space(3))) bf16x8*)(kp+512);
  kf[2]=*(const __attribute__((address_space(3))) bf16x8*)(kp+2048); kf[3]=*(const __attribute__((address_space(3))) bf16x8*)(kp+2560);
  kf[4]=*(const __attribute__((address_space(3))) bf16x8*)(kp+4096); kf[5]=*(const __attribute__((address_space(3))) bf16x8*)(kp+4608);
  kf[6]=*(const __attribute__((address_space(3))) bf16x8*)(kp+6144); kf[7]=*(const __attribute__((address_space(3))) bf16x8*)(kp+6656);
}
__device__ __forceinline__ void kload2(bf16x8*kf,lds_cptr kp,int j){ kf[2*j]=*(const __attribute__((address_space(3))) bf16x8*)(kp+j*2048); kf[2*j+1]=*(const __attribute__((address_space(3))) bf16x8*)(kp+j*2048+512); }
__device__ __forceinline__ s16x4 vtr(lds_cptr p){ return __builtin_bit_cast(s16x4,__builtin_amdgcn_ds_read_tr16_b64_v4i16((__attribute__((address_space(3))) v4i16_t*)p)); }
__device__ __forceinline__ float rowmax(const f32x16&p0,const f32x16&p1){
  float a=max3f(p0[0],p0[1],p1[0]),b=max3f(p0[2],p0[3],p1[1]);a=max3f(a,p1[2],p1[3]);
  #pragma unroll
  for(int r=4;r<16;r+=4){a=max3f(a,p0[r],p0[r+1]);b=max3f(b,p0[r+2],p0[r+3]);a=max3f(a,p1[r],p1[r+1]);b=max3f(b,p1[r+2],p1[r+3]);}
  const float m=max2f(a,b);
  auto rr=__builtin_amdgcn_permlane32_swap(__float_as_uint(m),__float_as_uint(m),false,false);
  return max2f(__uint_as_float(rr[0]),__uint_as_float(rr[1]));
}
__device__ __forceinline__ void pv(f32x16*o,int vb,bf16x8 pa0,bf16x8 pa1,bf16x8 pa2,bf16x8 pa3){
  #pragma unroll
  for(int d0=0;d0<2;++d0){s16x4 lo[4],hi[4];
    #pragma unroll
    for(int ks=0;ks<4;++ks){
      asm volatile("ds_read_b64_tr_b16 %0,%1 offset:%c2":"=&v"(lo[ks]):"v"(vb),"i"(d0*4096+ks*1024):"memory");
      asm volatile("ds_read_b64_tr_b16 %0,%1 offset:%c2":"=&v"(hi[ks]):"v"(vb),"i"(d0*4096+ks*1024+512):"memory");}
    asm volatile("s_waitcnt lgkmcnt(0)":::"memory");SBAR();
    #define PK(k) (bf16x8){lo[k][0],lo[k][1],lo[k][2],lo[k][3],hi[k][0],hi[k][1],hi[k][2],hi[k][3]}
    o[d0]=__builtin_amdgcn_mfma_f32_32x32x16_bf16(pa0,PK(0),o[d0],0,0,0);
    o[d0]=__builtin_amdgcn_mfma_f32_32x32x16_bf16(pa1,PK(1),o[d0],0,0,0);
    o[d0]=__builtin_amdgcn_mfma_f32_32x32x16_bf16(pa2,PK(2),o[d0],0,0,0);
    o[d0]=__builtin_amdgcn_mfma_f32_32x32x16_bf16(pa3,PK(3),o[d0],0,0,0);
    #undef PK
  }
}
template<int THRL> __device__ __forceinline__ void attn_unit(long rowbase,int seq,int h,int q0,const bf16*Q,const bf16*__restrict__ K,const bf16*__restrict__ V,bf16*O,char*shm){
  int tid_=threadIdx.x; asm volatile("":"+v"(tid_));
  const int tid=tid_,lane=tid&63,r32=lane&31,hi=lane>>5; const int wid=__builtin_amdgcn_readfirstlane(tid>>6);
  const bf16*Qw=Q+(rowbase+q0+wid*QBLK)*QP+h*D;
  const bf16*Kh=K+rowbase*KP+(h>>2)*D,*Vh=V+rowbase*KP+(h>>2)*D;
  const unsigned lds0=(unsigned)(uintptr_t)shm;
  float*wsf=(float*)(shm+LDS_WS)+wid*64;
  const bf16*ksrc=Kh+(long)lane*KP+wid*8;
  const bf16*vsrc=Vh+(long)(16*(wid&3)+(lane>>2))*KP+(wid>>2)*32+(lane&3)*8;
  const unsigned kdst=lds0+LDS_K+wid*1024, vdst=lds0+LDS_V+wid*1024;
  #define DMA_K(t,slot) glds16(ksrc+(long)(t)*KVBLK*KP,(unsigned)__builtin_amdgcn_readfirstlane(kdst+(slot)))
  #define DMA_V(t,slot) glds16(vsrc+(long)(t)*KVBLK*KP,(unsigned)__builtin_amdgcn_readfirstlane(vdst+(slot)))
  const int vb0=(int)(lds0+LDS_V)+((lane>>4)&1)*32+(lane&3)*8+(4*hi+((lane&15)>>2))*64;
  const char*Kbase=shm+LDS_K; bf16x8 kf[8];
  const lds_cptr shm3=(lds_cptr)shm; const lds_cptr kp0=shm3+LDS_K+hi*1024+r32*16; const lds_cptr vp0=shm3+LDS_V+((lane>>4)&1)*32+(lane&3)*8+(4*hi+((lane&15)>>2))*64;
  const int NT=seq/KVBLK;
  DMA_K(0,0);DMA_V(0,0);DMA_K(1,SLOTB);
  bf16x8 qr[4];
  #pragma unroll
  for(int d0=0;d0<4;++d0)qr[d0]=*reinterpret_cast<const bf16x8*>(&Qw[(long)r32*QP+d0*16+hi*8]);
  float mhat=0.f,l_reg=0.f;f32x16 o[2];o[0]=f32x16{};o[1]=f32x16{};f32x16 negm=f32x16{};asm volatile("":"+v"(negm));
  bool resc=false;
  #define START(P0,P1) do{ const float rm=rowmax(P0,P1); resc=false; \
    { const float dl=rm; mhat=fadd_s(mhat,dl); \
      _Pragma("unroll") for(int r=0;r<16;++r){P0[r]=fsub_s(P0[r],dl);P1[r]=fsub_s(P1[r],dl);} \
      _Pragma("unroll") for(int r=0;r<16;++r)negm[r]=-mhat; asm volatile("":"+v"(negm)); } \
    _Pragma("unroll") for(int r=0;r<16;++r)P0[r]=__builtin_amdgcn_exp2f(P0[r]); }while(0)
  #define RESC() do{ if(resc){ asm volatile("s_waitcnt lgkmcnt(0)":::"memory"); \
      _Pragma("unroll") for(int d_=0;d_<2;++d_) _Pragma("unroll") for(int r=0;r<16;++r)o[d_][r]*=wsf[crow(r,hi)]; } }while(0)
  f32x16 pA0,pA1,pB0,pB1;
  int sl_prev=0,sl_cur=0,sl_next=SLOTB;
  #define ROT() do{sl_prev=sl_cur;sl_cur=sl_next;sl_next=(sl_next==(NSLOT-1)*SLOTB)?0:sl_next+SLOTB;}while(0)
  DMA_K(2,2*SLOTB);
  WAIT_BAR(3);
  qkt(pA0,pA1,Kbase,qr,negm,r32,hi);asm volatile("s_nop 15\n\ts_nop 7":"+v"(pA0),"+v"(pA1));
  START(pA0,pA1);
  _Pragma("unroll") for(int r=0;r<16;++r)pA1[r]=__builtin_amdgcn_exp2f(pA1[r]);
  WAIT_BAR(0);
  DMA_K(3,0);DMA_V(1,SLOTB);
  ROT();
  kload8(kf,kp0+sl_cur);
  WAIT_BAR(2);
  s16x4 vlo[8],vhi[8]; u32x4 pw0,pw1,pw2,pw3;
  #define PKW(P,B) cvtpk_s(P[B],P[B+1])
  #define PAF(k) __builtin_bit_cast(bf16x8,pw##k)
  #define VFR(i) (bf16x8){vlo[i][0],vlo[i][1],vlo[i][2],vlo[i][3],vhi[i][0],vhi[i][1],vhi[i][2],vhi[i][3]}
  #define PIN(x) asm volatile("":"+v"(x))
  #define MX3(a,b,c) __builtin_fmaxf(__builtin_fmaxf((a),(b)),(c))
  #define GAPA(MF,A0,A1,A2,A3,W0,W1,PW) do{ MF; sacc+=A0; sacc+=A1; sacc+=A2; sacc+=A3; PIN(sacc); W0; W1; PIN(PW); SBAR(); }while(0)
  #define EX(v) __builtin_amdgcn_exp2f(v)
  #define GAPB(MF,X,B) do{ MF; X[B]=EX(X[B]); X[B+1]=EX(X[B+1]); X[B+2]=EX(X[B+2]); X[B+3]=EX(X[B+3]); PIN(X); SBAR(); }while(0)
  #define VRD(i) do{ vlo[i]=vtr(vp_+(((i)>>2)*4096+((i)&3)*1024)); vhi[i]=vtr(vp_+(((i)>>2)*4096+((i)&3)*1024+512)); }while(0)
  #define KRD(G,j) do{ if(G){ kload2(kf,kp0+sl_next,j); SBAR(); } }while(0)
  #define STEP(C0,C1,P0,P1,t,GK,GV,GL) do{ SBAR(); \
    const lds_cptr vp_=vp0+sl_prev; \
    VRD(0); SBAR(); float sacc=(P0[0]+P0[1]); \
    GAPA(C0=__builtin_amdgcn_mfma_f32_32x32x16_bf16(kf[0],qr[0],negm,0,0,0), P0[2],P0[3],P0[4],P0[5],     pw0[0]=PKW(P0,0), pw0[1]=PKW(P0,2), pw0); \
    VRD(4); SBAR(); GAPA(C1=__builtin_amdgcn_mfma_f32_32x32x16_bf16(kf[1],qr[0],negm,0,0,0), P0[6],P0[7],P0[8],P0[9],     pw0[2]=PKW(P0,4), pw0[3]=PKW(P0,6), pw0); \
    VRD(1); SBAR(); GAPA(C0=__builtin_amdgcn_mfma_f32_32x32x16_bf16(kf[2],qr[1],C0,0,0,0),   P0[10],P0[11],P0[12],P0[13], pw1[0]=PKW(P0,8), pw1[1]=PKW(P0,10), pw1); \
    VRD(5); SBAR(); GAPA(C1=__builtin_amdgcn_mfma_f32_32x32x16_bf16(kf[3],qr[1],C1,0,0,0),   P0[14],P0[15],P1[0],P1[1],   pw1[2]=PKW(P0,12),pw1[3]=PKW(P0,14), pw1); \
    VRD(2); SBAR(); GAPA(C0=__builtin_amdgcn_mfma_f32_32x32x16_bf16(kf[4],qr[2],C0,0,0,0),   P1[2],P1[3],P1[4],P1[5],     pw2[0]=PKW(P1,0), pw2[1]=PKW(P1,2), pw2); \
    VRD(6); SBAR(); GAPA(C1=__builtin_amdgcn_mfma_f32_32x32x16_bf16(kf[5],qr[2],C1,0,0,0),   P1[6],P1[7],P1[8],P1[9],     pw2[2]=PKW(P1,4), pw2[3]=PKW(P1,6), pw2); \
    VRD(3); SBAR(); GAPA(C0=__builtin_amdgcn_mfma_f32_32x32x16_bf16(kf[6],qr[3],C0,0,0,0),   P1[10],P1[11],P1[12],P1[13], pw3[0]=PKW(P1,8), pw3[1]=PKW(P1,10), pw3); \
    VRD(7); SBAR(); GAPA(C1=__builtin_amdgcn_mfma_f32_32x32x16_bf16(kf[7],qr[3],C1,0,0,0),   P1[14],P1[15],0.f,0.f,       pw3[2]=PKW(P1,12),pw3[3]=PKW(P1,14), pw3); \
    l_reg+=sacc; \
    if(GK){DMA_K((t)+3,sl_cur);} if(GV){DMA_V((t)+1,sl_next);} \
    { float a=MX3(C0[0],C0[1],C1[0]),b=MX3(C0[2],C0[3],C1[1]); a=MX3(a,C1[2],C1[3]); \
      _Pragma("unroll") for(int r=4;r<16;r+=4){a=MX3(a,C0[r],C0[r+1]);b=MX3(b,C0[r+2],C0[r+3]);a=MX3(a,C1[r],C1[r+1]);b=MX3(b,C1[r+2],C1[r+3]);} \
      float rm=__builtin_fmaxf(a,b); { auto rr=__builtin_amdgcn_permlane32_swap(__float_as_uint(rm),__float_as_uint(rm),false,false); rm=__builtin_fmaxf(__uint_as_float(rr[0]),__uint_as_float(rr[1])); } \
      resc=false; \
      if(__builtin_expect(__any(rm>(float)THRL),0)){ const float dl=__builtin_fmaxf(rm,0.f); mhat+=dl; \
        _Pragma("unroll") for(int r=0;r<16;++r){C0[r]-=dl;C1[r]-=dl;} \
        _Pragma("unroll") for(int r=0;r<16;++r)negm[r]=-mhat; asm volatile("":"+v"(negm)); \
        const float f=__builtin_amdgcn_exp2f(-dl); l_reg*=f; if(hi==0)wsf[r32]=f; resc=true; } } \
    SBAR(); \
    GAPB(o[0]=__builtin_amdgcn_mfma_f32_32x32x16_bf16(PAF(0),VFR(0),o[0],0,0,0), C0,0); \
    GAPB(o[1]=__builtin_amdgcn_mfma_f32_32x32x16_bf16(PAF(0),VFR(4),o[1],0,0,0), C0,4); \
    KRD(GL,0); GAPB(o[0]=__builtin_amdgcn_mfma_f32_32x32x16_bf16(PAF(1),VFR(1),o[0],0,0,0), C0,8); \
    KRD(GL,1); GAPB(o[1]=__builtin_amdgcn_mfma_f32_32x32x16_bf16(PAF(1),VFR(5),o[1],0,0,0), C0,12); \
    KRD(GL,2); GAPB(o[0]=__builtin_amdgcn_mfma_f32_32x32x16_bf16(PAF(2),VFR(2),o[0],0,0,0), C1,0); \
    KRD(GL,3); GAPB(o[1]=__builtin_amdgcn_mfma_f32_32x32x16_bf16(PAF(2),VFR(6),o[1],0,0,0), C1,4); \
    GAPB(o[0]=__builtin_amdgcn_mfma_f32_32x32x16_bf16(PAF(3),VFR(3),o[0],0,0,0), C1,8); \
    GAPB(o[1]=__builtin_amdgcn_mfma_f32_32x32x16_bf16(PAF(3),VFR(7),o[1],0,0,0), C1,12); \
    }while(0)
  int t=1;
  for(;t+5<NT;t+=2){
    STEP(pB0,pB1,pA0,pA1,t,true,true,true);     WAIT_BAR(2); RESC(); ROT();
    STEP(pA0,pA1,pB0,pB1,t+1,true,true,true);   WAIT_BAR(2); RESC(); ROT();
  }
  #define ENDW(tt) do{ if((tt)+3<NT){WAIT_BAR(2);} else if((tt)+2<NT){WAIT_BAR(1);} else {WAIT_BAR(0);} }while(0)
  for(;t+1<NT;t+=2){
    STEP(pB0,pB1,pA0,pA1,t,(t+3<NT),(t+1<NT),(t+1<NT));       ENDW(t);   RESC(); ROT();
    STEP(pA0,pA1,pB0,pB1,t+1,(t+4<NT),(t+2<NT),(t+2<NT));     ENDW(t+1); RESC(); ROT();
  }
  STEP(pB0,pB1,pA0,pA1,NT-1,false,false,false); RESC();
  { float sacc=pB0[0]+pB0[1]; _Pragma("unroll") for(int r=2;r<16;++r)sacc+=pB0[r]; _Pragma("unroll") for(int r=0;r<16;++r)sacc+=pB1[r]; l_reg+=sacc;
    pw0=(u32x4){PKW(pB0,0),PKW(pB0,2),PKW(pB0,4),PKW(pB0,6)};pw1=(u32x4){PKW(pB0,8),PKW(pB0,10),PKW(pB0,12),PKW(pB0,14)};pw2=(u32x4){PKW(pB1,0),PKW(pB1,2),PKW(pB1,4),PKW(pB1,6)};pw3=(u32x4){PKW(pB1,8),PKW(pB1,10),PKW(pB1,12),PKW(pB1,14)};
    SBAR(); pv(o,vb0+sl_cur,PAF(0),PAF(1),PAF(2),PAF(3)); }
  #undef PKW
  #undef PAF
  #undef VFR
  #undef PIN
  #undef MX3
  #undef GAPA
  #undef GAPB
  #undef EX
  #undef VRD
  #undef KRD
  #undef STEP
  #undef ENDW
  {auto rr=__builtin_amdgcn_permlane32_swap(__float_as_uint(l_reg),__float_as_uint(l_reg),false,false);l_reg=__uint_as_float(rr[0])+__uint_as_float(rr[1]);}
  if(hi==0)wsf[32+r32]=l_reg;asm volatile("s_waitcnt lgkmcnt(0)":::"memory");
  float rli[16];
  #pragma unroll
  for(int r=0;r<16;++r)rli[r]=__builtin_amdgcn_rcpf(wsf[32+crow(r,hi)]);
  bf16*Ow=O+(rowbase+q0+wid*QBLK)*QP+h*D;
  { bf16*stg=(bf16*)(shm+LDS_OST)+wid*2048;
    #pragma unroll
    for(int r=0;r<16;++r){const int orow=crow(r,hi);
      #pragma unroll
      for(int d0=0;d0<2;++d0)stg[orow*64+d0*32+r32]=__float2bfloat16(o[d0][r]*rli[r]);}
    asm volatile("s_waitcnt lgkmcnt(0)":::"memory");
    #pragma unroll
    for(int i=0;i<4;++i){const int row=i*8+(lane>>3),ch=lane&7; const u32x4 v=*(const u32x4*)(stg+row*64+ch*8); *(u32x4*)(Ow+(long)row*QP+ch*8)=v;} }
  asm volatile("s_waitcnt lgkmcnt(0)\n\ts_barrier":::"memory");
  #undef DMA_K
  #undef DMA_V
  #undef START
  #undef RESC
  #undef ROT
}
constexpr int ATTN_LDS_BYTES=LDS_BYTES;
#undef SBAR
#undef WAIT_BAR
}

#define GRID_SYNC() do { asm volatile("s_waitcnt vmcnt(0) lgkmcnt(0)" ::: "memory"); grid.sync(); __builtin_amdgcn_fence(__ATOMIC_ACQUIRE, "agent"); asm volatile("s_waitcnt vmcnt(0)" ::: "memory"); } while (0)
#ifndef N_LAUNCH_MODE
#define N_LAUNCH_MODE 0
#endif
constexpr int N_PHASES = 2 + 6 * NLAYER;
constexpr int NWAVES = 8;
constexpr size_t MiB = 1u << 20;
constexpr size_t WL_IN = 0, WL_A = WL_IN + (size_t)INW * 1024, WL_B = WL_A + 1024 * 512, WL_MIX = WL_B + 1024 * 512, WL_UP = WL_MIX + 1024 * 1024,
                 WL_DOWN = WL_UP + 4096 * 1024, WL_SG = WL_DOWN + 1024 * 2048, WL_SIZE = WL_SG + 8 * 128 * 128;
static_assert(WL_SIZE * 2 * NLAYER <= 95 * MiB, "weights region");
constexpr size_t WS_ROPE = 0, WS_W = 1 * MiB, WS_XB = 96 * MiB + 4096, WS_QU = 289 * MiB, WS_K = 481 * MiB, WS_V = 505 * MiB, WS_VST = 529 * MiB,
                 WS_GA = 625 * MiB, WS_GB = 817 * MiB, WS_H2 = 625 * MiB, WS_SS = 1009 * MiB, WS_SSG = 1015 * MiB, WS_END = 1018 * MiB;
constexpr int LDS_BYTES = 147456, SG_SCR_OFF = 135168, BARST_OFF = 140288;
constexpr size_t WS_BAR = 65536, BAR_BYTES = 16384;


#define XB_TMO      128
#define XB_XCNT(j)  (256  + 64 * (j))
#define XB_XSUB(j)  (1280 + 64 * (j))
#define XB_XGEN(j)  (2304 + 64 * (j))
#define XB_TOP      3328
#define XB_TOPGEN   3392
#define XCD_BAR_WORDS 3456
#define XB_SPIN_CAP (1u << 22)
__device__ __forceinline__ unsigned xb_ld(unsigned* p)              { return __hip_atomic_load(p, __ATOMIC_RELAXED, __HIP_MEMORY_SCOPE_AGENT); }
__device__ __forceinline__ unsigned xb_add(unsigned* p, unsigned v) { return __hip_atomic_fetch_add(p, v, __ATOMIC_RELAXED, __HIP_MEMORY_SCOPE_AGENT); }
__device__ __forceinline__ unsigned xb_xcc_id() { return (unsigned)__builtin_amdgcn_s_getreg((3 << 11) | 20) & 0xFu; }
#define XB_SPIN(cond, bar) do { unsigned _sp = 0; while (cond) { __builtin_amdgcn_s_sleep(1); \
    if ((++_sp & 255u) == 0u) { if (xb_ld(&(bar)[XB_TMO])) break; if (_sp > XB_SPIN_CAP) { atomicAdd(&(bar)[XB_TMO], 1u); break; } } } } while (0)
struct XcdBarrier { unsigned* bar; unsigned x; volatile LAS unsigned* st; };
__device__ __forceinline__ XcdBarrier xcd_barrier_post(unsigned* bar, volatile LAS unsigned* st) {
    XcdBarrier b; b.bar = bar; b.x = xb_xcc_id(); b.st = st;
    if (threadIdx.x == 0) (void)xb_add(&bar[XB_XCNT(b.x)], 1u);
    return b;
}
__device__ __forceinline__ void xcd_barrier_complete(unsigned* bar, unsigned x, unsigned& nloc, unsigned& nx) {
    const unsigned G = gridDim.x * gridDim.y * gridDim.z;
    unsigned sum, cnt, mine, sp = 0u;
    for (;;) {
        sum = 0u; cnt = 0u; mine = 0u;
#pragma unroll
        for (unsigned j = 0; j < 16; ++j) { const unsigned c = xb_ld(&bar[XB_XCNT(j)]); sum += c; cnt += (c > 0u) ? 1u : 0u; mine = (j == x) ? c : mine; }
        if (sum == G) break;
        __builtin_amdgcn_s_sleep(1);
        if ((++sp & 255u) == 0u) { if (xb_ld(&bar[XB_TMO])) break; if (sp > XB_SPIN_CAP) { atomicAdd(&bar[XB_TMO], 1u); break; } }
    }
    nloc = mine > 0u ? mine : 1u; nx = cnt > 0u ? cnt : 1u;
}
__device__ __forceinline__ void xcd_barrier(const XcdBarrier& b) {
    asm volatile("s_waitcnt vmcnt(0)" ::: "memory");
    __syncthreads();
    if (threadIdx.x == 0) {
        unsigned* bar = b.bar;
        __builtin_amdgcn_s_waitcnt(0);
        unsigned nloc = b.st[0], nx = b.st[1];
        if (nloc == 0u) { xcd_barrier_complete(bar, b.x, nloc, nx); b.st[0] = nloc; b.st[1] = nx; }
        const unsigned old = xb_add(&bar[XB_XSUB(b.x)], 1u);
        const unsigned gen = old / nloc;
        if (old + 1u == (gen + 1u) * nloc) {
            __builtin_amdgcn_fence(__ATOMIC_RELEASE, "agent");
            asm volatile("s_waitcnt vmcnt(0)" ::: "memory");
            const unsigned og = xb_add(&bar[XB_TOP], 1u);
            const unsigned tg = og / nx;
            if (og + 1u == (tg + 1u) * nx) xb_add(&bar[XB_TOPGEN], 1u);
            else XB_SPIN(xb_ld(&bar[XB_TOPGEN]) == tg, bar);
            __builtin_amdgcn_fence(__ATOMIC_ACQUIRE, "agent");
            xb_add(&bar[XB_XGEN(b.x)], 1u);
            asm volatile("s_waitcnt vmcnt(0)" ::: "memory");
        } else {
            XB_SPIN(xb_ld(&bar[XB_XGEN(b.x)]) == gen, bar);
            __builtin_amdgcn_fence(__ATOMIC_ACQUIRE, "agent");
            asm volatile("s_waitcnt vmcnt(0)" ::: "memory");
        }
    }
    __syncthreads();
}

struct Args { const float* in[18]; float* out; unsigned char* ws; int ph_lo, ph_hi; };

__device__ __forceinline__ float wave_sum(float v) {
#pragma unroll
    for (int o = 1; o < 64; o <<= 1) v += __shfl_xor(v, o);
    return v;
}
__device__ __forceinline__ int invperm32(int cc) { return 16 * ((cc >> 2) & 1) + 4 * (cc >> 3) + (cc & 3); }
__device__ __forceinline__ int map_plain(int n) { return (n & ~31) + invperm32(n & 31); }
__device__ __forceinline__ int map_in(int n) {
    if (n < 512) { const int pn = n >> 8, hh = (n >> 6) & 3, d = n & 63; return 256 * pn + 128 * (d >> 5) + 32 * hh + (d & 31); }
    if (n < 768) { const int c = n - 512, isv = c >> 7, head = (c >> 6) & 1, d = c & 63, wc = 2 * isv + head; return 512 + 128 * (d >> 5) + 32 * wc + (d & 31); }
    return map_plain(n);
}
__device__ __forceinline__ int map_up(int n) { const int bj = n >> 11, c = n & 2047, pn = c >> 7, r = c & 127; return 256 * pn + 128 * bj + (r & ~31) + invperm32(r & 31); }

template <int MAP>
__device__ __forceinline__ void transpose_item(const float* W, const float* g, int K, int N, bf16_t* WT, LAS float* scr, int item, int lane) {
    const int nblk = N / 32, kb = item / nblk, nb = item % nblk, k0 = 64 * kb, n0 = 32 * nb;
#pragma unroll 8
    for (int i = 0; i < 32; ++i) { const int kk = 2 * i + (lane >> 5); float v = W[(size_t)(k0 + kk) * N + n0 + (lane & 31)]; if (g) v *= g[k0 + kk]; scr[kk * 33 + (lane & 31)] = v; }
    asm volatile("s_waitcnt lgkmcnt(0)" ::: "memory");
    const int c = lane & 7;
#pragma unroll
    for (int j = 0; j < 4; ++j) { const int n = (lane >> 3) + 8 * j; const LAS float* s = scr + (8 * c) * 33 + n;
        u32x4 o; o.x = cvt_pk_bf16(s[0 * 33], s[1 * 33]); o.y = cvt_pk_bf16(s[2 * 33], s[3 * 33]); o.z = cvt_pk_bf16(s[4 * 33], s[5 * 33]); o.w = cvt_pk_bf16(s[6 * 33], s[7 * 33]);
        const int nn = n0 + n; const int row = MAP == 0 ? map_plain(nn) : (MAP == 1 ? map_in(nn) : map_up(nn));
        *(u32x4*)(WT + (size_t)row * K + k0 + 8 * c) = o; }
    asm volatile("s_waitcnt lgkmcnt(0)" ::: "memory");
}

__device__ __forceinline__ void sincos_tab(float x, float& c, float& s) {
    const float n = rintf(x * 0.63661977236758134308f);
    float r = fmaf(-n, 1.5703125f, x); r = fmaf(-n, 4.83751296997070312500e-4f, r); r = fmaf(-n, 7.5497899548918821e-8f, r);
    const float r2 = r * r;
    const float sp = r + r * r2 * (-1.0f / 6 + r2 * (1.0f / 120 + r2 * (-1.0f / 5040 + r2 * (1.0f / 362880))));
    const float cp = 1.0f + r2 * (-0.5f + r2 * (1.0f / 24 + r2 * (-1.0f / 720 + r2 * (1.0f / 40320 + r2 * (-1.0f / 3628800)))));
    const int q = ((int)n) & 3;
    s = (q == 0) ? sp : (q == 1) ? cp : (q == 2) ? -sp : -cp;
    c = (q == 0) ? cp : (q == 1) ? -sp : (q == 2) ? -cp : sp;
}

__device__ __forceinline__ void sg_unit(int ch, int g, const bf16_t* VST, const float* ssg, const bf16_t* Wg, const float* sgb, const float* gsg, bf16_t* QU, LAS float* scr, int lane) {
    asm volatile("" : "+v"(lane));
    const int fr = lane & 15, fq = lane >> 4;
#pragma unroll
    for (int hh = 0; hh < 2; ++hh) { const int p = lane + 64 * hh; const float* sp = ssg + (size_t)(ch * 128 + p) * 8; const f32x4 a = *(const f32x4*)sp, b = *(const f32x4*)(sp + 4);
        const float s = ((a.x + a.y) + (a.z + a.w)) + ((b.x + b.y) + (b.z + b.w)); scr[p] = __builtin_amdgcn_rsqf(s * (1.0f / 512.0f) + EPS); }
    asm volatile("s_waitcnt lgkmcnt(0)" ::: "memory");
    f32x4 acc[8][4];
#pragma unroll
    for (int pt = 0; pt < 8; ++pt)
#pragma unroll
        for (int ct = 0; ct < 4; ++ct) acc[pt][ct] = (f32x4){0.f, 0.f, 0.f, 0.f};
    const bf16_t* vbase = VST + ((size_t)ch * 512 + g * 64) * 128;
    const bf16_t* wbase = Wg + (size_t)g * 128 * 128;
#pragma unroll 1
    for (int kk = 0; kk < 4; ++kk) {
        const int k0 = kk * 32 + 8 * fq;
        bf16x8 af[4];
#pragma unroll
        for (int ct = 0; ct < 4; ++ct) af[ct] = *(const bf16x8*)(vbase + (size_t)(ct * 16 + fr) * 128 + k0);
        float r[8];
#pragma unroll
        for (int e = 0; e < 8; ++e) r[e] = scr[k0 + e];
#pragma unroll
        for (int pt = 0; pt < 8; ++pt) {
            const u32x4 w = *(const u32x4*)(wbase + (size_t)(pt * 16 + fr) * 128 + k0);
            u32x4 ws; ws.x = cvt_pk_bf16(bf_lo(w.x) * r[0], bf_hi(w.x) * r[1]); ws.y = cvt_pk_bf16(bf_lo(w.y) * r[2], bf_hi(w.y) * r[3]);
            ws.z = cvt_pk_bf16(bf_lo(w.z) * r[4], bf_hi(w.z) * r[5]); ws.w = cvt_pk_bf16(bf_lo(w.w) * r[6], bf_hi(w.w) * r[7]);
            const bf16x8 bfz = __builtin_bit_cast(bf16x8, ws);
#pragma unroll
            for (int ct = 0; ct < 4; ++ct) acc[pt][ct] = __builtin_amdgcn_mfma_f32_16x16x32_bf16(af[ct], bfz, acc[pt][ct], 0, 0, 0);
        }
    }
    f32x4 gs[4];
#pragma unroll
    for (int ct = 0; ct < 4; ++ct) gs[ct] = *(const f32x4*)(gsg + g * 64 + ct * 16 + 4 * fq);
#pragma unroll
    for (int pt = 0; pt < 8; ++pt) {
        const int p = pt * 16 + fr; const float b = sgb[g * 128 + p];
        bf16_t* up = QU + (size_t)(ch * 128 + p) * 1024 + 512 + g * 64 + 4 * fq;
#pragma unroll
        for (int ct = 0; ct < 4; ++ct) {
            const u32x2 uu = *(const u32x2*)(up + ct * 16);
            const f32x4 sp = acc[pt][ct] * gs[ct] + b;
            u32x2 w; w.x = cvt_pk_bf16(bf_lo(uu.x) * sp.x, bf_hi(uu.x) * sp.y); w.y = cvt_pk_bf16(bf_lo(uu.y) * sp.z, bf_hi(uu.y) * sp.w);
            *(u32x2*)(up + ct * 16) = w;
        }
    }
    asm volatile("s_waitcnt lgkmcnt(0)" ::: "memory");
}

__global__ void __launch_bounds__(NWAVES * 64, 2) fwd_megakernel(Args args) {
    extern __shared__ __attribute__((aligned(16))) unsigned char lds[];
    cg::grid_group grid = cg::this_grid();
    LAS unsigned char* L = (LAS unsigned char*)lds;
    volatile LAS unsigned* barst = (volatile LAS unsigned*)(L + BARST_OFF);
    if (threadIdx.x < 2) barst[threadIdx.x] = 0u;
    __syncthreads();
    const XcdBarrier xbar = xcd_barrier_post((unsigned*)(args.ws + WS_BAR), barst);
    const int G = gridDim.x, bx = blockIdx.x;
    const int vcu = (G % 8 == 0) ? (bx % 8) * (G / 8) + bx / 8 : bx;
    const int NGW = G * NWAVES;
    unsigned char* ws = args.ws;
    const float* x_prompt = args.in[0]; const float* x_sample = args.in[1];
    const float* attn_norm_g = args.in[2]; const float* w_in = args.in[3]; const float* q_norm_g = args.in[4]; const float* k_norm_g = args.in[5];
    const float* sg_norm_g = args.in[6]; const float* sg_w = args.in[7]; const float* sg_b = args.in[8]; const float* w_branch_a = args.in[9];
    const float* w_branch_b = args.in[10]; const float* w_mix_out = args.in[11]; const float* ffn_norm_g = args.in[12]; const float* w_up = args.in[13];
    const float* conv_w = args.in[14]; const float* conv_b = args.in[15]; const float* w_down = args.in[16]; const float* final_norm_g = args.in[17];
    float* out = args.out;
    float* rope = (float*)(ws + WS_ROPE);
    bf16_t* Wall = (bf16_t*)(ws + WS_W);
    bf16_t* XB = (bf16_t*)(ws + WS_XB); bf16_t* QU = (bf16_t*)(ws + WS_QU); bf16_t* KB = (bf16_t*)(ws + WS_K); bf16_t* VB = (bf16_t*)(ws + WS_V);
    bf16_t* VST = (bf16_t*)(ws + WS_VST); bf16_t* GA = (bf16_t*)(ws + WS_GA); bf16_t* GB = (bf16_t*)(ws + WS_GB); bf16_t* H2 = (bf16_t*)(ws + WS_H2);
    float* SSQ = (float*)(ws + WS_SS); float* SSG = (float*)(ws + WS_SSG);

    for (int p = args.ph_lo; p < args.ph_hi; ++p) {
    if (p > args.ph_lo) { if (p == 1) GRID_SYNC(); else xcd_barrier(xbar); }
    int tid_ = threadIdx.x; asm volatile("" : "+v"(tid_));
    const int tid = tid_, lane = tid & 63, wave = __builtin_amdgcn_readfirstlane(tid >> 6);
    const int gw = vcu * NWAVES + wave;
    if (p == 0) {
        LAS float* scr = (LAS float*)(L + wave * 16384);
        constexpr int I_IN = 16 * (INW / 32), I_A = 8 * 32, I_MIX = 16 * 32, I_UP = 16 * 128, I_DOWN = 32 * 32, I_L = I_IN + 2 * I_A + I_MIX + I_UP + I_DOWN;
        for (int it = gw; it < I_L * NLAYER; it += NGW) {
            const int l = it / I_L; int r = it % I_L; bf16_t* wl = Wall + (size_t)l * WL_SIZE;
            if (r < I_IN) { transpose_item<1>(w_in + (size_t)l * 1024 * INW, attn_norm_g + l * 1024, 1024, INW, wl + WL_IN, scr, r, lane); continue; } r -= I_IN;
            if (r < I_A) { transpose_item<0>(w_branch_a + (size_t)l * 512 * 1024, nullptr, 512, 1024, wl + WL_A, scr, r, lane); continue; } r -= I_A;
            if (r < I_A) { transpose_item<0>(w_branch_b + (size_t)l * 512 * 1024, nullptr, 512, 1024, wl + WL_B, scr, r, lane); continue; } r -= I_A;
            if (r < I_MIX) { transpose_item<0>(w_mix_out + (size_t)l * 1024 * 1024, nullptr, 1024, 1024, wl + WL_MIX, scr, r, lane); continue; } r -= I_MIX;
            if (r < I_UP) { transpose_item<2>(w_up + (size_t)l * 1024 * 4096, ffn_norm_g + l * 1024, 1024, 4096, wl + WL_UP, scr, r, lane); continue; } r -= I_UP;
            transpose_item<0>(w_down + (size_t)l * 2048 * 1024, nullptr, 2048, 1024, wl + WL_DOWN, scr, r, lane);
        }
        for (int i = gw * 64 + lane; i < NLAYER * 8 * 128 * 128 / 4; i += NGW * 64) {
            const int l = i / (8 * 128 * 128 / 4), r = i % (8 * 128 * 128 / 4);
            const f32x4 v = *(const f32x4*)(sg_w + (size_t)l * 131072 + (size_t)r * 4);
            u32x2 w; w.x = cvt_pk_bf16(v.x, v.y); w.y = cvt_pk_bf16(v.z, v.w);
            *(u32x2*)(Wall + (size_t)l * WL_SIZE + WL_SG + (size_t)r * 4) = w;
        }
        for (int i = gw * 64 + lane; i < 128 * 16; i += NGW * 64) {
            const int pos = i >> 4, f = i & 15; float fr_ = 1.0f; for (int k = 0; k < f; ++k) fr_ *= 0.56234132519034907f;
            float c, s; sincos_tab((float)pos * fr_, c, s); rope[2 * i] = c; rope[2 * i + 1] = s;
        }
        for (int i = gw * 64 + lane; i < 257 * 128; i += NGW * 64) {
            const int r = i / 128, c = i % 128; const long row = (r == 0) ? -1 : (long)M_TOK + r - 1;
            *(u32x4*)(XB + row * 1024 + c * 8) = (u32x4){0u, 0u, 0u, 0u};
        }
        for (int m0 = gw; m0 < M_TOK; m0 += 2 * NGW) {
            const int nr = (m0 + NGW < M_TOK) ? 2 : 1;
            f32x4 v[2][4]; float sq[2];
#pragma unroll
            for (int r = 0; r < 2; ++r) { const int m = (r < nr) ? m0 + r * NGW : m0;
                const float* xr = (m < NPROMPT) ? x_prompt + (size_t)m * 1024 : x_sample + (size_t)(m - NPROMPT) * 1024; float s = 0.f;
#pragma unroll
                for (int j = 0; j < 4; ++j) { v[r][j] = *(const f32x4*)(xr + 4 * lane + 256 * j); s += (v[r][j].x * v[r][j].x + v[r][j].y * v[r][j].y) + (v[r][j].z * v[r][j].z + v[r][j].w * v[r][j].w); }
                sq[r] = s; }
#pragma unroll
            for (int r = 0; r < 2; ++r) if (r < nr) { const int m = m0 + r * NGW; const float s = wave_sum(sq[r]);
#pragma unroll
                for (int j = 0; j < 4; ++j) { u32x2 w; w.x = cvt_pk_bf16(v[r][j].x, v[r][j].y); w.y = cvt_pk_bf16(v[r][j].z, v[r][j].w); *(u32x2*)(XB + (size_t)m * 1024 + 4 * lane + 256 * j) = w; }
                if (lane < 16) SSQ[(size_t)m * 16 + lane] = (lane == 0) ? s : 0.f; }
        }
    }
    else if (p < N_PHASES - 1) {
        const int l = (p - 1) / 6, k = (p - 1) % 6;
        const bf16_t* wl = Wall + (size_t)l * WL_SIZE;
        if (k == 0) {
            pg8::Gemm g{XB, wl + WL_IN, 1024, 1024, 1024, 0, 0, 256, 128, 0};
            { pg8::StaticOrder S; S.init(M_TOK / 256, 3, 1, G, bx, 0); S.rev = (5 * l + 1) & 1;
              pg8::EpiQKV E{SSQ, q_norm_g + l * 64, k_norm_g + l * 64, rope, QU, KB, VB};
              pg8::gemm_phase<pg8::EpiQKV, 1>(L, g, S, E); }
            { pg8::StaticOrder S; S.init(M_TOK / 256, 2, 1, G, bx, 5); S.rev = (5 * l + 1) & 1;
              pg8::EpiVS E{SSQ, VST, SSG};
              pg8::gemm_phase<pg8::EpiVS, 1>(L, g, S, E); }
            { pg8::StaticOrder S; S.init(M_TOK / 256, 10, 1, G, bx, 3, 2, 7); S.rev = (5 * l + 1) & 1;
              pg8::EpiEW E{SSQ, QU, GA, GB};
              pg8::gemm_phase<pg8::EpiEW, 1>(L, g, S, E); }
        }
        else if (k == 1) {
            LAS float* scr = (LAS float*)(L + SG_SCR_OFF) + wave * 128;
            for (int u = gw; u < 768 * 8; u += NGW)
                sg_unit(u >> 3, u & 7, VST, SSG, wl + WL_SG, sg_b + l * 1024, sg_norm_g + l * 512, QU, scr, lane);
            for (int u = bx; u < 3072; u += G) {
                const int i = u >> 8, c = u & 255, x = c & 7, w = c >> 3;
                long rowbase; int seq, h, q0;
                if (i < 4) { const int idx = w * 4 + i; rowbase = (long)(x >> 1) * SEQ_P; seq = SEQ_P; h = (x & 1) * 4 + (idx >> 5); q0 = (idx & 31) * 256; }
                else { const int pair = 8 * x + (i - 4); rowbase = (long)NPROMPT + (long)(pair >> 1) * SEQ_S; seq = SEQ_S; h = (pair & 1) * 4 + (w >> 3); q0 = (w & 7) * 256; }
                attn_body::attn_unit<8>(rowbase, seq, h, q0, (const attn_body::bf16*)QU, (const attn_body::bf16*)KB, (const attn_body::bf16*)VB, (attn_body::bf16*)QU, (char*)lds);
            }
        }
        else if (k == 2) {
            pg8::Gemm g{QU, wl + WL_A, 1024, 512, 512, 512 * 2, (long)(WL_B - WL_A) * 2, 256, 0, 0};
            pg8::StaticOrder S; S.init(M_TOK / 256, 4, 2, G, bx); S.rev = (5 * l + 2) & 1;
            pg8::EpiMerge E{GA, GB};
            pg8::gemm_phase<pg8::EpiMerge, 2>(L, g, S, E);
        }
        else if (k == 3) {
            pg8::Gemm g{GA, wl + WL_MIX, 1024, 1024, 1024, 0, 0, 256, 0, 0};
            pg8::StaticOrder S; S.init(M_TOK / 256, 4, 1, G, bx); S.rev = (5 * l + 3) & 1;
            pg8::EpiRes E{x_prompt, x_sample, 0, out, XB, SSQ, 1, 0};
            pg8::gemm_phase<pg8::EpiRes, 1>(L, g, S, E);
        }
        else if (k == 4) {
            pg8::Gemm g{XB, wl + WL_UP, 1024, 1024, 1024, 0, 0, 252, 126, -1};
            pg8::StaticOrder S; S.init((M_TOK + 251) / 252, 16, 1, G, bx); S.rev = (5 * l + 4) & 1;
            pg8::EpiUp E{SSQ, conv_w + (size_t)l * 3 * 4096, conv_b + (size_t)l * 4096, H2};
            pg8::gemm_phase<pg8::EpiUp, 1>(L, g, S, E);
        }
        else {
            pg8::Gemm g{H2, wl + WL_DOWN, 2048, 2048, 2048, 0, 0, 256, 0, 0};
            pg8::StaticOrder S; S.init(M_TOK / 256, 4, 1, G, bx); S.rev = (5 * l + 5) & 1;
            pg8::EpiRes E{x_prompt, x_sample, 0, out, XB, SSQ, 1, l == NLAYER - 1 ? 1 : 0};
            pg8::gemm_phase<pg8::EpiRes, 1>(L, g, S, E);
        }
    } else
    {
        f32x4 gv[4];
#pragma unroll
        for (int j = 0; j < 4; ++j) gv[j] = *(const f32x4*)(final_norm_g + 4 * lane + 256 * j);
        for (int m = gw; m < M_TOK; m += 2 * NGW) {
            const int m2 = (m + NGW < M_TOK) ? m + NGW : m;
            float* xr = out + (size_t)m * 1024; float* xr2 = out + (size_t)m2 * 1024;
            const float sp = (lane < 16) ? SSQ[(size_t)m * 16 + lane] : 0.f, sp2 = (lane < 16) ? SSQ[(size_t)m2 * 16 + lane] : 0.f;
            f32x4 v[4], w[4];
#pragma unroll
            for (int j = 0; j < 4; ++j) { v[j] = *(const f32x4*)(xr + 4 * lane + 256 * j); w[j] = *(const f32x4*)(xr2 + 4 * lane + 256 * j); }
            const float rs = __builtin_amdgcn_rsqf(wave_sum(sp) * (1.0f / DMOD) + EPS), rs2 = __builtin_amdgcn_rsqf(wave_sum(sp2) * (1.0f / DMOD) + EPS);
#pragma unroll
            for (int j = 0; j < 4; ++j) { *(f32x4*)(xr + 4 * lane + 256 * j) = v[j] * gv[j] * rs; if (m2 != m) *(f32x4*)(xr2 + 4 * lane + 256 * j) = w[j] * gv[j] * rs2; }
        }
    }
    }
}

extern "C" void kernel_launch(void* const* d_in, const int* in_sizes, int n_in, void* d_out, int out_size, void* d_ws, size_t ws_size, hipStream_t stream) {
    static int grid = 0;
    if (grid == 0) {
        if (n_in != 18 || out_size != M_TOK * DMOD || ws_size < WS_END) { fprintf(stderr, "kernel_launch: unexpected shapes (n_in %d out %d ws %zu)\n", n_in, out_size, ws_size); grid = -1; return; }
        int dev = 0, cus = 0, per_cu = 0;
        (void)hipGetDevice(&dev); (void)hipDeviceGetAttribute(&cus, hipDeviceAttributeMultiprocessorCount, dev);
        (void)hipFuncSetAttribute((const void*)fwd_megakernel, hipFuncAttributeMaxDynamicSharedMemorySize, LDS_BYTES);
        (void)hipOccupancyMaxActiveBlocksPerMultiprocessor(&per_cu, (const void*)fwd_megakernel, NWAVES * 64, LDS_BYTES);
        if (per_cu < 1) { fprintf(stderr, "kernel_launch: occupancy query says %d blocks/CU\n", per_cu); per_cu = 1; }
        (void)hipGetLastError();
        grid = cus * 1;
    }
    if (grid < 0) return;
    (void)hipMemsetAsync((char*)d_ws + WS_BAR, 0, BAR_BYTES, stream);
    Args a{};
    for (int i = 0; i < 18; ++i) a.in[i] = (const float*)d_in[i];
    a.out = (float*)d_out; a.ws = (unsigned char*)d_ws;
    if (N_LAUNCH_MODE == 0) {
        a.ph_lo = 0; a.ph_hi = N_PHASES;
        void* params[] = {&a};
        hipError_t e = hipLaunchCooperativeKernel((const void*)fwd_megakernel, dim3(grid), dim3(NWAVES * 64), params, LDS_BYTES, stream);
        if (e != hipSuccess) fprintf(stderr, "cooperative launch failed: %s (grid %d)\n", hipGetErrorString(e), grid);
    } else {
        for (int p = 0; p < N_PHASES; ++p) { a.ph_lo = p; a.ph_hi = p + 1;
            hipLaunchKernelGGL(fwd_megakernel, dim3(grid), dim3(NWAVES * 64), LDS_BYTES, stream, a); }
    }
}
```

```cpp
#include <hip/hip_runtime.h>
#include <hip/hip_cooperative_groups.h>
#include <hip/hip_bf16.h>
#include <cstdio>
#include <cstdint>
#include <cmath>
namespace cg = cooperative_groups;

constexpr int M_TOK = 98304, NPROMPT = 32768, SEQ_P = 8192, SEQ_S = 2048;
constexpr int DMOD = 1024, INW = 3840, DFF = 2048, NLAYER = 4;
constexpr float EPS = 1e-6f;
constexpr float C2 = 0.125f * 1.4426950408889634f;

#define LAS __attribute__((address_space(3)))
typedef unsigned short bf16_t;
typedef short bf16x8 __attribute__((ext_vector_type(8)));
typedef float f32x4 __attribute__((ext_vector_type(4)));
typedef float f32x2 __attribute__((ext_vector_type(2)));
typedef unsigned u32x4 __attribute__((ext_vector_type(4)));
typedef unsigned u32x2 __attribute__((ext_vector_type(2)));

typedef __bf16 bf16x2_t_ __attribute__((ext_vector_type(2)));
__device__ __forceinline__ unsigned cvt_pk_bf16(float lo, float hi) { f32x2 v = {lo, hi}; bf16x2_t_ b = __builtin_convertvector(v, bf16x2_t_); return __builtin_bit_cast(unsigned, b); }
__device__ __forceinline__ float bf_lo(unsigned w) { return __uint_as_float(w << 16); }
__device__ __forceinline__ float bf_hi(unsigned w) { return __uint_as_float(w & 0xffff0000u); }
__device__ __forceinline__ float gelu_t(float x) {
    const float u = x * (0.7978845608f + 0.0356774081f * x * x);
    const float e = __builtin_amdgcn_exp2f(u * -2.8853900818f);
    return x * __builtin_amdgcn_rcpf(1.0f + e);
}
__device__ __forceinline__ float sigmoid_f(float x) { return __builtin_amdgcn_rcpf(1.0f + __builtin_amdgcn_exp2f(x * -1.4426950409f)); }
__device__ __forceinline__ float dpp_shr1(float v) { return __int_as_float(__builtin_amdgcn_update_dpp(0, __float_as_int(v), 0x111, 0xF, 0xF, true)); }
__device__ __forceinline__ float dpp_shl1(float v) { return __int_as_float(__builtin_amdgcn_update_dpp(0, __float_as_int(v), 0x101, 0xF, 0xF, true)); }

namespace pg8 {
constexpr int BM = 256, BK = 64, HALF = 128, HTB = HALF * BK * 2, STAGE_BYTES = 8 * HTB, NXCD = 8, WGM = 8;
__host__ __device__ __forceinline__ int lds_byte(int r, int c) { const int st = (r >> 4) * 2 + (c >> 5), rr = r & 15, cc = c & 31, ob = rr * 64 + cc * 2; return st * 1024 + (ob ^ (((ob >> 9) & 1) << 5)); }
__host__ __device__ __forceinline__ void stage_rc(int b, int& R, int& C) { const int st = b / 1024, sb = b % 1024, swz = sb ^ (((sb >> 9) & 1) << 5); R = (st >> 1) * 16 + swz / 64; C = (st & 1) * 32 + (swz % 64) / 2; }

struct Unit { int pm, pn, part; };
struct Gemm { const bf16_t* A; const bf16_t* Bt; int lda, ldb, K; long partA, partB; int tstride, wstride, shift; };

struct StaticOrder {
    int nM, nN, nwg, G, c, parts, pn_lo, pn_split, pn_hi, rev;
    __device__ void init(int nM_, int nN_, int parts_, int G_, int c_, int pn_lo_ = 0, int pn_split_ = 1 << 20, int pn_hi_ = 0) { nM = nM_; nN = nN_; nwg = nM * nN; G = G_; c = c_; parts = parts_; pn_lo = pn_lo_; pn_split = pn_split_; pn_hi = pn_hi_; rev = 0; }
    __device__ bool next(int i, Unit& u) const {
        const int it = (parts == 2) ? (i >> 1) : i; u.part = (parts == 2) ? (i & 1) : 0;
        const long L = (long)it * G + c; if (L >= nwg) return false;
        int wgid = (int)L; { const int q = nwg / NXCD, r = nwg % NXCD, xcd = wgid % NXCD, off = wgid / NXCD; wgid = (xcd < r ? xcd * (q + 1) : r * (q + 1) + (xcd - r) * q) + off; }
        const int nig = WGM * nN, gid = wgid / nig, fm = gid * WGM, gsz = (nM - fm) < WGM ? (nM - fm) : WGM;
        u.pm = fm + ((wgid % nig) % gsz); if (rev) u.pm = nM - 1 - u.pm; { const int ix = (wgid % nig) / gsz; u.pn = ix < pn_split ? pn_lo + ix : pn_hi + (ix - pn_split); } return true;
    }
};

template <class Epi, int PARTS>
__device__ __forceinline__ void gemm_phase(LAS unsigned char* lds, const Gemm g, const StaticOrder& S, const Epi& E) {
    int tid_ = threadIdx.x; asm volatile("" : "+v"(tid_));
    const int tid = tid_, wid = __builtin_amdgcn_readfirstlane(tid >> 6), lane = tid & 63, wr = wid >> 2, wc = wid & 3, fr = lane & 15, fq = lane >> 4;
    const int K = g.K, nt = K / BK;
    unsigned voffA[2], voffB[2];
#pragma unroll
    for (int i = 0; i < 2; ++i) { int R, C; stage_rc(tid * 16 + i * 8192, R, C);
        const int TR = g.wstride ? g.wstride * (R >> 6) + 8 * (R & 15) + ((R >> 4) & 3) : R;
        voffA[i] = (unsigned)(TR * g.lda + C) * 2u; voffB[i] = (unsigned)(R * g.ldb + C) * 2u; }
    const size_t kstep = (size_t)(BK * 2);
    const size_t hstepA = (size_t)(g.wstride ? 4 : HALF) * g.lda * 2, hstepB = (size_t)HALF * g.ldb * 2;
    const unsigned ldsw = (unsigned)wid * 1024u;
    const int aoff = lds_byte(wr * 64 + fr, fq * 8), boff = lds_byte(wc * 32 + fr, fq * 8);
#define PG8_SA(b, h) (((b) * 2 + (h)) * HTB)
#define PG8_SB(b, h) ((4 + (b) * 2 + (h)) * HTB)
#define PG8_STAGE(bufoff, gbase, voff) do { _Pragma("unroll") for (int _i = 0; _i < 2; ++_i) \
        __builtin_amdgcn_global_load_lds((const unsigned*)((const char*)(gbase) + (voff)[_i]), (LAS unsigned*)(lds + (bufoff) + ldsw + _i * 8192), 16, 0, 0); } while (0)
#define PG8_STAGEA(bufoff, gbase, voff) do { _Pragma("unroll") for (int _i = 0; _i < 2; ++_i) \
        __builtin_amdgcn_global_load_lds((const unsigned*)((const char*)(gbase) + (voff)[_i]), (LAS unsigned*)(lds + (bufoff) + ldsw + _i * 8192), 16, 0, 0); } while (0)
#define PG8_LDA(dst, b, h) do { _Pragma("unroll") for (int m = 0; m < 4; ++m) _Pragma("unroll") for (int k = 0; k < 2; ++k) dst[m][k] = *(const LAS bf16x8*)(lds + PG8_SA(b, h) + aoff + m * 2048 + k * 1024); } while (0)
#define PG8_LDB(dst, b, h) do { _Pragma("unroll") for (int n = 0; n < 2; ++n) _Pragma("unroll") for (int k = 0; k < 2; ++k) dst[n][k] = *(const LAS bf16x8*)(lds + PG8_SB(b, h) + boff + n * 2048 + k * 1024); } while (0)
#define PG8_MMA(ai, bj, At, Bt) do { __builtin_amdgcn_s_setprio(1); _Pragma("unroll") for (int m = 0; m < 4; ++m) _Pragma("unroll") for (int n = 0; n < 2; ++n) _Pragma("unroll") for (int k = 0; k < 2; ++k) \
        acc[ai][bj][m][n] = __builtin_amdgcn_mfma_f32_16x16x32_bf16(Bt[n][k], At[m][k], acc[ai][bj][m][n], 0, 0, 0); __builtin_amdgcn_s_setprio(0); } while (0)
#define PG8_WAIT_V(n) asm volatile("s_waitcnt vmcnt(" #n ")" ::: "memory")
#define PG8_WAIT_L(n) asm volatile("s_waitcnt lgkmcnt(" #n ")" ::: "memory")
#define PG8_BAR __builtin_amdgcn_s_barrier()
#define PG8_SCHED __builtin_amdgcn_sched_barrier(0)
#define PG8_UA(u) ((const char*)g.A + (size_t)(u).part * g.partA + ((long)(u).pm * g.tstride + g.shift) * (long)g.lda * 2)
#define PG8_UB(u) ((const char*)g.Bt + (size_t)(u).part * g.partB + (size_t)(u).pn * 256 * g.ldb * 2)
    Unit cur, nxt; int ui = 0;
    if (!S.next(0, cur)) return;
    f32x4 acc[2][2][4][2];
#pragma unroll
    for (int a = 0; a < 2; ++a)
#pragma unroll
        for (int b = 0; b < 2; ++b)
#pragma unroll
            for (int m = 0; m < 4; ++m)
#pragma unroll
                for (int n = 0; n < 2; ++n) acc[a][b][m][n] = (f32x4){0.f, 0.f, 0.f, 0.f};
    bf16x8 At[4][2], B0[2][2], B1[2][2];
    const char* cA = PG8_UA(cur); const char* cB = PG8_UB(cur);
    PG8_STAGE(PG8_SB(0, 0), cB, voffB); PG8_STAGE(PG8_SB(0, 1), cB + hstepB, voffB); PG8_STAGEA(PG8_SA(0, 0), cA, voffA); PG8_STAGEA(PG8_SA(0, 1), cA + hstepA, voffA);
    if (wr == 1) PG8_BAR;
    PG8_WAIT_V(2); PG8_BAR;
    PG8_STAGE(PG8_SB(1, 0), cB + kstep, voffB); PG8_STAGEA(PG8_SA(1, 0), cA + kstep, voffA); PG8_STAGE(PG8_SB(1, 1), cB + hstepB + kstep, voffB);
    PG8_WAIT_V(6); PG8_BAR;
    for (;;) {
        const bool has_next = S.next(ui + 1, nxt);
        const char* nA = has_next ? PG8_UA(nxt) : cA; const char* nB = has_next ? PG8_UB(nxt) : cB;
        for (int t = 0; t < nt; t += 2) {
            const bool last = (t == nt - 2);
            const char* a1 = cA + (size_t)(t + 1) * kstep;
            const char* a2 = last ? nA : cA + (size_t)(t + 2) * kstep; const char* b2 = last ? nB : cB + (size_t)(t + 2) * kstep;
            const char* a3 = a2 + kstep; const char* b3 = b2 + kstep;
            PG8_LDB(B0, 0, 0); PG8_LDB(B1, 0, 1); PG8_SCHED; PG8_LDA(At, 0, 0); PG8_STAGEA(PG8_SA(1, 1), a1 + hstepA, voffA);
            PG8_WAIT_V(8); PG8_WAIT_L(0); PG8_BAR; PG8_MMA(0, 0, At, B0); PG8_MMA(0, 1, At, B1); PG8_BAR; PG8_SCHED;
            PG8_LDA(At, 0, 1); PG8_STAGE(PG8_SB(0, 0), b2, voffB); PG8_STAGE(PG8_SB(0, 1), b2 + hstepB, voffB); PG8_STAGEA(PG8_SA(0, 0), a2, voffA);
            PG8_WAIT_V(8); PG8_WAIT_L(0); PG8_BAR; PG8_MMA(1, 0, At, B0); PG8_MMA(1, 1, At, B1); PG8_BAR; PG8_SCHED;
            PG8_LDB(B0, 1, 0); PG8_LDB(B1, 1, 1); PG8_SCHED; PG8_LDA(At, 1, 0); PG8_STAGEA(PG8_SA(0, 1), a2 + hstepA, voffA);
            PG8_WAIT_V(8); PG8_WAIT_L(0); PG8_BAR; PG8_MMA(0, 0, At, B0); PG8_MMA(0, 1, At, B1); PG8_BAR; PG8_SCHED;
            PG8_LDA(At, 1, 1); PG8_STAGE(PG8_SB(1, 0), b3, voffB); PG8_STAGE(PG8_SB(1, 1), b3 + hstepB, voffB); PG8_STAGEA(PG8_SA(1, 0), a3, voffA);
            PG8_WAIT_V(8); PG8_WAIT_L(0); PG8_BAR; PG8_MMA(1, 0, At, B0); PG8_MMA(1, 1, At, B1); PG8_BAR; PG8_SCHED;
        }
        if (wr == 0) PG8_BAR;
        E(acc, cur, wr, wc, fr, fq);
        if (!has_next) break;
        if (PARTS == 1 || nxt.part == 0) {
#pragma unroll
        for (int a = 0; a < 2; ++a)
#pragma unroll
            for (int b = 0; b < 2; ++b)
#pragma unroll
                for (int m = 0; m < 4; ++m)
#pragma unroll
                    for (int n = 0; n < 2; ++n) acc[a][b][m][n] = (f32x4){0.f, 0.f, 0.f, 0.f};
        }
        cur = nxt; cA = nA; cB = nB; ++ui;
        if (wr == 1) PG8_BAR;
    }
    PG8_WAIT_V(0);
    PG8_BAR;
#undef PG8_SA
#undef PG8_SB
#undef PG8_STAGE
#undef PG8_STAGEA
#undef PG8_LDA
#undef PG8_LDB
#undef PG8_MMA
#undef PG8_WAIT_V
#undef PG8_WAIT_L
#undef PG8_BAR
#undef PG8_SCHED
#undef PG8_UA
#undef PG8_UB
}

__device__ __forceinline__ void load_rs8(const float* ss, int t0, int fq, float (&rs)[8], int tmax) {
#pragma unroll
    for (int j = 0; j < 8; ++j) { int t = t0 + j; t = t < 0 ? 0 : (t > tmax ? tmax : t);
        const f32x4 p = *(const f32x4*)(ss + (size_t)t * 16 + 4 * fq); float s = (p.x + p.y) + (p.z + p.w);
        s += __shfl_xor(s, 16); s += __shfl_xor(s, 32); rs[j] = __builtin_amdgcn_rsqf(s * (1.0f / DMOD) + EPS); }
}

struct EpiQKV {
    const float* ss; const float* qg; const float* kg; const float* rope;
    bf16_t* QU; bf16_t* Kb; bf16_t* Vb;
    __device__ __forceinline__ void operator()(f32x4 (&acc)[2][2][4][2], const Unit& u, int wr, int wc, int fr, int fq) const {
        const int t0 = u.pm * 256 + wr * 128 + fr * 8;
        { float rs[8]; load_rs8(ss, t0, fq, rs, M_TOK - 1);
#pragma unroll
          for (int ai = 0; ai < 2; ++ai)
#pragma unroll
            for (int m = 0; m < 4; ++m)
#pragma unroll
                for (int bj = 0; bj < 2; ++bj)
#pragma unroll
                    for (int n = 0; n < 2; ++n) acc[ai][bj][m][n] = acc[ai][bj][m][n] * rs[4 * ai + m]; }
        const int pn = u.pn;
        {
            const bool isq = pn < 2;
            if (isq || wc < 2) {
                const float* gp = isq ? qg : kg; const float osc = isq ? C2 : 1.0f;
                f32x4 gv[2][2];
#pragma unroll
                for (int bj = 0; bj < 2; ++bj)
#pragma unroll
                    for (int n = 0; n < 2; ++n) gv[bj][n] = *(const f32x4*)(gp + 32 * bj + 16 * n + 4 * fq);
                const int smask = (t0 < NPROMPT) ? (SEQ_P - 1) : (SEQ_S - 1);
                const int prow = (t0 & smask) >> 6;
                const f32x4 rr0 = *(const f32x4*)(rope + (prow * 16 + 4 * fq) * 2), rr1 = *(const f32x4*)(rope + (prow * 16 + 4 * fq) * 2 + 4);
                bf16_t* dst = isq ? (QU + (size_t)t0 * 1024 + (4 * pn + wc) * 64) : (Kb + (size_t)t0 * 128 + wc * 64);
                const int pitch = isq ? 1024 : 128;
#pragma unroll
                for (int ai = 0; ai < 2; ++ai)
#pragma unroll
                    for (int m = 0; m < 4; ++m) {
                        const int j = 4 * ai + m;
                        float sq = 0.f;
#pragma unroll
                        for (int bj = 0; bj < 2; ++bj)
#pragma unroll
                            for (int n = 0; n < 2; ++n) { const f32x4 v = acc[ai][bj][m][n]; sq += (v.x * v.x + v.y * v.y) + (v.z * v.z + v.w * v.w); }
                        sq += __shfl_xor(sq, 16); sq += __shfl_xor(sq, 32);
                        const float rn = __builtin_amdgcn_rsqf(sq * (1.0f / 64.0f) + EPS) * osc;
                        const int pcol = (t0 + j) & 63;
                        const f32x4 cc0 = *(const f32x4*)(rope + (pcol * 16 + 4 * fq) * 2), cc1 = *(const f32x4*)(rope + (pcol * 16 + 4 * fq) * 2 + 4);
#pragma unroll
                        for (int bj = 0; bj < 2; ++bj) {
                            const f32x4 t0v = bj == 0 ? rr0 : cc0, t1v = bj == 0 ? rr1 : cc1;
                            const f32x4 x1 = acc[ai][bj][m][0] * gv[bj][0] * rn, x2 = acc[ai][bj][m][1] * gv[bj][1] * rn;
                            const f32x4 cs = (f32x4){t0v.x, t0v.z, t1v.x, t1v.z}, sn = (f32x4){t0v.y, t0v.w, t1v.y, t1v.w};
                            const f32x4 o1 = x1 * cs - x2 * sn, o2 = x1 * sn + x2 * cs;
                            u32x2 w1, w2; w1.x = cvt_pk_bf16(o1.x, o1.y); w1.y = cvt_pk_bf16(o1.z, o1.w); w2.x = cvt_pk_bf16(o2.x, o2.y); w2.y = cvt_pk_bf16(o2.z, o2.w);
                            bf16_t* p = dst + (size_t)j * pitch + 32 * bj + 4 * fq;
                            *(u32x2*)p = w1; *(u32x2*)(p + 16) = w2;
                        }
                    }
            } else {
                bf16_t* dst = Vb + (size_t)t0 * 128 + (wc - 2) * 64;
#pragma unroll
                for (int ai = 0; ai < 2; ++ai)
#pragma unroll
                    for (int m = 0; m < 4; ++m)
#pragma unroll
                        for (int bj = 0; bj < 2; ++bj)
#pragma unroll
                            for (int n = 0; n < 2; ++n) { const f32x4 v = acc[ai][bj][m][n]; u32x2 w; w.x = cvt_pk_bf16(v.x, v.y); w.y = cvt_pk_bf16(v.z, v.w);
                                *(u32x2*)(dst + (size_t)(4 * ai + m) * 128 + 32 * bj + 16 * n + 4 * fq) = w; }
            }
        }
    }
};
struct EpiVS {
    const float* ss; bf16_t* VST; float* ssg;
    __device__ __forceinline__ void operator()(f32x4 (&acc)[2][2][4][2], const Unit& u, int wr, int wc, int fr, int fq) const {
        const int t0 = u.pm * 256 + wr * 128 + fr * 8;
        { float rs[8]; load_rs8(ss, t0, fq, rs, M_TOK - 1);
#pragma unroll
          for (int ai = 0; ai < 2; ++ai)
#pragma unroll
            for (int m = 0; m < 4; ++m)
#pragma unroll
                for (int bj = 0; bj < 2; ++bj)
#pragma unroll
                    for (int n = 0; n < 2; ++n) acc[ai][bj][m][n] = acc[ai][bj][m][n] * rs[4 * ai + m]; }
        const int pn = u.pn;
        {
            const int chunk = 2 * u.pm + wr;
            bf16_t* dst = VST + ((size_t)chunk * 512 + 256 * (pn - 5) + 32 * wc + 8 * fq) * 128 + 8 * fr;
#pragma unroll
            for (int ai = 0; ai < 2; ++ai)
#pragma unroll
                for (int m = 0; m < 4; ++m) {
                    float sq = 0.f;
#pragma unroll
                    for (int bj = 0; bj < 2; ++bj)
#pragma unroll
                        for (int n = 0; n < 2; ++n) { f32x4 v = acc[ai][bj][m][n]; v = (f32x4){gelu_t(v.x), gelu_t(v.y), gelu_t(v.z), gelu_t(v.w)}; acc[ai][bj][m][n] = v;
                            sq += (v.x * v.x + v.y * v.y) + (v.z * v.z + v.w * v.w); }
                    sq += __shfl_xor(sq, 16); sq += __shfl_xor(sq, 32);
                    if (fq == 0) ssg[(size_t)(t0 + 4 * ai + m) * 8 + 4 * (pn - 5) + wc] = sq;
                    asm volatile("" : "+v"(acc[ai][0][m][0]), "+v"(acc[ai][0][m][1]), "+v"(acc[ai][1][m][0]), "+v"(acc[ai][1][m][1]));
                }
#pragma unroll
            for (int bj = 0; bj < 2; ++bj)
#pragma unroll
                for (int n = 0; n < 2; ++n)
#pragma unroll
                    for (int i = 0; i < 4; ++i) {
                        u32x4 w; w.x = cvt_pk_bf16(acc[0][bj][0][n][i], acc[0][bj][1][n][i]); w.y = cvt_pk_bf16(acc[0][bj][2][n][i], acc[0][bj][3][n][i]);
                        w.z = cvt_pk_bf16(acc[1][bj][0][n][i], acc[1][bj][1][n][i]); w.w = cvt_pk_bf16(acc[1][bj][2][n][i], acc[1][bj][3][n][i]);
                        *(u32x4*)(dst + (size_t)(128 * bj + 4 * n + i) * 128) = w;
                    }
        }
    }
};
struct EpiEW {
    const float* ss; bf16_t* QU; bf16_t* GA; bf16_t* GB;
    __device__ __forceinline__ void operator()(f32x4 (&acc)[2][2][4][2], const Unit& u, int wr, int wc, int fr, int fq) const {
        const int t0 = u.pm * 256 + wr * 128 + fr * 8;
        float rs[8]; load_rs8(ss, t0, fq, rs, M_TOK - 1);
        const int pn = u.pn;
        const bool isu = pn < 5;
        bf16_t* dst = (isu ? QU + 512 + 256 * (pn - 3) : ((pn < 11) ? GA : GB) + 256 * ((pn - 7) & 3)) + (size_t)t0 * 1024 + 32 * wc + 8 * fq;
        if (isu) {
#pragma unroll
            for (int ai = 0; ai < 2; ++ai)
#pragma unroll
                for (int m = 0; m < 4; ++m)
#pragma unroll
                    for (int bj = 0; bj < 2; ++bj) { const f32x4 a = acc[ai][bj][m][0] * rs[4 * ai + m], b = acc[ai][bj][m][1] * rs[4 * ai + m]; u32x4 w;
                        w.x = cvt_pk_bf16(gelu_t(a.x), gelu_t(a.y)); w.y = cvt_pk_bf16(gelu_t(a.z), gelu_t(a.w)); w.z = cvt_pk_bf16(gelu_t(b.x), gelu_t(b.y)); w.w = cvt_pk_bf16(gelu_t(b.z), gelu_t(b.w));
                        *(u32x4*)(dst + (size_t)(4 * ai + m) * 1024 + 128 * bj) = w; }
        } else {
#pragma unroll
            for (int ai = 0; ai < 2; ++ai)
#pragma unroll
                for (int m = 0; m < 4; ++m) { const float k2 = rs[4 * ai + m] * -1.4426950409f;
#pragma unroll
                    for (int bj = 0; bj < 2; ++bj) { const f32x4 a = acc[ai][bj][m][0], b = acc[ai][bj][m][1]; u32x4 w;
#define SG_(x) __builtin_amdgcn_rcpf(1.0f + __builtin_amdgcn_exp2f((x) * k2))
                        w.x = cvt_pk_bf16(SG_(a.x), SG_(a.y)); w.y = cvt_pk_bf16(SG_(a.z), SG_(a.w)); w.z = cvt_pk_bf16(SG_(b.x), SG_(b.y)); w.w = cvt_pk_bf16(SG_(b.z), SG_(b.w));
#undef SG_
                        *(u32x4*)(dst + (size_t)(4 * ai + m) * 1024 + 128 * bj) = w; } }
        }
    }
};

struct EpiMerge {
    bf16_t* GA; const bf16_t* GB;
    __device__ __forceinline__ void operator()(f32x4 (&acc)[2][2][4][2], const Unit& u, int wr, int wc, int fr, int fq) const {
        const int t0 = u.pm * 256 + wr * 64 + fr;
        const size_t off0 = (size_t)t0 * 1024 + 256 * u.pn + 32 * wc + 8 * fq;
#pragma unroll
        for (int ai = 0; ai < 2; ++ai)
#pragma unroll
            for (int m = 0; m < 4; ++m)
#pragma unroll
                for (int bj = 0; bj < 2; ++bj) {
                    const size_t off = off0 + (size_t)(128 * ai + 16 * m) * 1024 + 128 * bj;
                    const u32x4 gb = *(const u32x4*)(GB + off);
                    f32x4 s0 = (f32x4){bf_lo(gb.x), bf_hi(gb.x), bf_lo(gb.y), bf_hi(gb.y)}, s1 = (f32x4){bf_lo(gb.z), bf_hi(gb.z), bf_lo(gb.w), bf_hi(gb.w)};
                    if (u.part == 0) {
                        const u32x4 ga = *(const u32x4*)(GA + off);
                        const f32x4 a0 = (f32x4){bf_lo(ga.x), bf_hi(ga.x), bf_lo(ga.y), bf_hi(ga.y)}, a1 = (f32x4){bf_lo(ga.z), bf_hi(ga.z), bf_lo(ga.w), bf_hi(ga.w)};
                        s0 = (f32x4){__builtin_amdgcn_rcpf(s0.x), __builtin_amdgcn_rcpf(s0.y), __builtin_amdgcn_rcpf(s0.z), __builtin_amdgcn_rcpf(s0.w)};
                        s1 = (f32x4){__builtin_amdgcn_rcpf(s1.x), __builtin_amdgcn_rcpf(s1.y), __builtin_amdgcn_rcpf(s1.z), __builtin_amdgcn_rcpf(s1.w)};
                        acc[ai][bj][m][0] = acc[ai][bj][m][0] * (a0 * s0); acc[ai][bj][m][1] = acc[ai][bj][m][1] * (a1 * s1);
                    } else {
                        const f32x4 v0 = acc[ai][bj][m][0] * s0, v1 = acc[ai][bj][m][1] * s1; u32x4 w;
                        w.x = cvt_pk_bf16(v0.x, v0.y); w.y = cvt_pk_bf16(v0.z, v0.w); w.z = cvt_pk_bf16(v1.x, v1.y); w.w = cvt_pk_bf16(v1.z, v1.w);
                        *(u32x4*)(GA + off) = w;
                    }
                }
    }
};

struct EpiRes {
    const float* xp; const float* xs; int first; float* out; bf16_t* xb; float* ss; int bb; int wout;
    __device__ __forceinline__ void operator()(f32x4 (&acc)[2][2][4][2], const Unit& u, int wr, int wc, int fr, int fq) const {
        const int t0 = u.pm * 256 + wr * 64 + fr;
        const int col0 = 256 * u.pn + 32 * wc + 8 * fq;
        const float* bp0 = first ? ((t0 < NPROMPT) ? xp + (size_t)t0 * 1024 : xs + (size_t)(t0 - NPROMPT) * 1024) : out + (size_t)t0 * 1024;
#pragma unroll
        for (int ai = 0; ai < 2; ++ai)
#pragma unroll
            for (int m = 0; m < 4; ++m) {
                const int j = 128 * ai + 16 * m; float sq = 0.f;
#pragma unroll
                for (int bj = 0; bj < 2; ++bj) {
                    const size_t o = (size_t)j * 1024 + col0 + 128 * bj;
                    f32x4 a, b;
                    if (bb) { const u32x4 w = *(const u32x4*)(xb + (size_t)t0 * 1024 + o);
                        a = (f32x4){bf_lo(w.x), bf_hi(w.x), bf_lo(w.y), bf_hi(w.y)}; b = (f32x4){bf_lo(w.z), bf_hi(w.z), bf_lo(w.w), bf_hi(w.w)}; }
                    else { a = *(const f32x4*)(bp0 + o); b = *(const f32x4*)(bp0 + o + 4); }
                    a = a + acc[ai][bj][m][0]; b = b + acc[ai][bj][m][1];
                    if (wout) { float* op = out + (size_t)t0 * 1024 + o; *(f32x4*)op = a; *(f32x4*)(op + 4) = b; }
                    u32x4 w; w.x = cvt_pk_bf16(a.x, a.y); w.y = cvt_pk_bf16(a.z, a.w); w.z = cvt_pk_bf16(b.x, b.y); w.w = cvt_pk_bf16(b.z, b.w);
                    *(u32x4*)(xb + (size_t)t0 * 1024 + o) = w;
                    sq += (a.x * a.x + a.y * a.y) + (a.z * a.z + a.w * a.w) + (b.x * b.x + b.y * b.y) + (b.z * b.z + b.w * b.w);
                }
                sq += __shfl_xor(sq, 16); sq += __shfl_xor(sq, 32);
                if (fq == 0) ss[(size_t)(t0 + j) * 16 + 4 * u.pn + wc] = sq;
            }
    }
};

struct EpiUp {
    const float* ss; const float* cw; const float* cb; bf16_t* H2;
    __device__ __forceinline__ void operator()(f32x4 (&acc)[2][2][4][2], const Unit& u, int wr, int wc, int fr, int fq) const {
        const int t0 = u.pm * 252 - 1 + wr * 126 + fr * 8;
        { float rs[8]; load_rs8(ss, t0, fq, rs, M_TOK - 1);
#pragma unroll
          for (int ai = 0; ai < 2; ++ai)
#pragma unroll
            for (int m = 0; m < 4; ++m)
#pragma unroll
                for (int bj = 0; bj < 2; ++bj)
#pragma unroll
                    for (int n = 0; n < 2; ++n) acc[ai][bj][m][n] = acc[ai][bj][m][n] * rs[4 * ai + m]; }
        unsigned vmask = 0, smask = 0, emask = 0;
#pragma unroll
        for (int j = 0; j < 8; ++j) { const int t = t0 + j, loc = fr * 8 + j;
            if (loc >= 1 && loc <= 126 && t < M_TOK) vmask |= 1u << j;
            const int sm = (t < NPROMPT) ? (SEQ_P - 1) : (SEQ_S - 1);
            if ((t & sm) == 0) smask |= 1u << j;
            if ((t & sm) == sm) emask |= 1u << j; }
#pragma unroll
        for (int n = 0; n < 2; ++n) {
            const int cg_ = 128 * u.pn + 32 * wc + 8 * fq + 4 * n;
            const f32x4 w0g = *(const f32x4*)(cw + cg_), w1g = *(const f32x4*)(cw + 4096 + cg_), w2g = *(const f32x4*)(cw + 8192 + cg_), bg = *(const f32x4*)(cb + cg_);
            const f32x4 w0v = *(const f32x4*)(cw + 2048 + cg_), w1v = *(const f32x4*)(cw + 4096 + 2048 + cg_), w2v = *(const f32x4*)(cw + 8192 + 2048 + cg_), bv = *(const f32x4*)(cb + 2048 + cg_);
            float h[8][4];
#pragma unroll
            for (int i = 0; i < 4; ++i) {
                float ag[8], av[8];
#pragma unroll
                for (int j = 0; j < 8; ++j) { ag[j] = acc[j >> 2][0][j & 3][n][i]; av[j] = acc[j >> 2][1][j & 3][n][i]; }
                const float lg = dpp_shr1(ag[7]), rg = dpp_shl1(ag[0]), lv = dpp_shr1(av[7]), rv = dpp_shl1(av[0]);
#pragma unroll
                for (int j = 0; j < 8; ++j) {
                    float Lg = j == 0 ? lg : ag[j == 0 ? 0 : j - 1], Rg = j == 7 ? rg : ag[j == 7 ? 7 : j + 1];
                    float Lv = j == 0 ? lv : av[j == 0 ? 0 : j - 1], Rv = j == 7 ? rv : av[j == 7 ? 7 : j + 1];
                    if ((smask >> j) & 1u) { Lg = 0.f; Lv = 0.f; }
                    if ((emask >> j) & 1u) { Rg = 0.f; Rv = 0.f; }
                    const float cgv = w0g[i] * Lg + w1g[i] * ag[j] + w2g[i] * Rg + bg[i];
                    const float cvv = w0v[i] * Lv + w1v[i] * av[j] + w2v[i] * Rv + bv[i];
                    h[j][i] = gelu_t(cgv) * cvv;
                }
            }
#pragma unroll
            for (int j = 0; j < 8; ++j) if ((vmask >> j) & 1u) { u32x2 w; w.x = cvt_pk_bf16(h[j][0], h[j][1]); w.y = cvt_pk_bf16(h[j][2], h[j][3]);
                *(u32x2*)(H2 + (size_t)(t0 + j) * 2048 + cg_) = w; }
        }
    }
};
}

namespace attn_body {
using bf16=__hip_bfloat16;
using bf16x8=__attribute__((ext_vector_type(8)))short;
using s16x4=__attribute__((ext_vector_type(4)))short;
using f32x16=__attribute__((ext_vector_type(16)))float;
using u32x4=__attribute__((ext_vector_type(4)))unsigned;
constexpr int D=64,QP=1024,KP=128;
constexpr int NW=8,QBLK=32,QB=QBLK*NW,KVBLK=64;
__device__ __forceinline__ int crow(int r,int hi){return (r&3)+8*(r>>2)+4*hi;}
#define SBAR() __builtin_amdgcn_sched_barrier(0)
constexpr int NSLOT=3, SLOTB=8192;
constexpr int LDS_K=0, LDS_V=NSLOT*SLOTB, LDS_WS=2*NSLOT*SLOTB, LDS_OST=LDS_WS+NW*64*4, LDS_BYTES=LDS_OST+NW*4096;
__device__ __forceinline__ void glds16(const void*gsrc,unsigned lds_dst){unsigned keep;
  asm volatile("s_mov_b32 %0, m0\n\ts_mov_b32 m0, %2\n\ts_nop 0\n\tglobal_load_lds_dwordx4 %1, off\n\ts_mov_b32 m0, %0":"=&s"(keep):"v"(gsrc),"s"(lds_dst):"memory");}
__device__ __forceinline__ float max3f(float a,float b,float c){float r;asm("v_max3_f32 %0, %1, %2, %3":"=v"(r):"v"(a),"v"(b),"v"(c));return r;}
__device__ __forceinline__ float max2f(float a,float b){float r;asm("v_max_f32_e32 %0, %1, %2":"=v"(r):"v"(a),"v"(b));return r;}
__device__ __forceinline__ float fadd_s(float a,float b){float r;asm("v_add_f32_e32 %0, %1, %2":"=v"(r):"v"(a),"v"(b));return r;}
__device__ __forceinline__ float fsub_s(float a,float b){float r;asm("v_sub_f32_e32 %0, %1, %2":"=v"(r):"v"(a),"v"(b));return r;}
typedef float f32x2_t __attribute__((ext_vector_type(2))); typedef __bf16 bf16x2_t __attribute__((ext_vector_type(2)));
__device__ __forceinline__ unsigned cvtpk_s(float lo,float hi){f32x2_t v={lo,hi};bf16x2_t b=__builtin_convertvector(v,bf16x2_t);return __builtin_bit_cast(unsigned,b);}
#define WAIT_BAR(N) asm volatile("s_waitcnt vmcnt(" #N ") lgkmcnt(0)\n\ts_barrier":::"memory")
__device__ __forceinline__ void qkt(f32x16&p0,f32x16&p1,const char*Kslot,const bf16x8*qr,const f32x16&negm,int r32,int hi){
  const char*kb=Kslot+hi*1024+r32*16;
  #pragma unroll
  for(int d0=0;d0<4;++d0){
    const bf16x8 b0=*reinterpret_cast<const bf16x8*>(kb+d0*2048);
    const bf16x8 b1=*reinterpret_cast<const bf16x8*>(kb+d0*2048+512);
    if(d0==0){p0=__builtin_amdgcn_mfma_f32_32x32x16_bf16(b0,qr[0],negm,0,0,0);p1=__builtin_amdgcn_mfma_f32_32x32x16_bf16(b1,qr[0],negm,0,0,0);}
    else{p0=__builtin_amdgcn_mfma_f32_32x32x16_bf16(b0,qr[d0],p0,0,0,0);p1=__builtin_amdgcn_mfma_f32_32x32x16_bf16(b1,qr[d0],p1,0,0,0);}}
}
typedef __attribute__((address_space(3))) const char* lds_cptr;
typedef short v4i16_t __attribute__((ext_vector_type(4)));
__device__ __forceinline__ void kload8(bf16x8*kf,lds_cptr kp){
  kf[0]=*(const __attribute__((address_space(3))) bf16x8*)(kp);      kf[1]=*(const __attribute__((address_space(3))) bf16x8*)(kp+512);
  kf[2]=*(const __attribute__((address_space(3))) bf16x8*)(kp+2048); kf[3]=*(const __attribute__((address_space(3))) bf16x8*)(kp+2560);
  kf[4]=*(const __attribute__((address_space(3))) bf16x8*)(kp+4096); kf[5]=*(const __attribute__((address_space(3))) bf16x8*)(kp+4608);
  kf[6]=*(const __attribute__((address_space(3))) bf16x8*)(kp+6144); kf[7]=*(const __attribute__((address_space(3))) bf16x8*)(kp+6656);
}
__device__ __forceinline__ void kload2(bf16x8*kf,lds_cptr kp,int j){ kf[2*j]=*(const __attribute__((address_space(3))) bf16x8*)(kp+j*2048); kf[2*j+1]=*(const __attribute__((address_space(3))) bf16x8*)(kp+j*2048+512); }
__device__ __forceinline__ s16x4 vtr(lds_cptr p){ return __builtin_bit_cast(s16x4,__builtin_amdgcn_ds_read_tr16_b64_v4i16((__attribute__((address_space(3))) v4i16_t*)p)); }
__device__ __forceinline__ float rowmax(const f32x16&p0,const f32x16&p1){
  float a=max3f(p0[0],p0[1],p1[0]),b=max3f(p0[2],p0[3],p1[1]);a=max3f(a,p1[2],p1[3]);
  #pragma unroll
  for(int r=4;r<16;r+=4){a=max3f(a,p0[r],p0[r+1]);b=max3f(b,p0[r+2],p0[r+3]);a=max3f(a,p1[r],p1[r+1]);b=max3f(b,p1[r+2],p1[r+3]);}
  const float m=max2f(a,b);
  auto rr=__builtin_amdgcn_permlane32_swap(__float_as_uint(m),__float_as_uint(m),false,false);
  return max2f(__uint_as_float(rr[0]),__uint_as_float(rr[1]));
}
__device__ __forceinline__ void pv(f32x16*o,int vb,bf16x8 pa0,bf16x8 pa1,bf16x8 pa2,bf16x8 pa3){
  #pragma unroll
  for(int d0=0;d0<2;++d0){s16x4 lo[4],hi[4];
    #pragma unroll
    for(int ks=0;ks<4;++ks){
      asm volatile("ds_read_b64_tr_b16 %0,%1 offset:%c2":"=&v"(lo[ks]):"v"(vb),"i"(d0*4096+ks*1024):"memory");
      asm volatile("ds_read_b64_tr_b16 %0,%1 offset:%c2":"=&v"(hi[ks]):"v"(vb),"i"(d0*4096+ks*1024+512):"memory");}
    asm volatile("s_waitcnt lgkmcnt(0)":::"memory");SBAR();
    #define PK(k) (bf16x8){lo[k][0],lo[k][1],lo[k][2],lo[k][3],hi[k][0],hi[k][1],hi[k][2],hi[k][3]}
    o[d0]=__builtin_amdgcn_mfma_f32_32x32x16_bf16(pa0,PK(0),o[d0],0,0,0);
    o[d0]=__builtin_amdgcn_mfma_f32_32x32x16_bf16(pa1,PK(1),o[d0],0,0,0);
    o[d0]=__builtin_amdgcn_mfma_f32_32x32x16_bf16(pa2,PK(2),o[d0],0,0,0);
    o[d0]=__builtin_amdgcn_mfma_f32_32x32x16_bf16(pa3,PK(3),o[d0],0,0,0);
    #undef PK
  }
}
template<int THRL> __device__ __forceinline__ void attn_unit(long rowbase,int seq,int h,int q0,const bf16*Q,const bf16*__restrict__ K,const bf16*__restrict__ V,bf16*O,char*shm){
  int tid_=threadIdx.x; asm volatile("":"+v"(tid_));
  const int tid=tid_,lane=tid&63,r32=lane&31,hi=lane>>5; const int wid=__builtin_amdgcn_readfirstlane(tid>>6);
  const bf16*Qw=Q+(rowbase+q0+wid*QBLK)*QP+h*D;
  const bf16*Kh=K+rowbase*KP+(h>>2)*D,*Vh=V+rowbase*KP+(h>>2)*D;
  const unsigned lds0=(unsigned)(uintptr_t)shm;
  float*wsf=(float*)(shm+LDS_WS)+wid*64;
  const bf16*ksrc=Kh+(long)lane*KP+wid*8;
  const bf16*vsrc=Vh+(long)(16*(wid&3)+(lane>>2))*KP+(wid>>2)*32+(lane&3)*8;
  const unsigned kdst=lds0+LDS_K+wid*1024, vdst=lds0+LDS_V+wid*1024;
  #define DMA_K(t,slot) glds16(ksrc+(long)(t)*KVBLK*KP,(unsigned)__builtin_amdgcn_readfirstlane(kdst+(slot)))
  #define DMA_V(t,slot) glds16(vsrc+(long)(t)*KVBLK*KP,(unsigned)__builtin_amdgcn_readfirstlane(vdst+(slot)))
  const int vb0=(int)(lds0+LDS_V)+((lane>>4)&1)*32+(lane&3)*8+(4*hi+((lane&15)>>2))*64;
  const char*Kbase=shm+LDS_K; bf16x8 kf[8];
  const lds_cptr shm3=(lds_cptr)shm; const lds_cptr kp0=shm3+LDS_K+hi*1024+r32*16; const lds_cptr vp0=shm3+LDS_V+((lane>>4)&1)*32+(lane&3)*8+(4*hi+((lane&15)>>2))*64;
  const int NT=seq/KVBLK;
  DMA_K(0,0);DMA_V(0,0);DMA_K(1,SLOTB);
  bf16x8 qr[4];
  #pragma unroll
  for(int d0=0;d0<4;++d0)qr[d0]=*reinterpret_cast<const bf16x8*>(&Qw[(long)r32*QP+d0*16+hi*8]);
  float mhat=0.f,l_reg=0.f;f32x16 o[2];o[0]=f32x16{};o[1]=f32x16{};f32x16 negm=f32x16{};asm volatile("":"+v"(negm));
  bool resc=false;
  #define START(P0,P1) do{ const float rm=rowmax(P0,P1); resc=false; \
    { const float dl=rm; mhat=fadd_s(mhat,dl); \
      _Pragma("unroll") for(int r=0;r<16;++r){P0[r]=fsub_s(P0[r],dl);P1[r]=fsub_s(P1[r],dl);} \
      _Pragma("unroll") for(int r=0;r<16;++r)negm[r]=-mhat; asm volatile("":"+v"(negm)); } \
    _Pragma("unroll") for(int r=0;r<16;++r)P0[r]=__builtin_amdgcn_exp2f(P0[r]); }while(0)
  #define RESC() do{ if(resc){ asm volatile("s_waitcnt lgkmcnt(0)":::"memory"); \
      _Pragma("unroll") for(int d_=0;d_<2;++d_) _Pragma("unroll") for(int r=0;r<16;++r)o[d_][r]*=wsf[crow(r,hi)]; } }while(0)
  f32x16 pA0,pA1,pB0,pB1;
  int sl_prev=0,sl_cur=0,sl_next=SLOTB;
  #define ROT() do{sl_prev=sl_cur;sl_cur=sl_next;sl_next=(sl_next==(NSLOT-1)*SLOTB)?0:sl_next+SLOTB;}while(0)
  DMA_K(2,2*SLOTB);
  WAIT_BAR(3);
  qkt(pA0,pA1,Kbase,qr,negm,r32,hi);asm volatile("s_nop 15\n\ts_nop 7":"+v"(pA0),"+v"(pA1));
  START(pA0,pA1);
  _Pragma("unroll") for(int r=0;r<16;++r)pA1[r]=__builtin_amdgcn_exp2f(pA1[r]);
  WAIT_BAR(0);
  DMA_K(3,0);DMA_V(1,SLOTB);
  ROT();
  kload8(kf,kp0+sl_cur);
  WAIT_BAR(2);
  s16x4 vlo[8],vhi[8]; u32x4 pw0,pw1,pw2,pw3;
  #define PKW(P,B) cvtpk_s(P[B],P[B+1])
  #define PAF(k) __builtin_bit_cast(bf16x8,pw##k)
  #define VFR(i) (bf16x8){vlo[i][0],vlo[i][1],vlo[i][2],vlo[i][3],vhi[i][0],vhi[i][1],vhi[i][2],vhi[i][3]}
  #define PIN(x) asm volatile("":"+v"(x))
  #define MX3(a,b,c) __builtin_fmaxf(__builtin_fmaxf((a),(b)),(c))
  #define GAPA(MF,A0,A1,A2,A3,W0,W1,PW) do{ MF; sacc+=A0; sacc+=A1; sacc+=A2; sacc+=A3; PIN(sacc); W0; W1; PIN(PW); SBAR(); }while(0)
  #define EX(v) __builtin_amdgcn_exp2f(v)
  #define GAPB(MF,X,B) do{ MF; X[B]=EX(X[B]); X[B+1]=EX(X[B+1]); X[B+2]=EX(X[B+2]); X[B+3]=EX(X[B+3]); PIN(X); SBAR(); }while(0)
  #define VRD(i) do{ vlo[i]=vtr(vp_+(((i)>>2)*4096+((i)&3)*1024)); vhi[i]=vtr(vp_+(((i)>>2)*4096+((i)&3)*1024+512)); }while(0)
  #define KRD(G,j) do{ if(G){ kload2(kf,kp0+sl_next,j); SBAR(); } }while(0)
  #define STEP(C0,C1,P0,P1,t,GK,GV,GL) do{ SBAR(); \
    const lds_cptr vp_=vp0+sl_prev; \
    VRD(0); SBAR(); float sacc=(P0[0]+P0[1]); \
    GAPA(C0=__builtin_amdgcn_mfma_f32_32x32x16_bf16(kf[0],qr[0],negm,0,0,0), P0[2],P0[3],P0[4],P0[5],     pw0[0]=PKW(P0,0), pw0[1]=PKW(P0,2), pw0); \
    VRD(4); SBAR(); GAPA(C1=__builtin_amdgcn_mfma_f32_32x32x16_bf16(kf[1],qr[0],negm,0,0,0), P0[6],P0[7],P0[8],P0[9],     pw0[2]=PKW(P0,4), pw0[3]=PKW(P0,6), pw0); \
    VRD(1); SBAR(); GAPA(C0=__builtin_amdgcn_mfma_f32_32x32x16_bf16(kf[2],qr[1],C0,0,0,0),   P0[10],P0[11],P0[12],P0[13], pw1[0]=PKW(P0,8), pw1[1]=PKW(P0,10), pw1); \
    VRD(5); SBAR(); GAPA(C1=__builtin_amdgcn_mfma_f32_32x32x16_bf16(kf[3],qr[1],C1,0,0,0),   P0[14],P0[15],P1[0],P1[1],   pw1[2]=PKW(P0,12),pw1[3]=PKW(P0,14), pw1); \
    VRD(2); SBAR(); GAPA(C0=__builtin_amdgcn_mfma_f32_32x32x16_bf16(kf[4],qr[2],C0,0,0,0),   P1[2],P1[3],P1[4],P1[5],     pw2[0]=PKW(P1,0), pw2[1]=PKW(P1,2), pw2); \
    VRD(6); SBAR(); GAPA(C1=__builtin_amdgcn_mfma_f32_32x32x16_bf16(kf[5],qr[2],C1,0,0,0),   P1[6],P1[7],P1[8],P1[9],     pw2[2]=PKW(P1,4), pw2[3]=PKW(P1,6), pw2); \
    VRD(3); SBAR(); GAPA(C0=__builtin_amdgcn_mfma_f32_32x32x16_bf16(kf[6],qr[3],C0,0,0,0),   P1[10],P1[11],P1[12],P1[13], pw3[0]=PKW(P1,8), pw3[1]=PKW(P1,10), pw3); \
    VRD(7); SBAR(); GAPA(C1=__builtin_amdgcn_mfma_f32_32x32x16_bf16(kf[7],qr[3],C1,0,0,0),   P1[14],P1[15],0.f,0.f,       pw3[2]=PKW(P1,12),pw3[3]=PKW(P1,14), pw3); \
    l_reg+=sacc; \
    if(GK){DMA_K((t)+3,sl_cur);} if(GV){DMA_V((t)+1,sl_next);} \
    { float a=MX3(C0[0],C0[1],C1[0]),b=MX3(C0[2],C0[3],C1[1]); a=MX3(a,C1[2],C1[3]); \
      _Pragma("unroll") for(int r=4;r<16;r+=4){a=MX3(a,C0[r],C0[r+1]);b=MX3(b,C0[r+2],C0[r+3]);a=MX3(a,C1[r],C1[r+1]);b=MX3(b,C1[r+2],C1[r+3]);} \
      float rm=__builtin_fmaxf(a,b); { auto rr=__builtin_amdgcn_permlane32_swap(__float_as_uint(rm),__float_as_uint(rm),false,false); rm=__builtin_fmaxf(__uint_as_float(rr[0]),__uint_as_float(rr[1])); } \
      resc=false; \
      if(__builtin_expect(__any(rm>(float)THRL),0)){ const float dl=__builtin_fmaxf(rm,0.f); mhat+=dl; \
        _Pragma("unroll") for(int r=0;r<16;++r){C0[r]-=dl;C1[r]-=dl;} \
        _Pragma("unroll") for(int r=0;r<16;++r)negm[r]=-mhat; asm volatile("":"+v"(negm)); \
        const float f=__builtin_amdgcn_exp2f(-dl); l_reg*=f; if(hi==0)wsf[r32]=f; resc=true; } } \
    SBAR(); \
    GAPB(o[0]=__builtin_amdgcn_mfma_f32_32x32x16_bf16(PAF(0),VFR(0),o[0],0,0,0), C0,0); \
    GAPB(o[1]=__builtin_amdgcn_mfma_f32_32x32x16_bf16(PAF(0),VFR(4),o[1],0,0,0), C0,4); \
    KRD(GL,0); GAPB(o[0]=__builtin_amdgcn_mfma_f32_32x32x16_bf16(PAF(1),VFR(1),o[0],0,0,0), C0,8); \
    KRD(GL,1); GAPB(o[1]=__builtin_amdgcn_mfma_f32_32x32x16_bf16(PAF(1),VFR(5),o[1],0,0,0), C0,12); \
    KRD(GL,2); GAPB(o[0]=__builtin_amdgcn_mfma_f32_32x32x16_bf16(PAF(2),VFR(2),o[0],0,0,0), C1,0); \
    KRD(GL,3); GAPB(o[1]=__builtin_amdgcn_mfma_f32_32x32x16_bf16(PAF(2),VFR(6),o[1],0,0,0), C1,4); \
    GAPB(o[0]=__builtin_amdgcn_mfma_f32_32x32x16_bf16(PAF(3),VFR(3),o[0],0,0,0), C1,8); \
    GAPB(o[1]=__builtin_amdgcn_mfma_f32_32x32x16_bf16(PAF(3),VFR(7),o[1],0,0,0), C1,12); \
    }while(0)
  int t=1;
  for(;t+5<NT;t+=2){
    STEP(pB0,pB1,pA0,pA1,t,true,true,true);     WAIT_BAR(2); RESC(); ROT();
    STEP(pA0,pA1,pB0,pB1,t+1,true,true,true);   WAIT_BAR(2); RESC(); ROT();
  }
  #define ENDW(tt) do{ if((tt)+3<NT){WAIT_BAR(2);} else if((tt)+2<NT){WAIT_BAR(1);} else {WAIT_BAR(0);} }while(0)
  for(;t+1<NT;t+=2){
    STEP(pB0,pB1,pA0,pA1,t,(t+3<NT),(t+1<NT),(t+1<NT));       ENDW(t);   RESC(); ROT();
    STEP(pA0,pA1,pB0,pB1,t+1,(t+4<NT),(t+2<NT),(t+2<NT));     ENDW(t+1); RESC(); ROT();
  }
  STEP(pB0,pB1,pA0,pA1,NT-1,false,false,false); RESC();
  { float sacc=pB0[0]+pB0[1]; _Pragma("unroll") for(int r=2;r<16;++r)sacc+=pB0[r]; _Pragma("unroll") for(int r=0;r<16;++r)sacc+=pB1[r]; l_reg+=sacc;
    pw0=(u32x4){PKW(pB0,0),PKW(pB0,2),PKW(pB0,4),PKW(pB0,6)};pw1=(u32x4){PKW(pB0,8),PKW(pB0,10),PKW(pB0,12),PKW(pB0,14)};pw2=(u32x4){PKW(pB1,0),PKW(pB1,2),PKW(pB1,4),PKW(pB1,6)};pw3=(u32x4){PKW(pB1,8),PKW(pB1,10),PKW(pB1,12),PKW(pB1,14)};
    SBAR(); pv(o,vb0+sl_cur,PAF(0),PAF(1),PAF(2),PAF(3)); }
  #undef PKW
  #undef PAF
  #undef VFR
  #undef PIN
  #undef MX3
  #undef GAPA
  #undef GAPB
  #undef EX
  #undef VRD
  #undef KRD
  #undef STEP
  #undef ENDW
  {auto rr=__builtin_amdgcn_permlane32_swap(__float_as_uint(l_reg),__float_as_uint(l_reg),false,false);l_reg=__uint_as_float(rr[0])+__uint_as_float(rr[1]);}
  if(hi==0)wsf[32+r32]=l_reg;asm volatile("s_waitcnt lgkmcnt(0)":::"memory");
  float rli[16];
  #pragma unroll
  for(int r=0;r<16;++r)rli[r]=__builtin_amdgcn_rcpf(wsf[32+crow(r,hi)]);
  bf16*Ow=O+(rowbase+q0+wid*QBLK)*QP+h*D;
  { bf16*stg=(bf16*)(shm+LDS_OST)+wid*2048;
    #pragma unroll
    for(int r=0;r<16;++r){const int orow=crow(r,hi);
      #pragma unroll
      for(int d0=0;d0<2;++d0)stg[orow*64+d0*32+r32]=__float2bfloat16(o[d0][r]*rli[r]);}
    asm volatile("s_waitcnt lgkmcnt(0)":::"memory");
    #pragma unroll
    for(int i=0;i<4;++i){const int row=i*8+(lane>>3),ch=lane&7; const u32x4 v=*(const u32x4*)(stg+row*64+ch*8); *(u32x4*)(Ow+(long)row*QP+ch*8)=v;} }
  asm volatile("s_waitcnt lgkmcnt(0)\n\ts_barrier":::"memory");
  #undef DMA_K
  #undef DMA_V
  #undef START
  #undef RESC
  #undef ROT
}
constexpr int ATTN_LDS_BYTES=LDS_BYTES;
#undef SBAR
#undef WAIT_BAR
}

#define GRID_SYNC() do { asm volatile("s_waitcnt vmcnt(0) lgkmcnt(0)" ::: "memory"); grid.sync(); __builtin_amdgcn_fence(__ATOMIC_ACQUIRE, "agent"); asm volatile("s_waitcnt vmcnt(0)" ::: "memory"); } while (0)
#ifndef N_LAUNCH_MODE
#define N_LAUNCH_MODE 0
#endif
constexpr int N_PHASES = 2 + 6 * NLAYER;
constexpr int NWAVES = 8;
constexpr size_t MiB = 1u << 20;
constexpr size_t WL_IN = 0, WL_A = WL_IN + (size_t)INW * 1024, WL_B = WL_A + 1024 * 512, WL_MIX = WL_B + 1024 * 512, WL_UP = WL_MIX + 1024 * 1024,
                 WL_DOWN = WL_UP + 4096 * 1024, WL_SG = WL_DOWN + 1024 * 2048, WL_SIZE = WL_SG + 8 * 128 * 128;
static_assert(WL_SIZE * 2 * NLAYER <= 95 * MiB, "weights region");
constexpr size_t WS_ROPE = 0, WS_W = 1 * MiB, WS_XB = 96 * MiB + 4096, WS_QU = 289 * MiB, WS_K = 481 * MiB, WS_V = 505 * MiB, WS_VST = 529 * MiB,
                 WS_GA = 625 * MiB, WS_GB = 817 * MiB, WS_H2 = 625 * MiB, WS_SS = 1009 * MiB, WS_SSG = 1015 * MiB, WS_END = 1018 * MiB;
constexpr int LDS_BYTES = 147456, SG_SCR_OFF = 135168, BARST_OFF = 140288;
constexpr size_t WS_BAR = 65536, BAR_BYTES = 16384;


#define XB_TMO      128
#define XB_XCNT(j)  (256  + 64 * (j))
#define XB_XSUB(j)  (1280 + 64 * (j))
#define XB_XGEN(j)  (2304 + 64 * (j))
#define XB_TOP      3328
#define XB_TOPGEN   3392
#define XCD_BAR_WORDS 3456
#define XB_SPIN_CAP (1u << 22)
__device__ __forceinline__ unsigned xb_ld(unsigned* p)              { return __hip_atomic_load(p, __ATOMIC_RELAXED, __HIP_MEMORY_SCOPE_AGENT); }
__device__ __forceinline__ unsigned xb_add(unsigned* p, unsigned v) { return __hip_atomic_fetch_add(p, v, __ATOMIC_RELAXED, __HIP_MEMORY_SCOPE_AGENT); }
__device__ __forceinline__ unsigned xb_xcc_id() { return (unsigned)__builtin_amdgcn_s_getreg((3 << 11) | 20) & 0xFu; }
#define XB_SPIN(cond, bar) do { unsigned _sp = 0; while (cond) { __builtin_amdgcn_s_sleep(1); \
    if ((++_sp & 255u) == 0u) { if (xb_ld(&(bar)[XB_TMO])) break; if (_sp > XB_SPIN_CAP) { atomicAdd(&(bar)[XB_TMO], 1u); break; } } } } while (0)
struct XcdBarrier { unsigned* bar; unsigned x; volatile LAS unsigned* st; };
__device__ __forceinline__ XcdBarrier xcd_barrier_post(unsigned* bar, volatile LAS unsigned* st) {
    XcdBarrier b; b.bar = bar; b.x = xb_xcc_id(); b.st = st;
    if (threadIdx.x == 0) (void)xb_add(&bar[XB_XCNT(b.x)], 1u);
    return b;
}
__device__ __forceinline__ void xcd_barrier_complete(unsigned* bar, unsigned x, unsigned& nloc, unsigned& nx) {
    const unsigned G = gridDim.x * gridDim.y * gridDim.z;
    unsigned sum, cnt, mine, sp = 0u;
    for (;;) {
        sum = 0u; cnt = 0u; mine = 0u;
#pragma unroll
        for (unsigned j = 0; j < 16; ++j) { const unsigned c = xb_ld(&bar[XB_XCNT(j)]); sum += c; cnt += (c > 0u) ? 1u : 0u; mine = (j == x) ? c : mine; }
        if (sum == G) break;
        __builtin_amdgcn_s_sleep(1);
        if ((++sp & 255u) == 0u) { if (xb_ld(&bar[XB_TMO])) break; if (sp > XB_SPIN_CAP) { atomicAdd(&bar[XB_TMO], 1u); break; } }
    }
    nloc = mine > 0u ? mine : 1u; nx = cnt > 0u ? cnt : 1u;
}
__device__ __forceinline__ void xcd_barrier(const XcdBarrier& b) {
    asm volatile("s_waitcnt vmcnt(0)" ::: "memory");
    __syncthreads();
    if (threadIdx.x == 0) {
        unsigned* bar = b.bar;
        __builtin_amdgcn_s_waitcnt(0);
        unsigned nloc = b.st[0], nx = b.st[1];
        if (nloc == 0u) { xcd_barrier_complete(bar, b.x, nloc, nx); b.st[0] = nloc; b.st[1] = nx; }
        const unsigned old = xb_add(&bar[XB_XSUB(b.x)], 1u);
        const unsigned gen = old / nloc;
        if (old + 1u == (gen + 1u) * nloc) {
            __builtin_amdgcn_fence(__ATOMIC_RELEASE, "agent");
            asm volatile("s_waitcnt vmcnt(0)" ::: "memory");
            const unsigned og = xb_add(&bar[XB_TOP], 1u);
            const unsigned tg = og / nx;
            if (og + 1u == (tg + 1u) * nx) xb_add(&bar[XB_TOPGEN], 1u);
            else XB_SPIN(xb_ld(&bar[XB_TOPGEN]) == tg, bar);
            __builtin_amdgcn_fence(__ATOMIC_ACQUIRE, "agent");
            xb_add(&bar[XB_XGEN(b.x)], 1u);
            asm volatile("s_waitcnt vmcnt(0)" ::: "memory");
        } else {
            XB_SPIN(xb_ld(&bar[XB_XGEN(b.x)]) == gen, bar);
            __builtin_amdgcn_fence(__ATOMIC_ACQUIRE, "agent");
            asm volatile("s_waitcnt vmcnt(0)" ::: "memory");
        }
    }
    __syncthreads();
}

struct Args { const float* in[18]; float* out; unsigned char* ws; int ph_lo, ph_hi; };

__device__ __forceinline__ float wave_sum(float v) {
#pragma unroll
    for (int o = 1; o < 64; o <<= 1) v += __shfl_xor(v, o);
    return v;
}
__device__ __forceinline__ int invperm32(int cc) { return 16 * ((cc >> 2) & 1) + 4 * (cc >> 3) + (cc & 3); }
__device__ __forceinline__ int map_plain(int n) { return (n & ~31) + invperm32(n & 31); }
__device__ __forceinline__ int map_in(int n) {
    if (n < 512) { const int pn = n >> 8, hh = (n >> 6) & 3, d = n & 63; return 256 * pn + 128 * (d >> 5) + 32 * hh + (d & 31); }
    if (n < 768) { const int c = n - 512, isv = c >> 7, head = (c >> 6) & 1, d = c & 63, wc = 2 * isv + head; return 512 + 128 * (d >> 5) + 32 * wc + (d & 31); }
    return map_plain(n);
}
__device__ __forceinline__ int map_up(int n) { const int bj = n >> 11, c = n & 2047, pn = c >> 7, r = c & 127; return 256 * pn + 128 * bj + (r & ~31) + invperm32(r & 31); }

template <int MAP>
__device__ __forceinline__ void transpose_item(const float* W, const float* g, int K, int N, bf16_t* WT, LAS float* scr, int item, int lane) {
    const int nblk = N / 32, kb = item / nblk, nb = item % nblk, k0 = 64 * kb, n0 = 32 * nb;
#pragma unroll 8
    for (int i = 0; i < 32; ++i) { const int kk = 2 * i + (lane >> 5); float v = W[(size_t)(k0 + kk) * N + n0 + (lane & 31)]; if (g) v *= g[k0 + kk]; scr[kk * 33 + (lane & 31)] = v; }
    asm volatile("s_waitcnt lgkmcnt(0)" ::: "memory");
    const int c = lane & 7;
#pragma unroll
    for (int j = 0; j < 4; ++j) { const int n = (lane >> 3) + 8 * j; const LAS float* s = scr + (8 * c) * 33 + n;
        u32x4 o; o.x = cvt_pk_bf16(s[0 * 33], s[1 * 33]); o.y = cvt_pk_bf16(s[2 * 33], s[3 * 33]); o.z = cvt_pk_bf16(s[4 * 33], s[5 * 33]); o.w = cvt_pk_bf16(s[6 * 33], s[7 * 33]);
        const int nn = n0 + n; const int row = MAP == 0 ? map_plain(nn) : (MAP == 1 ? map_in(nn) : map_up(nn));
        *(u32x4*)(WT + (size_t)row * K + k0 + 8 * c) = o; }
    asm volatile("s_waitcnt lgkmcnt(0)" ::: "memory");
}

__device__ __forceinline__ void sincos_tab(float x, float& c, float& s) {
    const float n = rintf(x * 0.63661977236758134308f);
    float r = fmaf(-n, 1.5703125f, x); r = fmaf(-n, 4.83751296997070312500e-4f, r); r = fmaf(-n, 7.5497899548918821e-8f, r);
    const float r2 = r * r;
    const float sp = r + r * r2 * (-1.0f / 6 + r2 * (1.0f / 120 + r2 * (-1.0f / 5040 + r2 * (1.0f / 362880))));
    const float cp = 1.0f + r2 * (-0.5f + r2 * (1.0f / 24 + r2 * (-1.0f / 720 + r2 * (1.0f / 40320 + r2 * (-1.0f / 3628800)))));
    const int q = ((int)n) & 3;
    s = (q == 0) ? sp : (q == 1) ? cp : (q == 2) ? -sp : -cp;
    c = (q == 0) ? cp : (q == 1) ? -sp : (q == 2) ? -cp : sp;
}

__device__ __forceinline__ void sg_unit(int ch, int g, const bf16_t* VST, const float* ssg, const bf16_t* Wg, const float* sgb, const float* gsg, bf16_t* QU, LAS float* scr, int lane) {
    asm volatile("" : "+v"(lane));
    const int fr = lane & 15, fq = lane >> 4;
#pragma unroll
    for (int hh = 0; hh < 2; ++hh) { const int p = lane + 64 * hh; const float* sp = ssg + (size_t)(ch * 128 + p) * 8; const f32x4 a = *(const f32x4*)sp, b = *(const f32x4*)(sp + 4);
        const float s = ((a.x + a.y) + (a.z + a.w)) + ((b.x + b.y) + (b.z + b.w)); scr[p] = __builtin_amdgcn_rsqf(s * (1.0f / 512.0f) + EPS); }
    asm volatile("s_waitcnt lgkmcnt(0)" ::: "memory");
    f32x4 acc[8][4];
#pragma unroll
    for (int pt = 0; pt < 8; ++pt)
#pragma unroll
        for (int ct = 0; ct < 4; ++ct) acc[pt][ct] = (f32x4){0.f, 0.f, 0.f, 0.f};
    const bf16_t* vbase = VST + ((size_t)ch * 512 + g * 64) * 128;
    const bf16_t* wbase = Wg + (size_t)g * 128 * 128;
#pragma unroll 1
    for (int kk = 0; kk < 4; ++kk) {
        const int k0 = kk * 32 + 8 * fq;
        bf16x8 af[4];
#pragma unroll
        for (int ct = 0; ct < 4; ++ct) af[ct] = *(const bf16x8*)(vbase + (size_t)(ct * 16 + fr) * 128 + k0);
        float r[8];
#pragma unroll
        for (int e = 0; e < 8; ++e) r[e] = scr[k0 + e];
#pragma unroll
        for (int pt = 0; pt < 8; ++pt) {
            const u32x4 w = *(const u32x4*)(wbase + (size_t)(pt * 16 + fr) * 128 + k0);
            u32x4 ws; ws.x = cvt_pk_bf16(bf_lo(w.x) * r[0], bf_hi(w.x) * r[1]); ws.y = cvt_pk_bf16(bf_lo(w.y) * r[2], bf_hi(w.y) * r[3]);
            ws.z = cvt_pk_bf16(bf_lo(w.z) * r[4], bf_hi(w.z) * r[5]); ws.w = cvt_pk_bf16(bf_lo(w.w) * r[6], bf_hi(w.w) * r[7]);
            const bf16x8 bfz = __builtin_bit_cast(bf16x8, ws);
#pragma unroll
            for (int ct = 0; ct < 4; ++ct) acc[pt][ct] = __builtin_amdgcn_mfma_f32_16x16x32_bf16(af[ct], bfz, acc[pt][ct], 0, 0, 0);
        }
    }
    f32x4 gs[4];
#pragma unroll
    for (int ct = 0; ct < 4; ++ct) gs[ct] = *(const f32x4*)(gsg + g * 64 + ct * 16 + 4 * fq);
#pragma unroll
    for (int pt = 0; pt < 8; ++pt) {
        const int p = pt * 16 + fr; const float b = sgb[g * 128 + p];
        bf16_t* up = QU + (size_t)(ch * 128 + p) * 1024 + 512 + g * 64 + 4 * fq;
#pragma unroll
        for (int ct = 0; ct < 4; ++ct) {
            const u32x2 uu = *(const u32x2*)(up + ct * 16);
            const f32x4 sp = acc[pt][ct] * gs[ct] + b;
            u32x2 w; w.x = cvt_pk_bf16(bf_lo(uu.x) * sp.x, bf_hi(uu.x) * sp.y); w.y = cvt_pk_bf16(bf_lo(uu.y) * sp.z, bf_hi(uu.y) * sp.w);
            *(u32x2*)(up + ct * 16) = w;
        }
    }
    asm volatile("s_waitcnt lgkmcnt(0)" ::: "memory");
}

__global__ void __launch_bounds__(NWAVES * 64, 2) fwd_megakernel(Args args) {
    extern __shared__ __attribute__((aligned(16))) unsigned char lds[];
    cg::grid_group grid = cg::this_grid();
    LAS unsigned char* L = (LAS unsigned char*)lds;
    volatile LAS unsigned* barst = (volatile LAS unsigned*)(L + BARST_OFF);
    if (threadIdx.x < 2) barst[threadIdx.x] = 0u;
    __syncthreads();
    const XcdBarrier xbar = xcd_barrier_post((unsigned*)(args.ws + WS_BAR), barst);
    const int G = gridDim.x, bx = blockIdx.x;
    const int vcu = (G % 8 == 0) ? (bx % 8) * (G / 8) + bx / 8 : bx;
    const int NGW = G * NWAVES;
    unsigned char* ws = args.ws;
    const float* x_prompt = args.in[0]; const float* x_sample = args.in[1];
    const float* attn_norm_g = args.in[2]; const float* w_in = args.in[3]; const float* q_norm_g = args.in[4]; const float* k_norm_g = args.in[5];
    const float* sg_norm_g = args.in[6]; const float* sg_w = args.in[7]; const float* sg_b = args.in[8]; const float* w_branch_a = args.in[9];
    const float* w_branch_b = args.in[10]; const float* w_mix_out = args.in[11]; const float* ffn_norm_g = args.in[12]; const float* w_up = args.in[13];
    const float* conv_w = args.in[14]; const float* conv_b = args.in[15]; const float* w_down = args.in[16]; const float* final_norm_g = args.in[17];
    float* out = args.out;
    float* rope = (float*)(ws + WS_ROPE);
    bf16_t* Wall = (bf16_t*)(ws + WS_W);
    bf16_t* XB = (bf16_t*)(ws + WS_XB); bf16_t* QU = (bf16_t*)(ws + WS_QU); bf16_t* KB = (bf16_t*)(ws + WS_K); bf16_t* VB = (bf16_t*)(ws + WS_V);
    bf16_t* VST = (bf16_t*)(ws + WS_VST); bf16_t* GA = (bf16_t*)(ws + WS_GA); bf16_t* GB = (bf16_t*)(ws + WS_GB); bf16_t* H2 = (bf16_t*)(ws + WS_H2);
    float* SSQ = (float*)(ws + WS_SS); float* SSG = (float*)(ws + WS_SSG);

    for (int p = args.ph_lo; p < args.ph_hi; ++p) {
    if (p > args.ph_lo) { if (p == 1) GRID_SYNC(); else xcd_barrier(xbar); }
    int tid_ = threadIdx.x; asm volatile("" : "+v"(tid_));
    const int tid = tid_, lane = tid & 63, wave = __builtin_amdgcn_readfirstlane(tid >> 6);
    const int gw = vcu * NWAVES + wave;
    if (p == 0) {
        LAS float* scr = (LAS float*)(L + wave * 16384);
        constexpr int I_IN = 16 * (INW / 32), I_A = 8 * 32, I_MIX = 16 * 32, I_UP = 16 * 128, I_DOWN = 32 * 32, I_L = I_IN + 2 * I_A + I_MIX + I_UP + I_DOWN;
        for (int it = gw; it < I_L * NLAYER; it += NGW) {
            const int l = it / I_L; int r = it % I_L; bf16_t* wl = Wall + (size_t)l * WL_SIZE;
            if (r < I_IN) { transpose_item<1>(w_in + (size_t)l * 1024 * INW, attn_norm_g + l * 1024, 1024, INW, wl + WL_IN, scr, r, lane); continue; } r -= I_IN;
            if (r < I_A) { transpose_item<0>(w_branch_a + (size_t)l * 512 * 1024, nullptr, 512, 1024, wl + WL_A, scr, r, lane); continue; } r -= I_A;
            if (r < I_A) { transpose_item<0>(w_branch_b + (size_t)l * 512 * 1024, nullptr, 512, 1024, wl + WL_B, scr, r, lane); continue; } r -= I_A;
            if (r < I_MIX) { transpose_item<0>(w_mix_out + (size_t)l * 1024 * 1024, nullptr, 1024, 1024, wl + WL_MIX, scr, r, lane); continue; } r -= I_MIX;
            if (r < I_UP) { transpose_item<2>(w_up + (size_t)l * 1024 * 4096, ffn_norm_g + l * 1024, 1024, 4096, wl + WL_UP, scr, r, lane); continue; } r -= I_UP;
            transpose_item<0>(w_down + (size_t)l * 2048 * 1024, nullptr, 2048, 1024, wl + WL_DOWN, scr, r, lane);
        }
        for (int i = gw * 64 + lane; i < NLAYER * 8 * 128 * 128 / 4; i += NGW * 64) {
            const int l = i / (8 * 128 * 128 / 4), r = i % (8 * 128 * 128 / 4);
            const f32x4 v = *(const f32x4*)(sg_w + (size_t)l * 131072 + (size_t)r * 4);
            u32x2 w; w.x = cvt_pk_bf16(v.x, v.y); w.y = cvt_pk_bf16(v.z, v.w);
            *(u32x2*)(Wall + (size_t)l * WL_SIZE + WL_SG + (size_t)r * 4) = w;
        }
        for (int i = gw * 64 + lane; i < 128 * 16; i += NGW * 64) {
            const int pos = i >> 4, f = i & 15; float fr_ = 1.0f; for (int k = 0; k < f; ++k) fr_ *= 0.56234132519034907f;
            float c, s; sincos_tab((float)pos * fr_, c, s); rope[2 * i] = c; rope[2 * i + 1] = s;
        }
        for (int i = gw * 64 + lane; i < 257 * 128; i += NGW * 64) {
            const int r = i / 128, c = i % 128; const long row = (r == 0) ? -1 : (long)M_TOK + r - 1;
            *(u32x4*)(XB + row * 1024 + c * 8) = (u32x4){0u, 0u, 0u, 0u};
        }
        for (int m0 = gw; m0 < M_TOK; m0 += 2 * NGW) {
            const int nr = (m0 + NGW < M_TOK) ? 2 : 1;
            f32x4 v[2][4]; float sq[2];
#pragma unroll
            for (int r = 0; r < 2; ++r) { const int m = (r < nr) ? m0 + r * NGW : m0;
                const float* xr = (m < NPROMPT) ? x_prompt + (size_t)m * 1024 : x_sample + (size_t)(m - NPROMPT) * 1024; float s = 0.f;
#pragma unroll
                for (int j = 0; j < 4; ++j) { v[r][j] = *(const f32x4*)(xr + 4 * lane + 256 * j); s += (v[r][j].x * v[r][j].x + v[r][j].y * v[r][j].y) + (v[r][j].z * v[r][j].z + v[r][j].w * v[r][j].w); }
                sq[r] = s; }
#pragma unroll
            for (int r = 0; r < 2; ++r) if (r < nr) { const int m = m0 + r * NGW; const float s = wave_sum(sq[r]);
#pragma unroll
                for (int j = 0; j < 4; ++j) { u32x2 w; w.x = cvt_pk_bf16(v[r][j].x, v[r][j].y); w.y = cvt_pk_bf16(v[r][j].z, v[r][j].w); *(u32x2*)(XB + (size_t)m * 1024 + 4 * lane + 256 * j) = w; }
                if (lane < 16) SSQ[(size_t)m * 16 + lane] = (lane == 0) ? s : 0.f; }
        }
    }
    else if (p < N_PHASES - 1) {
        const int l = (p - 1) / 6, k = (p - 1) % 6;
        const bf16_t* wl = Wall + (size_t)l * WL_SIZE;
        if (k == 0) {
            pg8::Gemm g{XB, wl + WL_IN, 1024, 1024, 1024, 0, 0, 256, 128, 0};
            { pg8::StaticOrder S; S.init(M_TOK / 256, 3, 1, G, bx, 0); S.rev = (5 * l + 1) & 1;
              pg8::EpiQKV E{SSQ, q_norm_g + l * 64, k_norm_g + l * 64, rope, QU, KB, VB};
              pg8::gemm_phase<pg8::EpiQKV, 1>(L, g, S, E); }
            { pg8::StaticOrder S; S.init(M_TOK / 256, 2, 1, G, bx, 5); S.rev = (5 * l + 1) & 1;
              pg8::EpiVS E{SSQ, VST, SSG};
              pg8::gemm_phase<pg8::EpiVS, 1>(L, g, S, E); }
            { pg8::StaticOrder S; S.init(M_TOK / 256, 10, 1, G, bx, 3, 2, 7); S.rev = (5 * l + 1) & 1;
              pg8::EpiEW E{SSQ, QU, GA, GB};
              pg8::gemm_phase<pg8::EpiEW, 1>(L, g, S, E); }
        }
        else if (k == 1) {
            LAS float* scr = (LAS float*)(L + SG_SCR_OFF) + wave * 128;
            for (int u = gw; u < 768 * 8; u += NGW)
                sg_unit(u >> 3, u & 7, VST, SSG, wl + WL_SG, sg_b + l * 1024, sg_norm_g + l * 512, QU, scr, lane);
            for (int u = bx; u < 3072; u += G) {
                const int i = u >> 8, c = u & 255, x = c & 7, w = c >> 3;
                long rowbase; int seq, h, q0;
                if (i < 4) { const int idx = w * 4 + i; rowbase = (long)(x >> 1) * SEQ_P; seq = SEQ_P; h = (x & 1) * 4 + (idx >> 5); q0 = (idx & 31) * 256; }
                else { const int pair = 8 * x + (i - 4); rowbase = (long)NPROMPT + (long)(pair >> 1) * SEQ_S; seq = SEQ_S; h = (pair & 1) * 4 + (w >> 3); q0 = (w & 7) * 256; }
                attn_body::attn_unit<8>(rowbase, seq, h, q0, (const attn_body::bf16*)QU, (const attn_body::bf16*)KB, (const attn_body::bf16*)VB, (attn_body::bf16*)QU, (char*)lds);
            }
        }
        else if (k == 2) {
            pg8::Gemm g{QU, wl + WL_A, 1024, 512, 512, 512 * 2, (long)(WL_B - WL_A) * 2, 256, 0, 0};
            pg8::StaticOrder S; S.init(M_TOK / 256, 4, 2, G, bx); S.rev = (5 * l + 2) & 1;
            pg8::EpiMerge E{GA, GB};
            pg8::gemm_phase<pg8::EpiMerge, 2>(L, g, S, E);
        }
        else if (k == 3) {
            pg8::Gemm g{GA, wl + WL_MIX, 1024, 1024, 1024, 0, 0, 256, 0, 0};
            pg8::StaticOrder S; S.init(M_TOK / 256, 4, 1, G, bx); S.rev = (5 * l + 3) & 1;
            pg8::EpiRes E{x_prompt, x_sample, 0, out, XB, SSQ, 1, 0};
            pg8::gemm_phase<pg8::EpiRes, 1>(L, g, S, E);
        }
        else if (k == 4) {
            pg8::Gemm g{XB, wl + WL_UP, 1024, 1024, 1024, 0, 0, 252, 126, -1};
            pg8::StaticOrder S; S.init((M_TOK + 251) / 252, 16, 1, G, bx); S.rev = (5 * l + 4) & 1;
            pg8::EpiUp E{SSQ, conv_w + (size_t)l * 3 * 4096, conv_b + (size_t)l * 4096, H2};
            pg8::gemm_phase<pg8::EpiUp, 1>(L, g, S, E);
        }
        else {
            pg8::Gemm g{H2, wl + WL_DOWN, 2048, 2048, 2048, 0, 0, 256, 0, 0};
            pg8::StaticOrder S; S.init(M_TOK / 256, 4, 1, G, bx); S.rev = (5 * l + 5) & 1;
            pg8::EpiRes E{x_prompt, x_sample, 0, out, XB, SSQ, 1, 0};
            pg8::gemm_phase<pg8::EpiRes, 1>(L, g, S, E);
        }
    } else
    {
        f32x4 gv[4];
#pragma unroll
        for (int j = 0; j < 4; ++j) gv[j] = *(const f32x4*)(final_norm_g + 4 * lane + 256 * j);
        for (int m = gw; m < M_TOK; m += 2 * NGW) {
            const int m2 = (m + NGW < M_TOK) ? m + NGW : m;
            float* xr = out + (size_t)m * 1024; float* xr2 = out + (size_t)m2 * 1024;
            const bf16_t* br = XB + (size_t)m * 1024; const bf16_t* br2 = XB + (size_t)m2 * 1024;
            const float sp = (lane < 16) ? SSQ[(size_t)m * 16 + lane] : 0.f, sp2 = (lane < 16) ? SSQ[(size_t)m2 * 16 + lane] : 0.f;
            f32x4 v[4], w[4];
#pragma unroll
            for (int j = 0; j < 4; ++j) { const u32x2 p = *(const u32x2*)(br + 4 * lane + 256 * j), q = *(const u32x2*)(br2 + 4 * lane + 256 * j);
                v[j] = (f32x4){bf_lo(p.x), bf_hi(p.x), bf_lo(p.y), bf_hi(p.y)}; w[j] = (f32x4){bf_lo(q.x), bf_hi(q.x), bf_lo(q.y), bf_hi(q.y)}; }
            const float rs = __builtin_amdgcn_rsqf(wave_sum(sp) * (1.0f / DMOD) + EPS), rs2 = __builtin_amdgcn_rsqf(wave_sum(sp2) * (1.0f / DMOD) + EPS);
#pragma unroll
            for (int j = 0; j < 4; ++j) { *(f32x4*)(xr + 4 * lane + 256 * j) = v[j] * gv[j] * rs; if (m2 != m) *(f32x4*)(xr2 + 4 * lane + 256 * j) = w[j] * gv[j] * rs2; }
        }
    }
    }
}

extern "C" void kernel_launch(void* const* d_in, const int* in_sizes, int n_in, void* d_out, int out_size, void* d_ws, size_t ws_size, hipStream_t stream) {
    static int grid = 0;
    if (grid == 0) {
        if (n_in != 18 || out_size != M_TOK * DMOD || ws_size < WS_END) { fprintf(stderr, "kernel_launch: unexpected shapes (n_in %d out %d ws %zu)\n", n_in, out_size, ws_size); grid = -1; return; }
        int dev = 0, cus = 0, per_cu = 0;
        (void)hipGetDevice(&dev); (void)hipDeviceGetAttribute(&cus, hipDeviceAttributeMultiprocessorCount, dev);
        (void)hipFuncSetAttribute((const void*)fwd_megakernel, hipFuncAttributeMaxDynamicSharedMemorySize, LDS_BYTES);
        (void)hipOccupancyMaxActiveBlocksPerMultiprocessor(&per_cu, (const void*)fwd_megakernel, NWAVES * 64, LDS_BYTES);
        if (per_cu < 1) { fprintf(stderr, "kernel_launch: occupancy query says %d blocks/CU\n", per_cu); per_cu = 1; }
        (void)hipGetLastError();
        grid = cus * 1;
    }
    if (grid < 0) return;
    (void)hipMemsetAsync((char*)d_ws + WS_BAR, 0, BAR_BYTES, stream);
    Args a{};
    for (int i = 0; i < 18; ++i) a.in[i] = (const float*)d_in[i];
    a.out = (float*)d_out; a.ws = (unsigned char*)d_ws;
    if (N_LAUNCH_MODE == 0) {
        a.ph_lo = 0; a.ph_hi = N_PHASES;
        void* params[] = {&a};
        hipError_t e = hipLaunchCooperativeKernel((const void*)fwd_megakernel, dim3(grid), dim3(NWAVES * 64), params, LDS_BYTES, stream);
        if (e != hipSuccess) fprintf(stderr, "cooperative launch failed: %s (grid %d)\n", hipGetErrorString(e), grid);
    } else {
        for (int p = 0; p < N_PHASES; ++p) { a.ph_lo = p; a.ph_hi = p + 1;
            hipLaunchKernelGGL(fwd_megakernel, dim3(grid), dim3(NWAVES * 64), LDS_BYTES, stream, a); }
    }
}
```

```cpp
#include <hip/hip_runtime.h>
#include <hip/hip_cooperative_groups.h>
#include <hip/hip_bf16.h>
#include <cstdio>
#include <cstdint>
#include <cmath>
namespace cg = cooperative_groups;

constexpr int M_TOK = 98304, NPROMPT = 32768, SEQ_P = 8192, SEQ_S = 2048;
constexpr int DMOD = 1024, INW = 3840, DFF = 2048, NLAYER = 4;
constexpr float EPS = 1e-6f;
constexpr float C2 = 0.125f * 1.4426950408889634f;

#define LAS __attribute__((address_space(3)))
typedef unsigned short bf16_t;
typedef short bf16x8 __attribute__((ext_vector_type(8)));
typedef float f32x4 __attribute__((ext_vector_type(4)));
typedef float f32x2 __attribute__((ext_vector_type(2)));
typedef unsigned u32x4 __attribute__((ext_vector_type(4)));
typedef unsigned u32x2 __attribute__((ext_vector_type(2)));

typedef __bf16 bf16x2_t_ __attribute__((ext_vector_type(2)));
__device__ __forceinline__ unsigned cvt_pk_bf16(float lo, float hi) { f32x2 v = {lo, hi}; bf16x2_t_ b = __builtin_convertvector(v, bf16x2_t_); return __builtin_bit_cast(unsigned, b); }
__device__ __forceinline__ float bf_lo(unsigned w) { return __uint_as_float(w << 16); }
__device__ __forceinline__ float bf_hi(unsigned w) { return __uint_as_float(w & 0xffff0000u); }
__device__ __forceinline__ float gelu_t(float x) {
    const float u = x * (0.7978845608f + 0.0356774081f * x * x);
    const float e = __builtin_amdgcn_exp2f(u * -2.8853900818f);
    return x * __builtin_amdgcn_rcpf(1.0f + e);
}
__device__ __forceinline__ float sigmoid_f(float x) { return __builtin_amdgcn_rcpf(1.0f + __builtin_amdgcn_exp2f(x * -1.4426950409f)); }
__device__ __forceinline__ float dpp_shr1(float v) { return __int_as_float(__builtin_amdgcn_update_dpp(0, __float_as_int(v), 0x111, 0xF, 0xF, true)); }
__device__ __forceinline__ float dpp_shl1(float v) { return __int_as_float(__builtin_amdgcn_update_dpp(0, __float_as_int(v), 0x101, 0xF, 0xF, true)); }

namespace pg8 {
constexpr int BM = 256, BK = 64, HALF = 128, HTB = HALF * BK * 2, STAGE_BYTES = 8 * HTB, NXCD = 8, WGM = 8;
__host__ __device__ __forceinline__ int lds_byte(int r, int c) { const int st = (r >> 4) * 2 + (c >> 5), rr = r & 15, cc = c & 31, ob = rr * 64 + cc * 2; return st * 1024 + (ob ^ (((ob >> 9) & 1) << 5)); }
__host__ __device__ __forceinline__ void stage_rc(int b, int& R, int& C) { const int st = b / 1024, sb = b % 1024, swz = sb ^ (((sb >> 9) & 1) << 5); R = (st >> 1) * 16 + swz / 64; C = (st & 1) * 32 + (swz % 64) / 2; }

struct Unit { int pm, pn, part; };
struct Gemm { const bf16_t* A; const bf16_t* Bt; int lda, ldb, K; long partA, partB; int tstride, wstride, shift; };

struct StaticOrder {
    int nM, nN, nwg, G, c, parts, pn_lo, pn_split, pn_hi, rev;
    __device__ void init(int nM_, int nN_, int parts_, int G_, int c_, int pn_lo_ = 0, int pn_split_ = 1 << 20, int pn_hi_ = 0) { nM = nM_; nN = nN_; nwg = nM * nN; G = G_; c = c_; parts = parts_; pn_lo = pn_lo_; pn_split = pn_split_; pn_hi = pn_hi_; rev = 0; }
    __device__ bool next(int i, Unit& u) const {
        const int it = (parts == 2) ? (i >> 1) : i; u.part = (parts == 2) ? (i & 1) : 0;
        const long L = (long)it * G + c; if (L >= nwg) return false;
        int wgid = (int)L; { const int q = nwg / NXCD, r = nwg % NXCD, xcd = wgid % NXCD, off = wgid / NXCD; wgid = (xcd < r ? xcd * (q + 1) : r * (q + 1) + (xcd - r) * q) + off; }
        const int nig = WGM * nN, gid = wgid / nig, fm = gid * WGM, gsz = (nM - fm) < WGM ? (nM - fm) : WGM;
        u.pm = fm + ((wgid % nig) % gsz); if (rev) u.pm = nM - 1 - u.pm; { const int ix = (wgid % nig) / gsz; u.pn = ix < pn_split ? pn_lo + ix : pn_hi + (ix - pn_split); } return true;
    }
};

template <class Epi, int PARTS>
__device__ __forceinline__ void gemm_phase(LAS unsigned char* lds, const Gemm g, const StaticOrder& S, const Epi& E) {
    int tid_ = threadIdx.x; asm volatile("" : "+v"(tid_));
    const int tid = tid_, wid = __builtin_amdgcn_readfirstlane(tid >> 6), lane = tid & 63, wr = wid >> 2, wc = wid & 3, fr = lane & 15, fq = lane >> 4;
    const int K = g.K, nt = K / BK;
    unsigned voffA[2], voffB[2];
#pragma unroll
    for (int i = 0; i < 2; ++i) { int R, C; stage_rc(tid * 16 + i * 8192, R, C);
        const int TR = g.wstride ? g.wstride * (R >> 6) + 8 * (R & 15) + ((R >> 4) & 3) : R;
        voffA[i] = (unsigned)(TR * g.lda + C) * 2u; voffB[i] = (unsigned)(R * g.ldb + C) * 2u; }
    const size_t kstep = (size_t)(BK * 2);
    const size_t hstepA = (size_t)(g.wstride ? 4 : HALF) * g.lda * 2, hstepB = (size_t)HALF * g.ldb * 2;
    const unsigned ldsw = (unsigned)wid * 1024u;
    const int aoff = lds_byte(wr * 64 + fr, fq * 8), boff = lds_byte(wc * 32 + fr, fq * 8);
#define PG8_SA(b, h) (((b) * 2 + (h)) * HTB)
#define PG8_SB(b, h) ((4 + (b) * 2 + (h)) * HTB)
#define PG8_STAGE(bufoff, gbase, voff) do { _Pragma("unroll") for (int _i = 0; _i < 2; ++_i) \
        __builtin_amdgcn_global_load_lds((const unsigned*)((const char*)(gbase) + (voff)[_i]), (LAS unsigned*)(lds + (bufoff) + ldsw + _i * 8192), 16, 0, 0); } while (0)
#define PG8_STAGEA(bufoff, gbase, voff) do { _Pragma("unroll") for (int _i = 0; _i < 2; ++_i) \
        __builtin_amdgcn_global_load_lds((const unsigned*)((const char*)(gbase) + (voff)[_i]), (LAS unsigned*)(lds + (bufoff) + ldsw + _i * 8192), 16, 0, 0); } while (0)
#define PG8_LDA(dst, b, h) do { _Pragma("unroll") for (int m = 0; m < 4; ++m) _Pragma("unroll") for (int k = 0; k < 2; ++k) dst[m][k] = *(const LAS bf16x8*)(lds + PG8_SA(b, h) + aoff + m * 2048 + k * 1024); } while (0)
#define PG8_LDB(dst, b, h) do { _Pragma("unroll") for (int n = 0; n < 2; ++n) _Pragma("unroll") for (int k = 0; k < 2; ++k) dst[n][k] = *(const LAS bf16x8*)(lds + PG8_SB(b, h) + boff + n * 2048 + k * 1024); } while (0)
#define PG8_MMA(ai, bj, At, Bt) do { __builtin_amdgcn_s_setprio(1); _Pragma("unroll") for (int m = 0; m < 4; ++m) _Pragma("unroll") for (int n = 0; n < 2; ++n) _Pragma("unroll") for (int k = 0; k < 2; ++k) \
        acc[ai][bj][m][n] = __builtin_amdgcn_mfma_f32_16x16x32_bf16(Bt[n][k], At[m][k], acc[ai][bj][m][n], 0, 0, 0); __builtin_amdgcn_s_setprio(0); } while (0)
#define PG8_WAIT_V(n) asm volatile("s_waitcnt vmcnt(" #n ")" ::: "memory")
#define PG8_WAIT_L(n) asm volatile("s_waitcnt lgkmcnt(" #n ")" ::: "memory")
#define PG8_BAR __builtin_amdgcn_s_barrier()
#define PG8_SCHED __builtin_amdgcn_sched_barrier(0)
#define PG8_UA(u) ((const char*)g.A + (size_t)(u).part * g.partA + ((long)(u).pm * g.tstride + g.shift) * (long)g.lda * 2)
#define PG8_UB(u) ((const char*)g.Bt + (size_t)(u).part * g.partB + (size_t)(u).pn * 256 * g.ldb * 2)
    Unit cur, nxt; int ui = 0;
    if (!S.next(0, cur)) return;
    f32x4 acc[2][2][4][2];
#pragma unroll
    for (int a = 0; a < 2; ++a)
#pragma unroll
        for (int b = 0; b < 2; ++b)
#pragma unroll
            for (int m = 0; m < 4; ++m)
#pragma unroll
                for (int n = 0; n < 2; ++n) acc[a][b][m][n] = (f32x4){0.f, 0.f, 0.f, 0.f};
    bf16x8 At[4][2], B0[2][2], B1[2][2];
    const char* cA = PG8_UA(cur); const char* cB = PG8_UB(cur);
    PG8_STAGE(PG8_SB(0, 0), cB, voffB); PG8_STAGE(PG8_SB(0, 1), cB + hstepB, voffB); PG8_STAGEA(PG8_SA(0, 0), cA, voffA); PG8_STAGEA(PG8_SA(0, 1), cA + hstepA, voffA);
    if (wr == 1) PG8_BAR;
    PG8_WAIT_V(2); PG8_BAR;
    PG8_STAGE(PG8_SB(1, 0), cB + kstep, voffB); PG8_STAGEA(PG8_SA(1, 0), cA + kstep, voffA); PG8_STAGE(PG8_SB(1, 1), cB + hstepB + kstep, voffB);
    PG8_WAIT_V(6); PG8_BAR;
    for (;;) {
        const bool has_next = S.next(ui + 1, nxt);
        const char* nA = has_next ? PG8_UA(nxt) : cA; const char* nB = has_next ? PG8_UB(nxt) : cB;
        for (int t = 0; t < nt; t += 2) {
            const bool last = (t == nt - 2);
            const char* a1 = cA + (size_t)(t + 1) * kstep;
            const char* a2 = last ? nA : cA + (size_t)(t + 2) * kstep; const char* b2 = last ? nB : cB + (size_t)(t + 2) * kstep;
            const char* a3 = a2 + kstep; const char* b3 = b2 + kstep;
            PG8_LDB(B0, 0, 0); PG8_LDB(B1, 0, 1); PG8_SCHED; PG8_LDA(At, 0, 0); PG8_STAGEA(PG8_SA(1, 1), a1 + hstepA, voffA);
            PG8_WAIT_V(8); PG8_WAIT_L(0); PG8_BAR; PG8_MMA(0, 0, At, B0); PG8_MMA(0, 1, At, B1); PG8_BAR; PG8_SCHED;
            PG8_LDA(At, 0, 1); PG8_STAGE(PG8_SB(0, 0), b2, voffB); PG8_STAGE(PG8_SB(0, 1), b2 + hstepB, voffB); PG8_STAGEA(PG8_SA(0, 0), a2, voffA);
            PG8_WAIT_V(8); PG8_WAIT_L(0); PG8_BAR; PG8_MMA(1, 0, At, B0); PG8_MMA(1, 1, At, B1); PG8_BAR; PG8_SCHED;
            PG8_LDB(B0, 1, 0); PG8_LDB(B1, 1, 1); PG8_SCHED; PG8_LDA(At, 1, 0); PG8_STAGEA(PG8_SA(0, 1), a2 + hstepA, voffA);
            PG8_WAIT_V(8); PG8_WAIT_L(0); PG8_BAR; PG8_MMA(0, 0, At, B0); PG8_MMA(0, 1, At, B1); PG8_BAR; PG8_SCHED;
            PG8_LDA(At, 1, 1); PG8_STAGE(PG8_SB(1, 0), b3, voffB); PG8_STAGE(PG8_SB(1, 1), b3 + hstepB, voffB); PG8_STAGEA(PG8_SA(1, 0), a3, voffA);
            PG8_WAIT_V(8); PG8_WAIT_L(0); PG8_BAR; PG8_MMA(1, 0, At, B0); PG8_MMA(1, 1, At, B1); PG8_BAR; PG8_SCHED;
        }
        if (wr == 0) PG8_BAR;
        E(acc, cur, wr, wc, fr, fq);
        if (!has_next) break;
        if (PARTS == 1 || nxt.part == 0) {
#pragma unroll
        for (int a = 0; a < 2; ++a)
#pragma unroll
            for (int b = 0; b < 2; ++b)
#pragma unroll
                for (int m = 0; m < 4; ++m)
#pragma unroll
                    for (int n = 0; n < 2; ++n) acc[a][b][m][n] = (f32x4){0.f, 0.f, 0.f, 0.f};
        }
        cur = nxt; cA = nA; cB = nB; ++ui;
        if (wr == 1) PG8_BAR;
    }
    PG8_WAIT_V(0);
    PG8_BAR;
#undef PG8_SA
#undef PG8_SB
#undef PG8_STAGE
#undef PG8_STAGEA
#undef PG8_LDA
#undef PG8_LDB
#undef PG8_MMA
#undef PG8_WAIT_V
#undef PG8_WAIT_L
#undef PG8_BAR
#undef PG8_SCHED
#undef PG8_UA
#undef PG8_UB
}

__device__ __forceinline__ void load_rs8(const float* ss, int t0, int fq, float (&rs)[8], int tmax) {
#pragma unroll
    for (int j = 0; j < 8; ++j) { int t = t0 + j; t = t < 0 ? 0 : (t > tmax ? tmax : t);
        const f32x4 p = *(const f32x4*)(ss + (size_t)t * 16 + 4 * fq); float s = (p.x + p.y) + (p.z + p.w);
        s += __shfl_xor(s, 16); s += __shfl_xor(s, 32); rs[j] = __builtin_amdgcn_rsqf(s * (1.0f / DMOD) + EPS); }
}

struct EpiQKV {
    const float* ss; const float* qg; const float* kg; const float* rope;
    bf16_t* QU; bf16_t* Kb; bf16_t* Vb;
    __device__ __forceinline__ void operator()(f32x4 (&acc)[2][2][4][2], const Unit& u, int wr, int wc, int fr, int fq) const {
        const int t0 = u.pm * 256 + wr * 128 + fr * 8;
        { float rs[8]; load_rs8(ss, t0, fq, rs, M_TOK - 1);
#pragma unroll
          for (int ai = 0; ai < 2; ++ai)
#pragma unroll
            for (int m = 0; m < 4; ++m)
#pragma unroll
                for (int bj = 0; bj < 2; ++bj)
#pragma unroll
                    for (int n = 0; n < 2; ++n) acc[ai][bj][m][n] = acc[ai][bj][m][n] * rs[4 * ai + m]; }
        const int pn = u.pn;
        {
            const bool isq = pn < 2;
            if (isq || wc < 2) {
                const float* gp = isq ? qg : kg; const float osc = isq ? C2 : 1.0f;
                f32x4 gv[2][2];
#pragma unroll
                for (int bj = 0; bj < 2; ++bj)
#pragma unroll
                    for (int n = 0; n < 2; ++n) gv[bj][n] = *(const f32x4*)(gp + 32 * bj + 16 * n + 4 * fq);
                const int smask = (t0 < NPROMPT) ? (SEQ_P - 1) : (SEQ_S - 1);
                const int prow = (t0 & smask) >> 6;
                const f32x4 rr0 = *(const f32x4*)(rope + (prow * 16 + 4 * fq) * 2), rr1 = *(const f32x4*)(rope + (prow * 16 + 4 * fq) * 2 + 4);
                bf16_t* dst = isq ? (QU + (size_t)t0 * 1024 + (4 * pn + wc) * 64) : (Kb + (size_t)t0 * 128 + wc * 64);
                const int pitch = isq ? 1024 : 128;
#pragma unroll
                for (int ai = 0; ai < 2; ++ai)
#pragma unroll
                    for (int m = 0; m < 4; ++m) {
                        const int j = 4 * ai + m;
                        float sq = 0.f;
#pragma unroll
                        for (int bj = 0; bj < 2; ++bj)
#pragma unroll
                            for (int n = 0; n < 2; ++n) { const f32x4 v = acc[ai][bj][m][n]; sq += (v.x * v.x + v.y * v.y) + (v.z * v.z + v.w * v.w); }
                        sq += __shfl_xor(sq, 16); sq += __shfl_xor(sq, 32);
                        const float rn = __builtin_amdgcn_rsqf(sq * (1.0f / 64.0f) + EPS) * osc;
                        const int pcol = (t0 + j) & 63;
                        const f32x4 cc0 = *(const f32x4*)(rope + (pcol * 16 + 4 * fq) * 2), cc1 = *(const f32x4*)(rope + (pcol * 16 + 4 * fq) * 2 + 4);
#pragma unroll
                        for (int bj = 0; bj < 2; ++bj) {
                            const f32x4 t0v = bj == 0 ? rr0 : cc0, t1v = bj == 0 ? rr1 : cc1;
                            const f32x4 x1 = acc[ai][bj][m][0] * gv[bj][0] * rn, x2 = acc[ai][bj][m][1] * gv[bj][1] * rn;
                            const f32x4 cs = (f32x4){t0v.x, t0v.z, t1v.x, t1v.z}, sn = (f32x4){t0v.y, t0v.w, t1v.y, t1v.w};
                            const f32x4 o1 = x1 * cs - x2 * sn, o2 = x1 * sn + x2 * cs;
                            u32x2 w1, w2; w1.x = cvt_pk_bf16(o1.x, o1.y); w1.y = cvt_pk_bf16(o1.z, o1.w); w2.x = cvt_pk_bf16(o2.x, o2.y); w2.y = cvt_pk_bf16(o2.z, o2.w);
                            bf16_t* p = dst + (size_t)j * pitch + 32 * bj + 4 * fq;
                            *(u32x2*)p = w1; *(u32x2*)(p + 16) = w2;
                        }
                    }
            } else {
                bf16_t* dst = Vb + (size_t)t0 * 128 + (wc - 2) * 64;
#pragma unroll
                for (int ai = 0; ai < 2; ++ai)
#pragma unroll
                    for (int m = 0; m < 4; ++m)
#pragma unroll
                        for (int bj = 0; bj < 2; ++bj)
#pragma unroll
                            for (int n = 0; n < 2; ++n) { const f32x4 v = acc[ai][bj][m][n]; u32x2 w; w.x = cvt_pk_bf16(v.x, v.y); w.y = cvt_pk_bf16(v.z, v.w);
                                *(u32x2*)(dst + (size_t)(4 * ai + m) * 128 + 32 * bj + 16 * n + 4 * fq) = w; }
            }
        }
    }
};
struct EpiVS {
    const float* ss; bf16_t* VST; float* ssg;
    __device__ __forceinline__ void operator()(f32x4 (&acc)[2][2][4][2], const Unit& u, int wr, int wc, int fr, int fq) const {
        const int t0 = u.pm * 256 + wr * 128 + fr * 8;
        { float rs[8]; load_rs8(ss, t0, fq, rs, M_TOK - 1);
#pragma unroll
          for (int ai = 0; ai < 2; ++ai)
#pragma unroll
            for (int m = 0; m < 4; ++m)
#pragma unroll
                for (int bj = 0; bj < 2; ++bj)
#pragma unroll
                    for (int n = 0; n < 2; ++n) acc[ai][bj][m][n] = acc[ai][bj][m][n] * rs[4 * ai + m]; }
        const int pn = u.pn;
        {
            const int chunk = 2 * u.pm + wr;
            bf16_t* dst = VST + ((size_t)chunk * 512 + 256 * (pn - 5) + 32 * wc + 8 * fq) * 128 + 8 * fr;
#pragma unroll
            for (int ai = 0; ai < 2; ++ai)
#pragma unroll
                for (int m = 0; m < 4; ++m) {
                    float sq = 0.f;
#pragma unroll
                    for (int bj = 0; bj < 2; ++bj)
#pragma unroll
                        for (int n = 0; n < 2; ++n) { f32x4 v = acc[ai][bj][m][n]; v = (f32x4){gelu_t(v.x), gelu_t(v.y), gelu_t(v.z), gelu_t(v.w)}; acc[ai][bj][m][n] = v;
                            sq += (v.x * v.x + v.y * v.y) + (v.z * v.z + v.w * v.w); }
                    sq += __shfl_xor(sq, 16); sq += __shfl_xor(sq, 32);
                    if (fq == 0) ssg[(size_t)(t0 + 4 * ai + m) * 8 + 4 * (pn - 5) + wc] = sq;
                    asm volatile("" : "+v"(acc[ai][0][m][0]), "+v"(acc[ai][0][m][1]), "+v"(acc[ai][1][m][0]), "+v"(acc[ai][1][m][1]));
                }
#pragma unroll
            for (int bj = 0; bj < 2; ++bj)
#pragma unroll
                for (int n = 0; n < 2; ++n)
#pragma unroll
                    for (int i = 0; i < 4; ++i) {
                        u32x4 w; w.x = cvt_pk_bf16(acc[0][bj][0][n][i], acc[0][bj][1][n][i]); w.y = cvt_pk_bf16(acc[0][bj][2][n][i], acc[0][bj][3][n][i]);
                        w.z = cvt_pk_bf16(acc[1][bj][0][n][i], acc[1][bj][1][n][i]); w.w = cvt_pk_bf16(acc[1][bj][2][n][i], acc[1][bj][3][n][i]);
                        *(u32x4*)(dst + (size_t)(128 * bj + 4 * n + i) * 128) = w;
                    }
        }
    }
};
struct EpiEW {
    const float* ss; bf16_t* QU; bf16_t* GA; bf16_t* GB;
    __device__ __forceinline__ void operator()(f32x4 (&acc)[2][2][4][2], const Unit& u, int wr, int wc, int fr, int fq) const {
        const int t0 = u.pm * 256 + wr * 128 + fr * 8;
        float rs[8]; load_rs8(ss, t0, fq, rs, M_TOK - 1);
        const int pn = u.pn;
        const bool isu = pn < 5;
        bf16_t* dst = QU + 512 + 256 * (pn - 3) + (size_t)t0 * 1024 + 32 * wc + 8 * fq;
        if (isu) {
#pragma unroll
            for (int ai = 0; ai < 2; ++ai)
#pragma unroll
                for (int m = 0; m < 4; ++m)
#pragma unroll
                    for (int bj = 0; bj < 2; ++bj) { const f32x4 a = acc[ai][bj][m][0] * rs[4 * ai + m], b = acc[ai][bj][m][1] * rs[4 * ai + m]; u32x4 w;
                        w.x = cvt_pk_bf16(gelu_t(a.x), gelu_t(a.y)); w.y = cvt_pk_bf16(gelu_t(a.z), gelu_t(a.w)); w.z = cvt_pk_bf16(gelu_t(b.x), gelu_t(b.y)); w.w = cvt_pk_bf16(gelu_t(b.z), gelu_t(b.w));
                        *(u32x4*)(dst + (size_t)(4 * ai + m) * 1024 + 128 * bj) = w; }
        } else {
            bf16_t* da = GA + (size_t)t0 * 1024 + 128 * (pn - 7) + 32 * wc + 8 * fq; bf16_t* db = GB + (size_t)t0 * 1024 + 128 * (pn - 7) + 32 * wc + 8 * fq;
#pragma unroll
            for (int ai = 0; ai < 2; ++ai)
#pragma unroll
                for (int m = 0; m < 4; ++m) { const float k2 = rs[4 * ai + m] * -1.4426950409f; u32x4 wa, wb; float sa[8], rt[8];
#pragma unroll
                    for (int n = 0; n < 2; ++n)
#pragma unroll
                        for (int i = 0; i < 4; ++i) { const float ea = 1.0f + __builtin_amdgcn_exp2f(acc[ai][0][m][n][i] * k2), eb = 1.0f + __builtin_amdgcn_exp2f(acc[ai][1][m][n][i] * k2);
                            sa[4 * n + i] = __builtin_amdgcn_rcpf(ea); rt[4 * n + i] = ea * __builtin_amdgcn_rcpf(eb); }
                    wa.x = cvt_pk_bf16(sa[0], sa[1]); wa.y = cvt_pk_bf16(sa[2], sa[3]); wa.z = cvt_pk_bf16(sa[4], sa[5]); wa.w = cvt_pk_bf16(sa[6], sa[7]);
                    wb.x = cvt_pk_bf16(rt[0], rt[1]); wb.y = cvt_pk_bf16(rt[2], rt[3]); wb.z = cvt_pk_bf16(rt[4], rt[5]); wb.w = cvt_pk_bf16(rt[6], rt[7]);
                    *(u32x4*)(da + (size_t)(4 * ai + m) * 1024) = wa; *(u32x4*)(db + (size_t)(4 * ai + m) * 1024) = wb; }
        }
    }
};

struct EpiMerge {
    bf16_t* GA; const bf16_t* GB;
    __device__ __forceinline__ void operator()(f32x4 (&acc)[2][2][4][2], const Unit& u, int wr, int wc, int fr, int fq) const {
        const int t0 = u.pm * 256 + wr * 64 + fr;
        const size_t off0 = (size_t)t0 * 1024 + 256 * u.pn + 32 * wc + 8 * fq;
        const bf16_t* src = (u.part == 0) ? GB : (const bf16_t*)GA;
#pragma unroll
        for (int ai = 0; ai < 2; ++ai)
#pragma unroll
            for (int m = 0; m < 4; ++m)
#pragma unroll
                for (int bj = 0; bj < 2; ++bj) {
                    const size_t off = off0 + (size_t)(128 * ai + 16 * m) * 1024 + 128 * bj;
                    const u32x4 g = *(const u32x4*)(src + off);
                    const f32x4 s0 = (f32x4){bf_lo(g.x), bf_hi(g.x), bf_lo(g.y), bf_hi(g.y)}, s1 = (f32x4){bf_lo(g.z), bf_hi(g.z), bf_lo(g.w), bf_hi(g.w)};
                    const f32x4 v0 = acc[ai][bj][m][0] * s0, v1 = acc[ai][bj][m][1] * s1;
                    if (u.part == 0) { acc[ai][bj][m][0] = v0; acc[ai][bj][m][1] = v1; }
                    else { u32x4 w; w.x = cvt_pk_bf16(v0.x, v0.y); w.y = cvt_pk_bf16(v0.z, v0.w); w.z = cvt_pk_bf16(v1.x, v1.y); w.w = cvt_pk_bf16(v1.z, v1.w);
                        *(u32x4*)(GA + off) = w; }
                }
    }
};

struct EpiRes {
    const float* xp; const float* xs; int first; float* out; bf16_t* xb; float* ss; int bb; int wout;
    __device__ __forceinline__ void operator()(f32x4 (&acc)[2][2][4][2], const Unit& u, int wr, int wc, int fr, int fq) const {
        const int t0 = u.pm * 256 + wr * 64 + fr;
        const int col0 = 256 * u.pn + 32 * wc + 8 * fq;
        const float* bp0 = first ? ((t0 < NPROMPT) ? xp + (size_t)t0 * 1024 : xs + (size_t)(t0 - NPROMPT) * 1024) : out + (size_t)t0 * 1024;
#pragma unroll
        for (int ai = 0; ai < 2; ++ai)
#pragma unroll
            for (int m = 0; m < 4; ++m) {
                const int j = 128 * ai + 16 * m; float sq = 0.f;
#pragma unroll
                for (int bj = 0; bj < 2; ++bj) {
                    const size_t o = (size_t)j * 1024 + col0 + 128 * bj;
                    f32x4 a, b;
                    if (bb) { const u32x4 w = *(const u32x4*)(xb + (size_t)t0 * 1024 + o);
                        a = (f32x4){bf_lo(w.x), bf_hi(w.x), bf_lo(w.y), bf_hi(w.y)}; b = (f32x4){bf_lo(w.z), bf_hi(w.z), bf_lo(w.w), bf_hi(w.w)}; }
                    else { a = *(const f32x4*)(bp0 + o); b = *(const f32x4*)(bp0 + o + 4); }
                    a = a + acc[ai][bj][m][0]; b = b + acc[ai][bj][m][1];
                    if (wout) { float* op = out + (size_t)t0 * 1024 + o; *(f32x4*)op = a; *(f32x4*)(op + 4) = b; }
                    u32x4 w; w.x = cvt_pk_bf16(a.x, a.y); w.y = cvt_pk_bf16(a.z, a.w); w.z = cvt_pk_bf16(b.x, b.y); w.w = cvt_pk_bf16(b.z, b.w);
                    *(u32x4*)(xb + (size_t)t0 * 1024 + o) = w;
                    sq += (a.x * a.x + a.y * a.y) + (a.z * a.z + a.w * a.w) + (b.x * b.x + b.y * b.y) + (b.z * b.z + b.w * b.w);
                }
                sq += __shfl_xor(sq, 16); sq += __shfl_xor(sq, 32);
                if (fq == 0) ss[(size_t)(t0 + j) * 16 + 4 * u.pn + wc] = sq;
            }
    }
};

struct EpiUp {
    const float* ss; const float* cw; const float* cb; bf16_t* H2;
    __device__ __forceinline__ void operator()(f32x4 (&acc)[2][2][4][2], const Unit& u, int wr, int wc, int fr, int fq) const {
        const int t0 = u.pm * 252 - 1 + wr * 126 + fr * 8;
        { float rs[8]; load_rs8(ss, t0, fq, rs, M_TOK - 1);
#pragma unroll
          for (int ai = 0; ai < 2; ++ai)
#pragma unroll
            for (int m = 0; m < 4; ++m)
#pragma unroll
                for (int bj = 0; bj < 2; ++bj)
#pragma unroll
                    for (int n = 0; n < 2; ++n) acc[ai][bj][m][n] = acc[ai][bj][m][n] * rs[4 * ai + m]; }
        unsigned vmask = 0, smask = 0, emask = 0;
#pragma unroll
        for (int j = 0; j < 8; ++j) { const int t = t0 + j, loc = fr * 8 + j;
            if (loc >= 1 && loc <= 126 && t < M_TOK) vmask |= 1u << j;
            const int sm = (t < NPROMPT) ? (SEQ_P - 1) : (SEQ_S - 1);
            if ((t & sm) == 0) smask |= 1u << j;
            if ((t & sm) == sm) emask |= 1u << j; }
#pragma unroll
        for (int n = 0; n < 2; ++n) {
            const int cg_ = 128 * u.pn + 32 * wc + 8 * fq + 4 * n;
            const f32x4 w0g = *(const f32x4*)(cw + cg_), w1g = *(const f32x4*)(cw + 4096 + cg_), w2g = *(const f32x4*)(cw + 8192 + cg_), bg = *(const f32x4*)(cb + cg_);
            const f32x4 w0v = *(const f32x4*)(cw + 2048 + cg_), w1v = *(const f32x4*)(cw + 4096 + 2048 + cg_), w2v = *(const f32x4*)(cw + 8192 + 2048 + cg_), bv = *(const f32x4*)(cb + 2048 + cg_);
            float h[8][4];
#pragma unroll
            for (int i = 0; i < 4; ++i) {
                float ag[8], av[8];
#pragma unroll
                for (int j = 0; j < 8; ++j) { ag[j] = acc[j >> 2][0][j & 3][n][i]; av[j] = acc[j >> 2][1][j & 3][n][i]; }
                const float lg = dpp_shr1(ag[7]), rg = dpp_shl1(ag[0]), lv = dpp_shr1(av[7]), rv = dpp_shl1(av[0]);
#pragma unroll
                for (int j = 0; j < 8; ++j) {
                    float Lg = j == 0 ? lg : ag[j == 0 ? 0 : j - 1], Rg = j == 7 ? rg : ag[j == 7 ? 7 : j + 1];
                    float Lv = j == 0 ? lv : av[j == 0 ? 0 : j - 1], Rv = j == 7 ? rv : av[j == 7 ? 7 : j + 1];
                    if ((smask >> j) & 1u) { Lg = 0.f; Lv = 0.f; }
                    if ((emask >> j) & 1u) { Rg = 0.f; Rv = 0.f; }
                    const float cgv = w0g[i] * Lg + w1g[i] * ag[j] + w2g[i] * Rg + bg[i];
                    const float cvv = w0v[i] * Lv + w1v[i] * av[j] + w2v[i] * Rv + bv[i];
                    h[j][i] = gelu_t(cgv) * cvv;
                }
            }
#pragma unroll
            for (int j = 0; j < 8; ++j) if ((vmask >> j) & 1u) { u32x2 w; w.x = cvt_pk_bf16(h[j][0], h[j][1]); w.y = cvt_pk_bf16(h[j][2], h[j][3]);
                *(u32x2*)(H2 + (size_t)(t0 + j) * 2048 + cg_) = w; }
        }
    }
};
}

namespace attn_body {
using bf16=__hip_bfloat16;
using bf16x8=__attribute__((ext_vector_type(8)))short;
using s16x4=__attribute__((ext_vector_type(4)))short;
using f32x16=__attribute__((ext_vector_type(16)))float;
using u32x4=__attribute__((ext_vector_type(4)))unsigned;
constexpr int D=64,QP=1024,KP=128;
constexpr int NW=8,QBLK=32,QB=QBLK*NW,KVBLK=64;
__device__ __forceinline__ int crow(int r,int hi){return (r&3)+8*(r>>2)+4*hi;}
#define SBAR() __builtin_amdgcn_sched_barrier(0)
constexpr int NSLOT=3, SLOTB=8192;
constexpr int LDS_K=0, LDS_V=NSLOT*SLOTB, LDS_WS=2*NSLOT*SLOTB, LDS_OST=LDS_WS+NW*64*4, LDS_BYTES=LDS_OST+NW*4096;
__device__ __forceinline__ void glds16(const void*gsrc,unsigned lds_dst){unsigned keep;
  asm volatile("s_mov_b32 %0, m0\n\ts_mov_b32 m0, %2\n\ts_nop 0\n\tglobal_load_lds_dwordx4 %1, off\n\ts_mov_b32 m0, %0":"=&s"(keep):"v"(gsrc),"s"(lds_dst):"memory");}
__device__ __forceinline__ float max3f(float a,float b,float c){float r;asm("v_max3_f32 %0, %1, %2, %3":"=v"(r):"v"(a),"v"(b),"v"(c));return r;}
__device__ __forceinline__ float max2f(float a,float b){float r;asm("v_max_f32_e32 %0, %1, %2":"=v"(r):"v"(a),"v"(b));return r;}
__device__ __forceinline__ float fadd_s(float a,float b){float r;asm("v_add_f32_e32 %0, %1, %2":"=v"(r):"v"(a),"v"(b));return r;}
__device__ __forceinline__ float fsub_s(float a,float b){float r;asm("v_sub_f32_e32 %0, %1, %2":"=v"(r):"v"(a),"v"(b));return r;}
typedef float f32x2_t __attribute__((ext_vector_type(2))); typedef __bf16 bf16x2_t __attribute__((ext_vector_type(2)));
__device__ __forceinline__ unsigned cvtpk_s(float lo,float hi){f32x2_t v={lo,hi};bf16x2_t b=__builtin_convertvector(v,bf16x2_t);return __builtin_bit_cast(unsigned,b);}
#define WAIT_BAR(N) asm volatile("s_waitcnt vmcnt(" #N ") lgkmcnt(0)\n\ts_barrier":::"memory")
__device__ __forceinline__ void qkt(f32x16&p0,f32x16&p1,const char*Kslot,const bf16x8*qr,const f32x16&negm,int r32,int hi){
  const char*kb=Kslot+hi*1024+r32*16;
  #pragma unroll
  for(int d0=0;d0<4;++d0){
    const bf16x8 b0=*reinterpret_cast<const bf16x8*>(kb+d0*2048);
    const bf16x8 b1=*reinterpret_cast<const bf16x8*>(kb+d0*2048+512);
    if(d0==0){p0=__builtin_amdgcn_mfma_f32_32x32x16_bf16(b0,qr[0],negm,0,0,0);p1=__builtin_amdgcn_mfma_f32_32x32x16_bf16(b1,qr[0],negm,0,0,0);}
    else{p0=__builtin_amdgcn_mfma_f32_32x32x16_bf16(b0,qr[d0],p0,0,0,0);p1=__builtin_amdgcn_mfma_f32_32x32x16_bf16(b1,qr[d0],p1,0,0,0);}}
}
typedef __attribute__((address_space(3))) const char* lds_cptr;
typedef short v4i16_t __attribute__((ext_vector_type(4)));
__device__ __forceinline__ void kload8(bf16x8*kf,lds_cptr kp){
  kf[0]=*(const __attribute__((address_space(3))) bf16x8*)(kp);      kf[1]=*(const __attribute__((address_space(3))) bf16x8*)(kp+512);
  kf[2]=*(const __attribute__((address_space(3))) bf16x8*)(kp+2048); kf[3]=*(const __attribute__((address_space(3))) bf16x8*)(kp+2560);
  kf[4]=*(const __attribute__((address_space(3))) bf16x8*)(kp+4096); kf[5]=*(const __attribute__((address_space(3))) bf16x8*)(kp+4608);
  kf[6]=*(const __attribute__((address_space(3))) bf16x8*)(kp+6144); kf[7]=*(const __attribute__((address_space(3))) bf16x8*)(kp+6656);
}
__device__ __forceinline__ void kload2(bf16x8*kf,lds_cptr kp,int j){ kf[2*j]=*(const __attribute__((address_space(3))) bf16x8*)(kp+j*2048); kf[2*j+1]=*(const __attribute__((address_space(3))) bf16x8*)(kp+j*2048+512); }
__device__ __forceinline__ s16x4 vtr(lds_cptr p){ return __builtin_bit_cast(s16x4,__builtin_amdgcn_ds_read_tr16_b64_v4i16((__attribute__((address_space(3))) v4i16_t*)p)); }
__device__ __forceinline__ float rowmax(const f32x16&p0,const f32x16&p1){
  float a=max3f(p0[0],p0[1],p1[0]),b=max3f(p0[2],p0[3],p1[1]);a=max3f(a,p1[2],p1[3]);
  #pragma unroll
  for(int r=4;r<16;r+=4){a=max3f(a,p0[r],p0[r+1]);b=max3f(b,p0[r+2],p0[r+3]);a=max3f(a,p1[r],p1[r+1]);b=max3f(b,p1[r+2],p1[r+3]);}
  const float m=max2f(a,b);
  auto rr=__builtin_amdgcn_permlane32_swap(__float_as_uint(m),__float_as_uint(m),false,false);
  return max2f(__uint_as_float(rr[0]),__uint_as_float(rr[1]));
}
__device__ __forceinline__ void pv(f32x16*o,int vb,bf16x8 pa0,bf16x8 pa1,bf16x8 pa2,bf16x8 pa3){
  #pragma unroll
  for(int d0=0;d0<2;++d0){s16x4 lo[4],hi[4];
    #pragma unroll
    for(int ks=0;ks<4;++ks){
      asm volatile("ds_read_b64_tr_b16 %0,%1 offset:%c2":"=&v"(lo[ks]):"v"(vb),"i"(d0*4096+ks*1024):"memory");
      asm volatile("ds_read_b64_tr_b16 %0,%1 offset:%c2":"=&v"(hi[ks]):"v"(vb),"i"(d0*4096+ks*1024+512):"memory");}
    asm volatile("s_waitcnt lgkmcnt(0)":::"memory");SBAR();
    #define PK(k) (bf16x8){lo[k][0],lo[k][1],lo[k][2],lo[k][3],hi[k][0],hi[k][1],hi[k][2],hi[k][3]}
    o[d0]=__builtin_amdgcn_mfma_f32_32x32x16_bf16(pa0,PK(0),o[d0],0,0,0);
    o[d0]=__builtin_amdgcn_mfma_f32_32x32x16_bf16(pa1,PK(1),o[d0],0,0,0);
    o[d0]=__builtin_amdgcn_mfma_f32_32x32x16_bf16(pa2,PK(2),o[d0],0,0,0);
    o[d0]=__builtin_amdgcn_mfma_f32_32x32x16_bf16(pa3,PK(3),o[d0],0,0,0);
    #undef PK
  }
}
template<int THRL> __device__ __forceinline__ void attn_unit(long rowbase,int seq,int h,int q0,const bf16*Q,const bf16*__restrict__ K,const bf16*__restrict__ V,bf16*O,char*shm){
  int tid_=threadIdx.x; asm volatile("":"+v"(tid_));
  const int tid=tid_,lane=tid&63,r32=lane&31,hi=lane>>5; const int wid=__builtin_amdgcn_readfirstlane(tid>>6);
  const bf16*Qw=Q+(rowbase+q0+wid*QBLK)*QP+h*D;
  const bf16*Kh=K+rowbase*KP+(h>>2)*D,*Vh=V+rowbase*KP+(h>>2)*D;
  const unsigned lds0=(unsigned)(uintptr_t)shm;
  float*wsf=(float*)(shm+LDS_WS)+wid*64;
  const bf16*ksrc=Kh+(long)lane*KP+wid*8;
  const bf16*vsrc=Vh+(long)(16*(wid&3)+(lane>>2))*KP+(wid>>2)*32+(lane&3)*8;
  const unsigned kdst=lds0+LDS_K+wid*1024, vdst=lds0+LDS_V+wid*1024;
  #define DMA_K(t,slot) glds16(ksrc+(long)(t)*KVBLK*KP,(unsigned)__builtin_amdgcn_readfirstlane(kdst+(slot)))
  #define DMA_V(t,slot) glds16(vsrc+(long)(t)*KVBLK*KP,(unsigned)__builtin_amdgcn_readfirstlane(vdst+(slot)))
  const int vb0=(int)(lds0+LDS_V)+((lane>>4)&1)*32+(lane&3)*8+(4*hi+((lane&15)>>2))*64;
  const char*Kbase=shm+LDS_K; bf16x8 kf[8];
  const lds_cptr shm3=(lds_cptr)shm; const lds_cptr kp0=shm3+LDS_K+hi*1024+r32*16; const lds_cptr vp0=shm3+LDS_V+((lane>>4)&1)*32+(lane&3)*8+(4*hi+((lane&15)>>2))*64;
  const int NT=seq/KVBLK;
  DMA_K(0,0);DMA_V(0,0);DMA_K(1,SLOTB);
  bf16x8 qr[4];
  #pragma unroll
  for(int d0=0;d0<4;++d0)qr[d0]=*reinterpret_cast<const bf16x8*>(&Qw[(long)r32*QP+d0*16+hi*8]);
  float mhat=0.f,l_reg=0.f;f32x16 o[2];o[0]=f32x16{};o[1]=f32x16{};f32x16 negm=f32x16{};asm volatile("":"+v"(negm));
  bool resc=false;
  #define START(P0,P1) do{ const float rm=rowmax(P0,P1); resc=false; \
    { const float dl=rm; mhat=fadd_s(mhat,dl); \
      _Pragma("unroll") for(int r=0;r<16;++r){P0[r]=fsub_s(P0[r],dl);P1[r]=fsub_s(P1[r],dl);} \
      _Pragma("unroll") for(int r=0;r<16;++r)negm[r]=-mhat; asm volatile("":"+v"(negm)); } \
    _Pragma("unroll") for(int r=0;r<16;++r)P0[r]=__builtin_amdgcn_exp2f(P0[r]); }while(0)
  #define RESC() do{ if(resc){ asm volatile("s_waitcnt lgkmcnt(0)":::"memory"); \
      _Pragma("unroll") for(int d_=0;d_<2;++d_) _Pragma("unroll") for(int r=0;r<16;++r)o[d_][r]*=wsf[crow(r,hi)]; } }while(0)
  f32x16 pA0,pA1,pB0,pB1;
  int sl_prev=0,sl_cur=0,sl_next=SLOTB;
  #define ROT() do{sl_prev=sl_cur;sl_cur=sl_next;sl_next=(sl_next==(NSLOT-1)*SLOTB)?0:sl_next+SLOTB;}while(0)
  DMA_K(2,2*SLOTB);
  WAIT_BAR(3);
  qkt(pA0,pA1,Kbase,qr,negm,r32,hi);asm volatile("s_nop 15\n\ts_nop 7":"+v"(pA0),"+v"(pA1));
  START(pA0,pA1);
  _Pragma("unroll") for(int r=0;r<16;++r)pA1[r]=__builtin_amdgcn_exp2f(pA1[r]);
  WAIT_BAR(0);
  DMA_K(3,0);DMA_V(1,SLOTB);
  ROT();
  kload8(kf,kp0+sl_cur);
  WAIT_BAR(2);
  s16x4 vlo[8],vhi[8]; u32x4 pw0,pw1,pw2,pw3;
  #define PKW(P,B) cvtpk_s(P[B],P[B+1])
  #define PAF(k) __builtin_bit_cast(bf16x8,pw##k)
  #define VFR(i) (bf16x8){vlo[i][0],vlo[i][1],vlo[i][2],vlo[i][3],vhi[i][0],vhi[i][1],vhi[i][2],vhi[i][3]}
  #define PIN(x) asm volatile("":"+v"(x))
  #define MX3(a,b,c) __builtin_fmaxf(__builtin_fmaxf((a),(b)),(c))
  #define GAPA(MF,A0,A1,A2,A3,W0,W1,PW) do{ MF; sacc+=A0; sacc+=A1; sacc+=A2; sacc+=A3; PIN(sacc); W0; W1; PIN(PW); SBAR(); }while(0)
  #define EX(v) __builtin_amdgcn_exp2f(v)
  #define GAPB(MF,X,B) do{ MF; X[B]=EX(X[B]); X[B+1]=EX(X[B+1]); X[B+2]=EX(X[B+2]); X[B+3]=EX(X[B+3]); PIN(X); SBAR(); }while(0)
  #define VRD(i) do{ vlo[i]=vtr(vp_+(((i)>>2)*4096+((i)&3)*1024)); vhi[i]=vtr(vp_+(((i)>>2)*4096+((i)&3)*1024+512)); }while(0)
  #define KRD(G,j) do{ if(G){ kload2(kf,kp0+sl_next,j); SBAR(); } }while(0)
  #define STEP(C0,C1,P0,P1,t,GK,GV,GL) do{ SBAR(); \
    const lds_cptr vp_=vp0+sl_prev; \
    VRD(0); SBAR(); float sacc=(P0[0]+P0[1]); \
    GAPA(C0=__builtin_amdgcn_mfma_f32_32x32x16_bf16(kf[0],qr[0],negm,0,0,0), P0[2],P0[3],P0[4],P0[5],     pw0[0]=PKW(P0,0), pw0[1]=PKW(P0,2), pw0); \
    VRD(4); SBAR(); GAPA(C1=__builtin_amdgcn_mfma_f32_32x32x16_bf16(kf[1],qr[0],negm,0,0,0), P0[6],P0[7],P0[8],P0[9],     pw0[2]=PKW(P0,4), pw0[3]=PKW(P0,6), pw0); \
    VRD(1); SBAR(); GAPA(C0=__builtin_amdgcn_mfma_f32_32x32x16_bf16(kf[2],qr[1],C0,0,0,0),   P0[10],P0[11],P0[12],P0[13], pw1[0]=PKW(P0,8), pw1[1]=PKW(P0,10), pw1); \
    VRD(5); SBAR(); GAPA(C1=__builtin_amdgcn_mfma_f32_32x32x16_bf16(kf[3],qr[1],C1,0,0,0),   P0[14],P0[15],P1[0],P1[1],   pw1[2]=PKW(P0,12),pw1[3]=PKW(P0,14), pw1); \
    VRD(2); SBAR(); GAPA(C0=__builtin_amdgcn_mfma_f32_32x32x16_bf16(kf[4],qr[2],C0,0,0,0),   P1[2],P1[3],P1[4],P1[5],     pw2[0]=PKW(P1,0), pw2[1]=PKW(P1,2), pw2); \
    VRD(6); SBAR(); GAPA(C1=__builtin_amdgcn_mfma_f32_32x32x16_bf16(kf[5],qr[2],C1,0,0,0),   P1[6],P1[7],P1[8],P1[9],     pw2[2]=PKW(P1,4), pw2[3]=PKW(P1,6), pw2); \
    VRD(3); SBAR(); GAPA(C0=__builtin_amdgcn_mfma_f32_32x32x16_bf16(kf[6],qr[3],C0,0,0,0),   P1[10],P1[11],P1[12],P1[13], pw3[0]=PKW(P1,8), pw3[1]=PKW(P1,10), pw3); \
    VRD(7); SBAR(); GAPA(C1=__builtin_amdgcn_mfma_f32_32x32x16_bf16(kf[7],qr[3],C1,0,0,0),   P1[14],P1[15],0.f,0.f,       pw3[2]=PKW(P1,12),pw3[3]=PKW(P1,14), pw3); \
    l_reg+=sacc; \
    if(GK){DMA_K((t)+3,sl_cur);} if(GV){DMA_V((t)+1,sl_next);} \
    { float a=MX3(C0[0],C0[1],C1[0]),b=MX3(C0[2],C0[3],C1[1]); a=MX3(a,C1[2],C1[3]); \
      _Pragma("unroll") for(int r=4;r<16;r+=4){a=MX3(a,C0[r],C0[r+1]);b=MX3(b,C0[r+2],C0[r+3]);a=MX3(a,C1[r],C1[r+1]);b=MX3(b,C1[r+2],C1[r+3]);} \
      float rm=__builtin_fmaxf(a,b); { auto rr=__builtin_amdgcn_permlane32_swap(__float_as_uint(rm),__float_as_uint(rm),false,false); rm=__builtin_fmaxf(__uint_as_float(rr[0]),__uint_as_float(rr[1])); } \
      resc=false; \
      if(__builtin_expect(__any(rm>(float)THRL),0)){ const float dl=__builtin_fmaxf(rm,0.f); mhat+=dl; \
        _Pragma("unroll") for(int r=0;r<16;++r){C0[r]-=dl;C1[r]-=dl;} \
        _Pragma("unroll") for(int r=0;r<16;++r)negm[r]=-mhat; asm volatile("":"+v"(negm)); \
        const float f=__builtin_amdgcn_exp2f(-dl); l_reg*=f; if(hi==0)wsf[r32]=f; resc=true; } } \
    SBAR(); \
    GAPB(o[0]=__builtin_amdgcn_mfma_f32_32x32x16_bf16(PAF(0),VFR(0),o[0],0,0,0), C0,0); \
    GAPB(o[1]=__builtin_amdgcn_mfma_f32_32x32x16_bf16(PAF(0),VFR(4),o[1],0,0,0), C0,4); \
    KRD(GL,0); GAPB(o[0]=__builtin_amdgcn_mfma_f32_32x32x16_bf16(PAF(1),VFR(1),o[0],0,0,0), C0,8); \
    KRD(GL,1); GAPB(o[1]=__builtin_amdgcn_mfma_f32_32x32x16_bf16(PAF(1),VFR(5),o[1],0,0,0), C0,12); \
    KRD(GL,2); GAPB(o[0]=__builtin_amdgcn_mfma_f32_32x32x16_bf16(PAF(2),VFR(2),o[0],0,0,0), C1,0); \
    KRD(GL,3); GAPB(o[1]=__builtin_amdgcn_mfma_f32_32x32x16_bf16(PAF(2),VFR(6),o[1],0,0,0), C1,4); \
    GAPB(o[0]=__builtin_amdgcn_mfma_f32_32x32x16_bf16(PAF(3),VFR(3),o[0],0,0,0), C1,8); \
    GAPB(o[1]=__builtin_amdgcn_mfma_f32_32x32x16_bf16(PAF(3),VFR(7),o[1],0,0,0), C1,12); \
    }while(0)
  int t=1;
  for(;t+5<NT;t+=2){
    STEP(pB0,pB1,pA0,pA1,t,true,true,true);     WAIT_BAR(2); RESC(); ROT();
    STEP(pA0,pA1,pB0,pB1,t+1,true,true,true);   WAIT_BAR(2); RESC(); ROT();
  }
  #define ENDW(tt) do{ if((tt)+3<NT){WAIT_BAR(2);} else if((tt)+2<NT){WAIT_BAR(1);} else {WAIT_BAR(0);} }while(0)
  for(;t+1<NT;t+=2){
    STEP(pB0,pB1,pA0,pA1,t,(t+3<NT),(t+1<NT),(t+1<NT));       ENDW(t);   RESC(); ROT();
    STEP(pA0,pA1,pB0,pB1,t+1,(t+4<NT),(t+2<NT),(t+2<NT));     ENDW(t+1); RESC(); ROT();
  }
  STEP(pB0,pB1,pA0,pA1,NT-1,false,false,false); RESC();
  { float sacc=pB0[0]+pB0[1]; _Pragma("unroll") for(int r=2;r<16;++r)sacc+=pB0[r]; _Pragma("unroll") for(int r=0;r<16;++r)sacc+=pB1[r]; l_reg+=sacc;
    pw0=(u32x4){PKW(pB0,0),PKW(pB0,2),PKW(pB0,4),PKW(pB0,6)};pw1=(u32x4){PKW(pB0,8),PKW(pB0,10),PKW(pB0,12),PKW(pB0,14)};pw2=(u32x4){PKW(pB1,0),PKW(pB1,2),PKW(pB1,4),PKW(pB1,6)};pw3=(u32x4){PKW(pB1,8),PKW(pB1,10),PKW(pB1,12),PKW(pB1,14)};
    SBAR(); pv(o,vb0+sl_cur,PAF(0),PAF(1),PAF(2),PAF(3)); }
  #undef PKW
  #undef PAF
  #undef VFR
  #undef PIN
  #undef MX3
  #undef GAPA
  #undef GAPB
  #undef EX
  #undef VRD
  #undef KRD
  #undef STEP
  #undef ENDW
  {auto rr=__builtin_amdgcn_permlane32_swap(__float_as_uint(l_reg),__float_as_uint(l_reg),false,false);l_reg=__uint_as_float(rr[0])+__uint_as_float(rr[1]);}
  if(hi==0)wsf[32+r32]=l_reg;asm volatile("s_waitcnt lgkmcnt(0)":::"memory");
  float rli[16];
  #pragma unroll
  for(int r=0;r<16;++r)rli[r]=__builtin_amdgcn_rcpf(wsf[32+crow(r,hi)]);
  bf16*Ow=O+(rowbase+q0+wid*QBLK)*QP+h*D;
  { bf16*stg=(bf16*)(shm+LDS_OST)+wid*2048;
    #pragma unroll
    for(int r=0;r<16;++r){const int orow=crow(r,hi);
      #pragma unroll
      for(int d0=0;d0<2;++d0)stg[orow*64+d0*32+r32]=__float2bfloat16(o[d0][r]*rli[r]);}
    asm volatile("s_waitcnt lgkmcnt(0)":::"memory");
    #pragma unroll
    for(int i=0;i<4;++i){const int row=i*8+(lane>>3),ch=lane&7; const u32x4 v=*(const u32x4*)(stg+row*64+ch*8); *(u32x4*)(Ow+(long)row*QP+ch*8)=v;} }
  asm volatile("s_waitcnt lgkmcnt(0)\n\ts_barrier":::"memory");
  #undef DMA_K
  #undef DMA_V
  #undef START
  #undef RESC
  #undef ROT
}
constexpr int ATTN_LDS_BYTES=LDS_BYTES;
#undef SBAR
#undef WAIT_BAR
}

#define GRID_SYNC() do { asm volatile("s_waitcnt vmcnt(0) lgkmcnt(0)" ::: "memory"); grid.sync(); __builtin_amdgcn_fence(__ATOMIC_ACQUIRE, "agent"); asm volatile("s_waitcnt vmcnt(0)" ::: "memory"); } while (0)
#ifndef N_LAUNCH_MODE
#define N_LAUNCH_MODE 0
#endif
constexpr int N_PHASES = 2 + 6 * NLAYER;
constexpr int NWAVES = 8;
constexpr size_t MiB = 1u << 20;
constexpr size_t WL_IN = 0, WL_A = WL_IN + (size_t)INW * 1024, WL_B = WL_A + 1024 * 512, WL_MIX = WL_B + 1024 * 512, WL_UP = WL_MIX + 1024 * 1024,
                 WL_DOWN = WL_UP + 4096 * 1024, WL_SG = WL_DOWN + 1024 * 2048, WL_SIZE = WL_SG + 8 * 128 * 128;
static_assert(WL_SIZE * 2 * NLAYER <= 95 * MiB, "weights region");
constexpr size_t WS_ROPE = 0, WS_W = 1 * MiB, WS_XB = 96 * MiB + 4096, WS_QU = 289 * MiB, WS_K = 481 * MiB, WS_V = 505 * MiB, WS_VST = 529 * MiB,
                 WS_GA = 625 * MiB, WS_GB = 817 * MiB, WS_H2 = 625 * MiB, WS_SS = 1009 * MiB, WS_SSG = 1015 * MiB, WS_END = 1018 * MiB;
constexpr int LDS_BYTES = 147456, SG_SCR_OFF = 135168, BARST_OFF = 140288;
constexpr size_t WS_BAR = 65536, BAR_BYTES = 16384;


#define XB_TMO      128
#define XB_XCNT(j)  (256  + 64 * (j))
#define XB_XSUB(j)  (1280 + 64 * (j))
#define XB_XGEN(j)  (2304 + 64 * (j))
#define XB_TOP      3328
#define XB_TOPGEN   3392
#define XCD_BAR_WORDS 3456
#define XB_SPIN_CAP (1u << 22)
__device__ __forceinline__ unsigned xb_ld(unsigned* p)              { return __hip_atomic_load(p, __ATOMIC_RELAXED, __HIP_MEMORY_SCOPE_AGENT); }
__device__ __forceinline__ unsigned xb_add(unsigned* p, unsigned v) { return __hip_atomic_fetch_add(p, v, __ATOMIC_RELAXED, __HIP_MEMORY_SCOPE_AGENT); }
__device__ __forceinline__ unsigned xb_xcc_id() { return (unsigned)__builtin_amdgcn_s_getreg((3 << 11) | 20) & 0xFu; }
#define XB_SPIN(cond, bar) do { unsigned _sp = 0; while (cond) { __builtin_amdgcn_s_sleep(1); \
    if ((++_sp & 255u) == 0u) { if (xb_ld(&(bar)[XB_TMO])) break; if (_sp > XB_SPIN_CAP) { atomicAdd(&(bar)[XB_TMO], 1u); break; } } } } while (0)
struct XcdBarrier { unsigned* bar; unsigned x; volatile LAS unsigned* st; };
__device__ __forceinline__ XcdBarrier xcd_barrier_post(unsigned* bar, volatile LAS unsigned* st) {
    XcdBarrier b; b.bar = bar; b.x = xb_xcc_id(); b.st = st;
    if (threadIdx.x == 0) (void)xb_add(&bar[XB_XCNT(b.x)], 1u);
    return b;
}
__device__ __forceinline__ void xcd_barrier_complete(unsigned* bar, unsigned x, unsigned& nloc, unsigned& nx) {
    const unsigned G = gridDim.x * gridDim.y * gridDim.z;
    unsigned sum, cnt, mine, sp = 0u;
    for (;;) {
        sum = 0u; cnt = 0u; mine = 0u;
#pragma unroll
        for (unsigned j = 0; j < 16; ++j) { const unsigned c = xb_ld(&bar[XB_XCNT(j)]); sum += c; cnt += (c > 0u) ? 1u : 0u; mine = (j == x) ? c : mine; }
        if (sum == G) break;
        __builtin_amdgcn_s_sleep(1);
        if ((++sp & 255u) == 0u) { if (xb_ld(&bar[XB_TMO])) break; if (sp > XB_SPIN_CAP) { atomicAdd(&bar[XB_TMO], 1u); break; } }
    }
    nloc = mine > 0u ? mine : 1u; nx = cnt > 0u ? cnt : 1u;
}
__device__ __forceinline__ void xcd_barrier(const XcdBarrier& b) {
    asm volatile("s_waitcnt vmcnt(0)" ::: "memory");
    __syncthreads();
    if (threadIdx.x == 0) {
        unsigned* bar = b.bar;
        __builtin_amdgcn_s_waitcnt(0);
        unsigned nloc = b.st[0], nx = b.st[1];
        if (nloc == 0u) { xcd_barrier_complete(bar, b.x, nloc, nx); b.st[0] = nloc; b.st[1] = nx; }
        const unsigned old = xb_add(&bar[XB_XSUB(b.x)], 1u);
        const unsigned gen = old / nloc;
        if (old + 1u == (gen + 1u) * nloc) {
            __builtin_amdgcn_fence(__ATOMIC_RELEASE, "agent");
            asm volatile("s_waitcnt vmcnt(0)" ::: "memory");
            const unsigned og = xb_add(&bar[XB_TOP], 1u);
            const unsigned tg = og / nx;
            if (og + 1u == (tg + 1u) * nx) xb_add(&bar[XB_TOPGEN], 1u);
            else XB_SPIN(xb_ld(&bar[XB_TOPGEN]) == tg, bar);
            __builtin_amdgcn_fence(__ATOMIC_ACQUIRE, "agent");
            xb_add(&bar[XB_XGEN(b.x)], 1u);
            asm volatile("s_waitcnt vmcnt(0)" ::: "memory");
        } else {
            XB_SPIN(xb_ld(&bar[XB_XGEN(b.x)]) == gen, bar);
            __builtin_amdgcn_fence(__ATOMIC_ACQUIRE, "agent");
            asm volatile("s_waitcnt vmcnt(0)" ::: "memory");
        }
    }
    __syncthreads();
}

struct Args { const float* in[18]; float* out; unsigned char* ws; int ph_lo, ph_hi; };

__device__ __forceinline__ float wave_sum(float v) {
#pragma unroll
    for (int o = 1; o < 64; o <<= 1) v += __shfl_xor(v, o);
    return v;
}
__device__ __forceinline__ int invperm32(int cc) { return 16 * ((cc >> 2) & 1) + 4 * (cc >> 3) + (cc & 3); }
__device__ __forceinline__ int map_plain(int n) { return (n & ~31) + invperm32(n & 31); }
__device__ __forceinline__ int map_in(int n) {
    if (n < 512) { const int pn = n >> 8, hh = (n >> 6) & 3, d = n & 63; return 256 * pn + 128 * (d >> 5) + 32 * hh + (d & 31); }
    if (n < 768) { const int c = n - 512, isv = c >> 7, head = (c >> 6) & 1, d = c & 63, wc = 2 * isv + head; return 512 + 128 * (d >> 5) + 32 * wc + (d & 31); }
    if (n >= 1792) { const int bj = (n >= 2816) ? 1 : 0, c = n - 1792 - 1024 * bj, r = c & 127;
        return 1792 + 256 * (c >> 7) + 128 * bj + (r & ~31) + invperm32(r & 31); }
    return map_plain(n);
}
__device__ __forceinline__ int map_up(int n) { const int bj = n >> 11, c = n & 2047, pn = c >> 7, r = c & 127; return 256 * pn + 128 * bj + (r & ~31) + invperm32(r & 31); }

template <int MAP>
__device__ __forceinline__ void transpose_item(const float* W, const float* g, int K, int N, bf16_t* WT, LAS float* scr, int item, int lane) {
    const int nblk = N / 32, kb = item / nblk, nb = item % nblk, k0 = 64 * kb, n0 = 32 * nb;
#pragma unroll 8
    for (int i = 0; i < 32; ++i) { const int kk = 2 * i + (lane >> 5); float v = W[(size_t)(k0 + kk) * N + n0 + (lane & 31)]; if (g) v *= g[k0 + kk]; scr[kk * 33 + (lane & 31)] = v; }
    asm volatile("s_waitcnt lgkmcnt(0)" ::: "memory");
    const int c = lane & 7;
#pragma unroll
    for (int j = 0; j < 4; ++j) { const int n = (lane >> 3) + 8 * j; const LAS float* s = scr + (8 * c) * 33 + n;
        u32x4 o; o.x = cvt_pk_bf16(s[0 * 33], s[1 * 33]); o.y = cvt_pk_bf16(s[2 * 33], s[3 * 33]); o.z = cvt_pk_bf16(s[4 * 33], s[5 * 33]); o.w = cvt_pk_bf16(s[6 * 33], s[7 * 33]);
        const int nn = n0 + n; const int row = MAP == 0 ? map_plain(nn) : (MAP == 1 ? map_in(nn) : map_up(nn));
        *(u32x4*)(WT + (size_t)row * K + k0 + 8 * c) = o; }
    asm volatile("s_waitcnt lgkmcnt(0)" ::: "memory");
}

__device__ __forceinline__ void sincos_tab(float x, float& c, float& s) {
    const float n = rintf(x * 0.63661977236758134308f);
    float r = fmaf(-n, 1.5703125f, x); r = fmaf(-n, 4.83751296997070312500e-4f, r); r = fmaf(-n, 7.5497899548918821e-8f, r);
    const float r2 = r * r;
    const float sp = r + r * r2 * (-1.0f / 6 + r2 * (1.0f / 120 + r2 * (-1.0f / 5040 + r2 * (1.0f / 362880))));
    const float cp = 1.0f + r2 * (-0.5f + r2 * (1.0f / 24 + r2 * (-1.0f / 720 + r2 * (1.0f / 40320 + r2 * (-1.0f / 3628800)))));
    const int q = ((int)n) & 3;
    s = (q == 0) ? sp : (q == 1) ? cp : (q == 2) ? -sp : -cp;
    c = (q == 0) ? cp : (q == 1) ? -sp : (q == 2) ? -cp : sp;
}

__device__ __forceinline__ void sg_unit(int ch, int g, const bf16_t* VST, const float* ssg, const bf16_t* Wg, const float* sgb, const float* gsg, bf16_t* QU, LAS float* scr, int lane) {
    asm volatile("" : "+v"(lane));
    const int fr = lane & 15, fq = lane >> 4;
#pragma unroll
    for (int hh = 0; hh < 2; ++hh) { const int p = lane + 64 * hh; const float* sp = ssg + (size_t)(ch * 128 + p) * 8; const f32x4 a = *(const f32x4*)sp, b = *(const f32x4*)(sp + 4);
        const float s = ((a.x + a.y) + (a.z + a.w)) + ((b.x + b.y) + (b.z + b.w)); scr[p] = __builtin_amdgcn_rsqf(s * (1.0f / 512.0f) + EPS); }
    asm volatile("s_waitcnt lgkmcnt(0)" ::: "memory");
    f32x4 acc[8][4];
#pragma unroll
    for (int pt = 0; pt < 8; ++pt)
#pragma unroll
        for (int ct = 0; ct < 4; ++ct) acc[pt][ct] = (f32x4){0.f, 0.f, 0.f, 0.f};
    const bf16_t* vbase = VST + ((size_t)ch * 512 + g * 64) * 128;
    const bf16_t* wbase = Wg + (size_t)g * 128 * 128;
#pragma unroll 1
    for (int kk = 0; kk < 4; ++kk) {
        const int k0 = kk * 32 + 8 * fq;
        bf16x8 af[4];
#pragma unroll
        for (int ct = 0; ct < 4; ++ct) af[ct] = *(const bf16x8*)(vbase + (size_t)(ct * 16 + fr) * 128 + k0);
        float r[8];
#pragma unroll
        for (int e = 0; e < 8; ++e) r[e] = scr[k0 + e];
#pragma unroll
        for (int pt = 0; pt < 8; ++pt) {
            const u32x4 w = *(const u32x4*)(wbase + (size_t)(pt * 16 + fr) * 128 + k0);
            u32x4 ws; ws.x = cvt_pk_bf16(bf_lo(w.x) * r[0], bf_hi(w.x) * r[1]); ws.y = cvt_pk_bf16(bf_lo(w.y) * r[2], bf_hi(w.y) * r[3]);
            ws.z = cvt_pk_bf16(bf_lo(w.z) * r[4], bf_hi(w.z) * r[5]); ws.w = cvt_pk_bf16(bf_lo(w.w) * r[6], bf_hi(w.w) * r[7]);
            const bf16x8 bfz = __builtin_bit_cast(bf16x8, ws);
#pragma unroll
            for (int ct = 0; ct < 4; ++ct) acc[pt][ct] = __builtin_amdgcn_mfma_f32_16x16x32_bf16(af[ct], bfz, acc[pt][ct], 0, 0, 0);
        }
    }
    f32x4 gs[4];
#pragma unroll
    for (int ct = 0; ct < 4; ++ct) gs[ct] = *(const f32x4*)(gsg + g * 64 + ct * 16 + 4 * fq);
#pragma unroll
    for (int pt = 0; pt < 8; ++pt) {
        const int p = pt * 16 + fr; const float b = sgb[g * 128 + p];
        bf16_t* up = QU + (size_t)(ch * 128 + p) * 1024 + 512 + g * 64 + 4 * fq;
#pragma unroll
        for (int ct = 0; ct < 4; ++ct) {
            const u32x2 uu = *(const u32x2*)(up + ct * 16);
            const f32x4 sp = acc[pt][ct] * gs[ct] + b;
            u32x2 w; w.x = cvt_pk_bf16(bf_lo(uu.x) * sp.x, bf_hi(uu.x) * sp.y); w.y = cvt_pk_bf16(bf_lo(uu.y) * sp.z, bf_hi(uu.y) * sp.w);
            *(u32x2*)(up + ct * 16) = w;
        }
    }
    asm volatile("s_waitcnt lgkmcnt(0)" ::: "memory");
}

__global__ void __launch_bounds__(NWAVES * 64, 2) fwd_megakernel(Args args) {
    extern __shared__ __attribute__((aligned(16))) unsigned char lds[];
    cg::grid_group grid = cg::this_grid();
    LAS unsigned char* L = (LAS unsigned char*)lds;
    volatile LAS unsigned* barst = (volatile LAS unsigned*)(L + BARST_OFF);
    if (threadIdx.x < 2) barst[threadIdx.x] = 0u;
    __syncthreads();
    const XcdBarrier xbar = xcd_barrier_post((unsigned*)(args.ws + WS_BAR), barst);
    const int G = gridDim.x, bx = blockIdx.x;
    const int vcu = (G % 8 == 0) ? (bx % 8) * (G / 8) + bx / 8 : bx;
    const int NGW = G * NWAVES;
    unsigned char* ws = args.ws;
    const float* x_prompt = args.in[0]; const float* x_sample = args.in[1];
    const float* attn_norm_g = args.in[2]; const float* w_in = args.in[3]; const float* q_norm_g = args.in[4]; const float* k_norm_g = args.in[5];
    const float* sg_norm_g = args.in[6]; const float* sg_w = args.in[7]; const float* sg_b = args.in[8]; const float* w_branch_a = args.in[9];
    const float* w_branch_b = args.in[10]; const float* w_mix_out = args.in[11]; const float* ffn_norm_g = args.in[12]; const float* w_up = args.in[13];
    const float* conv_w = args.in[14]; const float* conv_b = args.in[15]; const float* w_down = args.in[16]; const float* final_norm_g = args.in[17];
    float* out = args.out;
    float* rope = (float*)(ws + WS_ROPE);
    bf16_t* Wall = (bf16_t*)(ws + WS_W);
    bf16_t* XB = (bf16_t*)(ws + WS_XB); bf16_t* QU = (bf16_t*)(ws + WS_QU); bf16_t* KB = (bf16_t*)(ws + WS_K); bf16_t* VB = (bf16_t*)(ws + WS_V);
    bf16_t* VST = (bf16_t*)(ws + WS_VST); bf16_t* GA = (bf16_t*)(ws + WS_GA); bf16_t* GB = (bf16_t*)(ws + WS_GB); bf16_t* H2 = (bf16_t*)(ws + WS_H2);
    float* SSQ = (float*)(ws + WS_SS); float* SSG = (float*)(ws + WS_SSG);

    for (int p = args.ph_lo; p < args.ph_hi; ++p) {
    if (p > args.ph_lo) { if (p == 1) GRID_SYNC(); else xcd_barrier(xbar); }
    int tid_ = threadIdx.x; asm volatile("" : "+v"(tid_));
    const int tid = tid_, lane = tid & 63, wave = __builtin_amdgcn_readfirstlane(tid >> 6);
    const int gw = vcu * NWAVES + wave;
    if (p == 0) {
        LAS float* scr = (LAS float*)(L + wave * 16384);
        constexpr int I_IN = 16 * (INW / 32), I_A = 8 * 32, I_MIX = 16 * 32, I_UP = 16 * 128, I_DOWN = 32 * 32, I_L = I_IN + 2 * I_A + I_MIX + I_UP + I_DOWN;
        for (int it = gw; it < I_L * NLAYER; it += NGW) {
            const int l = it / I_L; int r = it % I_L; bf16_t* wl = Wall + (size_t)l * WL_SIZE;
            if (r < I_IN) { transpose_item<1>(w_in + (size_t)l * 1024 * INW, attn_norm_g + l * 1024, 1024, INW, wl + WL_IN, scr, r, lane); continue; } r -= I_IN;
            if (r < I_A) { transpose_item<0>(w_branch_a + (size_t)l * 512 * 1024, nullptr, 512, 1024, wl + WL_A, scr, r, lane); continue; } r -= I_A;
            if (r < I_A) { transpose_item<0>(w_branch_b + (size_t)l * 512 * 1024, nullptr, 512, 1024, wl + WL_B, scr, r, lane); continue; } r -= I_A;
            if (r < I_MIX) { transpose_item<0>(w_mix_out + (size_t)l * 1024 * 1024, nullptr, 1024, 1024, wl + WL_MIX, scr, r, lane); continue; } r -= I_MIX;
            if (r < I_UP) { transpose_item<2>(w_up + (size_t)l * 1024 * 4096, ffn_norm_g + l * 1024, 1024, 4096, wl + WL_UP, scr, r, lane); continue; } r -= I_UP;
            transpose_item<0>(w_down + (size_t)l * 2048 * 1024, nullptr, 2048, 1024, wl + WL_DOWN, scr, r, lane);
        }
        for (int i = gw * 64 + lane; i < NLAYER * 8 * 128 * 128 / 4; i += NGW * 64) {
            const int l = i / (8 * 128 * 128 / 4), r = i % (8 * 128 * 128 / 4);
            const f32x4 v = *(const f32x4*)(sg_w + (size_t)l * 131072 + (size_t)r * 4);
            u32x2 w; w.x = cvt_pk_bf16(v.x, v.y); w.y = cvt_pk_bf16(v.z, v.w);
            *(u32x2*)(Wall + (size_t)l * WL_SIZE + WL_SG + (size_t)r * 4) = w;
        }
        for (int i = gw * 64 + lane; i < 128 * 16; i += NGW * 64) {
            const int pos = i >> 4, f = i & 15; float fr_ = 1.0f; for (int k = 0; k < f; ++k) fr_ *= 0.56234132519034907f;
            float c, s; sincos_tab((float)pos * fr_, c, s); rope[2 * i] = c; rope[2 * i + 1] = s;
        }
        for (int i = gw * 64 + lane; i < 257 * 128; i += NGW * 64) {
            const int r = i / 128, c = i % 128; const long row = (r == 0) ? -1 : (long)M_TOK + r - 1;
            *(u32x4*)(XB + row * 1024 + c * 8) = (u32x4){0u, 0u, 0u, 0u};
        }
        for (int m0 = gw; m0 < M_TOK; m0 += 2 * NGW) {
            const int nr = (m0 + NGW < M_TOK) ? 2 : 1;
            f32x4 v[2][4]; float sq[2];
#pragma unroll
            for (int r = 0; r < 2; ++r) { const int m = (r < nr) ? m0 + r * NGW : m0;
                const float* xr = (m < NPROMPT) ? x_prompt + (size_t)m * 1024 : x_sample + (size_t)(m - NPROMPT) * 1024; float s = 0.f;
#pragma unroll
                for (int j = 0; j < 4; ++j) { v[r][j] = *(const f32x4*)(xr + 4 * lane + 256 * j); s += (v[r][j].x * v[r][j].x + v[r][j].y * v[r][j].y) + (v[r][j].z * v[r][j].z + v[r][j].w * v[r][j].w); }
                sq[r] = s; }
#pragma unroll
            for (int r = 0; r < 2; ++r) if (r < nr) { const int m = m0 + r * NGW; const float s = wave_sum(sq[r]);
#pragma unroll
                for (int j = 0; j < 4; ++j) { u32x2 w; w.x = cvt_pk_bf16(v[r][j].x, v[r][j].y); w.y = cvt_pk_bf16(v[r][j].z, v[r][j].w); *(u32x2*)(XB + (size_t)m * 1024 + 4 * lane + 256 * j) = w; }
                if (lane < 16) SSQ[(size_t)m * 16 + lane] = (lane == 0) ? s : 0.f; }
        }
    }
    else if (p < N_PHASES - 1) {
        const int l = (p - 1) / 6, k = (p - 1) % 6;
        const bf16_t* wl = Wall + (size_t)l * WL_SIZE;
        if (k == 0) {
            pg8::Gemm g{XB, wl + WL_IN, 1024, 1024, 1024, 0, 0, 256, 128, 0};
            { pg8::StaticOrder S; S.init(M_TOK / 256, 3, 1, G, bx, 0); S.rev = (5 * l + 1) & 1;
              pg8::EpiQKV E{SSQ, q_norm_g + l * 64, k_norm_g + l * 64, rope, QU, KB, VB};
              pg8::gemm_phase<pg8::EpiQKV, 1>(L, g, S, E); }
            { pg8::StaticOrder S; S.init(M_TOK / 256, 2, 1, G, bx, 5); S.rev = (5 * l + 1) & 1;
              pg8::EpiVS E{SSQ, VST, SSG};
              pg8::gemm_phase<pg8::EpiVS, 1>(L, g, S, E); }
            { pg8::StaticOrder S; S.init(M_TOK / 256, 10, 1, G, bx, 3, 2, 7); S.rev = (5 * l + 1) & 1;
              pg8::EpiEW E{SSQ, QU, GA, GB};
              pg8::gemm_phase<pg8::EpiEW, 1>(L, g, S, E); }
        }
        else if (k == 1) {
            LAS float* scr = (LAS float*)(L + SG_SCR_OFF) + wave * 128;
            for (int u = gw; u < 768 * 8; u += NGW)
                sg_unit(u >> 3, u & 7, VST, SSG, wl + WL_SG, sg_b + l * 1024, sg_norm_g + l * 512, QU, scr, lane);
            for (int u = bx; u < 3072; u += G) {
                const int i = u >> 8, c = u & 255, x = c & 7, w = c >> 3;
                long rowbase; int seq, h, q0;
                if (i < 4) { const int idx = w * 4 + i; rowbase = (long)(x >> 1) * SEQ_P; seq = SEQ_P; h = (x & 1) * 4 + (idx >> 5); q0 = (idx & 31) * 256; }
                else { const int pair = 8 * x + (i - 4); rowbase = (long)NPROMPT + (long)(pair >> 1) * SEQ_S; seq = SEQ_S; h = (pair & 1) * 4 + (w >> 3); q0 = (w & 7) * 256; }
                attn_body::attn_unit<8>(rowbase, seq, h, q0, (const attn_body::bf16*)QU, (const attn_body::bf16*)KB, (const attn_body::bf16*)VB, (attn_body::bf16*)QU, (char*)lds);
            }
        }
        else if (k == 2) {
            pg8::Gemm g{QU + 512, wl + WL_B, 1024, 512, 512, -512 * 2, -(long)(WL_B - WL_A) * 2, 256, 0, 0};
            pg8::StaticOrder S; S.init(M_TOK / 256, 4, 2, G, bx); S.rev = (5 * l + 2) & 1;
            pg8::EpiMerge E{GA, GB};
            pg8::gemm_phase<pg8::EpiMerge, 2>(L, g, S, E);
        }
        else if (k == 3) {
            pg8::Gemm g{GA, wl + WL_MIX, 1024, 1024, 1024, 0, 0, 256, 0, 0};
            pg8::StaticOrder S; S.init(M_TOK / 256, 4, 1, G, bx); S.rev = (5 * l + 3) & 1;
            pg8::EpiRes E{x_prompt, x_sample, 0, out, XB, SSQ, 1, 0};
            pg8::gemm_phase<pg8::EpiRes, 1>(L, g, S, E);
        }
        else if (k == 4) {
            pg8::Gemm g{XB, wl + WL_UP, 1024, 1024, 1024, 0, 0, 252, 126, -1};
            pg8::StaticOrder S; S.init((M_TOK + 251) / 252, 16, 1, G, bx); S.rev = (5 * l + 4) & 1;
            pg8::EpiUp E{SSQ, conv_w + (size_t)l * 3 * 4096, conv_b + (size_t)l * 4096, H2};
            pg8::gemm_phase<pg8::EpiUp, 1>(L, g, S, E);
        }
        else {
            pg8::Gemm g{H2, wl + WL_DOWN, 2048, 2048, 2048, 0, 0, 256, 0, 0};
            pg8::StaticOrder S; S.init(M_TOK / 256, 4, 1, G, bx); S.rev = (5 * l + 5) & 1;
            pg8::EpiRes E{x_prompt, x_sample, 0, out, XB, SSQ, 1, 0};
            pg8::gemm_phase<pg8::EpiRes, 1>(L, g, S, E);
        }
    } else
    {
        f32x4 gv[4];
#pragma unroll
        for (int j = 0; j < 4; ++j) gv[j] = *(const f32x4*)(final_norm_g + 4 * lane + 256 * j);
        for (int m = gw; m < M_TOK; m += 2 * NGW) {
            const int m2 = (m + NGW < M_TOK) ? m + NGW : m;
            float* xr = out + (size_t)m * 1024; float* xr2 = out + (size_t)m2 * 1024;
            const bf16_t* br = XB + (size_t)m * 1024; const bf16_t* br2 = XB + (size_t)m2 * 1024;
            const float sp = (lane < 16) ? SSQ[(size_t)m * 16 + lane] : 0.f, sp2 = (lane < 16) ? SSQ[(size_t)m2 * 16 + lane] : 0.f;
            f32x4 v[4], w[4];
#pragma unroll
            for (int j = 0; j < 4; ++j) { const u32x2 p = *(const u32x2*)(br + 4 * lane + 256 * j), q = *(const u32x2*)(br2 + 4 * lane + 256 * j);
                v[j] = (f32x4){bf_lo(p.x), bf_hi(p.x), bf_lo(p.y), bf_hi(p.y)}; w[j] = (f32x4){bf_lo(q.x), bf_hi(q.x), bf_lo(q.y), bf_hi(q.y)}; }
            const float rs = __builtin_amdgcn_rsqf(wave_sum(sp) * (1.0f / DMOD) + EPS), rs2 = __builtin_amdgcn_rsqf(wave_sum(sp2) * (1.0f / DMOD) + EPS);
#pragma unroll
            for (int j = 0; j < 4; ++j) { *(f32x4*)(xr + 4 * lane + 256 * j) = v[j] * gv[j] * rs; if (m2 != m) *(f32x4*)(xr2 + 4 * lane + 256 * j) = w[j] * gv[j] * rs2; }
        }
    }
    }
}

extern "C" void kernel_launch(void* const* d_in, const int* in_sizes, int n_in, void* d_out, int out_size, void* d_ws, size_t ws_size, hipStream_t stream) {
    static int grid = 0;
    if (grid == 0) {
        if (n_in != 18 || out_size != M_TOK * DMOD || ws_size < WS_END) { fprintf(stderr, "kernel_launch: unexpected shapes (n_in %d out %d ws %zu)\n", n_in, out_size, ws_size); grid = -1; return; }
        int dev = 0, cus = 0, per_cu = 0;
        (void)hipGetDevice(&dev); (void)hipDeviceGetAttribute(&cus, hipDeviceAttributeMultiprocessorCount, dev);
        (void)hipFuncSetAttribute((const void*)fwd_megakernel, hipFuncAttributeMaxDynamicSharedMemorySize, LDS_BYTES);
        (void)hipOccupancyMaxActiveBlocksPerMultiprocessor(&per_cu, (const void*)fwd_megakernel, NWAVES * 64, LDS_BYTES);
        if (per_cu < 1) { fprintf(stderr, "kernel_launch: occupancy query says %d blocks/CU\n", per_cu); per_cu = 1; }
        (void)hipGetLastError();
        grid = cus * 1;
    }
    if (grid < 0) return;
    (void)hipMemsetAsync((char*)d_ws + WS_BAR, 0, BAR_BYTES, stream);
    Args a{};
    for (int i = 0; i < 18; ++i) a.in[i] = (const float*)d_in[i];
    a.out = (float*)d_out; a.ws = (unsigned char*)d_ws;
    if (N_LAUNCH_MODE == 0) {
        a.ph_lo = 0; a.ph_hi = N_PHASES;
        void* params[] = {&a};
        hipError_t e = hipLaunchCooperativeKernel((const void*)fwd_megakernel, dim3(grid), dim3(NWAVES * 64), params, LDS_BYTES, stream);
        if (e != hipSuccess) fprintf(stderr, "cooperative launch failed: %s (grid %d)\n", hipGetErrorString(e), grid);
    } else {
        for (int p = 0; p < N_PHASES; ++p) { a.ph_lo = p; a.ph_hi = p + 1;
            hipLaunchKernelGGL(fwd_megakernel, dim3(grid), dim3(NWAVES * 64), LDS_BYTES, stream, a); }
    }
}
```

```cpp
#include <hip/hip_runtime.h>
#include <hip/hip_cooperative_groups.h>
#include <hip/hip_bf16.h>
#include <cstdio>
#include <cstdint>
#include <cmath>
namespace cg = cooperative_groups;

constexpr int M_TOK = 98304, NPROMPT = 32768, SEQ_P = 8192, SEQ_S = 2048;
constexpr int DMOD = 1024, INW = 3840, DFF = 2048, NLAYER = 4;
constexpr float EPS = 1e-6f;
constexpr float C2 = 0.125f * 1.4426950408889634f;

#define LAS __attribute__((address_space(3)))
typedef unsigned short bf16_t;
typedef short bf16x8 __attribute__((ext_vector_type(8)));
typedef float f32x4 __attribute__((ext_vector_type(4)));
typedef float f32x2 __attribute__((ext_vector_type(2)));
typedef unsigned u32x4 __attribute__((ext_vector_type(4)));
typedef unsigned u32x2 __attribute__((ext_vector_type(2)));

typedef __bf16 bf16x2_t_ __attribute__((ext_vector_type(2)));
__device__ __forceinline__ unsigned cvt_pk_bf16(float lo, float hi) { f32x2 v = {lo, hi}; bf16x2_t_ b = __builtin_convertvector(v, bf16x2_t_); return __builtin_bit_cast(unsigned, b); }
__device__ __forceinline__ float bf_lo(unsigned w) { return __uint_as_float(w << 16); }
__device__ __forceinline__ float bf_hi(unsigned w) { return __uint_as_float(w & 0xffff0000u); }
__device__ __forceinline__ float gelu_t(float x) {
    const float u = x * (0.7978845608f + 0.0356774081f * x * x);
    const float e = __builtin_amdgcn_exp2f(u * -2.8853900818f);
    return x * __builtin_amdgcn_rcpf(1.0f + e);
}
__device__ __forceinline__ float sigmoid_f(float x) { return __builtin_amdgcn_rcpf(1.0f + __builtin_amdgcn_exp2f(x * -1.4426950409f)); }
__device__ __forceinline__ float dpp_shr1(float v) { return __int_as_float(__builtin_amdgcn_update_dpp(0, __float_as_int(v), 0x111, 0xF, 0xF, true)); }
__device__ __forceinline__ float dpp_shl1(float v) { return __int_as_float(__builtin_amdgcn_update_dpp(0, __float_as_int(v), 0x101, 0xF, 0xF, true)); }

namespace pg8 {
constexpr int BM = 256, BK = 64, HALF = 128, HTB = HALF * BK * 2, STAGE_BYTES = 8 * HTB, NXCD = 8, WGM = 8;
__host__ __device__ __forceinline__ int lds_byte(int r, int c) { const int st = (r >> 4) * 2 + (c >> 5), rr = r & 15, cc = c & 31, ob = rr * 64 + cc * 2; return st * 1024 + (ob ^ (((ob >> 9) & 1) << 5)); }
__host__ __device__ __forceinline__ void stage_rc(int b, int& R, int& C) { const int st = b / 1024, sb = b % 1024, swz = sb ^ (((sb >> 9) & 1) << 5); R = (st >> 1) * 16 + swz / 64; C = (st & 1) * 32 + (swz % 64) / 2; }

struct Unit { int pm, pn, part; };
struct Gemm { const bf16_t* A; const bf16_t* Bt; int lda, ldb, K; long partA, partB; int tstride, wstride, shift; };

struct StaticOrder {
    int nM, nN, nwg, G, c, parts, pn_lo, pn_split, pn_hi, rev;
    __device__ void init(int nM_, int nN_, int parts_, int G_, int c_, int pn_lo_ = 0, int pn_split_ = 1 << 20, int pn_hi_ = 0) { nM = nM_; nN = nN_; nwg = nM * nN; G = G_; c = c_; parts = parts_; pn_lo = pn_lo_; pn_split = pn_split_; pn_hi = pn_hi_; rev = 0; }
    __device__ bool next(int i, Unit& u) const {
        const int it = (parts == 2) ? (i >> 1) : i; u.part = (parts == 2) ? (i & 1) : 0;
        const long L = (long)it * G + c; if (L >= nwg) return false;
        int wgid = (int)L; { const int q = nwg / NXCD, r = nwg % NXCD, xcd = wgid % NXCD, off = wgid / NXCD; wgid = (xcd < r ? xcd * (q + 1) : r * (q + 1) + (xcd - r) * q) + off; }
        const int nig = WGM * nN, gid = wgid / nig, fm = gid * WGM, gsz = (nM - fm) < WGM ? (nM - fm) : WGM;
        u.pm = fm + ((wgid % nig) % gsz); if (rev) u.pm = nM - 1 - u.pm; { const int ix = (wgid % nig) / gsz; u.pn = ix < pn_split ? pn_lo + ix : pn_hi + (ix - pn_split); } return true;
    }
};

template <class Epi, int PARTS>
__device__ __forceinline__ void gemm_phase(LAS unsigned char* lds, const Gemm g, const StaticOrder& S, const Epi& E) {
    int tid_ = threadIdx.x; asm volatile("" : "+v"(tid_));
    const int tid = tid_, wid = __builtin_amdgcn_readfirstlane(tid >> 6), lane = tid & 63, wr = wid >> 2, wc = wid & 3, fr = lane & 15, fq = lane >> 4;
    const int K = g.K, nt = K / BK;
    unsigned voffA[2], voffB[2];
#pragma unroll
    for (int i = 0; i < 2; ++i) { int R, C; stage_rc(tid * 16 + i * 8192, R, C);
        const int TR = g.wstride ? g.wstride * (R >> 6) + 8 * (R & 15) + ((R >> 4) & 3) : R;
        voffA[i] = (unsigned)(TR * g.lda + C) * 2u; voffB[i] = (unsigned)(R * g.ldb + C) * 2u; }
    const size_t kstep = (size_t)(BK * 2);
    const size_t hstepA = (size_t)(g.wstride ? 4 : HALF) * g.lda * 2, hstepB = (size_t)HALF * g.ldb * 2;
    const unsigned ldsw = (unsigned)wid * 1024u;
    const int aoff = lds_byte(wr * 64 + fr, fq * 8), boff = lds_byte(wc * 32 + fr, fq * 8);
#define PG8_SA(b, h) (((b) * 2 + (h)) * HTB)
#define PG8_SB(b, h) ((4 + (b) * 2 + (h)) * HTB)
#define PG8_STAGE(bufoff, gbase, voff) do { _Pragma("unroll") for (int _i = 0; _i < 2; ++_i) \
        __builtin_amdgcn_global_load_lds((const unsigned*)((const char*)(gbase) + (voff)[_i]), (LAS unsigned*)(lds + (bufoff) + ldsw + _i * 8192), 16, 0, 0); } while (0)
#define PG8_STAGEA(bufoff, gbase, voff) do { _Pragma("unroll") for (int _i = 0; _i < 2; ++_i) \
        __builtin_amdgcn_global_load_lds((const unsigned*)((const char*)(gbase) + (voff)[_i]), (LAS unsigned*)(lds + (bufoff) + ldsw + _i * 8192), 16, 0, 0); } while (0)
#define PG8_LDA(dst, b, h) do { _Pragma("unroll") for (int m = 0; m < 4; ++m) _Pragma("unroll") for (int k = 0; k < 2; ++k) dst[m][k] = *(const LAS bf16x8*)(lds + PG8_SA(b, h) + aoff + m * 2048 + k * 1024); } while (0)
#define PG8_LDB(dst, b, h) do { _Pragma("unroll") for (int n = 0; n < 2; ++n) _Pragma("unroll") for (int k = 0; k < 2; ++k) dst[n][k] = *(const LAS bf16x8*)(lds + PG8_SB(b, h) + boff + n * 2048 + k * 1024); } while (0)
#define PG8_MMA(ai, bj, At, Bt) do { __builtin_amdgcn_s_setprio(1); _Pragma("unroll") for (int m = 0; m < 4; ++m) _Pragma("unroll") for (int n = 0; n < 2; ++n) _Pragma("unroll") for (int k = 0; k < 2; ++k) \
        acc[ai][bj][m][n] = __builtin_amdgcn_mfma_f32_16x16x32_bf16(Bt[n][k], At[m][k], acc[ai][bj][m][n], 0, 0, 0); __builtin_amdgcn_s_setprio(0); } while (0)
#define PG8_WAIT_V(n) asm volatile("s_waitcnt vmcnt(" #n ")" ::: "memory")
#define PG8_WAIT_L(n) asm volatile("s_waitcnt lgkmcnt(" #n ")" ::: "memory")
#define PG8_BAR __builtin_amdgcn_s_barrier()
#define PG8_SCHED __builtin_amdgcn_sched_barrier(0)
#define PG8_UA(u) ((const char*)g.A + (size_t)(u).part * g.partA + ((long)(u).pm * g.tstride + g.shift) * (long)g.lda * 2)
#define PG8_UB(u) ((const char*)g.Bt + (size_t)(u).part * g.partB + (size_t)(u).pn * 256 * g.ldb * 2)
    Unit cur, nxt; int ui = 0;
    if (!S.next(0, cur)) return;
    f32x4 acc[2][2][4][2];
#pragma unroll
    for (int a = 0; a < 2; ++a)
#pragma unroll
        for (int b = 0; b < 2; ++b)
#pragma unroll
            for (int m = 0; m < 4; ++m)
#pragma unroll
                for (int n = 0; n < 2; ++n) acc[a][b][m][n] = (f32x4){0.f, 0.f, 0.f, 0.f};
    bf16x8 At[4][2], B0[2][2], B1[2][2];
    const char* cA = PG8_UA(cur); const char* cB = PG8_UB(cur);
    PG8_STAGE(PG8_SB(0, 0), cB, voffB); PG8_STAGE(PG8_SB(0, 1), cB + hstepB, voffB); PG8_STAGEA(PG8_SA(0, 0), cA, voffA); PG8_STAGEA(PG8_SA(0, 1), cA + hstepA, voffA);
    if (wr == 1) PG8_BAR;
    PG8_WAIT_V(2); PG8_BAR;
    PG8_STAGE(PG8_SB(1, 0), cB + kstep, voffB); PG8_STAGEA(PG8_SA(1, 0), cA + kstep, voffA); PG8_STAGE(PG8_SB(1, 1), cB + hstepB + kstep, voffB);
    PG8_WAIT_V(6); PG8_BAR;
    for (;;) {
        const bool has_next = S.next(ui + 1, nxt);
        const char* nA = has_next ? PG8_UA(nxt) : cA; const char* nB = has_next ? PG8_UB(nxt) : cB;
        for (int t = 0; t < nt; t += 2) {
            const bool last = (t == nt - 2);
            const char* a1 = cA + (size_t)(t + 1) * kstep;
            const char* a2 = last ? nA : cA + (size_t)(t + 2) * kstep; const char* b2 = last ? nB : cB + (size_t)(t + 2) * kstep;
            const char* a3 = a2 + kstep; const char* b3 = b2 + kstep;
            PG8_LDB(B0, 0, 0); PG8_LDB(B1, 0, 1); PG8_SCHED; PG8_LDA(At, 0, 0); PG8_STAGEA(PG8_SA(1, 1), a1 + hstepA, voffA);
            PG8_WAIT_V(8); PG8_WAIT_L(0); PG8_BAR; PG8_MMA(0, 0, At, B0); PG8_MMA(0, 1, At, B1); PG8_BAR; PG8_SCHED;
            PG8_LDA(At, 0, 1); PG8_STAGE(PG8_SB(0, 0), b2, voffB); PG8_STAGE(PG8_SB(0, 1), b2 + hstepB, voffB); PG8_STAGEA(PG8_SA(0, 0), a2, voffA);
            PG8_WAIT_V(8); PG8_WAIT_L(0); PG8_BAR; PG8_MMA(1, 0, At, B0); PG8_MMA(1, 1, At, B1); PG8_BAR; PG8_SCHED;
            PG8_LDB(B0, 1, 0); PG8_LDB(B1, 1, 1); PG8_SCHED; PG8_LDA(At, 1, 0); PG8_STAGEA(PG8_SA(0, 1), a2 + hstepA, voffA);
            PG8_WAIT_V(8); PG8_WAIT_L(0); PG8_BAR; PG8_MMA(0, 0, At, B0); PG8_MMA(0, 1, At, B1); PG8_BAR; PG8_SCHED;
            PG8_LDA(At, 1, 1); PG8_STAGE(PG8_SB(1, 0), b3, voffB); PG8_STAGE(PG8_SB(1, 1), b3 + hstepB, voffB); PG8_STAGEA(PG8_SA(1, 0), a3, voffA);
            PG8_WAIT_V(8); PG8_WAIT_L(0); PG8_BAR; PG8_MMA(1, 0, At, B0); PG8_MMA(1, 1, At, B1); PG8_BAR; PG8_SCHED;
        }
        if (wr == 0) PG8_BAR;
        E(acc, cur, wr, wc, fr, fq);
        if (!has_next) break;
        if (PARTS == 1 || nxt.part == 0) {
#pragma unroll
        for (int a = 0; a < 2; ++a)
#pragma unroll
            for (int b = 0; b < 2; ++b)
#pragma unroll
                for (int m = 0; m < 4; ++m)
#pragma unroll
                    for (int n = 0; n < 2; ++n) acc[a][b][m][n] = (f32x4){0.f, 0.f, 0.f, 0.f};
        }
        cur = nxt; cA = nA; cB = nB; ++ui;
        if (wr == 1) PG8_BAR;
    }
    PG8_WAIT_V(0);
    PG8_BAR;
#undef PG8_SA
#undef PG8_SB
#undef PG8_STAGE
#undef PG8_STAGEA
#undef PG8_LDA
#undef PG8_LDB
#undef PG8_MMA
#undef PG8_WAIT_V
#undef PG8_WAIT_L
#undef PG8_BAR
#undef PG8_SCHED
#undef PG8_UA
#undef PG8_UB
}

__device__ __forceinline__ void load_rs8(const float* ss, int t0, int fq, float (&rs)[8], int tmax) {
#pragma unroll
    for (int j = 0; j < 8; ++j) { int t = t0 + j; t = t < 0 ? 0 : (t > tmax ? tmax : t);
        const f32x4 p = *(const f32x4*)(ss + (size_t)t * 16 + 4 * fq); float s = (p.x + p.y) + (p.z + p.w);
        s += __shfl_xor(s, 16); s += __shfl_xor(s, 32); rs[j] = __builtin_amdgcn_rsqf(s * (1.0f / DMOD) + EPS); }
}

struct EpiQKV {
    const float* ss; const float* qg; const float* kg; const float* rope;
    bf16_t* QU; bf16_t* Kb; bf16_t* Vb;
    __device__ __forceinline__ void operator()(f32x4 (&acc)[2][2][4][2], const Unit& u, int wr, int wc, int fr, int fq) const {
        const int t0 = u.pm * 256 + wr * 128 + fr * 8;
        { float rs[8]; load_rs8(ss, t0, fq, rs, M_TOK - 1);
#pragma unroll
          for (int ai = 0; ai < 2; ++ai)
#pragma unroll
            for (int m = 0; m < 4; ++m)
#pragma unroll
                for (int bj = 0; bj < 2; ++bj)
#pragma unroll
                    for (int n = 0; n < 2; ++n) acc[ai][bj][m][n] = acc[ai][bj][m][n] * rs[4 * ai + m]; }
        const int pn = u.pn;
        {
            const bool isq = pn < 2;
            if (isq || wc < 2) {
                const float* gp = isq ? qg : kg; const float osc = isq ? C2 : 1.0f;
                f32x4 gv[2][2];
#pragma unroll
                for (int bj = 0; bj < 2; ++bj)
#pragma unroll
                    for (int n = 0; n < 2; ++n) gv[bj][n] = *(const f32x4*)(gp + 32 * bj + 16 * n + 4 * fq);
                const int smask = (t0 < NPROMPT) ? (SEQ_P - 1) : (SEQ_S - 1);
                const int prow = (t0 & smask) >> 6;
                const f32x4 rr0 = *(const f32x4*)(rope + (prow * 16 + 4 * fq) * 2), rr1 = *(const f32x4*)(rope + (prow * 16 + 4 * fq) * 2 + 4);
                bf16_t* dst = isq ? (QU + (size_t)t0 * 1024 + (4 * pn + wc) * 64) : (Kb + (size_t)t0 * 128 + wc * 64);
                const int pitch = isq ? 1024 : 128;
#pragma unroll
                for (int ai = 0; ai < 2; ++ai)
#pragma unroll
                    for (int m = 0; m < 4; ++m) {
                        const int j = 4 * ai + m;
                        float sq = 0.f;
#pragma unroll
                        for (int bj = 0; bj < 2; ++bj)
#pragma unroll
                            for (int n = 0; n < 2; ++n) { const f32x4 v = acc[ai][bj][m][n]; sq += (v.x * v.x + v.y * v.y) + (v.z * v.z + v.w * v.w); }
                        sq += __shfl_xor(sq, 16); sq += __shfl_xor(sq, 32);
                        const float rn = __builtin_amdgcn_rsqf(sq * (1.0f / 64.0f) + EPS) * osc;
                        const int pcol = (t0 + j) & 63;
                        const f32x4 cc0 = *(const f32x4*)(rope + (pcol * 16 + 4 * fq) * 2), cc1 = *(const f32x4*)(rope + (pcol * 16 + 4 * fq) * 2 + 4);
#pragma unroll
                        for (int bj = 0; bj < 2; ++bj) {
                            const f32x4 t0v = bj == 0 ? rr0 : cc0, t1v = bj == 0 ? rr1 : cc1;
                            const f32x4 x1 = acc[ai][bj][m][0] * gv[bj][0] * rn, x2 = acc[ai][bj][m][1] * gv[bj][1] * rn;
                            const f32x4 cs = (f32x4){t0v.x, t0v.z, t1v.x, t1v.z}, sn = (f32x4){t0v.y, t0v.w, t1v.y, t1v.w};
                            const f32x4 o1 = x1 * cs - x2 * sn, o2 = x1 * sn + x2 * cs;
                            u32x2 w1, w2; w1.x = cvt_pk_bf16(o1.x, o1.y); w1.y = cvt_pk_bf16(o1.z, o1.w); w2.x = cvt_pk_bf16(o2.x, o2.y); w2.y = cvt_pk_bf16(o2.z, o2.w);
                            bf16_t* p = dst + (size_t)j * pitch + 32 * bj + 4 * fq;
                            *(u32x2*)p = w1; *(u32x2*)(p + 16) = w2;
                        }
                    }
            } else {
                bf16_t* dst = Vb + (size_t)t0 * 128 + (wc - 2) * 64;
#pragma unroll
                for (int ai = 0; ai < 2; ++ai)
#pragma unroll
                    for (int m = 0; m < 4; ++m)
#pragma unroll
                        for (int bj = 0; bj < 2; ++bj)
#pragma unroll
                            for (int n = 0; n < 2; ++n) { const f32x4 v = acc[ai][bj][m][n]; u32x2 w; w.x = cvt_pk_bf16(v.x, v.y); w.y = cvt_pk_bf16(v.z, v.w);
                                *(u32x2*)(dst + (size_t)(4 * ai + m) * 128 + 32 * bj + 16 * n + 4 * fq) = w; }
            }
        }
    }
};
struct EpiVS {
    const float* ss; bf16_t* VST; float* ssg;
    __device__ __forceinline__ void operator()(f32x4 (&acc)[2][2][4][2], const Unit& u, int wr, int wc, int fr, int fq) const {
        const int t0 = u.pm * 256 + wr * 128 + fr * 8;
        { float rs[8]; load_rs8(ss, t0, fq, rs, M_TOK - 1);
#pragma unroll
          for (int ai = 0; ai < 2; ++ai)
#pragma unroll
            for (int m = 0; m < 4; ++m)
#pragma unroll
                for (int bj = 0; bj < 2; ++bj)
#pragma unroll
                    for (int n = 0; n < 2; ++n) acc[ai][bj][m][n] = acc[ai][bj][m][n] * rs[4 * ai + m]; }
        const int pn = u.pn;
        {
            const int chunk = 2 * u.pm + wr;
            bf16_t* dst = VST + ((size_t)chunk * 512 + 256 * (pn - 5) + 32 * wc + 8 * fq) * 128 + 8 * fr;
#pragma unroll
            for (int ai = 0; ai < 2; ++ai)
#pragma unroll
                for (int m = 0; m < 4; ++m) {
                    float sq = 0.f;
#pragma unroll
                    for (int bj = 0; bj < 2; ++bj)
#pragma unroll
                        for (int n = 0; n < 2; ++n) { f32x4 v = acc[ai][bj][m][n]; v = (f32x4){gelu_t(v.x), gelu_t(v.y), gelu_t(v.z), gelu_t(v.w)}; acc[ai][bj][m][n] = v;
                            sq += (v.x * v.x + v.y * v.y) + (v.z * v.z + v.w * v.w); }
                    sq += __shfl_xor(sq, 16); sq += __shfl_xor(sq, 32);
                    if (fq == 0) ssg[(size_t)(t0 + 4 * ai + m) * 8 + 4 * (pn - 5) + wc] = sq;
                    asm volatile("" : "+v"(acc[ai][0][m][0]), "+v"(acc[ai][0][m][1]), "+v"(acc[ai][1][m][0]), "+v"(acc[ai][1][m][1]));
                }
#pragma unroll
            for (int bj = 0; bj < 2; ++bj)
#pragma unroll
                for (int n = 0; n < 2; ++n)
#pragma unroll
                    for (int i = 0; i < 4; ++i) {
                        u32x4 w; w.x = cvt_pk_bf16(acc[0][bj][0][n][i], acc[0][bj][1][n][i]); w.y = cvt_pk_bf16(acc[0][bj][2][n][i], acc[0][bj][3][n][i]);
                        w.z = cvt_pk_bf16(acc[1][bj][0][n][i], acc[1][bj][1][n][i]); w.w = cvt_pk_bf16(acc[1][bj][2][n][i], acc[1][bj][3][n][i]);
                        *(u32x4*)(dst + (size_t)(128 * bj + 4 * n + i) * 128) = w;
                    }
        }
    }
};
struct EpiEW {
    const float* ss; bf16_t* QU; bf16_t* GA; bf16_t* GB;
    __device__ __forceinline__ void operator()(f32x4 (&acc)[2][2][4][2], const Unit& u, int wr, int wc, int fr, int fq) const {
        const int t0 = u.pm * 256 + wr * 128 + fr * 8;
        float rs[8]; load_rs8(ss, t0, fq, rs, M_TOK - 1);
        const int pn = u.pn;
        const bool isu = pn < 5;
        bf16_t* dst = QU + 512 + 256 * (pn - 3) + (size_t)t0 * 1024 + 32 * wc + 8 * fq;
        if (isu) {
#pragma unroll
            for (int ai = 0; ai < 2; ++ai)
#pragma unroll
                for (int m = 0; m < 4; ++m)
#pragma unroll
                    for (int bj = 0; bj < 2; ++bj) { const f32x4 a = acc[ai][bj][m][0] * rs[4 * ai + m], b = acc[ai][bj][m][1] * rs[4 * ai + m]; u32x4 w;
                        w.x = cvt_pk_bf16(gelu_t(a.x), gelu_t(a.y)); w.y = cvt_pk_bf16(gelu_t(a.z), gelu_t(a.w)); w.z = cvt_pk_bf16(gelu_t(b.x), gelu_t(b.y)); w.w = cvt_pk_bf16(gelu_t(b.z), gelu_t(b.w));
                        *(u32x4*)(dst + (size_t)(4 * ai + m) * 1024 + 128 * bj) = w; }
        } else {
            bf16_t* da = GA + (size_t)t0 * 1024 + 128 * (pn - 7) + 32 * wc + 8 * fq; bf16_t* db = GB + (size_t)t0 * 1024 + 128 * (pn - 7) + 32 * wc + 8 * fq;
#pragma unroll
            for (int ai = 0; ai < 2; ++ai)
#pragma unroll
                for (int m = 0; m < 4; ++m) { const float k2 = rs[4 * ai + m] * -1.4426950409f; u32x4 wa, wb; float sa[8], rt[8];
#pragma unroll
                    for (int n = 0; n < 2; ++n)
#pragma unroll
                        for (int i = 0; i < 4; ++i) { const float ea = 1.0f + __builtin_amdgcn_exp2f(acc[ai][0][m][n][i] * k2), eb = 1.0f + __builtin_amdgcn_exp2f(acc[ai][1][m][n][i] * k2);
                            sa[4 * n + i] = __builtin_amdgcn_rcpf(ea); rt[4 * n + i] = ea * __builtin_amdgcn_rcpf(eb); }
                    wa.x = cvt_pk_bf16(sa[0], sa[1]); wa.y = cvt_pk_bf16(sa[2], sa[3]); wa.z = cvt_pk_bf16(sa[4], sa[5]); wa.w = cvt_pk_bf16(sa[6], sa[7]);
                    wb.x = cvt_pk_bf16(rt[0], rt[1]); wb.y = cvt_pk_bf16(rt[2], rt[3]); wb.z = cvt_pk_bf16(rt[4], rt[5]); wb.w = cvt_pk_bf16(rt[6], rt[7]);
                    *(u32x4*)(da + (size_t)(4 * ai + m) * 1024) = wa; *(u32x4*)(db + (size_t)(4 * ai + m) * 1024) = wb; }
        }
    }
};

struct EpiMerge {
    bf16_t* GA; const bf16_t* GB;
    __device__ __forceinline__ void operator()(f32x4 (&acc)[2][2][4][2], const Unit& u, int wr, int wc, int fr, int fq) const {
        const int t0 = u.pm * 256 + wr * 64 + fr;
        const size_t off0 = (size_t)t0 * 1024 + 256 * u.pn + 32 * wc + 8 * fq;
        const bf16_t* src = (u.part == 0) ? GB : (const bf16_t*)GA;
#pragma unroll
        for (int ai = 0; ai < 2; ++ai)
#pragma unroll
            for (int m = 0; m < 4; ++m)
#pragma unroll
                for (int bj = 0; bj < 2; ++bj) {
                    const size_t off = off0 + (size_t)(128 * ai + 16 * m) * 1024 + 128 * bj;
                    const u32x4 g = *(const u32x4*)(src + off);
                    const f32x4 s0 = (f32x4){bf_lo(g.x), bf_hi(g.x), bf_lo(g.y), bf_hi(g.y)}, s1 = (f32x4){bf_lo(g.z), bf_hi(g.z), bf_lo(g.w), bf_hi(g.w)};
                    const f32x4 v0 = acc[ai][bj][m][0] * s0, v1 = acc[ai][bj][m][1] * s1;
                    if (u.part == 0) { acc[ai][bj][m][0] = v0; acc[ai][bj][m][1] = v1; }
                    else { u32x4 w; w.x = cvt_pk_bf16(v0.x, v0.y); w.y = cvt_pk_bf16(v0.z, v0.w); w.z = cvt_pk_bf16(v1.x, v1.y); w.w = cvt_pk_bf16(v1.z, v1.w);
                        *(u32x4*)(GA + off) = w; }
                }
    }
};

struct EpiRes {
    const float* xp; const float* xs; int first; float* out; bf16_t* xb; float* ss; int bb; int wout;
    __device__ __forceinline__ void operator()(f32x4 (&acc)[2][2][4][2], const Unit& u, int wr, int wc, int fr, int fq) const {
        const int t0 = u.pm * 256 + wr * 64 + fr;
        const int col0 = 256 * u.pn + 32 * wc + 8 * fq;
        const float* bp0 = first ? ((t0 < NPROMPT) ? xp + (size_t)t0 * 1024 : xs + (size_t)(t0 - NPROMPT) * 1024) : out + (size_t)t0 * 1024;
#pragma unroll
        for (int ai = 0; ai < 2; ++ai)
#pragma unroll
            for (int m = 0; m < 4; ++m) {
                const int j = 128 * ai + 16 * m; float sq = 0.f;
#pragma unroll
                for (int bj = 0; bj < 2; ++bj) {
                    const size_t o = (size_t)j * 1024 + col0 + 128 * bj;
                    f32x4 a, b;
                    if (bb) { const u32x4 w = *(const u32x4*)(xb + (size_t)t0 * 1024 + o);
                        a = (f32x4){bf_lo(w.x), bf_hi(w.x), bf_lo(w.y), bf_hi(w.y)}; b = (f32x4){bf_lo(w.z), bf_hi(w.z), bf_lo(w.w), bf_hi(w.w)}; }
                    else { a = *(const f32x4*)(bp0 + o); b = *(const f32x4*)(bp0 + o + 4); }
                    a = a + acc[ai][bj][m][0]; b = b + acc[ai][bj][m][1];
                    if (wout) { float* op = out + (size_t)t0 * 1024 + o; *(f32x4*)op = a; *(f32x4*)(op + 4) = b; }
                    u32x4 w; w.x = cvt_pk_bf16(a.x, a.y); w.y = cvt_pk_bf16(a.z, a.w); w.z = cvt_pk_bf16(b.x, b.y); w.w = cvt_pk_bf16(b.z, b.w);
                    *(u32x4*)(xb + (size_t)t0 * 1024 + o) = w;
                    sq += (a.x * a.x + a.y * a.y) + (a.z * a.z + a.w * a.w) + (b.x * b.x + b.y * b.y) + (b.z * b.z + b.w * b.w);
                }
                sq += __shfl_xor(sq, 16); sq += __shfl_xor(sq, 32);
                if (fq == 0) ss[(size_t)(t0 + j) * 16 + 4 * u.pn + wc] = sq;
            }
    }
};

struct EpiUp {
    const float* ss; const float* cw; const float* cb; bf16_t* H2;
    __device__ __forceinline__ void operator()(f32x4 (&acc)[2][2][4][2], const Unit& u, int wr, int wc, int fr, int fq) const {
        const int t0 = u.pm * 252 - 1 + wr * 126 + fr * 8;
        { float rs[8]; load_rs8(ss, t0, fq, rs, M_TOK - 1);
#pragma unroll
          for (int ai = 0; ai < 2; ++ai)
#pragma unroll
            for (int m = 0; m < 4; ++m)
#pragma unroll
                for (int bj = 0; bj < 2; ++bj)
#pragma unroll
                    for (int n = 0; n < 2; ++n) acc[ai][bj][m][n] = acc[ai][bj][m][n] * rs[4 * ai + m]; }
        unsigned vmask = 0, smask = 0, emask = 0;
#pragma unroll
        for (int j = 0; j < 8; ++j) { const int t = t0 + j, loc = fr * 8 + j;
            if (loc >= 1 && loc <= 126 && t < M_TOK) vmask |= 1u << j;
            const int sm = (t < NPROMPT) ? (SEQ_P - 1) : (SEQ_S - 1);
            if ((t & sm) == 0) smask |= 1u << j;
            if ((t & sm) == sm) emask |= 1u << j; }
#pragma unroll
        for (int n = 0; n < 2; ++n) {
            const int cg_ = 128 * u.pn + 32 * wc + 8 * fq + 4 * n;
            const f32x4 w0g = *(const f32x4*)(cw + cg_), w1g = *(const f32x4*)(cw + 4096 + cg_), w2g = *(const f32x4*)(cw + 8192 + cg_), bg = *(const f32x4*)(cb + cg_);
            const f32x4 w0v = *(const f32x4*)(cw + 2048 + cg_), w1v = *(const f32x4*)(cw + 4096 + 2048 + cg_), w2v = *(const f32x4*)(cw + 8192 + 2048 + cg_), bv = *(const f32x4*)(cb + 2048 + cg_);
            float h[8][4];
#pragma unroll
            for (int i = 0; i < 4; ++i) {
                float ag[8], av[8];
#pragma unroll
                for (int j = 0; j < 8; ++j) { ag[j] = acc[j >> 2][0][j & 3][n][i]; av[j] = acc[j >> 2][1][j & 3][n][i]; }
                const float lg = dpp_shr1(ag[7]), rg = dpp_shl1(ag[0]), lv = dpp_shr1(av[7]), rv = dpp_shl1(av[0]);
#pragma unroll
                for (int j = 0; j < 8; ++j) {
                    float Lg = j == 0 ? lg : ag[j == 0 ? 0 : j - 1], Rg = j == 7 ? rg : ag[j == 7 ? 7 : j + 1];
                    float Lv = j == 0 ? lv : av[j == 0 ? 0 : j - 1], Rv = j == 7 ? rv : av[j == 7 ? 7 : j + 1];
                    if ((smask >> j) & 1u) { Lg = 0.f; Lv = 0.f; }
                    if ((emask >> j) & 1u) { Rg = 0.f; Rv = 0.f; }
                    const float cgv = w0g[i] * Lg + w1g[i] * ag[j] + w2g[i] * Rg + bg[i];
                    const float cvv = w0v[i] * Lv + w1v[i] * av[j] + w2v[i] * Rv + bv[i];
                    h[j][i] = gelu_t(cgv) * cvv;
                }
            }
#pragma unroll
            for (int j = 0; j < 8; ++j) if ((vmask >> j) & 1u) { u32x2 w; w.x = cvt_pk_bf16(h[j][0], h[j][1]); w.y = cvt_pk_bf16(h[j][2], h[j][3]);
                *(u32x2*)(H2 + (size_t)(t0 + j) * 2048 + cg_) = w; }
        }
    }
};
}

namespace attn_body {
using bf16=__hip_bfloat16;
using bf16x8=__attribute__((ext_vector_type(8)))short;
using s16x4=__attribute__((ext_vector_type(4)))short;
using f32x16=__attribute__((ext_vector_type(16)))float;
using u32x4=__attribute__((ext_vector_type(4)))unsigned;
constexpr int D=64,QP=1024,KP=128;
constexpr int NW=8,QBLK=32,QB=QBLK*NW,KVBLK=64;
__device__ __forceinline__ int crow(int r,int hi){return (r&3)+8*(r>>2)+4*hi;}
#define SBAR() __builtin_amdgcn_sched_barrier(0)
constexpr int NSLOT=3, SLOTB=8192;
constexpr int LDS_K=0, LDS_V=NSLOT*SLOTB, LDS_WS=2*NSLOT*SLOTB, LDS_OST=LDS_WS+NW*64*4, LDS_BYTES=LDS_OST+NW*4096;
__device__ __forceinline__ void glds16(const void*gsrc,unsigned lds_dst){unsigned keep;
  asm volatile("s_mov_b32 %0, m0\n\ts_mov_b32 m0, %2\n\ts_nop 0\n\tglobal_load_lds_dwordx4 %1, off\n\ts_mov_b32 m0, %0":"=&s"(keep):"v"(gsrc),"s"(lds_dst):"memory");}
__device__ __forceinline__ float max3f(float a,float b,float c){float r;asm("v_max3_f32 %0, %1, %2, %3":"=v"(r):"v"(a),"v"(b),"v"(c));return r;}
__device__ __forceinline__ float max2f(float a,float b){float r;asm("v_max_f32_e32 %0, %1, %2":"=v"(r):"v"(a),"v"(b));return r;}
__device__ __forceinline__ float fadd_s(float a,float b){float r;asm("v_add_f32_e32 %0, %1, %2":"=v"(r):"v"(a),"v"(b));return r;}
__device__ __forceinline__ float fsub_s(float a,float b){float r;asm("v_sub_f32_e32 %0, %1, %2":"=v"(r):"v"(a),"v"(b));return r;}
typedef float f32x2_t __attribute__((ext_vector_type(2))); typedef __bf16 bf16x2_t __attribute__((ext_vector_type(2)));
__device__ __forceinline__ unsigned cvtpk_s(float lo,float hi){f32x2_t v={lo,hi};bf16x2_t b=__builtin_convertvector(v,bf16x2_t);return __builtin_bit_cast(unsigned,b);}
#define WAIT_BAR(N) asm volatile("s_waitcnt vmcnt(" #N ") lgkmcnt(0)\n\ts_barrier":::"memory")
__device__ __forceinline__ void qkt(f32x16&p0,f32x16&p1,const char*Kslot,const bf16x8*qr,const f32x16&negm,int r32,int hi){
  const char*kb=Kslot+hi*1024+r32*16;
  #pragma unroll
  for(int d0=0;d0<4;++d0){
    const bf16x8 b0=*reinterpret_cast<const bf16x8*>(kb+d0*2048);
    const bf16x8 b1=*reinterpret_cast<const bf16x8*>(kb+d0*2048+512);
    if(d0==0){p0=__builtin_amdgcn_mfma_f32_32x32x16_bf16(b0,qr[0],negm,0,0,0);p1=__builtin_amdgcn_mfma_f32_32x32x16_bf16(b1,qr[0],negm,0,0,0);}
    else{p0=__builtin_amdgcn_mfma_f32_32x32x16_bf16(b0,qr[d0],p0,0,0,0);p1=__builtin_amdgcn_mfma_f32_32x32x16_bf16(b1,qr[d0],p1,0,0,0);}}
}
typedef __attribute__((address_space(3))) const char* lds_cptr;
typedef short v4i16_t __attribute__((ext_vector_type(4)));
__device__ __forceinline__ void kload8(bf16x8*kf,lds_cptr kp){
  kf[0]=*(const __attribute__((address_space(3))) bf16x8*)(kp);      kf[1]=*(const __attribute__((address_space(3))) bf16x8*)(kp+512);
  kf[2]=*(const __attribute__((address_space(3))) bf16x8*)(kp+2048); kf[3]=*(const __attribute__((address_space(3))) bf16x8*)(kp+2560);
  kf[4]=*(const __attribute__((address_space(3))) bf16x8*)(kp+4096); kf[5]=*(const __attribute__((address_space(3))) bf16x8*)(kp+4608);
  kf[6]=*(const __attribute__((address_space(3))) bf16x8*)(kp+6144); kf[7]=*(const __attribute__((address_space(3))) bf16x8*)(kp+6656);
}
__device__ __forceinline__ void kload2(bf16x8*kf,lds_cptr kp,int j){ kf[2*j]=*(const __attribute__((address_space(3))) bf16x8*)(kp+j*2048); kf[2*j+1]=*(const __attribute__((address_space(3))) bf16x8*)(kp+j*2048+512); }
__device__ __forceinline__ s16x4 vtr(lds_cptr p){ return __builtin_bit_cast(s16x4,__builtin_amdgcn_ds_read_tr16_b64_v4i16((__attribute__((address_space(3))) v4i16_t*)p)); }
__device__ __forceinline__ float rowmax(const f32x16&p0,const f32x16&p1){
  float a=max3f(p0[0],p0[1],p1[0]),b=max3f(p0[2],p0[3],p1[1]);a=max3f(a,p1[2],p1[3]);
  #pragma unroll
  for(int r=4;r<16;r+=4){a=max3f(a,p0[r],p0[r+1]);b=max3f(b,p0[r+2],p0[r+3]);a=max3f(a,p1[r],p1[r+1]);b=max3f(b,p1[r+2],p1[r+3]);}
  const float m=max2f(a,b);
  auto rr=__builtin_amdgcn_permlane32_swap(__float_as_uint(m),__float_as_uint(m),false,false);
  return max2f(__uint_as_float(rr[0]),__uint_as_float(rr[1]));
}
__device__ __forceinline__ void pv(f32x16*o,int vb,bf16x8 pa0,bf16x8 pa1,bf16x8 pa2,bf16x8 pa3){
  #pragma unroll
  for(int d0=0;d0<2;++d0){s16x4 lo[4],hi[4];
    #pragma unroll
    for(int ks=0;ks<4;++ks){
      asm volatile("ds_read_b64_tr_b16 %0,%1 offset:%c2":"=&v"(lo[ks]):"v"(vb),"i"(d0*4096+ks*1024):"memory");
      asm volatile("ds_read_b64_tr_b16 %0,%1 offset:%c2":"=&v"(hi[ks]):"v"(vb),"i"(d0*4096+ks*1024+512):"memory");}
    asm volatile("s_waitcnt lgkmcnt(0)":::"memory");SBAR();
    #define PK(k) (bf16x8){lo[k][0],lo[k][1],lo[k][2],lo[k][3],hi[k][0],hi[k][1],hi[k][2],hi[k][3]}
    o[d0]=__builtin_amdgcn_mfma_f32_32x32x16_bf16(pa0,PK(0),o[d0],0,0,0);
    o[d0]=__builtin_amdgcn_mfma_f32_32x32x16_bf16(pa1,PK(1),o[d0],0,0,0);
    o[d0]=__builtin_amdgcn_mfma_f32_32x32x16_bf16(pa2,PK(2),o[d0],0,0,0);
    o[d0]=__builtin_amdgcn_mfma_f32_32x32x16_bf16(pa3,PK(3),o[d0],0,0,0);
    #undef PK
  }
}
template<int THRL> __device__ __forceinline__ void attn_unit(long rowbase,int seq,int h,int q0,const bf16*Q,const bf16*__restrict__ K,const bf16*__restrict__ V,bf16*O,char*shm){
  int tid_=threadIdx.x; asm volatile("":"+v"(tid_));
  const int tid=tid_,lane=tid&63,r32=lane&31,hi=lane>>5; const int wid=__builtin_amdgcn_readfirstlane(tid>>6);
  const bf16*Qw=Q+(rowbase+q0+wid*QBLK)*QP+h*D;
  const bf16*Kh=K+rowbase*KP+(h>>2)*D,*Vh=V+rowbase*KP+(h>>2)*D;
  const unsigned lds0=(unsigned)(uintptr_t)shm;
  float*wsf=(float*)(shm+LDS_WS)+wid*64;
  const bf16*ksrc=Kh+(long)lane*KP+wid*8;
  const bf16*vsrc=Vh+(long)(16*(wid&3)+(lane>>2))*KP+(wid>>2)*32+(lane&3)*8;
  const unsigned kdst=lds0+LDS_K+wid*1024, vdst=lds0+LDS_V+wid*1024;
  #define DMA_K(t,slot) glds16(ksrc+(long)(t)*KVBLK*KP,(unsigned)__builtin_amdgcn_readfirstlane(kdst+(slot)))
  #define DMA_V(t,slot) glds16(vsrc+(long)(t)*KVBLK*KP,(unsigned)__builtin_amdgcn_readfirstlane(vdst+(slot)))
  const int vb0=(int)(lds0+LDS_V)+((lane>>4)&1)*32+(lane&3)*8+(4*hi+((lane&15)>>2))*64;
  const char*Kbase=shm+LDS_K; bf16x8 kf[8];
  const lds_cptr shm3=(lds_cptr)shm; const lds_cptr kp0=shm3+LDS_K+hi*1024+r32*16; const lds_cptr vp0=shm3+LDS_V+((lane>>4)&1)*32+(lane&3)*8+(4*hi+((lane&15)>>2))*64;
  const int NT=seq/KVBLK;
  DMA_K(0,0);DMA_V(0,0);DMA_K(1,SLOTB);
  bf16x8 qr[4];
  #pragma unroll
  for(int d0=0;d0<4;++d0)qr[d0]=*reinterpret_cast<const bf16x8*>(&Qw[(long)r32*QP+d0*16+hi*8]);
  float mhat=0.f,l_reg=0.f;f32x16 o[2];o[0]=f32x16{};o[1]=f32x16{};f32x16 negm=f32x16{};asm volatile("":"+v"(negm));
  bool resc=false;
  #define START(P0,P1) do{ const float rm=rowmax(P0,P1); resc=false; \
    { const float dl=rm; mhat=fadd_s(mhat,dl); \
      _Pragma("unroll") for(int r=0;r<16;++r){P0[r]=fsub_s(P0[r],dl);P1[r]=fsub_s(P1[r],dl);} \
      _Pragma("unroll") for(int r=0;r<16;++r)negm[r]=-mhat; asm volatile("":"+v"(negm)); } \
    _Pragma("unroll") for(int r=0;r<16;++r)P0[r]=__builtin_amdgcn_exp2f(P0[r]); }while(0)
  #define RESC() do{ if(resc){ asm volatile("s_waitcnt lgkmcnt(0)":::"memory"); \
      _Pragma("unroll") for(int d_=0;d_<2;++d_) _Pragma("unroll") for(int r=0;r<16;++r)o[d_][r]*=wsf[crow(r,hi)]; } }while(0)
  f32x16 pA0,pA1,pB0,pB1;
  int sl_prev=0,sl_cur=0,sl_next=SLOTB;
  #define ROT() do{sl_prev=sl_cur;sl_cur=sl_next;sl_next=(sl_next==(NSLOT-1)*SLOTB)?0:sl_next+SLOTB;}while(0)
  DMA_K(2,2*SLOTB);
  WAIT_BAR(3);
  qkt(pA0,pA1,Kbase,qr,negm,r32,hi);asm volatile("s_nop 15\n\ts_nop 7":"+v"(pA0),"+v"(pA1));
  START(pA0,pA1);
  _Pragma("unroll") for(int r=0;r<16;++r)pA1[r]=__builtin_amdgcn_exp2f(pA1[r]);
  WAIT_BAR(0);
  DMA_K(3,0);DMA_V(1,SLOTB);
  ROT();
  kload8(kf,kp0+sl_cur);
  WAIT_BAR(2);
  s16x4 vlo[8],vhi[8]; u32x4 pw0,pw1,pw2,pw3;
  #define PKW(P,B) cvtpk_s(P[B],P[B+1])
  #define PAF(k) __builtin_bit_cast(bf16x8,pw##k)
  #define VFR(i) (bf16x8){vlo[i][0],vlo[i][1],vlo[i][2],vlo[i][3],vhi[i][0],vhi[i][1],vhi[i][2],vhi[i][3]}
  #define PIN(x) asm volatile("":"+v"(x))
  #define MX3(a,b,c) __builtin_fmaxf(__builtin_fmaxf((a),(b)),(c))
  #define GAPA(MF,A0,A1,A2,A3,W0,W1,PW) do{ MF; sacc+=A0; sacc+=A1; sacc+=A2; sacc+=A3; PIN(sacc); W0; W1; PIN(PW); SBAR(); }while(0)
  #define EX(v) __builtin_amdgcn_exp2f(v)
  #define GAPB(MF,X,B) do{ MF; X[B]=EX(X[B]); X[B+1]=EX(X[B+1]); X[B+2]=EX(X[B+2]); X[B+3]=EX(X[B+3]); PIN(X); SBAR(); }while(0)
  #define VRD(i) do{ vlo[i]=vtr(vp_+(((i)>>2)*4096+((i)&3)*1024)); vhi[i]=vtr(vp_+(((i)>>2)*4096+((i)&3)*1024+512)); }while(0)
  #define KRD(G,j) do{ if(G){ kload2(kf,kp0+sl_next,j); SBAR(); } }while(0)
  #define STEP(C0,C1,P0,P1,t,GK,GV,GL) do{ SBAR(); \
    const lds_cptr vp_=vp0+sl_prev; \
    VRD(0); SBAR(); float sacc=(P0[0]+P0[1]); \
    GAPA(C0=__builtin_amdgcn_mfma_f32_32x32x16_bf16(kf[0],qr[0],negm,0,0,0), P0[2],P0[3],P0[4],P0[5],     pw0[0]=PKW(P0,0), pw0[1]=PKW(P0,2), pw0); \
    VRD(4); SBAR(); GAPA(C1=__builtin_amdgcn_mfma_f32_32x32x16_bf16(kf[1],qr[0],negm,0,0,0), P0[6],P0[7],P0[8],P0[9],     pw0[2]=PKW(P0,4), pw0[3]=PKW(P0,6), pw0); \
    VRD(1); SBAR(); GAPA(C0=__builtin_amdgcn_mfma_f32_32x32x16_bf16(kf[2],qr[1],C0,0,0,0),   P0[10],P0[11],P0[12],P0[13], pw1[0]=PKW(P0,8), pw1[1]=PKW(P0,10), pw1); \
    VRD(5); SBAR(); GAPA(C1=__builtin_amdgcn_mfma_f32_32x32x16_bf16(kf[3],qr[1],C1,0,0,0),   P0[14],P0[15],P1[0],P1[1],   pw1[2]=PKW(P0,12),pw1[3]=PKW(P0,14), pw1); \
    VRD(2); SBAR(); GAPA(C0=__builtin_amdgcn_mfma_f32_32x32x16_bf16(kf[4],qr[2],C0,0,0,0),   P1[2],P1[3],P1[4],P1[5],     pw2[0]=PKW(P1,0), pw2[1]=PKW(P1,2), pw2); \
    VRD(6); SBAR(); GAPA(C1=__builtin_amdgcn_mfma_f32_32x32x16_bf16(kf[5],qr[2],C1,0,0,0),   P1[6],P1[7],P1[8],P1[9],     pw2[2]=PKW(P1,4), pw2[3]=PKW(P1,6), pw2); \
    VRD(3); SBAR(); GAPA(C0=__builtin_amdgcn_mfma_f32_32x32x16_bf16(kf[6],qr[3],C0,0,0,0),   P1[10],P1[11],P1[12],P1[13], pw3[0]=PKW(P1,8), pw3[1]=PKW(P1,10), pw3); \
    VRD(7); SBAR(); GAPA(C1=__builtin_amdgcn_mfma_f32_32x32x16_bf16(kf[7],qr[3],C1,0,0,0),   P1[14],P1[15],0.f,0.f,       pw3[2]=PKW(P1,12),pw3[3]=PKW(P1,14), pw3); \
    l_reg+=sacc; \
    if(GK){DMA_K((t)+3,sl_cur);} if(GV){DMA_V((t)+1,sl_next);} \
    { float a=MX3(C0[0],C0[1],C1[0]),b=MX3(C0[2],C0[3],C1[1]); a=MX3(a,C1[2],C1[3]); \
      _Pragma("unroll") for(int r=4;r<16;r+=4){a=MX3(a,C0[r],C0[r+1]);b=MX3(b,C0[r+2],C0[r+3]);a=MX3(a,C1[r],C1[r+1]);b=MX3(b,C1[r+2],C1[r+3]);} \
      float rm=__builtin_fmaxf(a,b); { auto rr=__builtin_amdgcn_permlane32_swap(__float_as_uint(rm),__float_as_uint(rm),false,false); rm=__builtin_fmaxf(__uint_as_float(rr[0]),__uint_as_float(rr[1])); } \
      resc=false; \
      if(__builtin_expect(__any(rm>(float)THRL),0)){ const float dl=__builtin_fmaxf(rm,0.f); mhat+=dl; \
        _Pragma("unroll") for(int r=0;r<16;++r){C0[r]-=dl;C1[r]-=dl;} \
        _Pragma("unroll") for(int r=0;r<16;++r)negm[r]=-mhat; asm volatile("":"+v"(negm)); \
        const float f=__builtin_amdgcn_exp2f(-dl); l_reg*=f; if(hi==0)wsf[r32]=f; resc=true; } } \
    SBAR(); \
    GAPB(o[0]=__builtin_amdgcn_mfma_f32_32x32x16_bf16(PAF(0),VFR(0),o[0],0,0,0), C0,0); \
    GAPB(o[1]=__builtin_amdgcn_mfma_f32_32x32x16_bf16(PAF(0),VFR(4),o[1],0,0,0), C0,4); \
    KRD(GL,0); GAPB(o[0]=__builtin_amdgcn_mfma_f32_32x32x16_bf16(PAF(1),VFR(1),o[0],0,0,0), C0,8); \
    KRD(GL,1); GAPB(o[1]=__builtin_amdgcn_mfma_f32_32x32x16_bf16(PAF(1),VFR(5),o[1],0,0,0), C0,12); \
    KRD(GL,2); GAPB(o[0]=__builtin_amdgcn_mfma_f32_32x32x16_bf16(PAF(2),VFR(2),o[0],0,0,0), C1,0); \
    KRD(GL,3); GAPB(o[1]=__builtin_amdgcn_mfma_f32_32x32x16_bf16(PAF(2),VFR(6),o[1],0,0,0), C1,4); \
    GAPB(o[0]=__builtin_amdgcn_mfma_f32_32x32x16_bf16(PAF(3),VFR(3),o[0],0,0,0), C1,8); \
    GAPB(o[1]=__builtin_amdgcn_mfma_f32_32x32x16_bf16(PAF(3),VFR(7),o[1],0,0,0), C1,12); \
    }while(0)
  int t=1;
  for(;t+5<NT;t+=2){
    STEP(pB0,pB1,pA0,pA1,t,true,true,true);     WAIT_BAR(2); RESC(); ROT();
    STEP(pA0,pA1,pB0,pB1,t+1,true,true,true);   WAIT_BAR(2); RESC(); ROT();
  }
  #define ENDW(tt) do{ if((tt)+3<NT){WAIT_BAR(2);} else if((tt)+2<NT){WAIT_BAR(1);} else {WAIT_BAR(0);} }while(0)
  for(;t+1<NT;t+=2){
    STEP(pB0,pB1,pA0,pA1,t,(t+3<NT),(t+1<NT),(t+1<NT));       ENDW(t);   RESC(); ROT();
    STEP(pA0,pA1,pB0,pB1,t+1,(t+4<NT),(t+2<NT),(t+2<NT));     ENDW(t+1); RESC(); ROT();
  }
  STEP(pB0,pB1,pA0,pA1,NT-1,false,false,false); RESC();
  { float sacc=pB0[0]+pB0[1]; _Pragma("unroll") for(int r=2;r<16;++r)sacc+=pB0[r]; _Pragma("unroll") for(int r=0;r<16;++r)sacc+=pB1[r]; l_reg+=sacc;
    pw0=(u32x4){PKW(pB0,0),PKW(pB0,2),PKW(pB0,4),PKW(pB0,6)};pw1=(u32x4){PKW(pB0,8),PKW(pB0,10),PKW(pB0,12),PKW(pB0,14)};pw2=(u32x4){PKW(pB1,0),PKW(pB1,2),PKW(pB1,4),PKW(pB1,6)};pw3=(u32x4){PKW(pB1,8),PKW(pB1,10),PKW(pB1,12),PKW(pB1,14)};
    SBAR(); pv(o,vb0+sl_cur,PAF(0),PAF(1),PAF(2),PAF(3)); }
  #undef PKW
  #undef PAF
  #undef VFR
  #undef PIN
  #undef MX3
  #undef GAPA
  #undef GAPB
  #undef EX
  #undef VRD
  #undef KRD
  #undef STEP
  #undef ENDW
  {auto rr=__builtin_amdgcn_permlane32_swap(__float_as_uint(l_reg),__float_as_uint(l_reg),false,false);l_reg=__uint_as_float(rr[0])+__uint_as_float(rr[1]);}
  if(hi==0)wsf[32+r32]=l_reg;asm volatile("s_waitcnt lgkmcnt(0)":::"memory");
  float rli[16];
  #pragma unroll
  for(int r=0;r<16;++r)rli[r]=__builtin_amdgcn_rcpf(wsf[32+crow(r,hi)]);
  bf16*Ow=O+(rowbase+q0+wid*QBLK)*QP+h*D;
  { bf16*stg=(bf16*)(shm+LDS_OST)+wid*2048;
    #pragma unroll
    for(int r=0;r<16;++r){const int orow=crow(r,hi);
      #pragma unroll
      for(int d0=0;d0<2;++d0)stg[orow*64+d0*32+r32]=__float2bfloat16(o[d0][r]*rli[r]);}
    asm volatile("s_waitcnt lgkmcnt(0)":::"memory");
    #pragma unroll
    for(int i=0;i<4;++i){const int row=i*8+(lane>>3),ch=lane&7; const u32x4 v=*(const u32x4*)(stg+row*64+ch*8); *(u32x4*)(Ow+(long)row*QP+ch*8)=v;} }
  asm volatile("s_waitcnt lgkmcnt(0)\n\ts_barrier":::"memory");
  #undef DMA_K
  #undef DMA_V
  #undef START
  #undef RESC
  #undef ROT
}
constexpr int ATTN_LDS_BYTES=LDS_BYTES;
#undef SBAR
#undef WAIT_BAR
}

#define GRID_SYNC() do { asm volatile("s_waitcnt vmcnt(0) lgkmcnt(0)" ::: "memory"); grid.sync(); __builtin_amdgcn_fence(__ATOMIC_ACQUIRE, "agent"); asm volatile("s_waitcnt vmcnt(0)" ::: "memory"); } while (0)
#ifndef N_LAUNCH_MODE
#define N_LAUNCH_MODE 0
#endif
constexpr int N_PHASES = 2 + 6 * NLAYER;
constexpr int NWAVES = 8;
constexpr size_t MiB = 1u << 20;
constexpr size_t WL_IN = 0, WL_A = WL_IN + (size_t)INW * 1024, WL_B = WL_A + 1024 * 512, WL_MIX = WL_B + 1024 * 512, WL_UP = WL_MIX + 1024 * 1024,
                 WL_DOWN = WL_UP + 4096 * 1024, WL_SG = WL_DOWN + 1024 * 2048, WL_SIZE = WL_SG + 8 * 128 * 128;
static_assert(WL_SIZE * 2 * NLAYER <= 95 * MiB, "weights region");
constexpr size_t WS_ROPE = 0, WS_W = 1 * MiB, WS_XB = 96 * MiB + 4096, WS_QU = 289 * MiB, WS_K = 481 * MiB, WS_V = 505 * MiB, WS_VST = 529 * MiB,
                 WS_GA = 625 * MiB, WS_GB = 817 * MiB, WS_H2 = 625 * MiB, WS_SS = 1009 * MiB, WS_SSG = 1015 * MiB, WS_END = 1018 * MiB;
constexpr int LDS_BYTES = 147456, SG_SCR_OFF = 135168, BARST_OFF = 140288;
constexpr size_t WS_BAR = 65536, BAR_BYTES = 16384;


#define XB_TMO      128
#define XB_XCNT(j)  (256  + 64 * (j))
#define XB_XSUB(j)  (1280 + 64 * (j))
#define XB_XGEN(j)  (2304 + 64 * (j))
#define XB_TOP      3328
#define XB_TOPGEN   3392
#define XCD_BAR_WORDS 3456
#define XB_SPIN_CAP (1u << 22)
__device__ __forceinline__ unsigned xb_ld(unsigned* p)              { return __hip_atomic_load(p, __ATOMIC_RELAXED, __HIP_MEMORY_SCOPE_AGENT); }
__device__ __forceinline__ unsigned xb_add(unsigned* p, unsigned v) { return __hip_atomic_fetch_add(p, v, __ATOMIC_RELAXED, __HIP_MEMORY_SCOPE_AGENT); }
__device__ __forceinline__ unsigned xb_xcc_id() { return (unsigned)__builtin_amdgcn_s_getreg((3 << 11) | 20) & 0xFu; }
#define XB_SPIN(cond, bar) do { unsigned _sp = 0; while (cond) { __builtin_amdgcn_s_sleep(1); \
    if ((++_sp & 255u) == 0u) { if (xb_ld(&(bar)[XB_TMO])) break; if (_sp > XB_SPIN_CAP) { atomicAdd(&(bar)[XB_TMO], 1u); break; } } } } while (0)
struct XcdBarrier { unsigned* bar; unsigned x; volatile LAS unsigned* st; };
__device__ __forceinline__ XcdBarrier xcd_barrier_post(unsigned* bar, volatile LAS unsigned* st) {
    XcdBarrier b; b.bar = bar; b.x = xb_xcc_id(); b.st = st;
    if (threadIdx.x == 0) (void)xb_add(&bar[XB_XCNT(b.x)], 1u);
    return b;
}
__device__ __forceinline__ void xcd_barrier_complete(unsigned* bar, unsigned x, unsigned& nloc, unsigned& nx) {
    const unsigned G = gridDim.x * gridDim.y * gridDim.z;
    unsigned sum, cnt, mine, sp = 0u;
    for (;;) {
        sum = 0u; cnt = 0u; mine = 0u;
#pragma unroll
        for (unsigned j = 0; j < 16; ++j) { const unsigned c = xb_ld(&bar[XB_XCNT(j)]); sum += c; cnt += (c > 0u) ? 1u : 0u; mine = (j == x) ? c : mine; }
        if (sum == G) break;
        __builtin_amdgcn_s_sleep(1);
        if ((++sp & 255u) == 0u) { if (xb_ld(&bar[XB_TMO])) break; if (sp > XB_SPIN_CAP) { atomicAdd(&bar[XB_TMO], 1u); break; } }
    }
    nloc = mine > 0u ? mine : 1u; nx = cnt > 0u ? cnt : 1u;
}
__device__ __forceinline__ void xcd_barrier(const XcdBarrier& b) {
    asm volatile("s_waitcnt vmcnt(0)" ::: "memory");
    __syncthreads();
    if (threadIdx.x == 0) {
        unsigned* bar = b.bar;
        __builtin_amdgcn_s_waitcnt(0);
        unsigned nloc = b.st[0], nx = b.st[1];
        if (nloc == 0u) { xcd_barrier_complete(bar, b.x, nloc, nx); b.st[0] = nloc; b.st[1] = nx; }
        const unsigned old = xb_add(&bar[XB_XSUB(b.x)], 1u);
        const unsigned gen = old / nloc;
        if (old + 1u == (gen + 1u) * nloc) {
            __builtin_amdgcn_fence(__ATOMIC_RELEASE, "agent");
            asm volatile("s_waitcnt vmcnt(0)" ::: "memory");
            const unsigned og = xb_add(&bar[XB_TOP], 1u);
            const unsigned tg = og / nx;
            if (og + 1u == (tg + 1u) * nx) xb_add(&bar[XB_TOPGEN], 1u);
            else XB_SPIN(xb_ld(&bar[XB_TOPGEN]) == tg, bar);
            __builtin_amdgcn_fence(__ATOMIC_ACQUIRE, "agent");
            xb_add(&bar[XB_XGEN(b.x)], 1u);
            asm volatile("s_waitcnt vmcnt(0)" ::: "memory");
        } else {
            XB_SPIN(xb_ld(&bar[XB_XGEN(b.x)]) == gen, bar);
            __builtin_amdgcn_fence(__ATOMIC_ACQUIRE, "agent");
            asm volatile("s_waitcnt vmcnt(0)" ::: "memory");
        }
    }
    __syncthreads();
}

struct Args { const float* in[18]; float* out; unsigned char* ws; int ph_lo, ph_hi; };

__device__ __forceinline__ float wave_sum(float v) {
#pragma unroll
    for (int o = 1; o < 64; o <<= 1) v += __shfl_xor(v, o);
    return v;
}
__device__ __forceinline__ int invperm32(int cc) { return 16 * ((cc >> 2) & 1) + 4 * (cc >> 3) + (cc & 3); }
__device__ __forceinline__ int map_plain(int n) { return (n & ~31) + invperm32(n & 31); }
__device__ __forceinline__ int map_in(int n) {
    if (n < 512) { const int pn = n >> 8, hh = (n >> 6) & 3, d = n & 63; return 256 * pn + 128 * (d >> 5) + 32 * hh + (d & 31); }
    if (n < 768) { const int c = n - 512, isv = c >> 7, head = (c >> 6) & 1, d = c & 63, wc = 2 * isv + head; return 512 + 128 * (d >> 5) + 32 * wc + (d & 31); }
    if (n >= 1792) { const int bj = (n >= 2816) ? 1 : 0, c = n - 1792 - 1024 * bj, r = c & 127;
        return 1792 + 256 * (c >> 7) + 128 * bj + (r & ~31) + invperm32(r & 31); }
    return map_plain(n);
}
__device__ __forceinline__ int map_up(int n) { const int bj = n >> 11, c = n & 2047, pn = c >> 7, r = c & 127; return 256 * pn + 128 * bj + (r & ~31) + invperm32(r & 31); }

template <int MAP>
__device__ __forceinline__ void transpose_item(const float* W, const float* g, int K, int N, bf16_t* WT, LAS float* scr, int item, int lane) {
    const int nblk = N / 32, kb = item / nblk, nb = item % nblk, k0 = 64 * kb, n0 = 32 * nb;
#pragma unroll 8
    for (int i = 0; i < 32; ++i) { const int kk = 2 * i + (lane >> 5); float v = W[(size_t)(k0 + kk) * N + n0 + (lane & 31)]; if (g) v *= g[k0 + kk]; scr[kk * 33 + (lane & 31)] = v; }
    asm volatile("s_waitcnt lgkmcnt(0)" ::: "memory");
    const int c = lane & 7;
#pragma unroll
    for (int j = 0; j < 4; ++j) { const int n = (lane >> 3) + 8 * j; const LAS float* s = scr + (8 * c) * 33 + n;
        u32x4 o; o.x = cvt_pk_bf16(s[0 * 33], s[1 * 33]); o.y = cvt_pk_bf16(s[2 * 33], s[3 * 33]); o.z = cvt_pk_bf16(s[4 * 33], s[5 * 33]); o.w = cvt_pk_bf16(s[6 * 33], s[7 * 33]);
        const int nn = n0 + n; const int row = MAP == 0 ? map_plain(nn) : (MAP == 1 ? map_in(nn) : map_up(nn));
        *(u32x4*)(WT + (size_t)row * K + k0 + 8 * c) = o; }
    asm volatile("s_waitcnt lgkmcnt(0)" ::: "memory");
}

__device__ __forceinline__ void sincos_tab(float x, float& c, float& s) {
    const float n = rintf(x * 0.63661977236758134308f);
    float r = fmaf(-n, 1.5703125f, x); r = fmaf(-n, 4.83751296997070312500e-4f, r); r = fmaf(-n, 7.5497899548918821e-8f, r);
    const float r2 = r * r;
    const float sp = r + r * r2 * (-1.0f / 6 + r2 * (1.0f / 120 + r2 * (-1.0f / 5040 + r2 * (1.0f / 362880))));
    const float cp = 1.0f + r2 * (-0.5f + r2 * (1.0f / 24 + r2 * (-1.0f / 720 + r2 * (1.0f / 40320 + r2 * (-1.0f / 3628800)))));
    const int q = ((int)n) & 3;
    s = (q == 0) ? sp : (q == 1) ? cp : (q == 2) ? -sp : -cp;
    c = (q == 0) ? cp : (q == 1) ? -sp : (q == 2) ? -cp : sp;
}

__device__ __forceinline__ void sg_unit(int ch, int g, const bf16_t* VST, const float* ssg, const bf16_t* Wg, const float* sgb, const float* gsg, bf16_t* QU, LAS float* scr, int lane) {
    asm volatile("" : "+v"(lane));
    const int fr = lane & 15, fq = lane >> 4;
#pragma unroll
    for (int hh = 0; hh < 2; ++hh) { const int p = lane + 64 * hh; const float* sp = ssg + (size_t)(ch * 128 + p) * 8; const f32x4 a = *(const f32x4*)sp, b = *(const f32x4*)(sp + 4);
        const float s = ((a.x + a.y) + (a.z + a.w)) + ((b.x + b.y) + (b.z + b.w)); scr[p] = __builtin_amdgcn_rsqf(s * (1.0f / 512.0f) + EPS); }
    asm volatile("s_waitcnt lgkmcnt(0)" ::: "memory");
    f32x4 acc[8][4];
#pragma unroll
    for (int pt = 0; pt < 8; ++pt)
#pragma unroll
        for (int ct = 0; ct < 4; ++ct) acc[pt][ct] = (f32x4){0.f, 0.f, 0.f, 0.f};
    const bf16_t* vbase = VST + ((size_t)ch * 512 + g * 64) * 128;
    const bf16_t* wbase = Wg + (size_t)g * 128 * 128;
#pragma unroll 1
    for (int kk = 0; kk < 4; ++kk) {
        const int k0 = kk * 32 + 8 * fq;
        bf16x8 af[4];
#pragma unroll
        for (int ct = 0; ct < 4; ++ct) af[ct] = *(const bf16x8*)(vbase + (size_t)(ct * 16 + fr) * 128 + k0);
        float r[8];
#pragma unroll
        for (int e = 0; e < 8; ++e) r[e] = scr[k0 + e];
#pragma unroll
        for (int pt = 0; pt < 8; ++pt) {
            const u32x4 w = *(const u32x4*)(wbase + (size_t)(pt * 16 + fr) * 128 + k0);
            u32x4 ws; ws.x = cvt_pk_bf16(bf_lo(w.x) * r[0], bf_hi(w.x) * r[1]); ws.y = cvt_pk_bf16(bf_lo(w.y) * r[2], bf_hi(w.y) * r[3]);
            ws.z = cvt_pk_bf16(bf_lo(w.z) * r[4], bf_hi(w.z) * r[5]); ws.w = cvt_pk_bf16(bf_lo(w.w) * r[6], bf_hi(w.w) * r[7]);
            const bf16x8 bfz = __builtin_bit_cast(bf16x8, ws);
#pragma unroll
            for (int ct = 0; ct < 4; ++ct) acc[pt][ct] = __builtin_amdgcn_mfma_f32_16x16x32_bf16(af[ct], bfz, acc[pt][ct], 0, 0, 0);
        }
    }
    f32x4 gs[4];
#pragma unroll
    for (int ct = 0; ct < 4; ++ct) gs[ct] = *(const f32x4*)(gsg + g * 64 + ct * 16 + 4 * fq);
#pragma unroll
    for (int pt = 0; pt < 8; ++pt) {
        const int p = pt * 16 + fr; const float b = sgb[g * 128 + p];
        bf16_t* up = QU + (size_t)(ch * 128 + p) * 1024 + 512 + g * 64 + 4 * fq;
#pragma unroll
        for (int ct = 0; ct < 4; ++ct) {
            const u32x2 uu = *(const u32x2*)(up + ct * 16);
            const f32x4 sp = acc[pt][ct] * gs[ct] + b;
            u32x2 w; w.x = cvt_pk_bf16(bf_lo(uu.x) * sp.x, bf_hi(uu.x) * sp.y); w.y = cvt_pk_bf16(bf_lo(uu.y) * sp.z, bf_hi(uu.y) * sp.w);
            *(u32x2*)(up + ct * 16) = w;
        }
    }
    asm volatile("s_waitcnt lgkmcnt(0)" ::: "memory");
}

__global__ void __launch_bounds__(NWAVES * 64, 2) fwd_megakernel(Args args) {
    extern __shared__ __attribute__((aligned(16))) unsigned char lds[];
    cg::grid_group grid = cg::this_grid();
    LAS unsigned char* L = (LAS unsigned char*)lds;
    volatile LAS unsigned* barst = (volatile LAS unsigned*)(L + BARST_OFF);
    if (threadIdx.x < 2) barst[threadIdx.x] = 0u;
    __syncthreads();
    const XcdBarrier xbar = xcd_barrier_post((unsigned*)(args.ws + WS_BAR), barst);
    const int G = gridDim.x, bx = blockIdx.x;
    const int vcu = (G % 8 == 0) ? (bx % 8) * (G / 8) + bx / 8 : bx;
    const int NGW = G * NWAVES;
    unsigned char* ws = args.ws;
    const float* x_prompt = args.in[0]; const float* x_sample = args.in[1];
    const float* attn_norm_g = args.in[2]; const float* w_in = args.in[3]; const float* q_norm_g = args.in[4]; const float* k_norm_g = args.in[5];
    const float* sg_norm_g = args.in[6]; const float* sg_w = args.in[7]; const float* sg_b = args.in[8]; const float* w_branch_a = args.in[9];
    const float* w_branch_b = args.in[10]; const float* w_mix_out = args.in[11]; const float* ffn_norm_g = args.in[12]; const float* w_up = args.in[13];
    const float* conv_w = args.in[14]; const float* conv_b = args.in[15]; const float* w_down = args.in[16]; const float* final_norm_g = args.in[17];
    float* out = args.out;
    float* rope = (float*)(ws + WS_ROPE);
    bf16_t* Wall = (bf16_t*)(ws + WS_W);
    bf16_t* XB = (bf16_t*)(ws + WS_XB); bf16_t* QU = (bf16_t*)(ws + WS_QU); bf16_t* KB = (bf16_t*)(ws + WS_K); bf16_t* VB = (bf16_t*)(ws + WS_V);
    bf16_t* VST = (bf16_t*)(ws + WS_VST); bf16_t* GA = (bf16_t*)(ws + WS_GA); bf16_t* GB = (bf16_t*)(ws + WS_GB); bf16_t* H2 = (bf16_t*)(ws + WS_H2);
    float* SSQ = (float*)(ws + WS_SS); float* SSG = (float*)(ws + WS_SSG);

    for (int p = args.ph_lo; p < args.ph_hi; ++p) {
    if (p > args.ph_lo) { if (p == 1) GRID_SYNC(); else xcd_barrier(xbar); }
    int tid_ = threadIdx.x; asm volatile("" : "+v"(tid_));
    const int tid = tid_, lane = tid & 63, wave = __builtin_amdgcn_readfirstlane(tid >> 6);
    const int gw = vcu * NWAVES + wave;
    if (p == 0) {
        LAS float* scr = (LAS float*)(L + wave * 16384);
        constexpr int I_IN = 16 * (INW / 32), I_A = 8 * 32, I_MIX = 16 * 32, I_UP = 16 * 128, I_DOWN = 32 * 32, I_L = I_IN + 2 * I_A + I_MIX + I_UP + I_DOWN;
        for (int it = gw; it < I_L * NLAYER; it += NGW) {
            const int l = it / I_L; int r = it % I_L; bf16_t* wl = Wall + (size_t)l * WL_SIZE;
            if (r < I_IN) { transpose_item<1>(w_in + (size_t)l * 1024 * INW, attn_norm_g + l * 1024, 1024, INW, wl + WL_IN, scr, r, lane); continue; } r -= I_IN;
            if (r < I_A) { transpose_item<0>(w_branch_a + (size_t)l * 512 * 1024, nullptr, 512, 1024, wl + WL_A, scr, r, lane); continue; } r -= I_A;
            if (r < I_A) { transpose_item<0>(w_branch_b + (size_t)l * 512 * 1024, nullptr, 512, 1024, wl + WL_B, scr, r, lane); continue; } r -= I_A;
            if (r < I_MIX) { transpose_item<0>(w_mix_out + (size_t)l * 1024 * 1024, nullptr, 1024, 1024, wl + WL_MIX, scr, r, lane); continue; } r -= I_MIX;
            if (r < I_UP) { transpose_item<2>(w_up + (size_t)l * 1024 * 4096, ffn_norm_g + l * 1024, 1024, 4096, wl + WL_UP, scr, r, lane); continue; } r -= I_UP;
            transpose_item<0>(w_down + (size_t)l * 2048 * 1024, nullptr, 2048, 1024, wl + WL_DOWN, scr, r, lane);
        }
        for (int i = gw * 64 + lane; i < NLAYER * 8 * 128 * 128 / 4; i += NGW * 64) {
            const int l = i / (8 * 128 * 128 / 4), r = i % (8 * 128 * 128 / 4);
            const f32x4 v = *(const f32x4*)(sg_w + (size_t)l * 131072 + (size_t)r * 4);
            u32x2 w; w.x = cvt_pk_bf16(v.x, v.y); w.y = cvt_pk_bf16(v.z, v.w);
            *(u32x2*)(Wall + (size_t)l * WL_SIZE + WL_SG + (size_t)r * 4) = w;
        }
        for (int i = gw * 64 + lane; i < 128 * 16; i += NGW * 64) {
            const int pos = i >> 4, f = i & 15; float fr_ = 1.0f; for (int k = 0; k < f; ++k) fr_ *= 0.56234132519034907f;
            float c, s; sincos_tab((float)pos * fr_, c, s); rope[2 * i] = c; rope[2 * i + 1] = s;
        }
        for (int i = gw * 64 + lane; i < 257 * 128; i += NGW * 64) {
            const int r = i / 128, c = i % 128; const long row = (r == 0) ? -1 : (long)M_TOK + r - 1;
            *(u32x4*)(XB + row * 1024 + c * 8) = (u32x4){0u, 0u, 0u, 0u};
        }
        for (int m0 = gw; m0 < M_TOK; m0 += 4 * NGW) {
            int nr = 1; if (m0 + NGW < M_TOK) nr = 2; if (m0 + 2 * NGW < M_TOK) nr = 3; if (m0 + 3 * NGW < M_TOK) nr = 4;
            f32x4 v[4][4]; float sq[4];
#pragma unroll
            for (int r = 0; r < 4; ++r) { const int m = (r < nr) ? m0 + r * NGW : m0;
                const float* xr = (m < NPROMPT) ? x_prompt + (size_t)m * 1024 : x_sample + (size_t)(m - NPROMPT) * 1024; float s = 0.f;
#pragma unroll
                for (int j = 0; j < 4; ++j) { v[r][j] = *(const f32x4*)(xr + 4 * lane + 256 * j); s += (v[r][j].x * v[r][j].x + v[r][j].y * v[r][j].y) + (v[r][j].z * v[r][j].z + v[r][j].w * v[r][j].w); }
                sq[r] = s; }
#pragma unroll
            for (int r = 0; r < 4; ++r) if (r < nr) { const int m = m0 + r * NGW; const float s = wave_sum(sq[r]);
#pragma unroll
                for (int j = 0; j < 4; ++j) { u32x2 w; w.x = cvt_pk_bf16(v[r][j].x, v[r][j].y); w.y = cvt_pk_bf16(v[r][j].z, v[r][j].w); *(u32x2*)(XB + (size_t)m * 1024 + 4 * lane + 256 * j) = w; }
                if (lane < 16) SSQ[(size_t)m * 16 + lane] = (lane == 0) ? s : 0.f; }
        }
    }
    else if (p < N_PHASES - 1) {
        const int l = (p - 1) / 6, k = (p - 1) % 6;
        const bf16_t* wl = Wall + (size_t)l * WL_SIZE;
        if (k == 0) {
            pg8::Gemm g{XB, wl + WL_IN, 1024, 1024, 1024, 0, 0, 256, 128, 0};
            { pg8::StaticOrder S; S.init(M_TOK / 256, 3, 1, G, bx, 0); S.rev = (5 * l + 1) & 1;
              pg8::EpiQKV E{SSQ, q_norm_g + l * 64, k_norm_g + l * 64, rope, QU, KB, VB};
              pg8::gemm_phase<pg8::EpiQKV, 1>(L, g, S, E); }
            { pg8::StaticOrder S; S.init(M_TOK / 256, 2, 1, G, bx, 5); S.rev = (5 * l + 1) & 1;
              pg8::EpiVS E{SSQ, VST, SSG};
              pg8::gemm_phase<pg8::EpiVS, 1>(L, g, S, E); }
            { pg8::StaticOrder S; S.init(M_TOK / 256, 10, 1, G, bx, 3, 2, 7); S.rev = (5 * l + 1) & 1;
              pg8::EpiEW E{SSQ, QU, GA, GB};
              pg8::gemm_phase<pg8::EpiEW, 1>(L, g, S, E); }
        }
        else if (k == 1) {
            LAS float* scr = (LAS float*)(L + SG_SCR_OFF) + wave * 128;
            for (int u = gw; u < 768 * 8; u += NGW)
                sg_unit(u >> 3, u & 7, VST, SSG, wl + WL_SG, sg_b + l * 1024, sg_norm_g + l * 512, QU, scr, lane);
            for (int u = bx; u < 3072; u += G) {
                const int i = u >> 8, c = u & 255, x = c & 7, w = c >> 3;
                long rowbase; int seq, h, q0;
                if (i < 4) { const int idx = w * 4 + i; rowbase = (long)(x >> 1) * SEQ_P; seq = SEQ_P; h = (x & 1) * 4 + (idx >> 5); q0 = (idx & 31) * 256; }
                else { const int pair = 8 * x + (i - 4); rowbase = (long)NPROMPT + (long)(pair >> 1) * SEQ_S; seq = SEQ_S; h = (pair & 1) * 4 + (w >> 3); q0 = (w & 7) * 256; }
                attn_body::attn_unit<8>(rowbase, seq, h, q0, (const attn_body::bf16*)QU, (const attn_body::bf16*)KB, (const attn_body::bf16*)VB, (attn_body::bf16*)QU, (char*)lds);
            }
        }
        else if (k == 2) {
            pg8::Gemm g{QU + 512, wl + WL_B, 1024, 512, 512, -512 * 2, -(long)(WL_B - WL_A) * 2, 256, 0, 0};
            pg8::StaticOrder S; S.init(M_TOK / 256, 4, 2, G, bx); S.rev = (5 * l + 2) & 1;
            pg8::EpiMerge E{GA, GB};
            pg8::gemm_phase<pg8::EpiMerge, 2>(L, g, S, E);
        }
        else if (k == 3) {
            pg8::Gemm g{GA, wl + WL_MIX, 1024, 1024, 1024, 0, 0, 256, 0, 0};
            pg8::StaticOrder S; S.init(M_TOK / 256, 4, 1, G, bx); S.rev = (5 * l + 3) & 1;
            pg8::EpiRes E{x_prompt, x_sample, 0, out, XB, SSQ, 1, 0};
            pg8::gemm_phase<pg8::EpiRes, 1>(L, g, S, E);
        }
        else if (k == 4) {
            pg8::Gemm g{XB, wl + WL_UP, 1024, 1024, 1024, 0, 0, 252, 126, -1};
            pg8::StaticOrder S; S.init((M_TOK + 251) / 252, 16, 1, G, bx); S.rev = (5 * l + 4) & 1;
            pg8::EpiUp E{SSQ, conv_w + (size_t)l * 3 * 4096, conv_b + (size_t)l * 4096, H2};
            pg8::gemm_phase<pg8::EpiUp, 1>(L, g, S, E);
        }
        else {
            pg8::Gemm g{H2, wl + WL_DOWN, 2048, 2048, 2048, 0, 0, 256, 0, 0};
            pg8::StaticOrder S; S.init(M_TOK / 256, 4, 1, G, bx); S.rev = (5 * l + 5) & 1;
            pg8::EpiRes E{x_prompt, x_sample, 0, out, XB, SSQ, 1, 0};
            pg8::gemm_phase<pg8::EpiRes, 1>(L, g, S, E);
        }
    } else
    {
        f32x4 gv[4];
#pragma unroll
        for (int j = 0; j < 4; ++j) gv[j] = *(const f32x4*)(final_norm_g + 4 * lane + 256 * j);
        for (int m0 = gw; m0 < M_TOK; m0 += 4 * NGW) {
            int nr = 1; if (m0 + NGW < M_TOK) nr = 2; if (m0 + 2 * NGW < M_TOK) nr = 3; if (m0 + 3 * NGW < M_TOK) nr = 4;
            f32x4 v[4][4]; float sp[4];
#pragma unroll
            for (int r = 0; r < 4; ++r) { const int m = (r < nr) ? m0 + r * NGW : m0; const bf16_t* br = XB + (size_t)m * 1024;
                sp[r] = (lane < 16) ? SSQ[(size_t)m * 16 + lane] : 0.f;
#pragma unroll
                for (int j = 0; j < 4; ++j) { const u32x2 p = *(const u32x2*)(br + 4 * lane + 256 * j); v[r][j] = (f32x4){bf_lo(p.x), bf_hi(p.x), bf_lo(p.y), bf_hi(p.y)}; } }
#pragma unroll
            for (int r = 0; r < 4; ++r) if (r < nr) { float* xr = out + (size_t)(m0 + r * NGW) * 1024;
                const float rs = __builtin_amdgcn_rsqf(wave_sum(sp[r]) * (1.0f / DMOD) + EPS);
#pragma unroll
                for (int j = 0; j < 4; ++j) *(f32x4*)(xr + 4 * lane + 256 * j) = v[r][j] * gv[j] * rs; }
        }
    }
    }
}

extern "C" void kernel_launch(void* const* d_in, const int* in_sizes, int n_in, void* d_out, int out_size, void* d_ws, size_t ws_size, hipStream_t stream) {
    static int grid = 0;
    if (grid == 0) {
        if (n_in != 18 || out_size != M_TOK * DMOD || ws_size < WS_END) { fprintf(stderr, "kernel_launch: unexpected shapes (n_in %d out %d ws %zu)\n", n_in, out_size, ws_size); grid = -1; return; }
        int dev = 0, cus = 0, per_cu = 0;
        (void)hipGetDevice(&dev); (void)hipDeviceGetAttribute(&cus, hipDeviceAttributeMultiprocessorCount, dev);
        (void)hipFuncSetAttribute((const void*)fwd_megakernel, hipFuncAttributeMaxDynamicSharedMemorySize, LDS_BYTES);
        (void)hipOccupancyMaxActiveBlocksPerMultiprocessor(&per_cu, (const void*)fwd_megakernel, NWAVES * 64, LDS_BYTES);
        if (per_cu < 1) { fprintf(stderr, "kernel_launch: occupancy query says %d blocks/CU\n", per_cu); per_cu = 1; }
        (void)hipGetLastError();
        grid = cus * 1;
    }
    if (grid < 0) return;
    (void)hipMemsetAsync((char*)d_ws + WS_BAR, 0, BAR_BYTES, stream);
    Args a{};
    for (int i = 0; i < 18; ++i) a.in[i] = (const float*)d_in[i];
    a.out = (float*)d_out; a.ws = (unsigned char*)d_ws;
    if (N_LAUNCH_MODE == 0) {
        a.ph_lo = 0; a.ph_hi = N_PHASES;
        void* params[] = {&a};
        hipError_t e = hipLaunchCooperativeKernel((const void*)fwd_megakernel, dim3(grid), dim3(NWAVES * 64), params, LDS_BYTES, stream);
        if (e != hipSuccess) fprintf(stderr, "cooperative launch failed: %s (grid %d)\n", hipGetErrorString(e), grid);
    } else {
        for (int p = 0; p < N_PHASES; ++p) { a.ph_lo = p; a.ph_hi = p + 1;
            hipLaunchKernelGGL(fwd_megakernel, dim3(grid), dim3(NWAVES * 64), LDS_BYTES, stream, a); }
    }
}
```

```cpp
#include <hip/hip_runtime.h>
#include <hip/hip_cooperative_groups.h>
#include <hip/hip_bf16.h>
#include <cstdio>
#include <cstdint>
#include <cmath>
namespace cg = cooperative_groups;

constexpr int M_TOK = 98304, NPROMPT = 32768, SEQ_P = 8192, SEQ_S = 2048;
constexpr int DMOD = 1024, INW = 3840, DFF = 2048, NLAYER = 4;
constexpr float EPS = 1e-6f;
constexpr float C2 = 0.125f * 1.4426950408889634f;

#define LAS __attribute__((address_space(3)))
typedef unsigned short bf16_t;
typedef short bf16x8 __attribute__((ext_vector_type(8)));
typedef float f32x4 __attribute__((ext_vector_type(4)));
typedef float f32x2 __attribute__((ext_vector_type(2)));
typedef unsigned u32x4 __attribute__((ext_vector_type(4)));
typedef unsigned u32x2 __attribute__((ext_vector_type(2)));

typedef __bf16 bf16x2_t_ __attribute__((ext_vector_type(2)));
__device__ __forceinline__ unsigned cvt_pk_bf16(float lo, float hi) { f32x2 v = {lo, hi}; bf16x2_t_ b = __builtin_convertvector(v, bf16x2_t_); return __builtin_bit_cast(unsigned, b); }
__device__ __forceinline__ float bf_lo(unsigned w) { return __uint_as_float(w << 16); }
__device__ __forceinline__ float bf_hi(unsigned w) { return __uint_as_float(w & 0xffff0000u); }
__device__ __forceinline__ float gelu_t(float x) {
    const float u = x * (0.7978845608f + 0.0356774081f * x * x);
    const float e = __builtin_amdgcn_exp2f(u * -2.8853900818f);
    return x * __builtin_amdgcn_rcpf(1.0f + e);
}
__device__ __forceinline__ float sigmoid_f(float x) { return __builtin_amdgcn_rcpf(1.0f + __builtin_amdgcn_exp2f(x * -1.4426950409f)); }
__device__ __forceinline__ float dpp_shr1(float v) { return __int_as_float(__builtin_amdgcn_update_dpp(0, __float_as_int(v), 0x111, 0xF, 0xF, true)); }
__device__ __forceinline__ float dpp_shl1(float v) { return __int_as_float(__builtin_amdgcn_update_dpp(0, __float_as_int(v), 0x101, 0xF, 0xF, true)); }

namespace pg8 {
constexpr int BM = 256, BK = 64, HALF = 128, HTB = HALF * BK * 2, STAGE_BYTES = 8 * HTB, NXCD = 8, WGM = 8;
__host__ __device__ __forceinline__ int lds_byte(int r, int c) { const int st = (r >> 4) * 2 + (c >> 5), rr = r & 15, cc = c & 31, ob = rr * 64 + cc * 2; return st * 1024 + (ob ^ (((ob >> 9) & 1) << 5)); }
__host__ __device__ __forceinline__ void stage_rc(int b, int& R, int& C) { const int st = b / 1024, sb = b % 1024, swz = sb ^ (((sb >> 9) & 1) << 5); R = (st >> 1) * 16 + swz / 64; C = (st & 1) * 32 + (swz % 64) / 2; }

struct Unit { int pm, pn, part; };
struct Gemm { const bf16_t* A; const bf16_t* Bt; int lda, ldb, K; long partA, partB; int tstride, wstride, shift; };

struct StaticOrder {
    int nM, nN, nwg, G, c, parts, pn_lo, pn_split, pn_hi, rev;
    __device__ void init(int nM_, int nN_, int parts_, int G_, int c_, int pn_lo_ = 0, int pn_split_ = 1 << 20, int pn_hi_ = 0) { nM = nM_; nN = nN_; nwg = nM * nN; G = G_; c = c_; parts = parts_; pn_lo = pn_lo_; pn_split = pn_split_; pn_hi = pn_hi_; rev = 0; }
    __device__ bool next(int i, Unit& u) const {
        const int it = (parts == 2) ? (i >> 1) : i; u.part = (parts == 2) ? (i & 1) : 0;
        const long L = (long)it * G + c; if (L >= nwg) return false;
        int wgid = (int)L; { const int q = nwg / NXCD, r = nwg % NXCD, xcd = wgid % NXCD, off = wgid / NXCD; wgid = (xcd < r ? xcd * (q + 1) : r * (q + 1) + (xcd - r) * q) + off; }
        const int nig = WGM * nN, gid = wgid / nig, fm = gid * WGM, gsz = (nM - fm) < WGM ? (nM - fm) : WGM;
        u.pm = fm + ((wgid % nig) % gsz); if (rev) u.pm = nM - 1 - u.pm; { const int ix = (wgid % nig) / gsz; u.pn = ix < pn_split ? pn_lo + ix : pn_hi + (ix - pn_split); } return true;
    }
};

template <class Epi, int PARTS>
__device__ __forceinline__ void gemm_phase(LAS unsigned char* lds, const Gemm g, const StaticOrder& S, const Epi& E) {
    int tid_ = threadIdx.x; asm volatile("" : "+v"(tid_));
    const int tid = tid_, wid = __builtin_amdgcn_readfirstlane(tid >> 6), lane = tid & 63, wr = wid >> 2, wc = wid & 3, fr = lane & 15, fq = lane >> 4;
    const int K = g.K, nt = K / BK;
    unsigned voffA[2], voffB[2];
#pragma unroll
    for (int i = 0; i < 2; ++i) { int R, C; stage_rc(tid * 16 + i * 8192, R, C);
        const int TR = g.wstride ? g.wstride * (R >> 6) + 8 * (R & 15) + ((R >> 4) & 3) : R;
        voffA[i] = (unsigned)(TR * g.lda + C) * 2u; voffB[i] = (unsigned)(R * g.ldb + C) * 2u; }
    const size_t kstep = (size_t)(BK * 2);
    const size_t hstepA = (size_t)(g.wstride ? 4 : HALF) * g.lda * 2, hstepB = (size_t)HALF * g.ldb * 2;
    const unsigned ldsw = (unsigned)wid * 1024u;
    const int aoff = lds_byte(wr * 64 + fr, fq * 8), boff = lds_byte(wc * 32 + fr, fq * 8);
#define PG8_SA(b, h) (((b) * 2 + (h)) * HTB)
#define PG8_SB(b, h) ((4 + (b) * 2 + (h)) * HTB)
#define PG8_STAGE(bufoff, gbase, voff) do { _Pragma("unroll") for (int _i = 0; _i < 2; ++_i) \
        __builtin_amdgcn_global_load_lds((const unsigned*)((const char*)(gbase) + (voff)[_i]), (LAS unsigned*)(lds + (bufoff) + ldsw + _i * 8192), 16, 0, 0); } while (0)
#define PG8_STAGEA(bufoff, gbase, voff) do { _Pragma("unroll") for (int _i = 0; _i < 2; ++_i) \
        __builtin_amdgcn_global_load_lds((const unsigned*)((const char*)(gbase) + (voff)[_i]), (LAS unsigned*)(lds + (bufoff) + ldsw + _i * 8192), 16, 0, 0); } while (0)
#define PG8_LDA(dst, b, h) do { _Pragma("unroll") for (int m = 0; m < 4; ++m) _Pragma("unroll") for (int k = 0; k < 2; ++k) dst[m][k] = *(const LAS bf16x8*)(lds + PG8_SA(b, h) + aoff + m * 2048 + k * 1024); } while (0)
#define PG8_LDB(dst, b, h) do { _Pragma("unroll") for (int n = 0; n < 2; ++n) _Pragma("unroll") for (int k = 0; k < 2; ++k) dst[n][k] = *(const LAS bf16x8*)(lds + PG8_SB(b, h) + boff + n * 2048 + k * 1024); } while (0)
#define PG8_MMA(ai, bj, At, Bt) do { __builtin_amdgcn_s_setprio(1); _Pragma("unroll") for (int m = 0; m < 4; ++m) _Pragma("unroll") for (int n = 0; n < 2; ++n) _Pragma("unroll") for (int k = 0; k < 2; ++k) \
        acc[ai][bj][m][n] = __builtin_amdgcn_mfma_f32_16x16x32_bf16(Bt[n][k], At[m][k], acc[ai][bj][m][n], 0, 0, 0); __builtin_amdgcn_s_setprio(0); } while (0)
#define PG8_WAIT_V(n) asm volatile("s_waitcnt vmcnt(" #n ")" ::: "memory")
#define PG8_WAIT_L(n) asm volatile("s_waitcnt lgkmcnt(" #n ")" ::: "memory")
#define PG8_BAR __builtin_amdgcn_s_barrier()
#define PG8_SCHED __builtin_amdgcn_sched_barrier(0)
#define PG8_UA(u) ((const char*)g.A + (size_t)(u).part * g.partA + ((long)(u).pm * g.tstride + g.shift) * (long)g.lda * 2)
#define PG8_UB(u) ((const char*)g.Bt + (size_t)(u).part * g.partB + (size_t)(u).pn * 256 * g.ldb * 2)
    Unit cur, nxt; int ui = 0;
    if (!S.next(0, cur)) return;
    f32x4 acc[2][2][4][2];
#pragma unroll
    for (int a = 0; a < 2; ++a)
#pragma unroll
        for (int b = 0; b < 2; ++b)
#pragma unroll
            for (int m = 0; m < 4; ++m)
#pragma unroll
                for (int n = 0; n < 2; ++n) acc[a][b][m][n] = (f32x4){0.f, 0.f, 0.f, 0.f};
    bf16x8 At[4][2], B0[2][2], B1[2][2];
    const char* cA = PG8_UA(cur); const char* cB = PG8_UB(cur);
    PG8_STAGE(PG8_SB(0, 0), cB, voffB); PG8_STAGE(PG8_SB(0, 1), cB + hstepB, voffB); PG8_STAGEA(PG8_SA(0, 0), cA, voffA); PG8_STAGEA(PG8_SA(0, 1), cA + hstepA, voffA);
    if (wr == 1) PG8_BAR;
    PG8_WAIT_V(2); PG8_BAR;
    PG8_STAGE(PG8_SB(1, 0), cB + kstep, voffB); PG8_STAGEA(PG8_SA(1, 0), cA + kstep, voffA); PG8_STAGE(PG8_SB(1, 1), cB + hstepB + kstep, voffB);
    PG8_WAIT_V(6); PG8_BAR;
    for (;;) {
        const bool has_next = S.next(ui + 1, nxt);
        const char* nA = has_next ? PG8_UA(nxt) : cA; const char* nB = has_next ? PG8_UB(nxt) : cB;
        for (int t = 0; t < nt; t += 2) {
            const bool last = (t == nt - 2);
            const char* a1 = cA + (size_t)(t + 1) * kstep;
            const char* a2 = last ? nA : cA + (size_t)(t + 2) * kstep; const char* b2 = last ? nB : cB + (size_t)(t + 2) * kstep;
            const char* a3 = a2 + kstep; const char* b3 = b2 + kstep;
            PG8_LDB(B0, 0, 0); PG8_LDB(B1, 0, 1); PG8_SCHED; PG8_LDA(At, 0, 0); PG8_STAGEA(PG8_SA(1, 1), a1 + hstepA, voffA);
            PG8_WAIT_V(8); PG8_WAIT_L(0); PG8_BAR; PG8_MMA(0, 0, At, B0); PG8_MMA(0, 1, At, B1); PG8_BAR; PG8_SCHED;
            PG8_LDA(At, 0, 1); PG8_STAGE(PG8_SB(0, 0), b2, voffB); PG8_STAGE(PG8_SB(0, 1), b2 + hstepB, voffB); PG8_STAGEA(PG8_SA(0, 0), a2, voffA);
            PG8_WAIT_V(8); PG8_WAIT_L(0); PG8_BAR; PG8_MMA(1, 0, At, B0); PG8_MMA(1, 1, At, B1); PG8_BAR; PG8_SCHED;
            PG8_LDB(B0, 1, 0); PG8_LDB(B1, 1, 1); PG8_SCHED; PG8_LDA(At, 1, 0); PG8_STAGEA(PG8_SA(0, 1), a2 + hstepA, voffA);
            PG8_WAIT_V(8); PG8_WAIT_L(0); PG8_BAR; PG8_MMA(0, 0, At, B0); PG8_MMA(0, 1, At, B1); PG8_BAR; PG8_SCHED;
            PG8_LDA(At, 1, 1); PG8_STAGE(PG8_SB(1, 0), b3, voffB); PG8_STAGE(PG8_SB(1, 1), b3 + hstepB, voffB); PG8_STAGEA(PG8_SA(1, 0), a3, voffA);
            PG8_WAIT_V(8); PG8_WAIT_L(0); PG8_BAR; PG8_MMA(1, 0, At, B0); PG8_MMA(1, 1, At, B1); PG8_BAR; PG8_SCHED;
        }
        if (wr == 0) PG8_BAR;
        E(acc, cur, wr, wc, fr, fq);
        if (!has_next) break;
        if (PARTS == 1 || nxt.part == 0) {
#pragma unroll
        for (int a = 0; a < 2; ++a)
#pragma unroll
            for (int b = 0; b < 2; ++b)
#pragma unroll
                for (int m = 0; m < 4; ++m)
#pragma unroll
                    for (int n = 0; n < 2; ++n) acc[a][b][m][n] = (f32x4){0.f, 0.f, 0.f, 0.f};
        }
        cur = nxt; cA = nA; cB = nB; ++ui;
        if (wr == 1) PG8_BAR;
    }
    PG8_WAIT_V(0);
    PG8_BAR;
#undef PG8_SA
#undef PG8_SB
#undef PG8_STAGE
#undef PG8_STAGEA
#undef PG8_LDA
#undef PG8_LDB
#undef PG8_MMA
#undef PG8_WAIT_V
#undef PG8_WAIT_L
#undef PG8_BAR
#undef PG8_SCHED
#undef PG8_UA
#undef PG8_UB
}

__device__ __forceinline__ void load_rs8(const float* ss, int t0, int fq, float (&rs)[8], int tmax) {
#pragma unroll
    for (int j = 0; j < 8; ++j) { int t = t0 + j; t = t < 0 ? 0 : (t > tmax ? tmax : t);
        const f32x4 p = *(const f32x4*)(ss + (size_t)t * 16 + 4 * fq); float s = (p.x + p.y) + (p.z + p.w);
        s += __shfl_xor(s, 16); s += __shfl_xor(s, 32); rs[j] = __builtin_amdgcn_rsqf(s * (1.0f / DMOD) + EPS); }
}

struct EpiQKV {
    const float* ss; const float* qg; const float* kg; const float* rope;
    bf16_t* QU; bf16_t* Kb; bf16_t* Vb;
    __device__ __forceinline__ void operator()(f32x4 (&acc)[2][2][4][2], const Unit& u, int wr, int wc, int fr, int fq) const {
        const int t0 = u.pm * 256 + wr * 128 + fr * 8;
        { float rs[8]; load_rs8(ss, t0, fq, rs, M_TOK - 1);
#pragma unroll
          for (int ai = 0; ai < 2; ++ai)
#pragma unroll
            for (int m = 0; m < 4; ++m)
#pragma unroll
                for (int bj = 0; bj < 2; ++bj)
#pragma unroll
                    for (int n = 0; n < 2; ++n) acc[ai][bj][m][n] = acc[ai][bj][m][n] * rs[4 * ai + m]; }
        const int pn = u.pn;
        {
            const bool isq = pn < 2;
            if (isq || wc < 2) {
                const float* gp = isq ? qg : kg; const float osc = isq ? C2 : 1.0f;
                f32x4 gv[2][2];
#pragma unroll
                for (int bj = 0; bj < 2; ++bj)
#pragma unroll
                    for (int n = 0; n < 2; ++n) gv[bj][n] = *(const f32x4*)(gp + 32 * bj + 16 * n + 4 * fq);
                const int smask = (t0 < NPROMPT) ? (SEQ_P - 1) : (SEQ_S - 1);
                const int prow = (t0 & smask) >> 6;
                const f32x4 rr0 = *(const f32x4*)(rope + (prow * 16 + 4 * fq) * 2), rr1 = *(const f32x4*)(rope + (prow * 16 + 4 * fq) * 2 + 4);
                bf16_t* dst = isq ? (QU + (size_t)t0 * 1024 + (4 * pn + wc) * 64) : (Kb + (size_t)t0 * 128 + wc * 64);
                const int pitch = isq ? 1024 : 128;
#pragma unroll
                for (int ai = 0; ai < 2; ++ai)
#pragma unroll
                    for (int m = 0; m < 4; ++m) {
                        const int j = 4 * ai + m;
                        float sq = 0.f;
#pragma unroll
                        for (int bj = 0; bj < 2; ++bj)
#pragma unroll
                            for (int n = 0; n < 2; ++n) { const f32x4 v = acc[ai][bj][m][n]; sq += (v.x * v.x + v.y * v.y) + (v.z * v.z + v.w * v.w); }
                        sq += __shfl_xor(sq, 16); sq += __shfl_xor(sq, 32);
                        const float rn = __builtin_amdgcn_rsqf(sq * (1.0f / 64.0f) + EPS) * osc;
                        const int pcol = (t0 + j) & 63;
                        const f32x4 cc0 = *(const f32x4*)(rope + (pcol * 16 + 4 * fq) * 2), cc1 = *(const f32x4*)(rope + (pcol * 16 + 4 * fq) * 2 + 4);
#pragma unroll
                        for (int bj = 0; bj < 2; ++bj) {
                            const f32x4 t0v = bj == 0 ? rr0 : cc0, t1v = bj == 0 ? rr1 : cc1;
                            const f32x4 x1 = acc[ai][bj][m][0] * gv[bj][0] * rn, x2 = acc[ai][bj][m][1] * gv[bj][1] * rn;
                            const f32x4 cs = (f32x4){t0v.x, t0v.z, t1v.x, t1v.z}, sn = (f32x4){t0v.y, t0v.w, t1v.y, t1v.w};
                            const f32x4 o1 = x1 * cs - x2 * sn, o2 = x1 * sn + x2 * cs;
                            u32x2 w1, w2; w1.x = cvt_pk_bf16(o1.x, o1.y); w1.y = cvt_pk_bf16(o1.z, o1.w); w2.x = cvt_pk_bf16(o2.x, o2.y); w2.y = cvt_pk_bf16(o2.z, o2.w);
                            bf16_t* p = dst + (size_t)j * pitch + 32 * bj + 4 * fq;
                            *(u32x2*)p = w1; *(u32x2*)(p + 16) = w2;
                        }
                    }
            } else {
                bf16_t* dst = Vb + (size_t)t0 * 128 + (wc - 2) * 64;
#pragma unroll
                for (int ai = 0; ai < 2; ++ai)
#pragma unroll
                    for (int m = 0; m < 4; ++m)
#pragma unroll
                        for (int bj = 0; bj < 2; ++bj)
#pragma unroll
                            for (int n = 0; n < 2; ++n) { const f32x4 v = acc[ai][bj][m][n]; u32x2 w; w.x = cvt_pk_bf16(v.x, v.y); w.y = cvt_pk_bf16(v.z, v.w);
                                *(u32x2*)(dst + (size_t)(4 * ai + m) * 128 + 32 * bj + 16 * n + 4 * fq) = w; }
            }
        }
    }
};
struct EpiVS {
    const float* ss; bf16_t* VST; float* ssg;
    __device__ __forceinline__ void operator()(f32x4 (&acc)[2][2][4][2], const Unit& u, int wr, int wc, int fr, int fq) const {
        const int t0 = u.pm * 256 + wr * 128 + fr * 8;
        { float rs[8]; load_rs8(ss, t0, fq, rs, M_TOK - 1);
#pragma unroll
          for (int ai = 0; ai < 2; ++ai)
#pragma unroll
            for (int m = 0; m < 4; ++m)
#pragma unroll
                for (int bj = 0; bj < 2; ++bj)
#pragma unroll
                    for (int n = 0; n < 2; ++n) acc[ai][bj][m][n] = acc[ai][bj][m][n] * rs[4 * ai + m]; }
        const int pn = u.pn;
        {
            const int chunk = 2 * u.pm + wr;
            bf16_t* dst = VST + ((size_t)chunk * 512 + 256 * (pn - 5) + 32 * wc + 8 * fq) * 128 + 8 * fr;
#pragma unroll
            for (int ai = 0; ai < 2; ++ai)
#pragma unroll
                for (int m = 0; m < 4; ++m) {
                    float sq = 0.f;
#pragma unroll
                    for (int bj = 0; bj < 2; ++bj)
#pragma unroll
                        for (int n = 0; n < 2; ++n) { f32x4 v = acc[ai][bj][m][n]; v = (f32x4){gelu_t(v.x), gelu_t(v.y), gelu_t(v.z), gelu_t(v.w)}; acc[ai][bj][m][n] = v;
                            sq += (v.x * v.x + v.y * v.y) + (v.z * v.z + v.w * v.w); }
                    sq += __shfl_xor(sq, 16); sq += __shfl_xor(sq, 32);
                    if (fq == 0) ssg[(size_t)(t0 + 4 * ai + m) * 8 + 4 * (pn - 5) + wc] = sq;
                    asm volatile("" : "+v"(acc[ai][0][m][0]), "+v"(acc[ai][0][m][1]), "+v"(acc[ai][1][m][0]), "+v"(acc[ai][1][m][1]));
                }
#pragma unroll
            for (int bj = 0; bj < 2; ++bj)
#pragma unroll
                for (int n = 0; n < 2; ++n)
#pragma unroll
                    for (int i = 0; i < 4; ++i) {
                        u32x4 w; w.x = cvt_pk_bf16(acc[0][bj][0][n][i], acc[0][bj][1][n][i]); w.y = cvt_pk_bf16(acc[0][bj][2][n][i], acc[0][bj][3][n][i]);
                        w.z = cvt_pk_bf16(acc[1][bj][0][n][i], acc[1][bj][1][n][i]); w.w = cvt_pk_bf16(acc[1][bj][2][n][i], acc[1][bj][3][n][i]);
                        *(u32x4*)(dst + (size_t)(128 * bj + 4 * n + i) * 128) = w;
                    }
        }
    }
};
struct EpiEW {
    const float* ss; bf16_t* QU; bf16_t* GA; bf16_t* GB;
    __device__ __forceinline__ void operator()(f32x4 (&acc)[2][2][4][2], const Unit& u, int wr, int wc, int fr, int fq) const {
        const int t0 = u.pm * 256 + wr * 128 + fr * 8;
        float rs[8]; load_rs8(ss, t0, fq, rs, M_TOK - 1);
        const int pn = u.pn;
        const bool isu = pn < 5;
        bf16_t* dst = QU + 512 + 256 * (pn - 3) + (size_t)t0 * 1024 + 32 * wc + 8 * fq;
        if (isu) {
#pragma unroll
            for (int ai = 0; ai < 2; ++ai)
#pragma unroll
                for (int m = 0; m < 4; ++m)
#pragma unroll
                    for (int bj = 0; bj < 2; ++bj) { const f32x4 a = acc[ai][bj][m][0] * rs[4 * ai + m], b = acc[ai][bj][m][1] * rs[4 * ai + m]; u32x4 w;
                        w.x = cvt_pk_bf16(gelu_t(a.x), gelu_t(a.y)); w.y = cvt_pk_bf16(gelu_t(a.z), gelu_t(a.w)); w.z = cvt_pk_bf16(gelu_t(b.x), gelu_t(b.y)); w.w = cvt_pk_bf16(gelu_t(b.z), gelu_t(b.w));
                        *(u32x4*)(dst + (size_t)(4 * ai + m) * 1024 + 128 * bj) = w; }
        } else {
            bf16_t* da = GA + (size_t)t0 * 1024 + 128 * (pn - 7) + 32 * wc + 8 * fq; bf16_t* db = GB + (size_t)t0 * 1024 + 128 * (pn - 7) + 32 * wc + 8 * fq;
#pragma unroll
            for (int ai = 0; ai < 2; ++ai)
#pragma unroll
                for (int m = 0; m < 4; ++m) { const float k2 = rs[4 * ai + m] * -1.4426950409f; u32x4 wa, wb; float sa[8], rt[8];
#pragma unroll
                    for (int n = 0; n < 2; ++n)
#pragma unroll
                        for (int i = 0; i < 4; ++i) { const float ea = 1.0f + __builtin_amdgcn_exp2f(acc[ai][0][m][n][i] * k2), eb = 1.0f + __builtin_amdgcn_exp2f(acc[ai][1][m][n][i] * k2);
                            sa[4 * n + i] = __builtin_amdgcn_rcpf(ea); rt[4 * n + i] = ea * __builtin_amdgcn_rcpf(eb); }
                    wa.x = cvt_pk_bf16(sa[0], sa[1]); wa.y = cvt_pk_bf16(sa[2], sa[3]); wa.z = cvt_pk_bf16(sa[4], sa[5]); wa.w = cvt_pk_bf16(sa[6], sa[7]);
                    wb.x = cvt_pk_bf16(rt[0], rt[1]); wb.y = cvt_pk_bf16(rt[2], rt[3]); wb.z = cvt_pk_bf16(rt[4], rt[5]); wb.w = cvt_pk_bf16(rt[6], rt[7]);
                    *(u32x4*)(da + (size_t)(4 * ai + m) * 1024) = wa; *(u32x4*)(db + (size_t)(4 * ai + m) * 1024) = wb; }
        }
    }
};

struct EpiMerge {
    bf16_t* GA; const bf16_t* GB;
    __device__ __forceinline__ void operator()(f32x4 (&acc)[2][2][4][2], const Unit& u, int wr, int wc, int fr, int fq) const {
        const int t0 = u.pm * 256 + wr * 64 + fr;
        const size_t off0 = (size_t)t0 * 1024 + 256 * u.pn + 32 * wc + 8 * fq;
        const bf16_t* src = (u.part == 0) ? GB : (const bf16_t*)GA;
#pragma unroll
        for (int ai = 0; ai < 2; ++ai)
#pragma unroll
            for (int m = 0; m < 4; ++m)
#pragma unroll
                for (int bj = 0; bj < 2; ++bj) {
                    const size_t off = off0 + (size_t)(128 * ai + 16 * m) * 1024 + 128 * bj;
                    const u32x4 g = *(const u32x4*)(src + off);
                    const f32x4 s0 = (f32x4){bf_lo(g.x), bf_hi(g.x), bf_lo(g.y), bf_hi(g.y)}, s1 = (f32x4){bf_lo(g.z), bf_hi(g.z), bf_lo(g.w), bf_hi(g.w)};
                    const f32x4 v0 = acc[ai][bj][m][0] * s0, v1 = acc[ai][bj][m][1] * s1;
                    if (u.part == 0) { acc[ai][bj][m][0] = v0; acc[ai][bj][m][1] = v1; }
                    else { u32x4 w; w.x = cvt_pk_bf16(v0.x, v0.y); w.y = cvt_pk_bf16(v0.z, v0.w); w.z = cvt_pk_bf16(v1.x, v1.y); w.w = cvt_pk_bf16(v1.z, v1.w);
                        *(u32x4*)(GA + off) = w; }
                }
    }
};

struct EpiRes {
    const float* xp; const float* xs; int first; float* out; bf16_t* xb; float* ss; int bb; int wout;
    __device__ __forceinline__ void operator()(f32x4 (&acc)[2][2][4][2], const Unit& u, int wr, int wc, int fr, int fq) const {
        const int t0 = u.pm * 256 + wr * 64 + fr;
        const int col0 = 256 * u.pn + 32 * wc + 8 * fq;
        const float* bp0 = first ? ((t0 < NPROMPT) ? xp + (size_t)t0 * 1024 : xs + (size_t)(t0 - NPROMPT) * 1024) : out + (size_t)t0 * 1024;
#pragma unroll
        for (int ai = 0; ai < 2; ++ai)
#pragma unroll
            for (int m = 0; m < 4; ++m) {
                const int j = 128 * ai + 16 * m; float sq = 0.f;
#pragma unroll
                for (int bj = 0; bj < 2; ++bj) {
                    const size_t o = (size_t)j * 1024 + col0 + 128 * bj;
                    f32x4 a, b;
                    if (bb) { const u32x4 w = *(const u32x4*)(xb + (size_t)t0 * 1024 + o);
                        a = (f32x4){bf_lo(w.x), bf_hi(w.x), bf_lo(w.y), bf_hi(w.y)}; b = (f32x4){bf_lo(w.z), bf_hi(w.z), bf_lo(w.w), bf_hi(w.w)}; }
                    else { a = *(const f32x4*)(bp0 + o); b = *(const f32x4*)(bp0 + o + 4); }
                    a = a + acc[ai][bj][m][0]; b = b + acc[ai][bj][m][1];
                    if (wout) { float* op = out + (size_t)t0 * 1024 + o; *(f32x4*)op = a; *(f32x4*)(op + 4) = b; }
                    u32x4 w; w.x = cvt_pk_bf16(a.x, a.y); w.y = cvt_pk_bf16(a.z, a.w); w.z = cvt_pk_bf16(b.x, b.y); w.w = cvt_pk_bf16(b.z, b.w);
                    *(u32x4*)(xb + (size_t)t0 * 1024 + o) = w;
                    sq += (a.x * a.x + a.y * a.y) + (a.z * a.z + a.w * a.w) + (b.x * b.x + b.y * b.y) + (b.z * b.z + b.w * b.w);
                }
                sq += __shfl_xor(sq, 16); sq += __shfl_xor(sq, 32);
                if (fq == 0) ss[(size_t)(t0 + j) * 16 + 4 * u.pn + wc] = sq;
            }
    }
};

struct EpiUp {
    const float* ss; const float* cw; const float* cb; bf16_t* H2;
    __device__ __forceinline__ void operator()(f32x4 (&acc)[2][2][4][2], const Unit& u, int wr, int wc, int fr, int fq) const {
        const int t0 = u.pm * 252 - 1 + wr * 126 + fr * 8;
        { float rs[8]; load_rs8(ss, t0, fq, rs, M_TOK - 1);
#pragma unroll
          for (int ai = 0; ai < 2; ++ai)
#pragma unroll
            for (int m = 0; m < 4; ++m)
#pragma unroll
                for (int bj = 0; bj < 2; ++bj)
#pragma unroll
                    for (int n = 0; n < 2; ++n) acc[ai][bj][m][n] = acc[ai][bj][m][n] * rs[4 * ai + m]; }
        unsigned vmask = 0, smask = 0, emask = 0;
#pragma unroll
        for (int j = 0; j < 8; ++j) { const int t = t0 + j, loc = fr * 8 + j;
            if (loc >= 1 && loc <= 126 && t < M_TOK) vmask |= 1u << j;
            const int sm = (t < NPROMPT) ? (SEQ_P - 1) : (SEQ_S - 1);
            if ((t & sm) == 0) smask |= 1u << j;
            if ((t & sm) == sm) emask |= 1u << j; }
#pragma unroll
        for (int n = 0; n < 2; ++n) {
            const int cg_ = 128 * u.pn + 32 * wc + 8 * fq + 4 * n;
            const f32x4 w0g = *(const f32x4*)(cw + cg_), w1g = *(const f32x4*)(cw + 4096 + cg_), w2g = *(const f32x4*)(cw + 8192 + cg_), bg = *(const f32x4*)(cb + cg_);
            const f32x4 w0v = *(const f32x4*)(cw + 2048 + cg_), w1v = *(const f32x4*)(cw + 4096 + 2048 + cg_), w2v = *(const f32x4*)(cw + 8192 + 2048 + cg_), bv = *(const f32x4*)(cb + 2048 + cg_);
            float h[8][4];
#pragma unroll
            for (int i = 0; i < 4; ++i) {
                float ag[8], av[8];
#pragma unroll
                for (int j = 0; j < 8; ++j) { ag[j] = acc[j >> 2][0][j & 3][n][i]; av[j] = acc[j >> 2][1][j & 3][n][i]; }
                const float lg = dpp_shr1(ag[7]), rg = dpp_shl1(ag[0]), lv = dpp_shr1(av[7]), rv = dpp_shl1(av[0]);
#pragma unroll
                for (int j = 0; j < 8; ++j) {
                    float Lg = j == 0 ? lg : ag[j == 0 ? 0 : j - 1], Rg = j == 7 ? rg : ag[j == 7 ? 7 : j + 1];
                    float Lv = j == 0 ? lv : av[j == 0 ? 0 : j - 1], Rv = j == 7 ? rv : av[j == 7 ? 7 : j + 1];
                    if ((smask >> j) & 1u) { Lg = 0.f; Lv = 0.f; }
                    if ((emask >> j) & 1u) { Rg = 0.f; Rv = 0.f; }
                    const float cgv = w0g[i] * Lg + w1g[i] * ag[j] + w2g[i] * Rg + bg[i];
                    const float cvv = w0v[i] * Lv + w1v[i] * av[j] + w2v[i] * Rv + bv[i];
                    h[j][i] = gelu_t(cgv) * cvv;
                }
            }
#pragma unroll
            for (int j = 0; j < 8; ++j) if ((vmask >> j) & 1u) { u32x2 w; w.x = cvt_pk_bf16(h[j][0], h[j][1]); w.y = cvt_pk_bf16(h[j][2], h[j][3]);
                *(u32x2*)(H2 + (size_t)(t0 + j) * 2048 + cg_) = w; }
        }
    }
};
}

namespace attn_body {
using bf16=__hip_bfloat16;
using bf16x8=__attribute__((ext_vector_type(8)))short;
using s16x4=__attribute__((ext_vector_type(4)))short;
using f32x16=__attribute__((ext_vector_type(16)))float;
using u32x4=__attribute__((ext_vector_type(4)))unsigned;
constexpr int D=64,QP=1024,KP=128;
constexpr int NW=8,QBLK=32,QB=QBLK*NW,KVBLK=64;
__device__ __forceinline__ int crow(int r,int hi){return (r&3)+8*(r>>2)+4*hi;}
#define SBAR() __builtin_amdgcn_sched_barrier(0)
constexpr int NSLOT=3, SLOTB=8192;
constexpr int LDS_K=0, LDS_V=NSLOT*SLOTB, LDS_WS=2*NSLOT*SLOTB, LDS_OST=LDS_WS+NW*64*4, LDS_BYTES=LDS_OST+NW*4096;
__device__ __forceinline__ void glds16(const void*gsrc,unsigned lds_dst){unsigned keep;
  asm volatile("s_mov_b32 %0, m0\n\ts_mov_b32 m0, %2\n\ts_nop 0\n\tglobal_load_lds_dwordx4 %1, off\n\ts_mov_b32 m0, %0":"=&s"(keep):"v"(gsrc),"s"(lds_dst):"memory");}
__device__ __forceinline__ float max3f(float a,float b,float c){float r;asm("v_max3_f32 %0, %1, %2, %3":"=v"(r):"v"(a),"v"(b),"v"(c));return r;}
__device__ __forceinline__ float max2f(float a,float b){float r;asm("v_max_f32_e32 %0, %1, %2":"=v"(r):"v"(a),"v"(b));return r;}
__device__ __forceinline__ float fadd_s(float a,float b){float r;asm("v_add_f32_e32 %0, %1, %2":"=v"(r):"v"(a),"v"(b));return r;}
__device__ __forceinline__ float fsub_s(float a,float b){float r;asm("v_sub_f32_e32 %0, %1, %2":"=v"(r):"v"(a),"v"(b));return r;}
typedef float f32x2_t __attribute__((ext_vector_type(2))); typedef __bf16 bf16x2_t __attribute__((ext_vector_type(2)));
__device__ __forceinline__ unsigned cvtpk_s(float lo,float hi){f32x2_t v={lo,hi};bf16x2_t b=__builtin_convertvector(v,bf16x2_t);return __builtin_bit_cast(unsigned,b);}
#define WAIT_BAR(N) asm volatile("s_waitcnt vmcnt(" #N ") lgkmcnt(0)\n\ts_barrier":::"memory")
__device__ __forceinline__ void qkt(f32x16&p0,f32x16&p1,const char*Kslot,const bf16x8*qr,const f32x16&negm,int r32,int hi){
  const char*kb=Kslot+hi*1024+r32*16;
  #pragma unroll
  for(int d0=0;d0<4;++d0){
    const bf16x8 b0=*reinterpret_cast<const bf16x8*>(kb+d0*2048);
    const bf16x8 b1=*reinterpret_cast<const bf16x8*>(kb+d0*2048+512);
    if(d0==0){p0=__builtin_amdgcn_mfma_f32_32x32x16_bf16(b0,qr[0],negm,0,0,0);p1=__builtin_amdgcn_mfma_f32_32x32x16_bf16(b1,qr[0],negm,0,0,0);}
    else{p0=__builtin_amdgcn_mfma_f32_32x32x16_bf16(b0,qr[d0],p0,0,0,0);p1=__builtin_amdgcn_mfma_f32_32x32x16_bf16(b1,qr[d0],p1,0,0,0);}}
}
typedef __attribute__((address_space(3))) const char* lds_cptr;
typedef short v4i16_t __attribute__((ext_vector_type(4)));
__device__ __forceinline__ void kload8(bf16x8*kf,lds_cptr kp){
  kf[0]=*(const __attribute__((address_space(3))) bf16x8*)(kp);      kf[1]=*(const __attribute__((address_space(3))) bf16x8*)(kp+512);
  kf[2]=*(const __attribute__((address_space(3))) bf16x8*)(kp+2048); kf[3]=*(const __attribute__((address_space(3))) bf16x8*)(kp+2560);
  kf[4]=*(const __attribute__((address_space(3))) bf16x8*)(kp+4096); kf[5]=*(const __attribute__((address_space(3))) bf16x8*)(kp+4608);
  kf[6]=*(const __attribute__((address_space(3))) bf16x8*)(kp+6144); kf[7]=*(const __attribute__((address_space(3))) bf16x8*)(kp+6656);
}
__device__ __forceinline__ void kload2(bf16x8*kf,lds_cptr kp,int j){ kf[2*j]=*(const __attribute__((address_space(3))) bf16x8*)(kp+j*2048); kf[2*j+1]=*(const __attribute__((address_space(3))) bf16x8*)(kp+j*2048+512); }
__device__ __forceinline__ s16x4 vtr(lds_cptr p){ return __builtin_bit_cast(s16x4,__builtin_amdgcn_ds_read_tr16_b64_v4i16((__attribute__((address_space(3))) v4i16_t*)p)); }
__device__ __forceinline__ float rowmax(const f32x16&p0,const f32x16&p1){
  float a=max3f(p0[0],p0[1],p1[0]),b=max3f(p0[2],p0[3],p1[1]);a=max3f(a,p1[2],p1[3]);
  #pragma unroll
  for(int r=4;r<16;r+=4){a=max3f(a,p0[r],p0[r+1]);b=max3f(b,p0[r+2],p0[r+3]);a=max3f(a,p1[r],p1[r+1]);b=max3f(b,p1[r+2],p1[r+3]);}
  const float m=max2f(a,b);
  auto rr=__builtin_amdgcn_permlane32_swap(__float_as_uint(m),__float_as_uint(m),false,false);
  return max2f(__uint_as_float(rr[0]),__uint_as_float(rr[1]));
}
__device__ __forceinline__ void pv(f32x16*o,int vb,bf16x8 pa0,bf16x8 pa1,bf16x8 pa2,bf16x8 pa3){
  #pragma unroll
  for(int d0=0;d0<2;++d0){s16x4 lo[4],hi[4];
    #pragma unroll
    for(int ks=0;ks<4;++ks){
      asm volatile("ds_read_b64_tr_b16 %0,%1 offset:%c2":"=&v"(lo[ks]):"v"(vb),"i"(d0*4096+ks*1024):"memory");
      asm volatile("ds_read_b64_tr_b16 %0,%1 offset:%c2":"=&v"(hi[ks]):"v"(vb),"i"(d0*4096+ks*1024+512):"memory");}
    asm volatile("s_waitcnt lgkmcnt(0)":::"memory");SBAR();
    #define PK(k) (bf16x8){lo[k][0],lo[k][1],lo[k][2],lo[k][3],hi[k][0],hi[k][1],hi[k][2],hi[k][3]}
    o[d0]=__builtin_amdgcn_mfma_f32_32x32x16_bf16(pa0,PK(0),o[d0],0,0,0);
    o[d0]=__builtin_amdgcn_mfma_f32_32x32x16_bf16(pa1,PK(1),o[d0],0,0,0);
    o[d0]=__builtin_amdgcn_mfma_f32_32x32x16_bf16(pa2,PK(2),o[d0],0,0,0);
    o[d0]=__builtin_amdgcn_mfma_f32_32x32x16_bf16(pa3,PK(3),o[d0],0,0,0);
    #undef PK
  }
}
template<int THRL> __device__ __forceinline__ void attn_unit(long rowbase,int seq,int h,int q0,const bf16*Q,const bf16*__restrict__ K,const bf16*__restrict__ V,bf16*O,char*shm){
  int tid_=threadIdx.x; asm volatile("":"+v"(tid_));
  const int tid=tid_,lane=tid&63,r32=lane&31,hi=lane>>5; const int wid=__builtin_amdgcn_readfirstlane(tid>>6);
  const bf16*Qw=Q+(rowbase+q0+wid*QBLK)*QP+h*D;
  const bf16*Kh=K+rowbase*KP+(h>>2)*D,*Vh=V+rowbase*KP+(h>>2)*D;
  const unsigned lds0=(unsigned)(uintptr_t)shm;
  float*wsf=(float*)(shm+LDS_WS)+wid*64;
  const bf16*ksrc=Kh+(long)lane*KP+wid*8;
  const bf16*vsrc=Vh+(long)(16*(wid&3)+(lane>>2))*KP+(wid>>2)*32+(lane&3)*8;
  const unsigned kdst=lds0+LDS_K+wid*1024, vdst=lds0+LDS_V+wid*1024;
  #define DMA_K(t,slot) glds16(ksrc+(long)(t)*KVBLK*KP,(unsigned)__builtin_amdgcn_readfirstlane(kdst+(slot)))
  #define DMA_V(t,slot) glds16(vsrc+(long)(t)*KVBLK*KP,(unsigned)__builtin_amdgcn_readfirstlane(vdst+(slot)))
  const int vb0=(int)(lds0+LDS_V)+((lane>>4)&1)*32+(lane&3)*8+(4*hi+((lane&15)>>2))*64;
  const char*Kbase=shm+LDS_K; bf16x8 kf[8];
  const lds_cptr shm3=(lds_cptr)shm; const lds_cptr kp0=shm3+LDS_K+hi*1024+r32*16; const lds_cptr vp0=shm3+LDS_V+((lane>>4)&1)*32+(lane&3)*8+(4*hi+((lane&15)>>2))*64;
  const int NT=seq/KVBLK;
  DMA_K(0,0);DMA_V(0,0);DMA_K(1,SLOTB);
  bf16x8 qr[4];
  #pragma unroll
  for(int d0=0;d0<4;++d0)qr[d0]=*reinterpret_cast<const bf16x8*>(&Qw[(long)r32*QP+d0*16+hi*8]);
  float mhat=0.f,l_reg=0.f;f32x16 o[2];o[0]=f32x16{};o[1]=f32x16{};f32x16 negm=f32x16{};asm volatile("":"+v"(negm));
  bool resc=false;
  #define START(P0,P1) do{ const float rm=rowmax(P0,P1); resc=false; \
    { const float dl=rm; mhat=fadd_s(mhat,dl); \
      _Pragma("unroll") for(int r=0;r<16;++r){P0[r]=fsub_s(P0[r],dl);P1[r]=fsub_s(P1[r],dl);} \
      _Pragma("unroll") for(int r=0;r<16;++r)negm[r]=-mhat; asm volatile("":"+v"(negm)); } \
    _Pragma("unroll") for(int r=0;r<16;++r)P0[r]=__builtin_amdgcn_exp2f(P0[r]); }while(0)
  #define RESC() do{ if(resc){ asm volatile("s_waitcnt lgkmcnt(0)":::"memory"); \
      _Pragma("unroll") for(int d_=0;d_<2;++d_) _Pragma("unroll") for(int r=0;r<16;++r)o[d_][r]*=wsf[crow(r,hi)]; } }while(0)
  f32x16 pA0,pA1,pB0,pB1;
  int sl_prev=0,sl_cur=0,sl_next=SLOTB;
  #define ROT() do{sl_prev=sl_cur;sl_cur=sl_next;sl_next=(sl_next==(NSLOT-1)*SLOTB)?0:sl_next+SLOTB;}while(0)
  DMA_K(2,2*SLOTB);
  WAIT_BAR(3);
  qkt(pA0,pA1,Kbase,qr,negm,r32,hi);asm volatile("s_nop 15\n\ts_nop 7":"+v"(pA0),"+v"(pA1));
  START(pA0,pA1);
  _Pragma("unroll") for(int r=0;r<16;++r)pA1[r]=__builtin_amdgcn_exp2f(pA1[r]);
  WAIT_BAR(0);
  DMA_K(3,0);DMA_V(1,SLOTB);
  ROT();
  kload8(kf,kp0+sl_cur);
  WAIT_BAR(2);
  s16x4 vlo[8],vhi[8]; u32x4 pw0,pw1,pw2,pw3;
  #define PKW(P,B) cvtpk_s(P[B],P[B+1])
  #define PAF(k) __builtin_bit_cast(bf16x8,pw##k)
  #define VFR(i) (bf16x8){vlo[i][0],vlo[i][1],vlo[i][2],vlo[i][3],vhi[i][0],vhi[i][1],vhi[i][2],vhi[i][3]}
  #define PIN(x) asm volatile("":"+v"(x))
  #define MX3(a,b,c) __builtin_fmaxf(__builtin_fmaxf((a),(b)),(c))
  #define GAPA(MF,A0,A1,A2,A3,W0,W1,PW) do{ MF; sacc+=A0; sacc+=A1; sacc+=A2; sacc+=A3; PIN(sacc); W0; W1; PIN(PW); SBAR(); }while(0)
  #define EX(v) __builtin_amdgcn_exp2f(v)
  #define GAPB(MF,X,B) do{ MF; X[B]=EX(X[B]); X[B+1]=EX(X[B+1]); X[B+2]=EX(X[B+2]); X[B+3]=EX(X[B+3]); PIN(X); SBAR(); }while(0)
  #define VRD(i) do{ vlo[i]=vtr(vp_+(((i)>>2)*4096+((i)&3)*1024)); vhi[i]=vtr(vp_+(((i)>>2)*4096+((i)&3)*1024+512)); }while(0)
  #define KRD(G,j) do{ if(G){ kload2(kf,kp0+sl_next,j); SBAR(); } }while(0)
  #define STEP(C0,C1,P0,P1,t,GK,GV,GL) do{ SBAR(); \
    const lds_cptr vp_=vp0+sl_prev; \
    VRD(0); SBAR(); float sacc=(P0[0]+P0[1]); \
    GAPA(C0=__builtin_amdgcn_mfma_f32_32x32x16_bf16(kf[0],qr[0],negm,0,0,0), P0[2],P0[3],P0[4],P0[5],     pw0[0]=PKW(P0,0), pw0[1]=PKW(P0,2), pw0); \
    VRD(4); SBAR(); GAPA(C1=__builtin_amdgcn_mfma_f32_32x32x16_bf16(kf[1],qr[0],negm,0,0,0), P0[6],P0[7],P0[8],P0[9],     pw0[2]=PKW(P0,4), pw0[3]=PKW(P0,6), pw0); \
    VRD(1); SBAR(); GAPA(C0=__builtin_amdgcn_mfma_f32_32x32x16_bf16(kf[2],qr[1],C0,0,0,0),   P0[10],P0[11],P0[12],P0[13], pw1[0]=PKW(P0,8), pw1[1]=PKW(P0,10), pw1); \
    VRD(5); SBAR(); GAPA(C1=__builtin_amdgcn_mfma_f32_32x32x16_bf16(kf[3],qr[1],C1,0,0,0),   P0[14],P0[15],P1[0],P1[1],   pw1[2]=PKW(P0,12),pw1[3]=PKW(P0,14), pw1); \
    VRD(2); SBAR(); GAPA(C0=__builtin_amdgcn_mfma_f32_32x32x16_bf16(kf[4],qr[2],C0,0,0,0),   P1[2],P1[3],P1[4],P1[5],     pw2[0]=PKW(P1,0), pw2[1]=PKW(P1,2), pw2); \
    VRD(6); SBAR(); GAPA(C1=__builtin_amdgcn_mfma_f32_32x32x16_bf16(kf[5],qr[2],C1,0,0,0),   P1[6],P1[7],P1[8],P1[9],     pw2[2]=PKW(P1,4), pw2[3]=PKW(P1,6), pw2); \
    VRD(3); SBAR(); GAPA(C0=__builtin_amdgcn_mfma_f32_32x32x16_bf16(kf[6],qr[3],C0,0,0,0),   P1[10],P1[11],P1[12],P1[13], pw3[0]=PKW(P1,8), pw3[1]=PKW(P1,10), pw3); \
    VRD(7); SBAR(); GAPA(C1=__builtin_amdgcn_mfma_f32_32x32x16_bf16(kf[7],qr[3],C1,0,0,0),   P1[14],P1[15],0.f,0.f,       pw3[2]=PKW(P1,12),pw3[3]=PKW(P1,14), pw3); \
    l_reg+=sacc; \
    if(GK){DMA_K((t)+3,sl_cur);} if(GV){DMA_V((t)+1,sl_next);} \
    { float a=MX3(C0[0],C0[1],C1[0]),b=MX3(C0[2],C0[3],C1[1]); a=MX3(a,C1[2],C1[3]); \
      _Pragma("unroll") for(int r=4;r<16;r+=4){a=MX3(a,C0[r],C0[r+1]);b=MX3(b,C0[r+2],C0[r+3]);a=MX3(a,C1[r],C1[r+1]);b=MX3(b,C1[r+2],C1[r+3]);} \
      float rm=__builtin_fmaxf(a,b); { auto rr=__builtin_amdgcn_permlane32_swap(__float_as_uint(rm),__float_as_uint(rm),false,false); rm=__builtin_fmaxf(__uint_as_float(rr[0]),__uint_as_float(rr[1])); } \
      resc=false; \
      if(__builtin_expect(__any(rm>(float)THRL),0)){ const float dl=__builtin_fmaxf(rm,0.f); mhat+=dl; \
        _Pragma("unroll") for(int r=0;r<16;++r){C0[r]-=dl;C1[r]-=dl;} \
        _Pragma("unroll") for(int r=0;r<16;++r)negm[r]=-mhat; asm volatile("":"+v"(negm)); \
        const float f=__builtin_amdgcn_exp2f(-dl); l_reg*=f; if(hi==0)wsf[r32]=f; resc=true; } } \
    SBAR(); \
    GAPB(o[0]=__builtin_amdgcn_mfma_f32_32x32x16_bf16(PAF(0),VFR(0),o[0],0,0,0), C0,0); \
    GAPB(o[1]=__builtin_amdgcn_mfma_f32_32x32x16_bf16(PAF(0),VFR(4),o[1],0,0,0), C0,4); \
    KRD(GL,0); GAPB(o[0]=__builtin_amdgcn_mfma_f32_32x32x16_bf16(PAF(1),VFR(1),o[0],0,0,0), C0,8); \
    KRD(GL,1); GAPB(o[1]=__builtin_amdgcn_mfma_f32_32x32x16_bf16(PAF(1),VFR(5),o[1],0,0,0), C0,12); \
    KRD(GL,2); GAPB(o[0]=__builtin_amdgcn_mfma_f32_32x32x16_bf16(PAF(2),VFR(2),o[0],0,0,0), C1,0); \
    KRD(GL,3); GAPB(o[1]=__builtin_amdgcn_mfma_f32_32x32x16_bf16(PAF(2),VFR(6),o[1],0,0,0), C1,4); \
    GAPB(o[0]=__builtin_amdgcn_mfma_f32_32x32x16_bf16(PAF(3),VFR(3),o[0],0,0,0), C1,8); \
    GAPB(o[1]=__builtin_amdgcn_mfma_f32_32x32x16_bf16(PAF(3),VFR(7),o[1],0,0,0), C1,12); \
    }while(0)
  int t=1;
  for(;t+5<NT;t+=2){
    STEP(pB0,pB1,pA0,pA1,t,true,true,true);     WAIT_BAR(2); RESC(); ROT();
    STEP(pA0,pA1,pB0,pB1,t+1,true,true,true);   WAIT_BAR(2); RESC(); ROT();
  }
  #define ENDW(tt) do{ if((tt)+3<NT){WAIT_BAR(2);} else if((tt)+2<NT){WAIT_BAR(1);} else {WAIT_BAR(0);} }while(0)
  for(;t+1<NT;t+=2){
    STEP(pB0,pB1,pA0,pA1,t,(t+3<NT),(t+1<NT),(t+1<NT));       ENDW(t);   RESC(); ROT();
    STEP(pA0,pA1,pB0,pB1,t+1,(t+4<NT),(t+2<NT),(t+2<NT));     ENDW(t+1); RESC(); ROT();
  }
  STEP(pB0,pB1,pA0,pA1,NT-1,false,false,false); RESC();
  { float sacc=pB0[0]+pB0[1]; _Pragma("unroll") for(int r=2;r<16;++r)sacc+=pB0[r]; _Pragma("unroll") for(int r=0;r<16;++r)sacc+=pB1[r]; l_reg+=sacc;
    pw0=(u32x4){PKW(pB0,0),PKW(pB0,2),PKW(pB0,4),PKW(pB0,6)};pw1=(u32x4){PKW(pB0,8),PKW(pB0,10),PKW(pB0,12),PKW(pB0,14)};pw2=(u32x4){PKW(pB1,0),PKW(pB1,2),PKW(pB1,4),PKW(pB1,6)};pw3=(u32x4){PKW(pB1,8),PKW(pB1,10),PKW(pB1,12),PKW(pB1,14)};
    SBAR(); pv(o,vb0+sl_cur,PAF(0),PAF(1),PAF(2),PAF(3)); }
  #undef PKW
  #undef PAF
  #undef VFR
  #undef PIN
  #undef MX3
  #undef GAPA
  #undef GAPB
  #undef EX
  #undef VRD
  #undef KRD
  #undef STEP
  #undef ENDW
  {auto rr=__builtin_amdgcn_permlane32_swap(__float_as_uint(l_reg),__float_as_uint(l_reg),false,false);l_reg=__uint_as_float(rr[0])+__uint_as_float(rr[1]);}
  if(hi==0)wsf[32+r32]=l_reg;asm volatile("s_waitcnt lgkmcnt(0)":::"memory");
  float rli[16];
  #pragma unroll
  for(int r=0;r<16;++r)rli[r]=__builtin_amdgcn_rcpf(wsf[32+crow(r,hi)]);
  bf16*Ow=O+(rowbase+q0+wid*QBLK)*QP+h*D;
  { bf16*stg=(bf16*)(shm+LDS_OST)+wid*2048;
    #pragma unroll
    for(int r=0;r<16;++r){const int orow=crow(r,hi);
      #pragma unroll
      for(int d0=0;d0<2;++d0)stg[orow*64+d0*32+r32]=__float2bfloat16(o[d0][r]*rli[r]);}
    asm volatile("s_waitcnt lgkmcnt(0)":::"memory");
    #pragma unroll
    for(int i=0;i<4;++i){const int row=i*8+(lane>>3),ch=lane&7; const u32x4 v=*(const u32x4*)(stg+row*64+ch*8); *(u32x4*)(Ow+(long)row*QP+ch*8)=v;} }
  asm volatile("s_waitcnt lgkmcnt(0)\n\ts_barrier":::"memory");
  #undef DMA_K
  #undef DMA_V
  #undef START
  #undef RESC
  #undef ROT
}
constexpr int ATTN_LDS_BYTES=LDS_BYTES;
#undef SBAR
#undef WAIT_BAR
}

#define GRID_SYNC() do { asm volatile("s_waitcnt vmcnt(0) lgkmcnt(0)" ::: "memory"); grid.sync(); __builtin_amdgcn_fence(__ATOMIC_ACQUIRE, "agent"); asm volatile("s_waitcnt vmcnt(0)" ::: "memory"); } while (0)
#ifndef N_LAUNCH_MODE
#define N_LAUNCH_MODE 0
#endif
constexpr int N_PHASES = 2 + 6 * NLAYER;
constexpr int NWAVES = 8;
constexpr size_t MiB = 1u << 20;
constexpr size_t WL_IN = 0, WL_A = WL_IN + (size_t)INW * 1024, WL_B = WL_A + 1024 * 512, WL_MIX = WL_B + 1024 * 512, WL_UP = WL_MIX + 1024 * 1024,
                 WL_DOWN = WL_UP + 4096 * 1024, WL_SG = WL_DOWN + 1024 * 2048, WL_SIZE = WL_SG + 8 * 128 * 128;
static_assert(WL_SIZE * 2 * NLAYER <= 95 * MiB, "weights region");
constexpr size_t WS_ROPE = 0, WS_W = 1 * MiB, WS_XB = 96 * MiB + 4096, WS_QU = 289 * MiB, WS_K = 481 * MiB, WS_V = 505 * MiB, WS_VST = 529 * MiB,
                 WS_GA = 625 * MiB, WS_GB = 817 * MiB, WS_H2 = 625 * MiB, WS_SS = 1009 * MiB, WS_SSG = 1015 * MiB, WS_END = 1018 * MiB;
constexpr int LDS_BYTES = 147456, SG_SCR_OFF = 135168, BARST_OFF = 140288;
constexpr size_t WS_BAR = 65536, BAR_BYTES = 16384;


#define XB_TMO      128
#define XB_XCNT(j)  (256  + 64 * (j))
#define XB_XSUB(j)  (1280 + 64 * (j))
#define XB_XGEN(j)  (2304 + 64 * (j))
#define XB_TOP      3328
#define XB_TOPGEN   3392
#define XCD_BAR_WORDS 3456
#define XB_SPIN_CAP (1u << 22)
__device__ __forceinline__ unsigned xb_ld(unsigned* p)              { return __hip_atomic_load(p, __ATOMIC_RELAXED, __HIP_MEMORY_SCOPE_AGENT); }
__device__ __forceinline__ unsigned xb_add(unsigned* p, unsigned v) { return __hip_atomic_fetch_add(p, v, __ATOMIC_RELAXED, __HIP_MEMORY_SCOPE_AGENT); }
__device__ __forceinline__ unsigned xb_xcc_id() { return (unsigned)__builtin_amdgcn_s_getreg((3 << 11) | 20) & 0xFu; }
#define XB_SPIN(cond, bar) do { unsigned _sp = 0; while (cond) { __builtin_amdgcn_s_sleep(1); \
    if ((++_sp & 255u) == 0u) { if (xb_ld(&(bar)[XB_TMO])) break; if (_sp > XB_SPIN_CAP) { atomicAdd(&(bar)[XB_TMO], 1u); break; } } } } while (0)
struct XcdBarrier { unsigned* bar; unsigned x; volatile LAS unsigned* st; };
__device__ __forceinline__ XcdBarrier xcd_barrier_post(unsigned* bar, volatile LAS unsigned* st) {
    XcdBarrier b; b.bar = bar; b.x = xb_xcc_id(); b.st = st;
    if (threadIdx.x == 0) (void)xb_add(&bar[XB_XCNT(b.x)], 1u);
    return b;
}
__device__ __forceinline__ void xcd_barrier_complete(unsigned* bar, unsigned x, unsigned& nloc, unsigned& nx) {
    const unsigned G = gridDim.x * gridDim.y * gridDim.z;
    unsigned sum, cnt, mine, sp = 0u;
    for (;;) {
        sum = 0u; cnt = 0u; mine = 0u;
#pragma unroll
        for (unsigned j = 0; j < 16; ++j) { const unsigned c = xb_ld(&bar[XB_XCNT(j)]); sum += c; cnt += (c > 0u) ? 1u : 0u; mine = (j == x) ? c : mine; }
        if (sum == G) break;
        __builtin_amdgcn_s_sleep(1);
        if ((++sp & 255u) == 0u) { if (xb_ld(&bar[XB_TMO])) break; if (sp > XB_SPIN_CAP) { atomicAdd(&bar[XB_TMO], 1u); break; } }
    }
    nloc = mine > 0u ? mine : 1u; nx = cnt > 0u ? cnt : 1u;
}
__device__ __forceinline__ void xcd_barrier(const XcdBarrier& b) {
    asm volatile("s_waitcnt vmcnt(0)" ::: "memory");
    __syncthreads();
    if (threadIdx.x == 0) {
        unsigned* bar = b.bar;
        __builtin_amdgcn_s_waitcnt(0);
        unsigned nloc = b.st[0], nx = b.st[1];
        if (nloc == 0u) { xcd_barrier_complete(bar, b.x, nloc, nx); b.st[0] = nloc; b.st[1] = nx; }
        const unsigned old = xb_add(&bar[XB_XSUB(b.x)], 1u);
        const unsigned gen = old / nloc;
        if (old + 1u == (gen + 1u) * nloc) {
            __builtin_amdgcn_fence(__ATOMIC_RELEASE, "agent");
            asm volatile("s_waitcnt vmcnt(0)" ::: "memory");
            const unsigned og = xb_add(&bar[XB_TOP], 1u);
            const unsigned tg = og / nx;
            if (og + 1u == (tg + 1u) * nx) xb_add(&bar[XB_TOPGEN], 1u);
            else XB_SPIN(xb_ld(&bar[XB_TOPGEN]) == tg, bar);
            __builtin_amdgcn_fence(__ATOMIC_ACQUIRE, "agent");
            xb_add(&bar[XB_XGEN(b.x)], 1u);
            asm volatile("s_waitcnt vmcnt(0)" ::: "memory");
        } else {
            XB_SPIN(xb_ld(&bar[XB_XGEN(b.x)]) == gen, bar);
            __builtin_amdgcn_fence(__ATOMIC_ACQUIRE, "agent");
            asm volatile("s_waitcnt vmcnt(0)" ::: "memory");
        }
    }
    __syncthreads();
}

struct Args { const float* in[18]; float* out; unsigned char* ws; int ph_lo, ph_hi; };

__device__ __forceinline__ float wave_sum(float v) {
#pragma unroll
    for (int o = 1; o < 64; o <<= 1) v += __shfl_xor(v, o);
    return v;
}
__device__ __forceinline__ int invperm32(int cc) { return 16 * ((cc >> 2) & 1) + 4 * (cc >> 3) + (cc & 3); }
__device__ __forceinline__ int map_plain(int n) { return (n & ~31) + invperm32(n & 31); }
__device__ __forceinline__ int map_in(int n) {
    if (n < 512) { const int pn = n >> 8, hh = (n >> 6) & 3, d = n & 63; return 256 * pn + 128 * (d >> 5) + 32 * hh + (d & 31); }
    if (n < 768) { const int c = n - 512, isv = c >> 7, head = (c >> 6) & 1, d = c & 63, wc = 2 * isv + head; return 512 + 128 * (d >> 5) + 32 * wc + (d & 31); }
    if (n >= 1792) { const int bj = (n >= 2816) ? 1 : 0, c = n - 1792 - 1024 * bj, r = c & 127;
        return 1792 + 256 * (c >> 7) + 128 * bj + (r & ~31) + invperm32(r & 31); }
    return map_plain(n);
}
__device__ __forceinline__ int map_up(int n) { const int bj = n >> 11, c = n & 2047, pn = c >> 7, r = c & 127; return 256 * pn + 128 * bj + (r & ~31) + invperm32(r & 31); }

template <int MAP>
__device__ __forceinline__ void transpose_item(const float* W, const float* g, int K, int N, bf16_t* WT, LAS float* scr, int item, int lane) {
    const int nblk = N / 32, kb = item / nblk, nb = item % nblk, k0 = 64 * kb, n0 = 32 * nb;
#pragma unroll 8
    for (int i = 0; i < 32; ++i) { const int kk = 2 * i + (lane >> 5); float v = W[(size_t)(k0 + kk) * N + n0 + (lane & 31)]; if (g) v *= g[k0 + kk]; scr[kk * 33 + (lane & 31)] = v; }
    asm volatile("s_waitcnt lgkmcnt(0)" ::: "memory");
    const int c = lane & 7;
#pragma unroll
    for (int j = 0; j < 4; ++j) { const int n = (lane >> 3) + 8 * j; const LAS float* s = scr + (8 * c) * 33 + n;
        u32x4 o; o.x = cvt_pk_bf16(s[0 * 33], s[1 * 33]); o.y = cvt_pk_bf16(s[2 * 33], s[3 * 33]); o.z = cvt_pk_bf16(s[4 * 33], s[5 * 33]); o.w = cvt_pk_bf16(s[6 * 33], s[7 * 33]);
        const int nn = n0 + n; const int row = MAP == 0 ? map_plain(nn) : (MAP == 1 ? map_in(nn) : map_up(nn));
        *(u32x4*)(WT + (size_t)row * K + k0 + 8 * c) = o; }
    asm volatile("s_waitcnt lgkmcnt(0)" ::: "memory");
}

__device__ __forceinline__ void sincos_tab(float x, float& c, float& s) {
    const float n = rintf(x * 0.63661977236758134308f);
    float r = fmaf(-n, 1.5703125f, x); r = fmaf(-n, 4.83751296997070312500e-4f, r); r = fmaf(-n, 7.5497899548918821e-8f, r);
    const float r2 = r * r;
    const float sp = r + r * r2 * (-1.0f / 6 + r2 * (1.0f / 120 + r2 * (-1.0f / 5040 + r2 * (1.0f / 362880))));
    const float cp = 1.0f + r2 * (-0.5f + r2 * (1.0f / 24 + r2 * (-1.0f / 720 + r2 * (1.0f / 40320 + r2 * (-1.0f / 3628800)))));
    const int q = ((int)n) & 3;
    s = (q == 0) ? sp : (q == 1) ? cp : (q == 2) ? -sp : -cp;
    c = (q == 0) ? cp : (q == 1) ? -sp : (q == 2) ? -cp : sp;
}

__device__ __forceinline__ void sg_unit(int ch, int g, const bf16_t* VST, const float* ssg, const bf16_t* Wg, const float* sgb, const float* gsg, bf16_t* QU, LAS float* scr, int lane) {
    asm volatile("" : "+v"(lane));
    const int fr = lane & 15, fq = lane >> 4;
#pragma unroll
    for (int hh = 0; hh < 2; ++hh) { const int p = lane + 64 * hh; const float* sp = ssg + (size_t)(ch * 128 + p) * 8; const f32x4 a = *(const f32x4*)sp, b = *(const f32x4*)(sp + 4);
        const float s = ((a.x + a.y) + (a.z + a.w)) + ((b.x + b.y) + (b.z + b.w)); scr[p] = __builtin_amdgcn_rsqf(s * (1.0f / 512.0f) + EPS); }
    asm volatile("s_waitcnt lgkmcnt(0)" ::: "memory");
    f32x4 acc[8][4];
#pragma unroll
    for (int pt = 0; pt < 8; ++pt)
#pragma unroll
        for (int ct = 0; ct < 4; ++ct) acc[pt][ct] = (f32x4){0.f, 0.f, 0.f, 0.f};
    const bf16_t* vbase = VST + ((size_t)ch * 512 + g * 64) * 128;
    const bf16_t* wbase = Wg + (size_t)g * 128 * 128;
#pragma unroll 1
    for (int kk = 0; kk < 4; ++kk) {
        const int k0 = kk * 32 + 8 * fq;
        bf16x8 af[4];
#pragma unroll
        for (int ct = 0; ct < 4; ++ct) af[ct] = *(const bf16x8*)(vbase + (size_t)(ct * 16 + fr) * 128 + k0);
        float r[8];
#pragma unroll
        for (int e = 0; e < 8; ++e) r[e] = scr[k0 + e];
#pragma unroll
        for (int pt = 0; pt < 8; ++pt) {
            const u32x4 w = *(const u32x4*)(wbase + (size_t)(pt * 16 + fr) * 128 + k0);
            u32x4 ws; ws.x = cvt_pk_bf16(bf_lo(w.x) * r[0], bf_hi(w.x) * r[1]); ws.y = cvt_pk_bf16(bf_lo(w.y) * r[2], bf_hi(w.y) * r[3]);
            ws.z = cvt_pk_bf16(bf_lo(w.z) * r[4], bf_hi(w.z) * r[5]); ws.w = cvt_pk_bf16(bf_lo(w.w) * r[6], bf_hi(w.w) * r[7]);
            const bf16x8 bfz = __builtin_bit_cast(bf16x8, ws);
#pragma unroll
            for (int ct = 0; ct < 4; ++ct) acc[pt][ct] = __builtin_amdgcn_mfma_f32_16x16x32_bf16(af[ct], bfz, acc[pt][ct], 0, 0, 0);
        }
    }
    f32x4 gs[4];
#pragma unroll
    for (int ct = 0; ct < 4; ++ct) gs[ct] = *(const f32x4*)(gsg + g * 64 + ct * 16 + 4 * fq);
#pragma unroll
    for (int pt = 0; pt < 8; ++pt) {
        const int p = pt * 16 + fr; const float b = sgb[g * 128 + p];
        bf16_t* up = QU + (size_t)(ch * 128 + p) * 1024 + 512 + g * 64 + 4 * fq;
#pragma unroll
        for (int ct = 0; ct < 4; ++ct) {
            const u32x2 uu = *(const u32x2*)(up + ct * 16);
            const f32x4 sp = acc[pt][ct] * gs[ct] + b;
            u32x2 w; w.x = cvt_pk_bf16(bf_lo(uu.x) * sp.x, bf_hi(uu.x) * sp.y); w.y = cvt_pk_bf16(bf_lo(uu.y) * sp.z, bf_hi(uu.y) * sp.w);
            *(u32x2*)(up + ct * 16) = w;
        }
    }
    asm volatile("s_waitcnt lgkmcnt(0)" ::: "memory");
}

__global__ void __launch_bounds__(NWAVES * 64, 2) fwd_megakernel(Args args) {
    extern __shared__ __attribute__((aligned(16))) unsigned char lds[];
    cg::grid_group grid = cg::this_grid();
    LAS unsigned char* L = (LAS unsigned char*)lds;
    volatile LAS unsigned* barst = (volatile LAS unsigned*)(L + BARST_OFF);
    if (threadIdx.x < 2) barst[threadIdx.x] = 0u;
    __syncthreads();
    const XcdBarrier xbar = xcd_barrier_post((unsigned*)(args.ws + WS_BAR), barst);
    const int G = gridDim.x, bx = blockIdx.x;
    const int vcu = (G % 8 == 0) ? (bx % 8) * (G / 8) + bx / 8 : bx;
    const int NGW = G * NWAVES;
    unsigned char* ws = args.ws;
    const float* x_prompt = args.in[0]; const float* x_sample = args.in[1];
    const float* attn_norm_g = args.in[2]; const float* w_in = args.in[3]; const float* q_norm_g = args.in[4]; const float* k_norm_g = args.in[5];
    const float* sg_norm_g = args.in[6]; const float* sg_w = args.in[7]; const float* sg_b = args.in[8]; const float* w_branch_a = args.in[9];
    const float* w_branch_b = args.in[10]; const float* w_mix_out = args.in[11]; const float* ffn_norm_g = args.in[12]; const float* w_up = args.in[13];
    const float* conv_w = args.in[14]; const float* conv_b = args.in[15]; const float* w_down = args.in[16]; const float* final_norm_g = args.in[17];
    float* out = args.out;
    float* rope = (float*)(ws + WS_ROPE);
    bf16_t* Wall = (bf16_t*)(ws + WS_W);
    bf16_t* XB = (bf16_t*)(ws + WS_XB); bf16_t* QU = (bf16_t*)(ws + WS_QU); bf16_t* KB = (bf16_t*)(ws + WS_K); bf16_t* VB = (bf16_t*)(ws + WS_V);
    bf16_t* VST = (bf16_t*)(ws + WS_VST); bf16_t* GA = (bf16_t*)(ws + WS_GA); bf16_t* GB = (bf16_t*)(ws + WS_GB); bf16_t* H2 = (bf16_t*)(ws + WS_H2);
    float* SSQ = (float*)(ws + WS_SS); float* SSG = (float*)(ws + WS_SSG);

    for (int p = args.ph_lo; p < args.ph_hi; ++p) {
    if (p > args.ph_lo) { if (args.ph_hi > N_PHASES) GRID_SYNC(); else xcd_barrier(xbar); }
    int tid_ = threadIdx.x; asm volatile("" : "+v"(tid_));
    const int tid = tid_, lane = tid & 63, wave = __builtin_amdgcn_readfirstlane(tid >> 6);
    const int gw = vcu * NWAVES + wave;
    if (p == 0) {
        LAS float* scr = (LAS float*)(L + wave * 16384);
        constexpr int I_IN = 16 * (INW / 32), I_A = 8 * 32, I_MIX = 16 * 32, I_UP = 16 * 128, I_DOWN = 32 * 32, I_L = I_IN + 2 * I_A + I_MIX + I_UP + I_DOWN;
        for (int it = gw; it < I_L * NLAYER; it += NGW) {
            const int l = it / I_L; int r = it % I_L; bf16_t* wl = Wall + (size_t)l * WL_SIZE;
            if (r < I_IN) { transpose_item<1>(w_in + (size_t)l * 1024 * INW, attn_norm_g + l * 1024, 1024, INW, wl + WL_IN, scr, r, lane); continue; } r -= I_IN;
            if (r < I_A) { transpose_item<0>(w_branch_a + (size_t)l * 512 * 1024, nullptr, 512, 1024, wl + WL_A, scr, r, lane); continue; } r -= I_A;
            if (r < I_A) { transpose_item<0>(w_branch_b + (size_t)l * 512 * 1024, nullptr, 512, 1024, wl + WL_B, scr, r, lane); continue; } r -= I_A;
            if (r < I_MIX) { transpose_item<0>(w_mix_out + (size_t)l * 1024 * 1024, nullptr, 1024, 1024, wl + WL_MIX, scr, r, lane); continue; } r -= I_MIX;
            if (r < I_UP) { transpose_item<2>(w_up + (size_t)l * 1024 * 4096, ffn_norm_g + l * 1024, 1024, 4096, wl + WL_UP, scr, r, lane); continue; } r -= I_UP;
            transpose_item<0>(w_down + (size_t)l * 2048 * 1024, nullptr, 2048, 1024, wl + WL_DOWN, scr, r, lane);
        }
        for (int i = gw * 64 + lane; i < NLAYER * 8 * 128 * 128 / 4; i += NGW * 64) {
            const int l = i / (8 * 128 * 128 / 4), r = i % (8 * 128 * 128 / 4);
            const f32x4 v = *(const f32x4*)(sg_w + (size_t)l * 131072 + (size_t)r * 4);
            u32x2 w; w.x = cvt_pk_bf16(v.x, v.y); w.y = cvt_pk_bf16(v.z, v.w);
            *(u32x2*)(Wall + (size_t)l * WL_SIZE + WL_SG + (size_t)r * 4) = w;
        }
        for (int i = gw * 64 + lane; i < 128 * 16; i += NGW * 64) {
            const int pos = i >> 4, f = i & 15; float fr_ = 1.0f; for (int k = 0; k < f; ++k) fr_ *= 0.56234132519034907f;
            float c, s; sincos_tab((float)pos * fr_, c, s); rope[2 * i] = c; rope[2 * i + 1] = s;
        }
        for (int i = gw * 64 + lane; i < 257 * 128; i += NGW * 64) {
            const int r = i / 128, c = i % 128; const long row = (r == 0) ? -1 : (long)M_TOK + r - 1;
            *(u32x4*)(XB + row * 1024 + c * 8) = (u32x4){0u, 0u, 0u, 0u};
        }
        for (int m0 = gw; m0 < M_TOK; m0 += 4 * NGW) {
            int nr = 1; if (m0 + NGW < M_TOK) nr = 2; if (m0 + 2 * NGW < M_TOK) nr = 3; if (m0 + 3 * NGW < M_TOK) nr = 4;
            f32x4 v[4][4]; float sq[4];
#pragma unroll
            for (int r = 0; r < 4; ++r) { const int m = (r < nr) ? m0 + r * NGW : m0;
                const float* xr = (m < NPROMPT) ? x_prompt + (size_t)m * 1024 : x_sample + (size_t)(m - NPROMPT) * 1024; float s = 0.f;
#pragma unroll
                for (int j = 0; j < 4; ++j) { v[r][j] = *(const f32x4*)(xr + 4 * lane + 256 * j); s += (v[r][j].x * v[r][j].x + v[r][j].y * v[r][j].y) + (v[r][j].z * v[r][j].z + v[r][j].w * v[r][j].w); }
                sq[r] = s; }
#pragma unroll
            for (int r = 0; r < 4; ++r) if (r < nr) { const int m = m0 + r * NGW; const float s = wave_sum(sq[r]);
#pragma unroll
                for (int j = 0; j < 4; ++j) { u32x2 w; w.x = cvt_pk_bf16(v[r][j].x, v[r][j].y); w.y = cvt_pk_bf16(v[r][j].z, v[r][j].w); *(u32x2*)(XB + (size_t)m * 1024 + 4 * lane + 256 * j) = w; }
                if (lane < 16) SSQ[(size_t)m * 16 + lane] = (lane == 0) ? s : 0.f; }
        }
    }
    else if (p < N_PHASES - 1) {
        const int l = (p - 1) / 6, k = (p - 1) % 6;
        const bf16_t* wl = Wall + (size_t)l * WL_SIZE;
        if (k == 0) {
            pg8::Gemm g{XB, wl + WL_IN, 1024, 1024, 1024, 0, 0, 256, 128, 0};
            { pg8::StaticOrder S; S.init(M_TOK / 256, 3, 1, G, bx, 0); S.rev = (5 * l + 1) & 1;
              pg8::EpiQKV E{SSQ, q_norm_g + l * 64, k_norm_g + l * 64, rope, QU, KB, VB};
              pg8::gemm_phase<pg8::EpiQKV, 1>(L, g, S, E); }
            { pg8::StaticOrder S; S.init(M_TOK / 256, 2, 1, G, bx, 5); S.rev = (5 * l + 1) & 1;
              pg8::EpiVS E{SSQ, VST, SSG};
              pg8::gemm_phase<pg8::EpiVS, 1>(L, g, S, E); }
            { pg8::StaticOrder S; S.init(M_TOK / 256, 10, 1, G, bx, 3, 2, 7); S.rev = (5 * l + 1) & 1;
              pg8::EpiEW E{SSQ, QU, GA, GB};
              pg8::gemm_phase<pg8::EpiEW, 1>(L, g, S, E); }
        }
        else if (k == 1) {
            LAS float* scr = (LAS float*)(L + SG_SCR_OFF) + wave * 128;
            for (int u = gw; u < 768 * 8; u += NGW)
                sg_unit(u >> 3, u & 7, VST, SSG, wl + WL_SG, sg_b + l * 1024, sg_norm_g + l * 512, QU, scr, lane);
            for (int u = bx; u < 3072; u += G) {
                const int i = u >> 8, c = u & 255, x = c & 7, w = c >> 3;
                long rowbase; int seq, h, q0;
                if (i < 4) { const int idx = w * 4 + i; rowbase = (long)(x >> 1) * SEQ_P; seq = SEQ_P; h = (x & 1) * 4 + (idx >> 5); q0 = (idx & 31) * 256; }
                else { const int pair = 8 * x + (i - 4); rowbase = (long)NPROMPT + (long)(pair >> 1) * SEQ_S; seq = SEQ_S; h = (pair & 1) * 4 + (w >> 3); q0 = (w & 7) * 256; }
                attn_body::attn_unit<8>(rowbase, seq, h, q0, (const attn_body::bf16*)QU, (const attn_body::bf16*)KB, (const attn_body::bf16*)VB, (attn_body::bf16*)QU, (char*)lds);
            }
        }
        else if (k == 2) {
            pg8::Gemm g{QU + 512, wl + WL_B, 1024, 512, 512, -512 * 2, -(long)(WL_B - WL_A) * 2, 256, 0, 0};
            pg8::StaticOrder S; S.init(M_TOK / 256, 4, 2, G, bx); S.rev = (5 * l + 2) & 1;
            pg8::EpiMerge E{GA, GB};
            pg8::gemm_phase<pg8::EpiMerge, 2>(L, g, S, E);
        }
        else if (k == 3) {
            pg8::Gemm g{GA, wl + WL_MIX, 1024, 1024, 1024, 0, 0, 256, 0, 0};
            pg8::StaticOrder S; S.init(M_TOK / 256, 4, 1, G, bx); S.rev = (5 * l + 3) & 1;
            pg8::EpiRes E{x_prompt, x_sample, 0, out, XB, SSQ, 1, 0};
            pg8::gemm_phase<pg8::EpiRes, 1>(L, g, S, E);
        }
        else if (k == 4) {
            pg8::Gemm g{XB, wl + WL_UP, 1024, 1024, 1024, 0, 0, 252, 126, -1};
            pg8::StaticOrder S; S.init((M_TOK + 251) / 252, 16, 1, G, bx); S.rev = (5 * l + 4) & 1;
            pg8::EpiUp E{SSQ, conv_w + (size_t)l * 3 * 4096, conv_b + (size_t)l * 4096, H2};
            pg8::gemm_phase<pg8::EpiUp, 1>(L, g, S, E);
        }
        else {
            pg8::Gemm g{H2, wl + WL_DOWN, 2048, 2048, 2048, 0, 0, 256, 0, 0};
            pg8::StaticOrder S; S.init(M_TOK / 256, 4, 1, G, bx); S.rev = (5 * l + 5) & 1;
            pg8::EpiRes E{x_prompt, x_sample, 0, out, XB, SSQ, 1, 0};
            pg8::gemm_phase<pg8::EpiRes, 1>(L, g, S, E);
        }
    } else
    {
        f32x4 gv[4];
#pragma unroll
        for (int j = 0; j < 4; ++j) gv[j] = *(const f32x4*)(final_norm_g + 4 * lane + 256 * j);
        for (int m0 = gw; m0 < M_TOK; m0 += 4 * NGW) {
            int nr = 1; if (m0 + NGW < M_TOK) nr = 2; if (m0 + 2 * NGW < M_TOK) nr = 3; if (m0 + 3 * NGW < M_TOK) nr = 4;
            f32x4 v[4][4]; float sp[4];
#pragma unroll
            for (int r = 0; r < 4; ++r) { const int m = (r < nr) ? m0 + r * NGW : m0; const bf16_t* br = XB + (size_t)m * 1024;
                sp[r] = (lane < 16) ? SSQ[(size_t)m * 16 + lane] : 0.f;
#pragma unroll
                for (int j = 0; j < 4; ++j) { const u32x2 p = *(const u32x2*)(br + 4 * lane + 256 * j); v[r][j] = (f32x4){bf_lo(p.x), bf_hi(p.x), bf_lo(p.y), bf_hi(p.y)}; } }
#pragma unroll
            for (int r = 0; r < 4; ++r) if (r < nr) { float* xr = out + (size_t)(m0 + r * NGW) * 1024;
                const float rs = __builtin_amdgcn_rsqf(wave_sum(sp[r]) * (1.0f / DMOD) + EPS);
#pragma unroll
                for (int j = 0; j < 4; ++j) *(f32x4*)(xr + 4 * lane + 256 * j) = v[r][j] * gv[j] * rs; }
        }
    }
    }
}

extern "C" void kernel_launch(void* const* d_in, const int* in_sizes, int n_in, void* d_out, int out_size, void* d_ws, size_t ws_size, hipStream_t stream) {
    static int grid = 0;
    if (grid == 0) {
        if (n_in != 18 || out_size != M_TOK * DMOD || ws_size < WS_END) { fprintf(stderr, "kernel_launch: unexpected shapes (n_in %d out %d ws %zu)\n", n_in, out_size, ws_size); grid = -1; return; }
        int dev = 0, cus = 0, per_cu = 0;
        (void)hipGetDevice(&dev); (void)hipDeviceGetAttribute(&cus, hipDeviceAttributeMultiprocessorCount, dev);
        (void)hipFuncSetAttribute((const void*)fwd_megakernel, hipFuncAttributeMaxDynamicSharedMemorySize, LDS_BYTES);
        (void)hipOccupancyMaxActiveBlocksPerMultiprocessor(&per_cu, (const void*)fwd_megakernel, NWAVES * 64, LDS_BYTES);
        if (per_cu < 1) { fprintf(stderr, "kernel_launch: occupancy query says %d blocks/CU\n", per_cu); per_cu = 1; }
        (void)hipGetLastError();
        grid = cus * 1;
    }
    if (grid < 0) return;
    (void)hipMemsetAsync((char*)d_ws + WS_BAR, 0, BAR_BYTES, stream);
    Args a{};
    for (int i = 0; i < 18; ++i) a.in[i] = (const float*)d_in[i];
    a.out = (float*)d_out; a.ws = (unsigned char*)d_ws;
    if (N_LAUNCH_MODE == 0) {
        a.ph_lo = 0; a.ph_hi = N_PHASES;
        void* params[] = {&a};
        hipError_t e = hipLaunchCooperativeKernel((const void*)fwd_megakernel, dim3(grid), dim3(NWAVES * 64), params, LDS_BYTES, stream);
        if (e != hipSuccess) fprintf(stderr, "cooperative launch failed: %s (grid %d)\n", hipGetErrorString(e), grid);
    } else {
        for (int p = 0; p < N_PHASES; ++p) { a.ph_lo = p; a.ph_hi = p + 1;
            hipLaunchKernelGGL(fwd_megakernel, dim3(grid), dim3(NWAVES * 64), LDS_BYTES, stream, a); }
    }
}
```

```cpp
#include <hip/hip_runtime.h>
#include <hip/hip_cooperative_groups.h>
#include <hip/hip_bf16.h>
#include <cstdio>
#include <cstdint>
#include <cmath>
namespace cg = cooperative_groups;

constexpr int M_TOK = 98304, NPROMPT = 32768, SEQ_P = 8192, SEQ_S = 2048;
constexpr int DMOD = 1024, INW = 3840, DFF = 2048, NLAYER = 4;
constexpr float EPS = 1e-6f;
constexpr float C2 = 0.125f * 1.4426950408889634f;

#define LAS __attribute__((address_space(3)))
typedef unsigned short bf16_t;
typedef short bf16x8 __attribute__((ext_vector_type(8)));
typedef float f32x4 __attribute__((ext_vector_type(4)));
typedef float f32x2 __attribute__((ext_vector_type(2)));
typedef unsigned u32x4 __attribute__((ext_vector_type(4)));
typedef unsigned u32x2 __attribute__((ext_vector_type(2)));

typedef __bf16 bf16x2_t_ __attribute__((ext_vector_type(2)));
__device__ __forceinline__ unsigned cvt_pk_bf16(float lo, float hi) { f32x2 v = {lo, hi}; bf16x2_t_ b = __builtin_convertvector(v, bf16x2_t_); return __builtin_bit_cast(unsigned, b); }
__device__ __forceinline__ float bf_lo(unsigned w) { return __uint_as_float(w << 16); }
__device__ __forceinline__ float bf_hi(unsigned w) { return __uint_as_float(w & 0xffff0000u); }
__device__ __forceinline__ float gelu_t(float x) {
    const float u = x * (0.7978845608f + 0.0356774081f * x * x);
    const float e = __builtin_amdgcn_exp2f(u * -2.8853900818f);
    return x * __builtin_amdgcn_rcpf(1.0f + e);
}
__device__ __forceinline__ float sigmoid_f(float x) { return __builtin_amdgcn_rcpf(1.0f + __builtin_amdgcn_exp2f(x * -1.4426950409f)); }
__device__ __forceinline__ float dpp_shr1(float v) { return __int_as_float(__builtin_amdgcn_update_dpp(0, __float_as_int(v), 0x111, 0xF, 0xF, true)); }
__device__ __forceinline__ float dpp_shl1(float v) { return __int_as_float(__builtin_amdgcn_update_dpp(0, __float_as_int(v), 0x101, 0xF, 0xF, true)); }

namespace pg8 {
constexpr int BM = 256, BK = 64, HALF = 128, HTB = HALF * BK * 2, STAGE_BYTES = 8 * HTB, NXCD = 8, WGM = 8;
__host__ __device__ __forceinline__ int lds_byte(int r, int c) { const int st = (r >> 4) * 2 + (c >> 5), rr = r & 15, cc = c & 31, ob = rr * 64 + cc * 2; return st * 1024 + (ob ^ (((ob >> 9) & 1) << 5)); }
__host__ __device__ __forceinline__ void stage_rc(int b, int& R, int& C) { const int st = b / 1024, sb = b % 1024, swz = sb ^ (((sb >> 9) & 1) << 5); R = (st >> 1) * 16 + swz / 64; C = (st & 1) * 32 + (swz % 64) / 2; }

struct Unit { int pm, pn, part; };
struct Gemm { const bf16_t* A; const bf16_t* Bt; int lda, ldb, K; long partA, partB; int tstride, wstride, shift; };

struct StaticOrder {
    int nM, nN, nwg, G, c, parts, pn_lo, pn_split, pn_hi, rev;
    __device__ void init(int nM_, int nN_, int parts_, int G_, int c_, int pn_lo_ = 0, int pn_split_ = 1 << 20, int pn_hi_ = 0) { nM = nM_; nN = nN_; nwg = nM * nN; G = G_; c = c_; parts = parts_; pn_lo = pn_lo_; pn_split = pn_split_; pn_hi = pn_hi_; rev = 0; }
    __device__ bool next(int i, Unit& u) const {
        const int it = (parts == 2) ? (i >> 1) : i; u.part = (parts == 2) ? (i & 1) : 0;
        const long L = (long)it * G + c; if (L >= nwg) return false;
        int wgid = (int)L; { const int q = nwg / NXCD, r = nwg % NXCD, xcd = wgid % NXCD, off = wgid / NXCD; wgid = (xcd < r ? xcd * (q + 1) : r * (q + 1) + (xcd - r) * q) + off; }
        const int nig = WGM * nN, gid = wgid / nig, fm = gid * WGM, gsz = (nM - fm) < WGM ? (nM - fm) : WGM;
        u.pm = fm + ((wgid % nig) % gsz); if (rev) u.pm = nM - 1 - u.pm; { const int ix = (wgid % nig) / gsz; u.pn = ix < pn_split ? pn_lo + ix : pn_hi + (ix - pn_split); } return true;
    }
};

template <class Epi, int PARTS>
__device__ __forceinline__ void gemm_phase(LAS unsigned char* lds, const Gemm g, const StaticOrder& S, const Epi& E) {
    int tid_ = threadIdx.x; asm volatile("" : "+v"(tid_));
    const int tid = tid_, wid = __builtin_amdgcn_readfirstlane(tid >> 6), lane = tid & 63, wr = wid >> 2, wc = wid & 3, fr = lane & 15, fq = lane >> 4;
    const int K = g.K, nt = K / BK;
    unsigned voffA[2], voffB[2];
#pragma unroll
    for (int i = 0; i < 2; ++i) { int R, C; stage_rc(tid * 16 + i * 8192, R, C);
        const int TR = g.wstride ? g.wstride * (R >> 6) + 8 * (R & 15) + ((R >> 4) & 3) : R;
        voffA[i] = (unsigned)(TR * g.lda + C) * 2u; voffB[i] = (unsigned)(R * g.ldb + C) * 2u; }
    const size_t kstep = (size_t)(BK * 2);
    const size_t hstepA = (size_t)(g.wstride ? 4 : HALF) * g.lda * 2, hstepB = (size_t)HALF * g.ldb * 2;
    const unsigned ldsw = (unsigned)wid * 1024u;
    const int aoff = lds_byte(wr * 64 + fr, fq * 8), boff = lds_byte(wc * 32 + fr, fq * 8);
#define PG8_SA(b, h) (((b) * 2 + (h)) * HTB)
#define PG8_SB(b, h) ((4 + (b) * 2 + (h)) * HTB)
#define PG8_STAGE(bufoff, gbase, voff) do { _Pragma("unroll") for (int _i = 0; _i < 2; ++_i) \
        __builtin_amdgcn_global_load_lds((const unsigned*)((const char*)(gbase) + (voff)[_i]), (LAS unsigned*)(lds + (bufoff) + ldsw + _i * 8192), 16, 0, 0); } while (0)
#define PG8_STAGEA(bufoff, gbase, voff) do { _Pragma("unroll") for (int _i = 0; _i < 2; ++_i) \
        __builtin_amdgcn_global_load_lds((const unsigned*)((const char*)(gbase) + (voff)[_i]), (LAS unsigned*)(lds + (bufoff) + ldsw + _i * 8192), 16, 0, 0); } while (0)
#define PG8_LDA(dst, b, h) do { _Pragma("unroll") for (int m = 0; m < 4; ++m) _Pragma("unroll") for (int k = 0; k < 2; ++k) dst[m][k] = *(const LAS bf16x8*)(lds + PG8_SA(b, h) + aoff + m * 2048 + k * 1024); } while (0)
#define PG8_LDB(dst, b, h) do { _Pragma("unroll") for (int n = 0; n < 2; ++n) _Pragma("unroll") for (int k = 0; k < 2; ++k) dst[n][k] = *(const LAS bf16x8*)(lds + PG8_SB(b, h) + boff + n * 2048 + k * 1024); } while (0)
#define PG8_MMA(ai, bj, At, Bt) do { __builtin_amdgcn_s_setprio(1); _Pragma("unroll") for (int m = 0; m < 4; ++m) _Pragma("unroll") for (int n = 0; n < 2; ++n) _Pragma("unroll") for (int k = 0; k < 2; ++k) \
        acc[ai][bj][m][n] = __builtin_amdgcn_mfma_f32_16x16x32_bf16(Bt[n][k], At[m][k], acc[ai][bj][m][n], 0, 0, 0); __builtin_amdgcn_s_setprio(0); } while (0)
#define PG8_WAIT_V(n) asm volatile("s_waitcnt vmcnt(" #n ")" ::: "memory")
#define PG8_WAIT_L(n) asm volatile("s_waitcnt lgkmcnt(" #n ")" ::: "memory")
#define PG8_BAR __builtin_amdgcn_s_barrier()
#define PG8_SCHED __builtin_amdgcn_sched_barrier(0)
#define PG8_UA(u) ((const char*)g.A + (size_t)(u).part * g.partA + ((long)(u).pm * g.tstride + g.shift) * (long)g.lda * 2)
#define PG8_UB(u) ((const char*)g.Bt + (size_t)(u).part * g.partB + (size_t)(u).pn * 256 * g.ldb * 2)
    Unit cur, nxt; int ui = 0;
    if (!S.next(0, cur)) return;
    f32x4 acc[2][2][4][2];
#pragma unroll
    for (int a = 0; a < 2; ++a)
#pragma unroll
        for (int b = 0; b < 2; ++b)
#pragma unroll
            for (int m = 0; m < 4; ++m)
#pragma unroll
                for (int n = 0; n < 2; ++n) acc[a][b][m][n] = (f32x4){0.f, 0.f, 0.f, 0.f};
    bf16x8 At[4][2], B0[2][2], B1[2][2];
    const char* cA = PG8_UA(cur); const char* cB = PG8_UB(cur);
    PG8_STAGE(PG8_SB(0, 0), cB, voffB); PG8_STAGE(PG8_SB(0, 1), cB + hstepB, voffB); PG8_STAGEA(PG8_SA(0, 0), cA, voffA); PG8_STAGEA(PG8_SA(0, 1), cA + hstepA, voffA);
    if (wr == 1) PG8_BAR;
    PG8_WAIT_V(2); PG8_BAR;
    PG8_STAGE(PG8_SB(1, 0), cB + kstep, voffB); PG8_STAGEA(PG8_SA(1, 0), cA + kstep, voffA); PG8_STAGE(PG8_SB(1, 1), cB + hstepB + kstep, voffB);
    PG8_WAIT_V(6); PG8_BAR;
    for (;;) {
        const bool has_next = S.next(ui + 1, nxt);
        const char* nA = has_next ? PG8_UA(nxt) : cA; const char* nB = has_next ? PG8_UB(nxt) : cB;
        for (int t = 0; t < nt; t += 2) {
            const bool last = (t == nt - 2);
            const char* a1 = cA + (size_t)(t + 1) * kstep;
            const char* a2 = last ? nA : cA + (size_t)(t + 2) * kstep; const char* b2 = last ? nB : cB + (size_t)(t + 2) * kstep;
            const char* a3 = a2 + kstep; const char* b3 = b2 + kstep;
            PG8_LDB(B0, 0, 0); PG8_LDB(B1, 0, 1); PG8_SCHED; PG8_LDA(At, 0, 0); PG8_STAGEA(PG8_SA(1, 1), a1 + hstepA, voffA);
            PG8_WAIT_V(8); PG8_WAIT_L(0); PG8_BAR; PG8_MMA(0, 0, At, B0); PG8_MMA(0, 1, At, B1); PG8_BAR; PG8_SCHED;
            PG8_LDA(At, 0, 1); PG8_STAGE(PG8_SB(0, 0), b2, voffB); PG8_STAGE(PG8_SB(0, 1), b2 + hstepB, voffB); PG8_STAGEA(PG8_SA(0, 0), a2, voffA);
            PG8_WAIT_V(8); PG8_WAIT_L(0); PG8_BAR; PG8_MMA(1, 0, At, B0); PG8_MMA(1, 1, At, B1); PG8_BAR; PG8_SCHED;
            PG8_LDB(B0, 1, 0); PG8_LDB(B1, 1, 1); PG8_SCHED; PG8_LDA(At, 1, 0); PG8_STAGEA(PG8_SA(0, 1), a2 + hstepA, voffA);
            PG8_WAIT_V(8); PG8_WAIT_L(0); PG8_BAR; PG8_MMA(0, 0, At, B0); PG8_MMA(0, 1, At, B1); PG8_BAR; PG8_SCHED;
            PG8_LDA(At, 1, 1); PG8_STAGE(PG8_SB(1, 0), b3, voffB); PG8_STAGE(PG8_SB(1, 1), b3 + hstepB, voffB); PG8_STAGEA(PG8_SA(1, 0), a3, voffA);
            PG8_WAIT_V(8); PG8_WAIT_L(0); PG8_BAR; PG8_MMA(1, 0, At, B0); PG8_MMA(1, 1, At, B1); PG8_BAR; PG8_SCHED;
        }
        if (wr == 0) PG8_BAR;
        E(acc, cur, wr, wc, fr, fq);
        if (!has_next) break;
        if (PARTS == 1 || nxt.part == 0) {
#pragma unroll
        for (int a = 0; a < 2; ++a)
#pragma unroll
            for (int b = 0; b < 2; ++b)
#pragma unroll
                for (int m = 0; m < 4; ++m)
#pragma unroll
                    for (int n = 0; n < 2; ++n) acc[a][b][m][n] = (f32x4){0.f, 0.f, 0.f, 0.f};
        }
        cur = nxt; cA = nA; cB = nB; ++ui;
        if (wr == 1) PG8_BAR;
    }
    PG8_WAIT_V(0);
    PG8_BAR;
#undef PG8_SA
#undef PG8_SB
#undef PG8_STAGE
#undef PG8_STAGEA
#undef PG8_LDA
#undef PG8_LDB
#undef PG8_MMA
#undef PG8_WAIT_V
#undef PG8_WAIT_L
#undef PG8_BAR
#undef PG8_SCHED
#undef PG8_UA
#undef PG8_UB
}

__device__ __forceinline__ void load_rs8(const float* ss, int t0, int fq, float (&rs)[8], int tmax) {
#pragma unroll
    for (int j = 0; j < 8; ++j) { int t = t0 + j; t = t < 0 ? 0 : (t > tmax ? tmax : t);
        const f32x4 p = *(const f32x4*)(ss + (size_t)t * 16 + 4 * fq); float s = (p.x + p.y) + (p.z + p.w);
        s += __shfl_xor(s, 16); s += __shfl_xor(s, 32); rs[j] = __builtin_amdgcn_rsqf(s * (1.0f / DMOD) + EPS); }
}

struct EpiQKV {
    const float* ss; const float* qg; const float* kg; const float* rope;
    bf16_t* QU; bf16_t* Kb; bf16_t* Vb;
    __device__ __forceinline__ void operator()(f32x4 (&acc)[2][2][4][2], const Unit& u, int wr, int wc, int fr, int fq) const {
        const int t0 = u.pm * 256 + wr * 128 + fr * 8;
        { float rs[8]; load_rs8(ss, t0, fq, rs, M_TOK - 1);
#pragma unroll
          for (int ai = 0; ai < 2; ++ai)
#pragma unroll
            for (int m = 0; m < 4; ++m)
#pragma unroll
                for (int bj = 0; bj < 2; ++bj)
#pragma unroll
                    for (int n = 0; n < 2; ++n) acc[ai][bj][m][n] = acc[ai][bj][m][n] * rs[4 * ai + m]; }
        const int pn = u.pn;
        {
            const bool isq = pn < 2;
            if (isq || wc < 2) {
                const float* gp = isq ? qg : kg; const float osc = isq ? C2 : 1.0f;
                f32x4 gv[2][2];
#pragma unroll
                for (int bj = 0; bj < 2; ++bj)
#pragma unroll
                    for (int n = 0; n < 2; ++n) gv[bj][n] = *(const f32x4*)(gp + 32 * bj + 16 * n + 4 * fq);
                const int smask = (t0 < NPROMPT) ? (SEQ_P - 1) : (SEQ_S - 1);
                const int prow = (t0 & smask) >> 6;
                const f32x4 rr0 = *(const f32x4*)(rope + (prow * 16 + 4 * fq) * 2), rr1 = *(const f32x4*)(rope + (prow * 16 + 4 * fq) * 2 + 4);
                bf16_t* dst = isq ? (QU + (size_t)t0 * 1024 + (4 * pn + wc) * 64) : (Kb + (size_t)t0 * 128 + wc * 64);
                const int pitch = isq ? 1024 : 128;
#pragma unroll
                for (int ai = 0; ai < 2; ++ai)
#pragma unroll
                    for (int m = 0; m < 4; ++m) {
                        const int j = 4 * ai + m;
                        float sq = 0.f;
#pragma unroll
                        for (int bj = 0; bj < 2; ++bj)
#pragma unroll
                            for (int n = 0; n < 2; ++n) { const f32x4 v = acc[ai][bj][m][n]; sq += (v.x * v.x + v.y * v.y) + (v.z * v.z + v.w * v.w); }
                        sq += __shfl_xor(sq, 16); sq += __shfl_xor(sq, 32);
                        const float rn = __builtin_amdgcn_rsqf(sq * (1.0f / 64.0f) + EPS) * osc;
                        const int pcol = (t0 + j) & 63;
                        const f32x4 cc0 = *(const f32x4*)(rope + (pcol * 16 + 4 * fq) * 2), cc1 = *(const f32x4*)(rope + (pcol * 16 + 4 * fq) * 2 + 4);
#pragma unroll
                        for (int bj = 0; bj < 2; ++bj) {
                            const f32x4 t0v = bj == 0 ? rr0 : cc0, t1v = bj == 0 ? rr1 : cc1;
                            const f32x4 x1 = acc[ai][bj][m][0] * gv[bj][0] * rn, x2 = acc[ai][bj][m][1] * gv[bj][1] * rn;
                            const f32x4 cs = (f32x4){t0v.x, t0v.z, t1v.x, t1v.z}, sn = (f32x4){t0v.y, t0v.w, t1v.y, t1v.w};
                            const f32x4 o1 = x1 * cs - x2 * sn, o2 = x1 * sn + x2 * cs;
                            u32x2 w1, w2; w1.x = cvt_pk_bf16(o1.x, o1.y); w1.y = cvt_pk_bf16(o1.z, o1.w); w2.x = cvt_pk_bf16(o2.x, o2.y); w2.y = cvt_pk_bf16(o2.z, o2.w);
                            bf16_t* p = dst + (size_t)j * pitch + 32 * bj + 4 * fq;
                            *(u32x2*)p = w1; *(u32x2*)(p + 16) = w2;
                        }
                    }
            } else {
                bf16_t* dst = Vb + (size_t)t0 * 128 + (wc - 2) * 64;
#pragma unroll
                for (int ai = 0; ai < 2; ++ai)
#pragma unroll
                    for (int m = 0; m < 4; ++m)
#pragma unroll
                        for (int bj = 0; bj < 2; ++bj)
#pragma unroll
                            for (int n = 0; n < 2; ++n) { const f32x4 v = acc[ai][bj][m][n]; u32x2 w; w.x = cvt_pk_bf16(v.x, v.y); w.y = cvt_pk_bf16(v.z, v.w);
                                *(u32x2*)(dst + (size_t)(4 * ai + m) * 128 + 32 * bj + 16 * n + 4 * fq) = w; }
            }
        }
    }
};
struct EpiVS {
    const float* ss; bf16_t* VST; float* ssg;
    __device__ __forceinline__ void operator()(f32x4 (&acc)[2][2][4][2], const Unit& u, int wr, int wc, int fr, int fq) const {
        const int t0 = u.pm * 256 + wr * 128 + fr * 8;
        { float rs[8]; load_rs8(ss, t0, fq, rs, M_TOK - 1);
#pragma unroll
          for (int ai = 0; ai < 2; ++ai)
#pragma unroll
            for (int m = 0; m < 4; ++m)
#pragma unroll
                for (int bj = 0; bj < 2; ++bj)
#pragma unroll
                    for (int n = 0; n < 2; ++n) acc[ai][bj][m][n] = acc[ai][bj][m][n] * rs[4 * ai + m]; }
        const int pn = u.pn;
        {
            const int chunk = 2 * u.pm + wr;
            bf16_t* dst = VST + ((size_t)chunk * 512 + 256 * (pn - 5) + 32 * wc + 8 * fq) * 128 + 8 * fr;
#pragma unroll
            for (int ai = 0; ai < 2; ++ai)
#pragma unroll
                for (int m = 0; m < 4; ++m) {
                    float sq = 0.f;
#pragma unroll
                    for (int bj = 0; bj < 2; ++bj)
#pragma unroll
                        for (int n = 0; n < 2; ++n) { f32x4 v = acc[ai][bj][m][n]; v = (f32x4){gelu_t(v.x), gelu_t(v.y), gelu_t(v.z), gelu_t(v.w)}; acc[ai][bj][m][n] = v;
                            sq += (v.x * v.x + v.y * v.y) + (v.z * v.z + v.w * v.w); }
                    sq += __shfl_xor(sq, 16); sq += __shfl_xor(sq, 32);
                    if (fq == 0) ssg[(size_t)(t0 + 4 * ai + m) * 8 + 4 * (pn - 5) + wc] = sq;
                    asm volatile("" : "+v"(acc[ai][0][m][0]), "+v"(acc[ai][0][m][1]), "+v"(acc[ai][1][m][0]), "+v"(acc[ai][1][m][1]));
                }
#pragma unroll
            for (int bj = 0; bj < 2; ++bj)
#pragma unroll
                for (int n = 0; n < 2; ++n)
#pragma unroll
                    for (int i = 0; i < 4; ++i) {
                        u32x4 w; w.x = cvt_pk_bf16(acc[0][bj][0][n][i], acc[0][bj][1][n][i]); w.y = cvt_pk_bf16(acc[0][bj][2][n][i], acc[0][bj][3][n][i]);
                        w.z = cvt_pk_bf16(acc[1][bj][0][n][i], acc[1][bj][1][n][i]); w.w = cvt_pk_bf16(acc[1][bj][2][n][i], acc[1][bj][3][n][i]);
                        *(u32x4*)(dst + (size_t)(128 * bj + 4 * n + i) * 128) = w;
                    }
        }
    }
};
struct EpiEW {
    const float* ss; bf16_t* QU; bf16_t* GA; bf16_t* GB;
    __device__ __forceinline__ void operator()(f32x4 (&acc)[2][2][4][2], const Unit& u, int wr, int wc, int fr, int fq) const {
        const int t0 = u.pm * 256 + wr * 128 + fr * 8;
        float rs[8]; load_rs8(ss, t0, fq, rs, M_TOK - 1);
        const int pn = u.pn;
        const bool isu = pn < 5;
        bf16_t* dst = QU + 512 + 256 * (pn - 3) + (size_t)t0 * 1024 + 32 * wc + 8 * fq;
        if (isu) {
#pragma unroll
            for (int ai = 0; ai < 2; ++ai)
#pragma unroll
                for (int m = 0; m < 4; ++m)
#pragma unroll
                    for (int bj = 0; bj < 2; ++bj) { const f32x4 a = acc[ai][bj][m][0] * rs[4 * ai + m], b = acc[ai][bj][m][1] * rs[4 * ai + m]; u32x4 w;
                        w.x = cvt_pk_bf16(gelu_t(a.x), gelu_t(a.y)); w.y = cvt_pk_bf16(gelu_t(a.z), gelu_t(a.w)); w.z = cvt_pk_bf16(gelu_t(b.x), gelu_t(b.y)); w.w = cvt_pk_bf16(gelu_t(b.z), gelu_t(b.w));
                        *(u32x4*)(dst + (size_t)(4 * ai + m) * 1024 + 128 * bj) = w; }
        } else {
            bf16_t* da = GA + (size_t)t0 * 1024 + 128 * (pn - 7) + 32 * wc + 8 * fq; bf16_t* db = GB + (size_t)t0 * 1024 + 128 * (pn - 7) + 32 * wc + 8 * fq;
#pragma unroll
            for (int ai = 0; ai < 2; ++ai)
#pragma unroll
                for (int m = 0; m < 4; ++m) { const float k2 = rs[4 * ai + m] * -1.4426950409f; u32x4 wa, wb; float sa[8], rt[8];
#pragma unroll
                    for (int n = 0; n < 2; ++n)
#pragma unroll
                        for (int i = 0; i < 4; ++i) { const float ea = 1.0f + __builtin_amdgcn_exp2f(acc[ai][0][m][n][i] * k2), eb = 1.0f + __builtin_amdgcn_exp2f(acc[ai][1][m][n][i] * k2);
                            sa[4 * n + i] = __builtin_amdgcn_rcpf(ea); rt[4 * n + i] = ea * __builtin_amdgcn_rcpf(eb); }
                    wa.x = cvt_pk_bf16(sa[0], sa[1]); wa.y = cvt_pk_bf16(sa[2], sa[3]); wa.z = cvt_pk_bf16(sa[4], sa[5]); wa.w = cvt_pk_bf16(sa[6], sa[7]);
                    wb.x = cvt_pk_bf16(rt[0], rt[1]); wb.y = cvt_pk_bf16(rt[2], rt[3]); wb.z = cvt_pk_bf16(rt[4], rt[5]); wb.w = cvt_pk_bf16(rt[6], rt[7]);
                    *(u32x4*)(da + (size_t)(4 * ai + m) * 1024) = wa; *(u32x4*)(db + (size_t)(4 * ai + m) * 1024) = wb; }
        }
    }
};

struct EpiMerge {
    bf16_t* GA; const bf16_t* GB;
    __device__ __forceinline__ void operator()(f32x4 (&acc)[2][2][4][2], const Unit& u, int wr, int wc, int fr, int fq) const {
        const int t0 = u.pm * 256 + wr * 64 + fr;
        const size_t off0 = (size_t)t0 * 1024 + 256 * u.pn + 32 * wc + 8 * fq;
        const bf16_t* src = (u.part == 0) ? GB : (const bf16_t*)GA;
#pragma unroll
        for (int ai = 0; ai < 2; ++ai)
#pragma unroll
            for (int m = 0; m < 4; ++m)
#pragma unroll
                for (int bj = 0; bj < 2; ++bj) {
                    const size_t off = off0 + (size_t)(128 * ai + 16 * m) * 1024 + 128 * bj;
                    const u32x4 g = *(const u32x4*)(src + off);
                    const f32x4 s0 = (f32x4){bf_lo(g.x), bf_hi(g.x), bf_lo(g.y), bf_hi(g.y)}, s1 = (f32x4){bf_lo(g.z), bf_hi(g.z), bf_lo(g.w), bf_hi(g.w)};
                    const f32x4 v0 = acc[ai][bj][m][0] * s0, v1 = acc[ai][bj][m][1] * s1;
                    if (u.part == 0) { acc[ai][bj][m][0] = v0; acc[ai][bj][m][1] = v1; }
                    else { u32x4 w; w.x = cvt_pk_bf16(v0.x, v0.y); w.y = cvt_pk_bf16(v0.z, v0.w); w.z = cvt_pk_bf16(v1.x, v1.y); w.w = cvt_pk_bf16(v1.z, v1.w);
                        *(u32x4*)(GA + off) = w; }
                }
    }
};

struct EpiRes {
    const float* xp; const float* xs; int first; float* out; bf16_t* xb; float* ss; int bb; int wout;
    __device__ __forceinline__ void operator()(f32x4 (&acc)[2][2][4][2], const Unit& u, int wr, int wc, int fr, int fq) const {
        const int t0 = u.pm * 256 + wr * 64 + fr;
        const int col0 = 256 * u.pn + 32 * wc + 8 * fq;
        const float* bp0 = first ? ((t0 < NPROMPT) ? xp + (size_t)t0 * 1024 : xs + (size_t)(t0 - NPROMPT) * 1024) : out + (size_t)t0 * 1024;
#pragma unroll
        for (int ai = 0; ai < 2; ++ai)
#pragma unroll
            for (int m = 0; m < 4; ++m) {
                const int j = 128 * ai + 16 * m; float sq = 0.f;
#pragma unroll
                for (int bj = 0; bj < 2; ++bj) {
                    const size_t o = (size_t)j * 1024 + col0 + 128 * bj;
                    f32x4 a, b;
                    if (bb) { const u32x4 w = *(const u32x4*)(xb + (size_t)t0 * 1024 + o);
                        a = (f32x4){bf_lo(w.x), bf_hi(w.x), bf_lo(w.y), bf_hi(w.y)}; b = (f32x4){bf_lo(w.z), bf_hi(w.z), bf_lo(w.w), bf_hi(w.w)}; }
                    else { a = *(const f32x4*)(bp0 + o); b = *(const f32x4*)(bp0 + o + 4); }
                    a = a + acc[ai][bj][m][0]; b = b + acc[ai][bj][m][1];
                    if (wout) { float* op = out + (size_t)t0 * 1024 + o; *(f32x4*)op = a; *(f32x4*)(op + 4) = b; }
                    u32x4 w; w.x = cvt_pk_bf16(a.x, a.y); w.y = cvt_pk_bf16(a.z, a.w); w.z = cvt_pk_bf16(b.x, b.y); w.w = cvt_pk_bf16(b.z, b.w);
                    *(u32x4*)(xb + (size_t)t0 * 1024 + o) = w;
                    sq += (a.x * a.x + a.y * a.y) + (a.z * a.z + a.w * a.w) + (b.x * b.x + b.y * b.y) + (b.z * b.z + b.w * b.w);
                }
                sq += __shfl_xor(sq, 16); sq += __shfl_xor(sq, 32);
                if (fq == 0) ss[(size_t)(t0 + j) * 16 + 4 * u.pn + wc] = sq;
            }
    }
};

struct EpiUp {
    const float* ss; const float* cw; const float* cb; bf16_t* H2;
    __device__ __forceinline__ void operator()(f32x4 (&acc)[2][2][4][2], const Unit& u, int wr, int wc, int fr, int fq) const {
        const int t0 = u.pm * 252 - 1 + wr * 126 + fr * 8;
        { float rs[8]; load_rs8(ss, t0, fq, rs, M_TOK - 1);
#pragma unroll
          for (int ai = 0; ai < 2; ++ai)
#pragma unroll
            for (int m = 0; m < 4; ++m)
#pragma unroll
                for (int bj = 0; bj < 2; ++bj)
#pragma unroll
                    for (int n = 0; n < 2; ++n) acc[ai][bj][m][n] = acc[ai][bj][m][n] * rs[4 * ai + m]; }
        unsigned vmask = 0, smask = 0, emask = 0;
#pragma unroll
        for (int j = 0; j < 8; ++j) { const int t = t0 + j, loc = fr * 8 + j;
            if (loc >= 1 && loc <= 126 && t < M_TOK) vmask |= 1u << j;
            const int sm = (t < NPROMPT) ? (SEQ_P - 1) : (SEQ_S - 1);
            if ((t & sm) == 0) smask |= 1u << j;
            if ((t & sm) == sm) emask |= 1u << j; }
#pragma unroll
        for (int n = 0; n < 2; ++n) {
            const int cg_ = 128 * u.pn + 32 * wc + 8 * fq + 4 * n;
            const f32x4 w0g = *(const f32x4*)(cw + cg_), w1g = *(const f32x4*)(cw + 4096 + cg_), w2g = *(const f32x4*)(cw + 8192 + cg_), bg = *(const f32x4*)(cb + cg_);
            const f32x4 w0v = *(const f32x4*)(cw + 2048 + cg_), w1v = *(const f32x4*)(cw + 4096 + 2048 + cg_), w2v = *(const f32x4*)(cw + 8192 + 2048 + cg_), bv = *(const f32x4*)(cb + 2048 + cg_);
            float h[8][4];
#pragma unroll
            for (int i = 0; i < 4; ++i) {
                float ag[8], av[8];
#pragma unroll
                for (int j = 0; j < 8; ++j) { ag[j] = acc[j >> 2][0][j & 3][n][i]; av[j] = acc[j >> 2][1][j & 3][n][i]; }
                const float lg = dpp_shr1(ag[7]), rg = dpp_shl1(ag[0]), lv = dpp_shr1(av[7]), rv = dpp_shl1(av[0]);
#pragma unroll
                for (int j = 0; j < 8; ++j) {
                    float Lg = j == 0 ? lg : ag[j == 0 ? 0 : j - 1], Rg = j == 7 ? rg : ag[j == 7 ? 7 : j + 1];
                    float Lv = j == 0 ? lv : av[j == 0 ? 0 : j - 1], Rv = j == 7 ? rv : av[j == 7 ? 7 : j + 1];
                    if ((smask >> j) & 1u) { Lg = 0.f; Lv = 0.f; }
                    if ((emask >> j) & 1u) { Rg = 0.f; Rv = 0.f; }
                    const float cgv = w0g[i] * Lg + w1g[i] * ag[j] + w2g[i] * Rg + bg[i];
                    const float cvv = w0v[i] * Lv + w1v[i] * av[j] + w2v[i] * Rv + bv[i];
                    h[j][i] = gelu_t(cgv) * cvv;
                }
            }
#pragma unroll
            for (int j = 0; j < 8; ++j) if ((vmask >> j) & 1u) { u32x2 w; w.x = cvt_pk_bf16(h[j][0], h[j][1]); w.y = cvt_pk_bf16(h[j][2], h[j][3]);
                *(u32x2*)(H2 + (size_t)(t0 + j) * 2048 + cg_) = w; }
        }
    }
};
}

namespace attn_body {
using bf16=__hip_bfloat16;
using bf16x8=__attribute__((ext_vector_type(8)))short;
using s16x4=__attribute__((ext_vector_type(4)))short;
using f32x16=__attribute__((ext_vector_type(16)))float;
using u32x4=__attribute__((ext_vector_type(4)))unsigned;
constexpr int D=64,QP=1024,KP=128;
constexpr int NW=8,QBLK=32,QB=QBLK*NW,KVBLK=64;
__device__ __forceinline__ int crow(int r,int hi){return (r&3)+8*(r>>2)+4*hi;}
#define SBAR() __builtin_amdgcn_sched_barrier(0)
constexpr int NSLOT=3, SLOTB=8192;
constexpr int LDS_K=0, LDS_V=NSLOT*SLOTB, LDS_WS=2*NSLOT*SLOTB, LDS_OST=LDS_WS+NW*64*4, LDS_BYTES=LDS_OST+NW*4096;
__device__ __forceinline__ void glds16(const void*gsrc,unsigned lds_dst){unsigned keep;
  asm volatile("s_mov_b32 %0, m0\n\ts_mov_b32 m0, %2\n\ts_nop 0\n\tglobal_load_lds_dwordx4 %1, off\n\ts_mov_b32 m0, %0":"=&s"(keep):"v"(gsrc),"s"(lds_dst):"memory");}
__device__ __forceinline__ float max3f(float a,float b,float c){float r;asm("v_max3_f32 %0, %1, %2, %3":"=v"(r):"v"(a),"v"(b),"v"(c));return r;}
__device__ __forceinline__ float max2f(float a,float b){float r;asm("v_max_f32_e32 %0, %1, %2":"=v"(r):"v"(a),"v"(b));return r;}
__device__ __forceinline__ float fadd_s(float a,float b){float r;asm("v_add_f32_e32 %0, %1, %2":"=v"(r):"v"(a),"v"(b));return r;}
__device__ __forceinline__ float fsub_s(float a,float b){float r;asm("v_sub_f32_e32 %0, %1, %2":"=v"(r):"v"(a),"v"(b));return r;}
typedef float f32x2_t __attribute__((ext_vector_type(2))); typedef __bf16 bf16x2_t __attribute__((ext_vector_type(2)));
__device__ __forceinline__ unsigned cvtpk_s(float lo,float hi){f32x2_t v={lo,hi};bf16x2_t b=__builtin_convertvector(v,bf16x2_t);return __builtin_bit_cast(unsigned,b);}
#define WAIT_BAR(N) asm volatile("s_waitcnt vmcnt(" #N ") lgkmcnt(0)\n\ts_barrier":::"memory")
__device__ __forceinline__ void qkt(f32x16&p0,f32x16&p1,const char*Kslot,const bf16x8*qr,const f32x16&negm,int r32,int hi){
  const char*kb=Kslot+hi*1024+r32*16;
  #pragma unroll
  for(int d0=0;d0<4;++d0){
    const bf16x8 b0=*reinterpret_cast<const bf16x8*>(kb+d0*2048);
    const bf16x8 b1=*reinterpret_cast<const bf16x8*>(kb+d0*2048+512);
    if(d0==0){p0=__builtin_amdgcn_mfma_f32_32x32x16_bf16(b0,qr[0],negm,0,0,0);p1=__builtin_amdgcn_mfma_f32_32x32x16_bf16(b1,qr[0],negm,0,0,0);}
    else{p0=__builtin_amdgcn_mfma_f32_32x32x16_bf16(b0,qr[d0],p0,0,0,0);p1=__builtin_amdgcn_mfma_f32_32x32x16_bf16(b1,qr[d0],p1,0,0,0);}}
}
typedef __attribute__((address_space(3))) const char* lds_cptr;
typedef short v4i16_t __attribute__((ext_vector_type(4)));
__device__ __forceinline__ void kload8(bf16x8*kf,lds_cptr kp){
  kf[0]=*(const __attribute__((address_space(3))) bf16x8*)(kp);      kf[1]=*(const __attribute__((address_space(3))) bf16x8*)(kp+512);
  kf[2]=*(const __attribute__((address_space(3))) bf16x8*)(kp+2048); kf[3]=*(const __attribute__((address_space(3))) bf16x8*)(kp+2560);
  kf[4]=*(const __attribute__((address_space(3))) bf16x8*)(kp+4096); kf[5]=*(const __attribute__((address_space(3))) bf16x8*)(kp+4608);
  kf[6]=*(const __attribute__((address_space(3))) bf16x8*)(kp+6144); kf[7]=*(const __attribute__((address_space(3))) bf16x8*)(kp+6656);
}
__device__ __forceinline__ void kload2(bf16x8*kf,lds_cptr kp,int j){ kf[2*j]=*(const __attribute__((address_space(3))) bf16x8*)(kp+j*2048); kf[2*j+1]=*(const __attribute__((address_space(3))) bf16x8*)(kp+j*2048+512); }
__device__ __forceinline__ s16x4 vtr(lds_cptr p){ return __builtin_bit_cast(s16x4,__builtin_amdgcn_ds_read_tr16_b64_v4i16((__attribute__((address_space(3))) v4i16_t*)p)); }
__device__ __forceinline__ float rowmax(const f32x16&p0,const f32x16&p1){
  float a=max3f(p0[0],p0[1],p1[0]),b=max3f(p0[2],p0[3],p1[1]);a=max3f(a,p1[2],p1[3]);
  #pragma unroll
  for(int r=4;r<16;r+=4){a=max3f(a,p0[r],p0[r+1]);b=max3f(b,p0[r+2],p0[r+3]);a=max3f(a,p1[r],p1[r+1]);b=max3f(b,p1[r+2],p1[r+3]);}
  const float m=max2f(a,b);
  auto rr=__builtin_amdgcn_permlane32_swap(__float_as_uint(m),__float_as_uint(m),false,false);
  return max2f(__uint_as_float(rr[0]),__uint_as_float(rr[1]));
}
__device__ __forceinline__ void pv(f32x16*o,int vb,bf16x8 pa0,bf16x8 pa1,bf16x8 pa2,bf16x8 pa3){
  #pragma unroll
  for(int d0=0;d0<2;++d0){s16x4 lo[4],hi[4];
    #pragma unroll
    for(int ks=0;ks<4;++ks){
      asm volatile("ds_read_b64_tr_b16 %0,%1 offset:%c2":"=&v"(lo[ks]):"v"(vb),"i"(d0*4096+ks*1024):"memory");
      asm volatile("ds_read_b64_tr_b16 %0,%1 offset:%c2":"=&v"(hi[ks]):"v"(vb),"i"(d0*4096+ks*1024+512):"memory");}
    asm volatile("s_waitcnt lgkmcnt(0)":::"memory");SBAR();
    #define PK(k) (bf16x8){lo[k][0],lo[k][1],lo[k][2],lo[k][3],hi[k][0],hi[k][1],hi[k][2],hi[k][3]}
    o[d0]=__builtin_amdgcn_mfma_f32_32x32x16_bf16(pa0,PK(0),o[d0],0,0,0);
    o[d0]=__builtin_amdgcn_mfma_f32_32x32x16_bf16(pa1,PK(1),o[d0],0,0,0);
    o[d0]=__builtin_amdgcn_mfma_f32_32x32x16_bf16(pa2,PK(2),o[d0],0,0,0);
    o[d0]=__builtin_amdgcn_mfma_f32_32x32x16_bf16(pa3,PK(3),o[d0],0,0,0);
    #undef PK
  }
}
template<int THRL> __device__ __forceinline__ void attn_unit(long rowbase,int seq,int h,int q0,const bf16*Q,const bf16*__restrict__ K,const bf16*__restrict__ V,bf16*O,char*shm){
  int tid_=threadIdx.x; asm volatile("":"+v"(tid_));
  const int tid=tid_,lane=tid&63,r32=lane&31,hi=lane>>5; const int wid=__builtin_amdgcn_readfirstlane(tid>>6);
  const bf16*Qw=Q+(rowbase+q0+wid*QBLK)*QP+h*D;
  const bf16*Kh=K+rowbase*KP+(h>>2)*D,*Vh=V+rowbase*KP+(h>>2)*D;
  const unsigned lds0=(unsigned)(uintptr_t)shm;
  float*wsf=(float*)(shm+LDS_WS)+wid*64;
  const bf16*ksrc=Kh+(long)lane*KP+wid*8;
  const bf16*vsrc=Vh+(long)(16*(wid&3)+(lane>>2))*KP+(wid>>2)*32+(lane&3)*8;
  const unsigned kdst=lds0+LDS_K+wid*1024, vdst=lds0+LDS_V+wid*1024;
  #define DMA_K(t,slot) glds16(ksrc+(long)(t)*KVBLK*KP,(unsigned)__builtin_amdgcn_readfirstlane(kdst+(slot)))
  #define DMA_V(t,slot) glds16(vsrc+(long)(t)*KVBLK*KP,(unsigned)__builtin_amdgcn_readfirstlane(vdst+(slot)))
  const int vb0=(int)(lds0+LDS_V)+((lane>>4)&1)*32+(lane&3)*8+(4*hi+((lane&15)>>2))*64;
  const char*Kbase=shm+LDS_K; bf16x8 kf[8];
  const lds_cptr shm3=(lds_cptr)shm; const lds_cptr kp0=shm3+LDS_K+hi*1024+r32*16; const lds_cptr vp0=shm3+LDS_V+((lane>>4)&1)*32+(lane&3)*8+(4*hi+((lane&15)>>2))*64;
  const int NT=seq/KVBLK;
  DMA_K(0,0);DMA_V(0,0);DMA_K(1,SLOTB);
  bf16x8 qr[4];
  #pragma unroll
  for(int d0=0;d0<4;++d0)qr[d0]=*reinterpret_cast<const bf16x8*>(&Qw[(long)r32*QP+d0*16+hi*8]);
  float mhat=0.f,l_reg=0.f;f32x16 o[2];o[0]=f32x16{};o[1]=f32x16{};f32x16 negm=f32x16{};asm volatile("":"+v"(negm));
  bool resc=false;
  #define START(P0,P1) do{ const float rm=rowmax(P0,P1); resc=false; \
    { const float dl=rm; mhat=fadd_s(mhat,dl); \
      _Pragma("unroll") for(int r=0;r<16;++r){P0[r]=fsub_s(P0[r],dl);P1[r]=fsub_s(P1[r],dl);} \
      _Pragma("unroll") for(int r=0;r<16;++r)negm[r]=-mhat; asm volatile("":"+v"(negm)); } \
    _Pragma("unroll") for(int r=0;r<16;++r)P0[r]=__builtin_amdgcn_exp2f(P0[r]); }while(0)
  #define RESC() do{ if(resc){ asm volatile("s_waitcnt lgkmcnt(0)":::"memory"); \
      _Pragma("unroll") for(int d_=0;d_<2;++d_) _Pragma("unroll") for(int r=0;r<16;++r)o[d_][r]*=wsf[crow(r,hi)]; } }while(0)
  f32x16 pA0,pA1,pB0,pB1;
  int sl_prev=0,sl_cur=0,sl_next=SLOTB;
  #define ROT() do{sl_prev=sl_cur;sl_cur=sl_next;sl_next=(sl_next==(NSLOT-1)*SLOTB)?0:sl_next+SLOTB;}while(0)
  DMA_K(2,2*SLOTB);
  WAIT_BAR(3);
  qkt(pA0,pA1,Kbase,qr,negm,r32,hi);asm volatile("s_nop 15\n\ts_nop 7":"+v"(pA0),"+v"(pA1));
  START(pA0,pA1);
  _Pragma("unroll") for(int r=0;r<16;++r)pA1[r]=__builtin_amdgcn_exp2f(pA1[r]);
  WAIT_BAR(0);
  DMA_K(3,0);DMA_V(1,SLOTB);
  ROT();
  kload8(kf,kp0+sl_cur);
  WAIT_BAR(2);
  s16x4 vlo[8],vhi[8]; u32x4 pw0,pw1,pw2,pw3;
  #define PKW(P,B) cvtpk_s(P[B],P[B+1])
  #define PAF(k) __builtin_bit_cast(bf16x8,pw##k)
  #define VFR(i) (bf16x8){vlo[i][0],vlo[i][1],vlo[i][2],vlo[i][3],vhi[i][0],vhi[i][1],vhi[i][2],vhi[i][3]}
  #define PIN(x) asm volatile("":"+v"(x))
  #define MX3(a,b,c) __builtin_fmaxf(__builtin_fmaxf((a),(b)),(c))
  #define GAPA(MF,A0,A1,A2,A3,W0,W1,PW) do{ MF; sacc+=A0; sacc+=A1; sacc+=A2; sacc+=A3; PIN(sacc); W0; W1; PIN(PW); SBAR(); }while(0)
  #define EX(v) __builtin_amdgcn_exp2f(v)
  #define GAPB(MF,X,B) do{ MF; X[B]=EX(X[B]); X[B+1]=EX(X[B+1]); X[B+2]=EX(X[B+2]); X[B+3]=EX(X[B+3]); PIN(X); SBAR(); }while(0)
  #define VRD(i) do{ vlo[i]=vtr(vp_+(((i)>>2)*4096+((i)&3)*1024)); vhi[i]=vtr(vp_+(((i)>>2)*4096+((i)&3)*1024+512)); }while(0)
  #define KRD(G,j) do{ if(G){ kload2(kf,kp0+sl_next,j); SBAR(); } }while(0)
  #define STEP(C0,C1,P0,P1,t,GK,GV,GL) do{ SBAR(); \
    const lds_cptr vp_=vp0+sl_prev; \
    VRD(0); SBAR(); float sacc=(P0[0]+P0[1]); \
    GAPA(C0=__builtin_amdgcn_mfma_f32_32x32x16_bf16(kf[0],qr[0],negm,0,0,0), P0[2],P0[3],P0[4],P0[5],     pw0[0]=PKW(P0,0), pw0[1]=PKW(P0,2), pw0); \
    VRD(4); SBAR(); GAPA(C1=__builtin_amdgcn_mfma_f32_32x32x16_bf16(kf[1],qr[0],negm,0,0,0), P0[6],P0[7],P0[8],P0[9],     pw0[2]=PKW(P0,4), pw0[3]=PKW(P0,6), pw0); \
    VRD(1); SBAR(); GAPA(C0=__builtin_amdgcn_mfma_f32_32x32x16_bf16(kf[2],qr[1],C0,0,0,0),   P0[10],P0[11],P0[12],P0[13], pw1[0]=PKW(P0,8), pw1[1]=PKW(P0,10), pw1); \
    VRD(5); SBAR(); GAPA(C1=__builtin_amdgcn_mfma_f32_32x32x16_bf16(kf[3],qr[1],C1,0,0,0),   P0[14],P0[15],P1[0],P1[1],   pw1[2]=PKW(P0,12),pw1[3]=PKW(P0,14), pw1); \
    VRD(2); SBAR(); GAPA(C0=__builtin_amdgcn_mfma_f32_32x32x16_bf16(kf[4],qr[2],C0,0,0,0),   P1[2],P1[3],P1[4],P1[5],     pw2[0]=PKW(P1,0), pw2[1]=PKW(P1,2), pw2); \
    VRD(6); SBAR(); GAPA(C1=__builtin_amdgcn_mfma_f32_32x32x16_bf16(kf[5],qr[2],C1,0,0,0),   P1[6],P1[7],P1[8],P1[9],     pw2[2]=PKW(P1,4), pw2[3]=PKW(P1,6), pw2); \
    VRD(3); SBAR(); GAPA(C0=__builtin_amdgcn_mfma_f32_32x32x16_bf16(kf[6],qr[3],C0,0,0,0),   P1[10],P1[11],P1[12],P1[13], pw3[0]=PKW(P1,8), pw3[1]=PKW(P1,10), pw3); \
    VRD(7); SBAR(); GAPA(C1=__builtin_amdgcn_mfma_f32_32x32x16_bf16(kf[7],qr[3],C1,0,0,0),   P1[14],P1[15],0.f,0.f,       pw3[2]=PKW(P1,12),pw3[3]=PKW(P1,14), pw3); \
    l_reg+=sacc; \
    if(GK){DMA_K((t)+3,sl_cur);} if(GV){DMA_V((t)+1,sl_next);} \
    { float a=MX3(C0[0],C0[1],C1[0]),b=MX3(C0[2],C0[3],C1[1]); a=MX3(a,C1[2],C1[3]); \
      _Pragma("unroll") for(int r=4;r<16;r+=4){a=MX3(a,C0[r],C0[r+1]);b=MX3(b,C0[r+2],C0[r+3]);a=MX3(a,C1[r],C1[r+1]);b=MX3(b,C1[r+2],C1[r+3]);} \
      float rm=__builtin_fmaxf(a,b); { auto rr=__builtin_amdgcn_permlane32_swap(__float_as_uint(rm),__float_as_uint(rm),false,false); rm=__builtin_fmaxf(__uint_as_float(rr[0]),__uint_as_float(rr[1])); } \
      resc=false; \
      if(__builtin_expect(__any(rm>(float)THRL),0)){ const float dl=__builtin_fmaxf(rm,0.f); mhat+=dl; \
        _Pragma("unroll") for(int r=0;r<16;++r){C0[r]-=dl;C1[r]-=dl;} \
        _Pragma("unroll") for(int r=0;r<16;++r)negm[r]=-mhat; asm volatile("":"+v"(negm)); \
        const float f=__builtin_amdgcn_exp2f(-dl); l_reg*=f; if(hi==0)wsf[r32]=f; resc=true; } } \
    SBAR(); \
    GAPB(o[0]=__builtin_amdgcn_mfma_f32_32x32x16_bf16(PAF(0),VFR(0),o[0],0,0,0), C0,0); \
    GAPB(o[1]=__builtin_amdgcn_mfma_f32_32x32x16_bf16(PAF(0),VFR(4),o[1],0,0,0), C0,4); \
    KRD(GL,0); GAPB(o[0]=__builtin_amdgcn_mfma_f32_32x32x16_bf16(PAF(1),VFR(1),o[0],0,0,0), C0,8); \
    KRD(GL,1); GAPB(o[1]=__builtin_amdgcn_mfma_f32_32x32x16_bf16(PAF(1),VFR(5),o[1],0,0,0), C0,12); \
    KRD(GL,2); GAPB(o[0]=__builtin_amdgcn_mfma_f32_32x32x16_bf16(PAF(2),VFR(2),o[0],0,0,0), C1,0); \
    KRD(GL,3); GAPB(o[1]=__builtin_amdgcn_mfma_f32_32x32x16_bf16(PAF(2),VFR(6),o[1],0,0,0), C1,4); \
    GAPB(o[0]=__builtin_amdgcn_mfma_f32_32x32x16_bf16(PAF(3),VFR(3),o[0],0,0,0), C1,8); \
    GAPB(o[1]=__builtin_amdgcn_mfma_f32_32x32x16_bf16(PAF(3),VFR(7),o[1],0,0,0), C1,12); \
    }while(0)
  int t=1;
  for(;t+5<NT;t+=2){
    STEP(pB0,pB1,pA0,pA1,t,true,true,true);     WAIT_BAR(2); RESC(); ROT();
    STEP(pA0,pA1,pB0,pB1,t+1,true,true,true);   WAIT_BAR(2); RESC(); ROT();
  }
  #define ENDW(tt) do{ if((tt)+3<NT){WAIT_BAR(2);} else if((tt)+2<NT){WAIT_BAR(1);} else {WAIT_BAR(0);} }while(0)
  for(;t+1<NT;t+=2){
    STEP(pB0,pB1,pA0,pA1,t,(t+3<NT),(t+1<NT),(t+1<NT));       ENDW(t);   RESC(); ROT();
    STEP(pA0,pA1,pB0,pB1,t+1,(t+4<NT),(t+2<NT),(t+2<NT));     ENDW(t+1); RESC(); ROT();
  }
  STEP(pB0,pB1,pA0,pA1,NT-1,false,false,false); RESC();
  { float sacc=pB0[0]+pB0[1]; _Pragma("unroll") for(int r=2;r<16;++r)sacc+=pB0[r]; _Pragma("unroll") for(int r=0;r<16;++r)sacc+=pB1[r]; l_reg+=sacc;
    pw0=(u32x4){PKW(pB0,0),PKW(pB0,2),PKW(pB0,4),PKW(pB0,6)};pw1=(u32x4){PKW(pB0,8),PKW(pB0,10),PKW(pB0,12),PKW(pB0,14)};pw2=(u32x4){PKW(pB1,0),PKW(pB1,2),PKW(pB1,4),PKW(pB1,6)};pw3=(u32x4){PKW(pB1,8),PKW(pB1,10),PKW(pB1,12),PKW(pB1,14)};
    SBAR(); pv(o,vb0+sl_cur,PAF(0),PAF(1),PAF(2),PAF(3)); }
  #undef PKW
  #undef PAF
  #undef VFR
  #undef PIN
  #undef MX3
  #undef GAPA
  #undef GAPB
  #undef EX
  #undef VRD
  #undef KRD
  #undef STEP
  #undef ENDW
  {auto rr=__builtin_amdgcn_permlane32_swap(__float_as_uint(l_reg),__float_as_uint(l_reg),false,false);l_reg=__uint_as_float(rr[0])+__uint_as_float(rr[1]);}
  if(hi==0)wsf[32+r32]=l_reg;asm volatile("s_waitcnt lgkmcnt(0)":::"memory");
  float rli[16];
  #pragma unroll
  for(int r=0;r<16;++r)rli[r]=__builtin_amdgcn_rcpf(wsf[32+crow(r,hi)]);
  bf16*Ow=O+(rowbase+q0+wid*QBLK)*QP+h*D;
  { bf16*stg=(bf16*)(shm+LDS_OST)+wid*2048;
    #pragma unroll
    for(int r=0;r<16;++r){const int orow=crow(r,hi);
      #pragma unroll
      for(int d0=0;d0<2;++d0)stg[orow*64+d0*32+r32]=__float2bfloat16(o[d0][r]*rli[r]);}
    asm volatile("s_waitcnt lgkmcnt(0)":::"memory");
    #pragma unroll
    for(int i=0;i<4;++i){const int row=i*8+(lane>>3),ch=lane&7; const u32x4 v=*(const u32x4*)(stg+row*64+ch*8); *(u32x4*)(Ow+(long)row*QP+ch*8)=v;} }
  asm volatile("s_waitcnt lgkmcnt(0)\n\ts_barrier":::"memory");
  #undef DMA_K
  #undef DMA_V
  #undef START
  #undef RESC
  #undef ROT
}
constexpr int ATTN_LDS_BYTES=LDS_BYTES;
#undef SBAR
#undef WAIT_BAR
}

#define GRID_SYNC() do { asm volatile("s_waitcnt vmcnt(0) lgkmcnt(0)" ::: "memory"); grid.sync(); __builtin_amdgcn_fence(__ATOMIC_ACQUIRE, "agent"); asm volatile("s_waitcnt vmcnt(0)" ::: "memory"); } while (0)
#ifndef N_LAUNCH_MODE
#define N_LAUNCH_MODE 0
#endif
constexpr int N_PHASES = 2 + 6 * NLAYER;
constexpr int NWAVES = 8;
constexpr size_t MiB = 1u << 20;
constexpr size_t WL_IN = 0, WL_A = WL_IN + (size_t)INW * 1024, WL_B = WL_A + 1024 * 512, WL_MIX = WL_B + 1024 * 512, WL_UP = WL_MIX + 1024 * 1024,
                 WL_DOWN = WL_UP + 4096 * 1024, WL_SG = WL_DOWN + 1024 * 2048, WL_SIZE = WL_SG + 8 * 128 * 128;
static_assert(WL_SIZE * 2 * NLAYER <= 95 * MiB, "weights region");
constexpr size_t WS_ROPE = 0, WS_W = 1 * MiB, WS_XB = 96 * MiB + 4096, WS_QU = 289 * MiB, WS_K = 481 * MiB, WS_V = 505 * MiB, WS_VST = 529 * MiB,
                 WS_GA = 625 * MiB, WS_GB = 817 * MiB, WS_H2 = 625 * MiB, WS_SS = 1009 * MiB, WS_SSG = 1015 * MiB, WS_END = 1018 * MiB;
constexpr int LDS_BYTES = 147456, SG_SCR_OFF = 135168, BARST_OFF = 140288;
constexpr size_t WS_BAR = 65536, BAR_BYTES = 16384;


#define XB_TMO      128
#define XB_XCNT(j)  (256  + 64 * (j))
#define XB_XSUB(j)  (1280 + 64 * (j))
#define XB_XGEN(j)  (2304 + 64 * (j))
#define XB_TOP      3328
#define XB_TOPGEN   3392
#define XCD_BAR_WORDS 3456
#define XB_SPIN_CAP (1u << 22)
__device__ __forceinline__ unsigned xb_ld(unsigned* p)              { return __hip_atomic_load(p, __ATOMIC_RELAXED, __HIP_MEMORY_SCOPE_AGENT); }
__device__ __forceinline__ unsigned xb_add(unsigned* p, unsigned v) { return __hip_atomic_fetch_add(p, v, __ATOMIC_RELAXED, __HIP_MEMORY_SCOPE_AGENT); }
__device__ __forceinline__ unsigned xb_xcc_id() { return (unsigned)__builtin_amdgcn_s_getreg((3 << 11) | 20) & 0xFu; }
#define XB_SPIN(cond, bar) do { unsigned _sp = 0; while (cond) { __builtin_amdgcn_s_sleep(1); \
    if ((++_sp & 255u) == 0u) { if (xb_ld(&(bar)[XB_TMO])) break; if (_sp > XB_SPIN_CAP) { atomicAdd(&(bar)[XB_TMO], 1u); break; } } } } while (0)
struct XcdBarrier { unsigned* bar; unsigned x; volatile LAS unsigned* st; };
__device__ __forceinline__ XcdBarrier xcd_barrier_post(unsigned* bar, volatile LAS unsigned* st) {
    XcdBarrier b; b.bar = bar; b.x = xb_xcc_id(); b.st = st;
    if (threadIdx.x == 0) (void)xb_add(&bar[XB_XCNT(b.x)], 1u);
    return b;
}
__device__ __forceinline__ void xcd_barrier_complete(unsigned* bar, unsigned x, unsigned& nloc, unsigned& nx) {
    const unsigned G = gridDim.x * gridDim.y * gridDim.z;
    unsigned sum, cnt, mine, sp = 0u;
    for (;;) {
        sum = 0u; cnt = 0u; mine = 0u;
#pragma unroll
        for (unsigned j = 0; j < 16; ++j) { const unsigned c = xb_ld(&bar[XB_XCNT(j)]); sum += c; cnt += (c > 0u) ? 1u : 0u; mine = (j == x) ? c : mine; }
        if (sum == G) break;
        __builtin_amdgcn_s_sleep(1);
        if ((++sp & 255u) == 0u) { if (xb_ld(&bar[XB_TMO])) break; if (sp > XB_SPIN_CAP) { atomicAdd(&bar[XB_TMO], 1u); break; } }
    }
    nloc = mine > 0u ? mine : 1u; nx = cnt > 0u ? cnt : 1u;
}
__device__ __forceinline__ void xcd_barrier(const XcdBarrier& b) {
    asm volatile("s_waitcnt vmcnt(0)" ::: "memory");
    __syncthreads();
    if (threadIdx.x == 0) {
        unsigned* bar = b.bar;
        __builtin_amdgcn_s_waitcnt(0);
        unsigned nloc = b.st[0], nx = b.st[1];
        if (nloc == 0u) { xcd_barrier_complete(bar, b.x, nloc, nx); b.st[0] = nloc; b.st[1] = nx; }
        const unsigned old = xb_add(&bar[XB_XSUB(b.x)], 1u);
        const unsigned gen = old / nloc;
        if (old + 1u == (gen + 1u) * nloc) {
            __builtin_amdgcn_fence(__ATOMIC_RELEASE, "agent");
            asm volatile("s_waitcnt vmcnt(0)" ::: "memory");
            const unsigned og = xb_add(&bar[XB_TOP], 1u);
            const unsigned tg = og / nx;
            if (og + 1u == (tg + 1u) * nx) xb_add(&bar[XB_TOPGEN], 1u);
            else XB_SPIN(xb_ld(&bar[XB_TOPGEN]) == tg, bar);
            __builtin_amdgcn_fence(__ATOMIC_ACQUIRE, "agent");
            xb_add(&bar[XB_XGEN(b.x)], 1u);
            asm volatile("s_waitcnt vmcnt(0)" ::: "memory");
        } else {
            XB_SPIN(xb_ld(&bar[XB_XGEN(b.x)]) == gen, bar);
            __builtin_amdgcn_fence(__ATOMIC_ACQUIRE, "agent");
            asm volatile("s_waitcnt vmcnt(0)" ::: "memory");
        }
    }
    __syncthreads();
}

struct Args { const float* in[18]; float* out; unsigned char* ws; int ph_lo, ph_hi; };

__device__ __forceinline__ float wave_sum(float v) {
#pragma unroll
    for (int o = 1; o < 64; o <<= 1) v += __shfl_xor(v, o);
    return v;
}
__device__ __forceinline__ int invperm32(int cc) { return 16 * ((cc >> 2) & 1) + 4 * (cc >> 3) + (cc & 3); }
__device__ __forceinline__ int map_plain(int n) { return (n & ~31) + invperm32(n & 31); }
__device__ __forceinline__ int map_in(int n) {
    if (n < 512) { const int pn = n >> 8, hh = (n >> 6) & 3, d = n & 63; return 256 * pn + 128 * (d >> 5) + 32 * hh + (d & 31); }
    if (n < 768) { const int c = n - 512, isv = c >> 7, head = (c >> 6) & 1, d = c & 63, wc = 2 * isv + head; return 512 + 128 * (d >> 5) + 32 * wc + (d & 31); }
    if (n >= 1792) { const int bj = (n >= 2816) ? 1 : 0, c = n - 1792 - 1024 * bj, r = c & 127;
        return 1792 + 256 * (c >> 7) + 128 * bj + (r & ~31) + invperm32(r & 31); }
    return map_plain(n);
}
__device__ __forceinline__ int map_up(int n) { const int bj = n >> 11, c = n & 2047, pn = c >> 7, r = c & 127; return 256 * pn + 128 * bj + (r & ~31) + invperm32(r & 31); }

template <int MAP>
__device__ __forceinline__ void transpose_item(const float* W, const float* g, int K, int N, bf16_t* WT, LAS float* scr, int item, int lane) {
    const int nblk = N / 32, kb = item / nblk, nb = item % nblk, k0 = 64 * kb, n0 = 32 * nb;
#pragma unroll 32
    for (int i = 0; i < 32; ++i) { const int kk = 2 * i + (lane >> 5); float v = W[(size_t)(k0 + kk) * N + n0 + (lane & 31)]; if (g) v *= g[k0 + kk]; scr[kk * 33 + (lane & 31)] = v; }
    asm volatile("s_waitcnt lgkmcnt(0)" ::: "memory");
    const int c = lane & 7;
#pragma unroll
    for (int j = 0; j < 4; ++j) { const int n = (lane >> 3) + 8 * j; const LAS float* s = scr + (8 * c) * 33 + n;
        u32x4 o; o.x = cvt_pk_bf16(s[0 * 33], s[1 * 33]); o.y = cvt_pk_bf16(s[2 * 33], s[3 * 33]); o.z = cvt_pk_bf16(s[4 * 33], s[5 * 33]); o.w = cvt_pk_bf16(s[6 * 33], s[7 * 33]);
        const int nn = n0 + n; const int row = MAP == 0 ? map_plain(nn) : (MAP == 1 ? map_in(nn) : map_up(nn));
        *(u32x4*)(WT + (size_t)row * K + k0 + 8 * c) = o; }
    asm volatile("s_waitcnt lgkmcnt(0)" ::: "memory");
}

__device__ __forceinline__ void sincos_tab(float x, float& c, float& s) {
    const float n = rintf(x * 0.63661977236758134308f);
    float r = fmaf(-n, 1.5703125f, x); r = fmaf(-n, 4.83751296997070312500e-4f, r); r = fmaf(-n, 7.5497899548918821e-8f, r);
    const float r2 = r * r;
    const float sp = r + r * r2 * (-1.0f / 6 + r2 * (1.0f / 120 + r2 * (-1.0f / 5040 + r2 * (1.0f / 362880))));
    const float cp = 1.0f + r2 * (-0.5f + r2 * (1.0f / 24 + r2 * (-1.0f / 720 + r2 * (1.0f / 40320 + r2 * (-1.0f / 3628800)))));
    const int q = ((int)n) & 3;
    s = (q == 0) ? sp : (q == 1) ? cp : (q == 2) ? -sp : -cp;
    c = (q == 0) ? cp : (q == 1) ? -sp : (q == 2) ? -cp : sp;
}

__device__ __forceinline__ void sg_unit(int ch, int g, const bf16_t* VST, const float* ssg, const bf16_t* Wg, const float* sgb, const float* gsg, bf16_t* QU, LAS float* scr, int lane) {
    asm volatile("" : "+v"(lane));
    const int fr = lane & 15, fq = lane >> 4;
#pragma unroll
    for (int hh = 0; hh < 2; ++hh) { const int p = lane + 64 * hh; const float* sp = ssg + (size_t)(ch * 128 + p) * 8; const f32x4 a = *(const f32x4*)sp, b = *(const f32x4*)(sp + 4);
        const float s = ((a.x + a.y) + (a.z + a.w)) + ((b.x + b.y) + (b.z + b.w)); scr[p] = __builtin_amdgcn_rsqf(s * (1.0f / 512.0f) + EPS); }
    asm volatile("s_waitcnt lgkmcnt(0)" ::: "memory");
    f32x4 acc[8][4];
#pragma unroll
    for (int pt = 0; pt < 8; ++pt)
#pragma unroll
        for (int ct = 0; ct < 4; ++ct) acc[pt][ct] = (f32x4){0.f, 0.f, 0.f, 0.f};
    const bf16_t* vbase = VST + ((size_t)ch * 512 + g * 64) * 128;
    const bf16_t* wbase = Wg + (size_t)g * 128 * 128;
#pragma unroll 1
    for (int kk = 0; kk < 4; ++kk) {
        const int k0 = kk * 32 + 8 * fq;
        bf16x8 af[4];
#pragma unroll
        for (int ct = 0; ct < 4; ++ct) af[ct] = *(const bf16x8*)(vbase + (size_t)(ct * 16 + fr) * 128 + k0);
        float r[8];
#pragma unroll
        for (int e = 0; e < 8; ++e) r[e] = scr[k0 + e];
#pragma unroll
        for (int pt = 0; pt < 8; ++pt) {
            const u32x4 w = *(const u32x4*)(wbase + (size_t)(pt * 16 + fr) * 128 + k0);
            u32x4 ws; ws.x = cvt_pk_bf16(bf_lo(w.x) * r[0], bf_hi(w.x) * r[1]); ws.y = cvt_pk_bf16(bf_lo(w.y) * r[2], bf_hi(w.y) * r[3]);
            ws.z = cvt_pk_bf16(bf_lo(w.z) * r[4], bf_hi(w.z) * r[5]); ws.w = cvt_pk_bf16(bf_lo(w.w) * r[6], bf_hi(w.w) * r[7]);
            const bf16x8 bfz = __builtin_bit_cast(bf16x8, ws);
#pragma unroll
            for (int ct = 0; ct < 4; ++ct) acc[pt][ct] = __builtin_amdgcn_mfma_f32_16x16x32_bf16(af[ct], bfz, acc[pt][ct], 0, 0, 0);
        }
    }
    f32x4 gs[4];
#pragma unroll
    for (int ct = 0; ct < 4; ++ct) gs[ct] = *(const f32x4*)(gsg + g * 64 + ct * 16 + 4 * fq);
#pragma unroll
    for (int pt = 0; pt < 8; ++pt) {
        const int p = pt * 16 + fr; const float b = sgb[g * 128 + p];
        bf16_t* up = QU + (size_t)(ch * 128 + p) * 1024 + 512 + g * 64 + 4 * fq;
#pragma unroll
        for (int ct = 0; ct < 4; ++ct) {
            const u32x2 uu = *(const u32x2*)(up + ct * 16);
            const f32x4 sp = acc[pt][ct] * gs[ct] + b;
            u32x2 w; w.x = cvt_pk_bf16(bf_lo(uu.x) * sp.x, bf_hi(uu.x) * sp.y); w.y = cvt_pk_bf16(bf_lo(uu.y) * sp.z, bf_hi(uu.y) * sp.w);
            *(u32x2*)(up + ct * 16) = w;
        }
    }
    asm volatile("s_waitcnt lgkmcnt(0)" ::: "memory");
}

__global__ void __launch_bounds__(NWAVES * 64, 2) fwd_megakernel(Args args) {
    extern __shared__ __attribute__((aligned(16))) unsigned char lds[];
    cg::grid_group grid = cg::this_grid();
    LAS unsigned char* L = (LAS unsigned char*)lds;
    volatile LAS unsigned* barst = (volatile LAS unsigned*)(L + BARST_OFF);
    if (threadIdx.x < 2) barst[threadIdx.x] = 0u;
    __syncthreads();
    const XcdBarrier xbar = xcd_barrier_post((unsigned*)(args.ws + WS_BAR), barst);
    const int G = gridDim.x, bx = blockIdx.x;
    const int vcu = (G % 8 == 0) ? (bx % 8) * (G / 8) + bx / 8 : bx;
    const int NGW = G * NWAVES;
    unsigned char* ws = args.ws;
    const float* x_prompt = args.in[0]; const float* x_sample = args.in[1];
    const float* attn_norm_g = args.in[2]; const float* w_in = args.in[3]; const float* q_norm_g = args.in[4]; const float* k_norm_g = args.in[5];
    const float* sg_norm_g = args.in[6]; const float* sg_w = args.in[7]; const float* sg_b = args.in[8]; const float* w_branch_a = args.in[9];
    const float* w_branch_b = args.in[10]; const float* w_mix_out = args.in[11]; const float* ffn_norm_g = args.in[12]; const float* w_up = args.in[13];
    const float* conv_w = args.in[14]; const float* conv_b = args.in[15]; const float* w_down = args.in[16]; const float* final_norm_g = args.in[17];
    float* out = args.out;
    float* rope = (float*)(ws + WS_ROPE);
    bf16_t* Wall = (bf16_t*)(ws + WS_W);
    bf16_t* XB = (bf16_t*)(ws + WS_XB); bf16_t* QU = (bf16_t*)(ws + WS_QU); bf16_t* KB = (bf16_t*)(ws + WS_K); bf16_t* VB = (bf16_t*)(ws + WS_V);
    bf16_t* VST = (bf16_t*)(ws + WS_VST); bf16_t* GA = (bf16_t*)(ws + WS_GA); bf16_t* GB = (bf16_t*)(ws + WS_GB); bf16_t* H2 = (bf16_t*)(ws + WS_H2);
    float* SSQ = (float*)(ws + WS_SS); float* SSG = (float*)(ws + WS_SSG);

    for (int p = args.ph_lo; p < args.ph_hi; ++p) {
    if (p > args.ph_lo) { if (args.ph_hi > N_PHASES) GRID_SYNC(); else xcd_barrier(xbar); }
    int tid_ = threadIdx.x; asm volatile("" : "+v"(tid_));
    const int tid = tid_, lane = tid & 63, wave = __builtin_amdgcn_readfirstlane(tid >> 6);
    const int gw = vcu * NWAVES + wave;
    if (p == 0) {
        LAS float* scr = (LAS float*)(L + wave * 16384);
        constexpr int I_IN = 16 * (INW / 32), I_A = 8 * 32, I_MIX = 16 * 32, I_UP = 16 * 128, I_DOWN = 32 * 32, I_L = I_IN + 2 * I_A + I_MIX + I_UP + I_DOWN;
        for (int it = gw; it < I_L * NLAYER; it += NGW) {
            const int l = it / I_L; int r = it % I_L; bf16_t* wl = Wall + (size_t)l * WL_SIZE;
            if (r < I_IN) { transpose_item<1>(w_in + (size_t)l * 1024 * INW, attn_norm_g + l * 1024, 1024, INW, wl + WL_IN, scr, r, lane); continue; } r -= I_IN;
            if (r < I_A) { transpose_item<0>(w_branch_a + (size_t)l * 512 * 1024, nullptr, 512, 1024, wl + WL_A, scr, r, lane); continue; } r -= I_A;
            if (r < I_A) { transpose_item<0>(w_branch_b + (size_t)l * 512 * 1024, nullptr, 512, 1024, wl + WL_B, scr, r, lane); continue; } r -= I_A;
            if (r < I_MIX) { transpose_item<0>(w_mix_out + (size_t)l * 1024 * 1024, nullptr, 1024, 1024, wl + WL_MIX, scr, r, lane); continue; } r -= I_MIX;
            if (r < I_UP) { transpose_item<2>(w_up + (size_t)l * 1024 * 4096, ffn_norm_g + l * 1024, 1024, 4096, wl + WL_UP, scr, r, lane); continue; } r -= I_UP;
            transpose_item<0>(w_down + (size_t)l * 2048 * 1024, nullptr, 2048, 1024, wl + WL_DOWN, scr, r, lane);
        }
        for (int i = gw * 64 + lane; i < NLAYER * 8 * 128 * 128 / 4; i += NGW * 64) {
            const int l = i / (8 * 128 * 128 / 4), r = i % (8 * 128 * 128 / 4);
            const f32x4 v = *(const f32x4*)(sg_w + (size_t)l * 131072 + (size_t)r * 4);
            u32x2 w; w.x = cvt_pk_bf16(v.x, v.y); w.y = cvt_pk_bf16(v.z, v.w);
            *(u32x2*)(Wall + (size_t)l * WL_SIZE + WL_SG + (size_t)r * 4) = w;
        }
        for (int i = gw * 64 + lane; i < 128 * 16; i += NGW * 64) {
            const int pos = i >> 4, f = i & 15; float fr_ = 1.0f; for (int k = 0; k < f; ++k) fr_ *= 0.56234132519034907f;
            float c, s; sincos_tab((float)pos * fr_, c, s); rope[2 * i] = c; rope[2 * i + 1] = s;
        }
        for (int i = gw * 64 + lane; i < 257 * 128; i += NGW * 64) {
            const int r = i / 128, c = i % 128; const long row = (r == 0) ? -1 : (long)M_TOK + r - 1;
            *(u32x4*)(XB + row * 1024 + c * 8) = (u32x4){0u, 0u, 0u, 0u};
        }
        for (int m0 = gw; m0 < M_TOK; m0 += 4 * NGW) {
            int nr = 1; if (m0 + NGW < M_TOK) nr = 2; if (m0 + 2 * NGW < M_TOK) nr = 3; if (m0 + 3 * NGW < M_TOK) nr = 4;
            f32x4 v[4][4]; float sq[4];
#pragma unroll
            for (int r = 0; r < 4; ++r) { const int m = (r < nr) ? m0 + r * NGW : m0;
                const float* xr = (m < NPROMPT) ? x_prompt + (size_t)m * 1024 : x_sample + (size_t)(m - NPROMPT) * 1024; float s = 0.f;
#pragma unroll
                for (int j = 0; j < 4; ++j) { v[r][j] = *(const f32x4*)(xr + 4 * lane + 256 * j); s += (v[r][j].x * v[r][j].x + v[r][j].y * v[r][j].y) + (v[r][j].z * v[r][j].z + v[r][j].w * v[r][j].w); }
                sq[r] = s; }
#pragma unroll
            for (int r = 0; r < 4; ++r) if (r < nr) { const int m = m0 + r * NGW; const float s = wave_sum(sq[r]);
#pragma unroll
                for (int j = 0; j < 4; ++j) { u32x2 w; w.x = cvt_pk_bf16(v[r][j].x, v[r][j].y); w.y = cvt_pk_bf16(v[r][j].z, v[r][j].w); *(u32x2*)(XB + (size_t)m * 1024 + 4 * lane + 256 * j) = w; }
                if (lane < 16) SSQ[(size_t)m * 16 + lane] = (lane == 0) ? s : 0.f; }
        }
    }
    else if (p < N_PHASES - 1) {
        const int l = (p - 1) / 6, k = (p - 1) % 6;
        const bf16_t* wl = Wall + (size_t)l * WL_SIZE;
        if (k == 0) {
            pg8::Gemm g{XB, wl + WL_IN, 1024, 1024, 1024, 0, 0, 256, 128, 0};
            { pg8::StaticOrder S; S.init(M_TOK / 256, 3, 1, G, bx, 0); S.rev = (5 * l + 1) & 1;
              pg8::EpiQKV E{SSQ, q_norm_g + l * 64, k_norm_g + l * 64, rope, QU, KB, VB};
              pg8::gemm_phase<pg8::EpiQKV, 1>(L, g, S, E); }
            { pg8::StaticOrder S; S.init(M_TOK / 256, 2, 1, G, bx, 5); S.rev = (5 * l + 1) & 1;
              pg8::EpiVS E{SSQ, VST, SSG};
              pg8::gemm_phase<pg8::EpiVS, 1>(L, g, S, E); }
            { pg8::StaticOrder S; S.init(M_TOK / 256, 10, 1, G, bx, 3, 2, 7); S.rev = (5 * l + 1) & 1;
              pg8::EpiEW E{SSQ, QU, GA, GB};
              pg8::gemm_phase<pg8::EpiEW, 1>(L, g, S, E); }
        }
        else if (k == 1) {
            LAS float* scr = (LAS float*)(L + SG_SCR_OFF) + wave * 128;
            for (int u = gw; u < 768 * 8; u += NGW)
                sg_unit(u >> 3, u & 7, VST, SSG, wl + WL_SG, sg_b + l * 1024, sg_norm_g + l * 512, QU, scr, lane);
            for (int u = bx; u < 3072; u += G) {
                const int i = u >> 8, c = u & 255, x = c & 7, w = c >> 3;
                long rowbase; int seq, h, q0;
                if (i < 4) { const int idx = w * 4 + i; rowbase = (long)(x >> 1) * SEQ_P; seq = SEQ_P; h = (x & 1) * 4 + (idx >> 5); q0 = (idx & 31) * 256; }
                else { const int pair = 8 * x + (i - 4); rowbase = (long)NPROMPT + (long)(pair >> 1) * SEQ_S; seq = SEQ_S; h = (pair & 1) * 4 + (w >> 3); q0 = (w & 7) * 256; }
                attn_body::attn_unit<8>(rowbase, seq, h, q0, (const attn_body::bf16*)QU, (const attn_body::bf16*)KB, (const attn_body::bf16*)VB, (attn_body::bf16*)QU, (char*)lds);
            }
        }
        else if (k == 2) {
            pg8::Gemm g{QU + 512, wl + WL_B, 1024, 512, 512, -512 * 2, -(long)(WL_B - WL_A) * 2, 256, 0, 0};
            pg8::StaticOrder S; S.init(M_TOK / 256, 4, 2, G, bx); S.rev = (5 * l + 2) & 1;
            pg8::EpiMerge E{GA, GB};
            pg8::gemm_phase<pg8::EpiMerge, 2>(L, g, S, E);
        }
        else if (k == 3) {
            pg8::Gemm g{GA, wl + WL_MIX, 1024, 1024, 1024, 0, 0, 256, 0, 0};
            pg8::StaticOrder S; S.init(M_TOK / 256, 4, 1, G, bx); S.rev = (5 * l + 3) & 1;
            pg8::EpiRes E{x_prompt, x_sample, 0, out, XB, SSQ, 1, 0};
            pg8::gemm_phase<pg8::EpiRes, 1>(L, g, S, E);
        }
        else if (k == 4) {
            pg8::Gemm g{XB, wl + WL_UP, 1024, 1024, 1024, 0, 0, 252, 126, -1};
            pg8::StaticOrder S; S.init((M_TOK + 251) / 252, 16, 1, G, bx); S.rev = (5 * l + 4) & 1;
            pg8::EpiUp E{SSQ, conv_w + (size_t)l * 3 * 4096, conv_b + (size_t)l * 4096, H2};
            pg8::gemm_phase<pg8::EpiUp, 1>(L, g, S, E);
        }
        else {
            pg8::Gemm g{H2, wl + WL_DOWN, 2048, 2048, 2048, 0, 0, 256, 0, 0};
            pg8::StaticOrder S; S.init(M_TOK / 256, 4, 1, G, bx); S.rev = (5 * l + 5) & 1;
            pg8::EpiRes E{x_prompt, x_sample, 0, out, XB, SSQ, 1, 0};
            pg8::gemm_phase<pg8::EpiRes, 1>(L, g, S, E);
        }
    } else
    {
        f32x4 gv[4];
#pragma unroll
        for (int j = 0; j < 4; ++j) gv[j] = *(const f32x4*)(final_norm_g + 4 * lane + 256 * j);
        for (int m0 = gw; m0 < M_TOK; m0 += 4 * NGW) {
            int nr = 1; if (m0 + NGW < M_TOK) nr = 2; if (m0 + 2 * NGW < M_TOK) nr = 3; if (m0 + 3 * NGW < M_TOK) nr = 4;
            f32x4 v[4][4]; float sp[4];
#pragma unroll
            for (int r = 0; r < 4; ++r) { const int m = (r < nr) ? m0 + r * NGW : m0; const bf16_t* br = XB + (size_t)m * 1024;
                sp[r] = (lane < 16) ? SSQ[(size_t)m * 16 + lane] : 0.f;
#pragma unroll
                for (int j = 0; j < 4; ++j) { const u32x2 p = *(const u32x2*)(br + 4 * lane + 256 * j); v[r][j] = (f32x4){bf_lo(p.x), bf_hi(p.x), bf_lo(p.y), bf_hi(p.y)}; } }
#pragma unroll
            for (int r = 0; r < 4; ++r) if (r < nr) { float* xr = out + (size_t)(m0 + r * NGW) * 1024;
                const float rs = __builtin_amdgcn_rsqf(wave_sum(sp[r]) * (1.0f / DMOD) + EPS);
#pragma unroll
                for (int j = 0; j < 4; ++j) *(f32x4*)(xr + 4 * lane + 256 * j) = v[r][j] * gv[j] * rs; }
        }
    }
    }
}

extern "C" void kernel_launch(void* const* d_in, const int* in_sizes, int n_in, void* d_out, int out_size, void* d_ws, size_t ws_size, hipStream_t stream) {
    static int grid = 0;
    if (grid == 0) {
        if (n_in != 18 || out_size != M_TOK * DMOD || ws_size < WS_END) { fprintf(stderr, "kernel_launch: unexpected shapes (n_in %d out %d ws %zu)\n", n_in, out_size, ws_size); grid = -1; return; }
        int dev = 0, cus = 0, per_cu = 0;
        (void)hipGetDevice(&dev); (void)hipDeviceGetAttribute(&cus, hipDeviceAttributeMultiprocessorCount, dev);
        (void)hipFuncSetAttribute((const void*)fwd_megakernel, hipFuncAttributeMaxDynamicSharedMemorySize, LDS_BYTES);
        (void)hipOccupancyMaxActiveBlocksPerMultiprocessor(&per_cu, (const void*)fwd_megakernel, NWAVES * 64, LDS_BYTES);
        if (per_cu < 1) { fprintf(stderr, "kernel_launch: occupancy query says %d blocks/CU\n", per_cu); per_cu = 1; }
        (void)hipGetLastError();
        grid = cus * 1;
    }
    if (grid < 0) return;
    (void)hipMemsetAsync((char*)d_ws + WS_BAR, 0, BAR_BYTES, stream);
    Args a{};
    for (int i = 0; i < 18; ++i) a.in[i] = (const float*)d_in[i];
    a.out = (float*)d_out; a.ws = (unsigned char*)d_ws;
    if (N_LAUNCH_MODE == 0) {
        a.ph_lo = 0; a.ph_hi = N_PHASES;
        void* params[] = {&a};
        hipError_t e = hipLaunchCooperativeKernel((const void*)fwd_megakernel, dim3(grid), dim3(NWAVES * 64), params, LDS_BYTES, stream);
        if (e != hipSuccess) fprintf(stderr, "cooperative launch failed: %s (grid %d)\n", hipGetErrorString(e), grid);
    } else {
        for (int p = 0; p < N_PHASES; ++p) { a.ph_lo = p; a.ph_hi = p + 1;
            hipLaunchKernelGGL(fwd_megakernel, dim3(grid), dim3(NWAVES * 64), LDS_BYTES, stream, a); }
    }
}
```
